# Optimizing an MI355X kernel written in HIP

```python
import jax
import jax.numpy as jnp
from jax import lax
import numpy as np

D_MODEL = 1024
BATCH = 8
SEQ = 4096
DEPTH = 4

GRID_W = 64
CTX_LEN = 256
N_MIXERS = 4
ROPE_BASE = 10000.0
NORM_EPS = 1e-6
NEG_INF = -1e30
Q_BLOCK = 128

NA_HEADS = 16
NA_HEAD_DIM = D_MODEL // NA_HEADS
NA_WIN_ROWS = 8
NA_WIN_COLS = 16

RW_HEAD = 64
RW_HEADS = D_MODEL // RW_HEAD
RW_DECAY_LORA = 64
RW_ICLR_LORA = 64
RW_GATE_LORA = 128
RW_GN_EPS = 64e-5

MLA_HEADS = 16
MLA_Q_RANK = 384
MLA_KV_RANK = 256
MLA_NOPE = 64
MLA_ROPE = 32
MLA_V = 64

SWA_Q_HEADS = 16
SWA_KV_HEADS = 4
SWA_GROUP = SWA_Q_HEADS // SWA_KV_HEADS
SWA_HEAD_DIM = 64
SWA_WINDOW = 128

N_EXPERTS = 16
EC_CAPACITY = 2
D_FF_EXPERT = 1024

kernel_name = 'hybrid_dit_na_rwkv7_mla_swa_ecmoe'


def rms_norm(x, g):
    xf = x.astype(jnp.float32)
    y = xf * lax.rsqrt(jnp.mean(xf * xf, axis=-1, keepdims=True) + NORM_EPS)
    return (y * g.astype(jnp.float32)).astype(x.dtype)


def modulate(h, shift, scale):
    return h * (1 + scale) + shift


def ada_modulation(cond, w, b):
    m = jax.nn.silu(cond) @ w + b
    return jnp.split(m, 6, axis=-1)


def axial_rope(n, d_rot):
    t = jnp.arange(n)
    row = (t // GRID_W).astype(jnp.float32)
    col = (t % GRID_W).astype(jnp.float32)
    d_axis = d_rot // 2
    inv = ROPE_BASE ** (-jnp.arange(0, d_axis, 2, dtype=jnp.float32) / d_axis)
    ang = jnp.concatenate([row[:, None] * inv, col[:, None] * inv], axis=-1)
    return jnp.cos(ang), jnp.sin(ang)


def apply_rope(x, cos, sin):
    half = x.shape[-1] // 2
    xf = x.astype(jnp.float32)
    x1, x2 = xf[..., :half], xf[..., half:]
    return jnp.concatenate([x1 * cos - x2 * sin, x2 * cos + x1 * sin], axis=-1).astype(x.dtype)


def context_attention(q, k, v, scale, sink=None):
    L = k.shape[1]
    s = jnp.einsum('bqhgd,bkhd->bhgqk', q, k).astype(jnp.float32) * scale
    if sink is not None:
        snk = jnp.broadcast_to(sink.astype(jnp.float32)[None, :, :, None, None], s.shape[:-1] + (1,))
        s = jnp.concatenate([s, snk], axis=-1)
    p = jax.nn.softmax(s, axis=-1)[..., :L]
    return jnp.einsum('bhgqk,bkhd->bqhgd', p.astype(v.dtype), v)


def neighbourhood_attention(hc, hl, w_qkv, q_g, k_g, rpb, w_o, ctx_out):
    B, n, D = hl.shape
    L = hc.shape[1]
    rows = n // GRID_W
    H, dh = NA_HEADS, NA_HEAD_DIM
    scale = dh ** -0.5

    def project(h):
        qkv = (h @ w_qkv).reshape(h.shape[0], h.shape[1], 3, H, dh)
        return rms_norm(qkv[:, :, 0], q_g), rms_norm(qkv[:, :, 1], k_g), qkv[:, :, 2]

    qc, kc, vc = project(hc)
    ql, kl, vl = project(hl)

    kr = min(NA_WIN_ROWS, rows)
    n_cb = GRID_W // NA_WIN_COLS
    strip = 2 * NA_WIN_COLS
    qcol = np.arange(GRID_W).reshape(n_cb, NA_WIN_COLS)
    strip0 = np.clip(np.arange(n_cb) * NA_WIN_COLS - NA_WIN_COLS // 2, 0, GRID_W - strip)
    kcol = strip0[:, None] + np.arange(strip)
    cstart = np.clip(qcol - NA_WIN_COLS // 2, 0, GRID_W - NA_WIN_COLS)
    kc3 = kcol[:, None, :]
    col_ok = (kc3 >= cstart[:, :, None]) & (kc3 < cstart[:, :, None] + NA_WIN_COLS)
    dcol_idx = np.clip(kc3 - qcol[:, :, None] + NA_WIN_COLS - 1, 0, 2 * NA_WIN_COLS - 2)
    rpb_cols = rpb[:, :, dcol_idx]
    col_ok = jnp.asarray(col_ok)[:, :, None, :]

    qg = ql.reshape(B, rows, GRID_W, H, dh)
    kg = kl.reshape(B, rows, GRID_W, H, dh)
    vg = vl.reshape(B, rows, GRID_W, H, dh)

    def row_step(r):
        r0 = jnp.clip(r - kr // 2, 0, rows - kr)
        kw = lax.dynamic_slice_in_dim(kg, r0, kr, axis=1)[:, :, kcol]
        vw = lax.dynamic_slice_in_dim(vg, r0, kr, axis=1)[:, :, kcol]
        q = lax.dynamic_index_in_dim(qg, r, axis=1, keepdims=False)[:, qcol]
        dr_idx = r0 + jnp.arange(kr) - r + (NA_WIN_ROWS - 1)
        bias = jnp.transpose(rpb_cols[:, dr_idx], (0, 2, 3, 1, 4)).astype(jnp.float32)
        s_lat = jnp.einsum('bjqhd,brjkhd->bhjqrk', q, kw).astype(jnp.float32) * scale + bias[None]
        s_lat = jnp.where(col_ok, s_lat, NEG_INF).reshape(B, H, n_cb, NA_WIN_COLS, kr * strip)
        s_ctx = jnp.einsum('bjqhd,bkhd->bhjqk', q, kc).astype(jnp.float32) * scale
        p = jax.nn.softmax(jnp.concatenate([s_lat, s_ctx], axis=-1), axis=-1).astype(vl.dtype)
        p_lat = p[..., :kr * strip].reshape(B, H, n_cb, NA_WIN_COLS, kr, strip)
        o = (jnp.einsum('bhjqrk,brjkhd->bjqhd', p_lat, vw)
             + jnp.einsum('bhjqk,bkhd->bjqhd', p[..., kr * strip:], vc))
        return o.reshape(B, GRID_W, H, dh)

    o = lax.map(row_step, jnp.arange(rows))
    ol = jnp.moveaxis(o, 0, 1).reshape(B, n, H * dh) @ w_o
    oc = None
    if ctx_out:
        oc = context_attention(qc[:, :, :, None], kc, vc, scale).reshape(B, L, H * dh) @ w_o
    return oc, ol


def centred_shift(h):
    hp = jnp.pad(h, ((0, 0), (1, 1), (0, 0)))
    return 0.5 * (hp[:, :-2] + hp[:, 2:])


def _rwkv_step(S, inp):
    r, w, kk, kka, kt, v = inp
    sk = jnp.einsum('bhij,bhj->bhi', S, kk)
    S = S * w[:, :, None, :] - sk[..., None] * kka[:, :, None, :] + v[..., None] * kt[:, :, None, :]
    return S, jnp.einsum('bhij,bhj->bhi', S, r)


def _rwkv_scan(S0, seqs, reverse):
    xs = tuple(jnp.swapaxes(t, 0, 1) for t in seqs)
    S, y = lax.scan(_rwkv_step, S0, xs, reverse=reverse)
    return S, jnp.swapaxes(y, 0, 1)


def rwkv7_bidirectional(hc, hl, mix, w_r, w_k, w_v, w0, w1, w2, a0, a1, a2, g1, g2,
                        k_k, k_a, r_k, ln_g, ln_b, w_o, ctx_out):
    f32 = jnp.float32
    H, N = RW_HEADS, RW_HEAD

    def heads(t):
        return t.reshape(t.shape[:-1] + (H, N))

    def stream(h, S0):
        B = h.shape[0]
        xx = centred_shift(h) - h
        xr, xw, xk, xv, xa, xg = (h + xx * mix[s] for s in range(6))
        r = heads((xr @ w_r).astype(f32))
        k = (xk @ w_k).astype(f32)
        v = heads((xv @ w_v).astype(f32))
        g = jax.nn.sigmoid(xg @ g1) @ g2
        dec = w0[:, None, None, :] + jnp.einsum('zbtr,zrd->zbtd', jnp.tanh(jnp.einsum('btd,zdr->zbtr', xw, w1)), w2)
        logw = -jax.nn.softplus(-dec.astype(f32)) - 0.5
        w = heads(jnp.exp(-jnp.exp(logw)))
        a = heads(jax.nn.sigmoid((a0[:, None, None, :] + jnp.einsum(
            'zbtr,zrd->zbtd', jnp.einsum('btd,zdr->zbtr', xa, a1), a2)).astype(f32)))
        kk = heads(k * k_k.astype(f32))
        kk = kk / jnp.maximum(jnp.linalg.norm(kk, axis=-1, keepdims=True), 1e-12)
        kt = heads(k)[None] * (1 + (a - 1) * heads(k_a.astype(f32)))
        if S0 is None:
            z = jnp.zeros((B, H, N, N), f32)
            S0 = (z, z)
        S_f, y_f = _rwkv_scan(S0[0], (r, w[0], kk, kk * a[0], kt[0], v), False)
        S_b, y_b = _rwkv_scan(S0[1], (r, w[1], kk, kk * a[1], kt[1], v), True)
        return (S_f, S_b), (y_f + y_b, r, kt, v, g)

    def readout(y, r, kt, v, g, dtype):
        B, T = y.shape[:2]
        mu = jnp.mean(y, axis=-1, keepdims=True)
        var = jnp.mean(jnp.square(y - mu), axis=-1, keepdims=True)
        yn = ((y - mu) * lax.rsqrt(var + RW_GN_EPS)).reshape(B, T, -1) * ln_g.astype(f32) + ln_b.astype(f32)
        bonus = jnp.sum(jnp.sum(r[None] * kt * r_k.astype(f32), axis=-1, keepdims=True), axis=0) * v
        return ((yn + bonus.reshape(B, T, -1)).astype(dtype) * g) @ w_o

    ctx_state, ctx_feats = stream(hc, None)
    _, lat_feats = stream(hl, ctx_state)
    ol = readout(*lat_feats, hl.dtype)
    oc = readout(*ctx_feats, hc.dtype) if ctx_out else None
    return oc, ol


def multi_head_latent_attention(hc, hl, w_down, q_norm_g, kv_norm_g, w_uq, w_ukv,
                                qn_g, qr_g, kn_g, kr_g, w_o, cos, sin, ctx_out):
    f32 = jnp.float32
    H = MLA_HEADS
    scale = (MLA_NOPE + MLA_ROPE) ** -0.5

    def project(h, rope):
        B, T, _ = h.shape
        d = h @ w_down
        cq = rms_norm(d[..., :MLA_Q_RANK], q_norm_g)
        ckv = rms_norm(d[..., MLA_Q_RANK:MLA_Q_RANK + MLA_KV_RANK], kv_norm_g)
        k_r = rms_norm(d[..., MLA_Q_RANK + MLA_KV_RANK:], kr_g)
        q = (cq @ w_uq).reshape(B, T, H, MLA_NOPE + MLA_ROPE)
        kv = (ckv @ w_ukv).reshape(B, T, H, MLA_NOPE + MLA_V)
        q_n = rms_norm(q[..., :MLA_NOPE], qn_g)
        q_r = rms_norm(q[..., MLA_NOPE:], qr_g)
        k_n = rms_norm(kv[..., :MLA_NOPE], kn_g)
        v = kv[..., MLA_NOPE:]
        if rope:
            q_r = apply_rope(q_r, cos[:, None], sin[:, None])
            k_r = apply_rope(k_r, cos, sin)
        return q_n, q_r, k_n, k_r, v

    qn_l, qr_l, kn_l, kr_l, v_l = project(hl, True)
    qn_c, qr_c, kn_c, kr_c, v_c = project(hc, False)
    B, n = hl.shape[:2]
    L = hc.shape[1]

    def block(b):
        s0 = b * Q_BLOCK
        qn = lax.dynamic_slice_in_dim(qn_l, s0, Q_BLOCK, axis=1)
        qr = lax.dynamic_slice_in_dim(qr_l, s0, Q_BLOCK, axis=1)
        s_lat = jnp.einsum('bqhd,bkhd->bhqk', qn, kn_l) + jnp.einsum('bqhd,bkd->bhqk', qr, kr_l)
        s_ctx = jnp.einsum('bqhd,bkhd->bhqk', qn, kn_c) + jnp.einsum('bqhd,bkd->bhqk', qr, kr_c)
        s = jnp.concatenate([s_lat, s_ctx], axis=-1).astype(f32) * scale
        p = jax.nn.softmax(s, axis=-1).astype(v_l.dtype)
        return (jnp.einsum('bhqk,bkhd->bqhd', p[..., :n], v_l)
                + jnp.einsum('bhqk,bkhd->bqhd', p[..., n:], v_c))

    o = lax.map(block, jnp.arange(n // Q_BLOCK))
    ol = jnp.moveaxis(o, 0, 1).reshape(B, n, H * MLA_V) @ w_o
    oc = None
    if ctx_out:
        q = jnp.concatenate([qn_c, qr_c], axis=-1)
        k = jnp.concatenate([kn_c, jnp.broadcast_to(kr_c[:, :, None, :], (B, L, H, MLA_ROPE))], axis=-1)
        oc = context_attention(q[:, :, :, None], k, v_c, scale).reshape(B, L, H * MLA_V) @ w_o
    return oc, ol


def window_gqa_sink(hc, hl, w_qkv, q_g, k_g, sink, w_o, cos, sin, ctx_out):
    f32 = jnp.float32
    Hk, G, dh = SWA_KV_HEADS, SWA_GROUP, SWA_HEAD_DIM
    scale = dh ** -0.5
    sink_hg = sink.reshape(Hk, G)
    nq = Hk * G * dh

    def project(h, rope):
        B, T, _ = h.shape
        qkv = h @ w_qkv
        q = rms_norm(qkv[..., :nq].reshape(B, T, Hk, G, dh), q_g)
        k = rms_norm(qkv[..., nq:nq + Hk * dh].reshape(B, T, Hk, dh), k_g)
        v = qkv[..., nq + Hk * dh:].reshape(B, T, Hk, dh)
        if rope:
            q = apply_rope(q, cos[:, None, None], sin[:, None, None])
            k = apply_rope(k, cos[:, None], sin[:, None])
        return q, k, v

    ql, kl, vl = project(hl, True)
    qc, kc, vc = project(hc, False)
    B, n = hl.shape[:2]
    L = hc.shape[1]
    pad = ((0, 0), (Q_BLOCK, Q_BLOCK), (0, 0), (0, 0))
    kp, vp = jnp.pad(kl, pad), jnp.pad(vl, pad)
    q_off = jnp.arange(Q_BLOCK)
    k_off = jnp.arange(3 * Q_BLOCK) - Q_BLOCK

    def block(b):
        s0 = b * Q_BLOCK
        q = lax.dynamic_slice_in_dim(ql, s0, Q_BLOCK, axis=1)
        k = lax.dynamic_slice_in_dim(kp, s0, 3 * Q_BLOCK, axis=1)
        v = lax.dynamic_slice_in_dim(vp, s0, 3 * Q_BLOCK, axis=1)
        qpos, kpos = s0 + q_off, s0 + k_off
        ok = ((kpos >= 0) & (kpos < n))[None, :] & (jnp.abs(qpos[:, None] - kpos[None, :]) <= SWA_WINDOW)
        s_loc = jnp.where(ok, jnp.einsum('bqhgd,bkhd->bhgqk', q, k).astype(f32) * scale, NEG_INF)
        s_ctx = jnp.einsum('bqhgd,bkhd->bhgqk', q, kc).astype(f32) * scale
        s_snk = jnp.broadcast_to(sink_hg.astype(f32)[None, :, :, None, None], s_loc.shape[:-1] + (1,))
        p = jax.nn.softmax(jnp.concatenate([s_loc, s_ctx, s_snk], axis=-1), axis=-1).astype(vl.dtype)
        return (jnp.einsum('bhgqk,bkhd->bqhgd', p[..., :3 * Q_BLOCK], v)
                + jnp.einsum('bhgqk,bkhd->bqhgd', p[..., 3 * Q_BLOCK:-1], vc))

    o = lax.map(block, jnp.arange(n // Q_BLOCK))
    ol = jnp.moveaxis(o, 0, 1).reshape(B, n, nq) @ w_o
    oc = None
    if ctx_out:
        oc = context_attention(qc, kc, vc, scale, sink_hg).reshape(B, L, nq) @ w_o
    return oc, ol


def expert_choice_ffn(h, w_router, w1, w3, w2):
    B, T, D = h.shape
    cap = max(1, EC_CAPACITY * T // N_EXPERTS)
    aff = jax.nn.softmax((h @ w_router).astype(jnp.float32), axis=-1)
    gate, idx = lax.top_k(jnp.swapaxes(aff, 1, 2), cap)
    xin = jax.vmap(lambda hb, ib: hb[ib])(h, idx)
    hid = jax.nn.silu(jnp.einsum('becd,edf->becf', xin, w1)) * jnp.einsum('becd,edf->becf', xin, w3)
    y = jnp.einsum('becf,efd->becd', hid, w2) * gate[..., None].astype(h.dtype)
    return jax.vmap(lambda yb, ib: jax.ops.segment_sum(
        yb.reshape(-1, D), ib.reshape(-1), num_segments=T))(y, idx)


def _layers_of(mixer):
    return len(range(mixer, DEPTH, N_MIXERS))


def setup_inputs(seed: int = 0) -> dict:
    key = jax.random.key(seed)
    keys = iter(jax.random.split(key, 96))
    f32 = jnp.float32
    D = D_MODEL

    def normal(shape, scale):
        return jax.random.normal(next(keys), shape, f32) * scale

    def gain(shape):
        return 1.0 + 0.1 * jax.random.normal(next(keys), shape, f32)

    def uniform(shape, lo, hi):
        return jax.random.uniform(next(keys), shape, f32, lo, hi)

    nA, nB, nC, nD = (_layers_of(m) for m in range(N_MIXERS))
    swa_cols = (SWA_Q_HEADS + 2 * SWA_KV_HEADS) * SWA_HEAD_DIM
    return {
        'x': normal((BATCH, SEQ, D), 1.0),
        'c': normal((BATCH, D), 1.0),
        'ctx': normal((BATCH, CTX_LEN, D), 1.0),
        'c_ctx': normal((D,), 1.0),
        'norm1_g': gain((DEPTH, D)),
        'norm2_g': gain((DEPTH, D)),
        'ada_w': normal((DEPTH, D, 6 * D), 0.5 * D ** -0.5),
        'ada_b': normal((DEPTH, 6 * D), 0.02),
        'na_w_qkv': normal((nA, D, 3 * D), D ** -0.5),
        'na_q_g': gain((nA, NA_HEAD_DIM)),
        'na_k_g': gain((nA, NA_HEAD_DIM)),
        'na_rpb': normal((nA, NA_HEADS, 2 * NA_WIN_ROWS - 1, 2 * NA_WIN_COLS - 1), 0.5),
        'na_w_o': normal((nA, D, D), D ** -0.5),
        'rw_mix': uniform((nB, 6, D), 0.0, 1.0),
        'rw_w_r': normal((nB, D, D), D ** -0.5),
        'rw_w_k': normal((nB, D, D), D ** -0.5),
        'rw_w_v': normal((nB, D, D), D ** -0.5),
        'rw_w0': uniform((nB, 2, D), -6.0, -1.0),
        'rw_w1': normal((nB, 2, D, RW_DECAY_LORA), D ** -0.5),
        'rw_w2': normal((nB, 2, RW_DECAY_LORA, D), 0.5 * RW_DECAY_LORA ** -0.5),
        'rw_a0': normal((nB, 2, D), 0.5),
        'rw_a1': normal((nB, 2, D, RW_ICLR_LORA), D ** -0.5),
        'rw_a2': normal((nB, 2, RW_ICLR_LORA, D), 0.5 * RW_ICLR_LORA ** -0.5),
        'rw_g1': normal((nB, D, RW_GATE_LORA), D ** -0.5),
        'rw_g2': normal((nB, RW_GATE_LORA, D), RW_GATE_LORA ** -0.5),
        'rw_k_k': uniform((nB, D), 0.7, 1.0),
        'rw_k_a': uniform((nB, D), 0.8, 1.2),
        'rw_r_k': normal((nB, RW_HEADS, RW_HEAD), 0.1),
        'rw_ln_g': gain((nB, D)),
        'rw_ln_b': normal((nB, D), 0.02),
        'rw_w_o': normal((nB, D, D), D ** -0.5),
        'mla_w_down': normal((nC, D, MLA_Q_RANK + MLA_KV_RANK + MLA_ROPE), D ** -0.5),
        'mla_q_norm_g': gain((nC, MLA_Q_RANK)),
        'mla_kv_norm_g': gain((nC, MLA_KV_RANK)),
        'mla_w_uq': normal((nC, MLA_Q_RANK, MLA_HEADS * (MLA_NOPE + MLA_ROPE)), MLA_Q_RANK ** -0.5),
        'mla_w_ukv': normal((nC, MLA_KV_RANK, MLA_HEADS * (MLA_NOPE + MLA_V)), MLA_KV_RANK ** -0.5),
        'mla_qn_g': gain((nC, MLA_NOPE)),
        'mla_qr_g': gain((nC, MLA_ROPE)),
        'mla_kn_g': gain((nC, MLA_NOPE)),
        'mla_kr_g': gain((nC, MLA_ROPE)),
        'mla_w_o': normal((nC, MLA_HEADS * MLA_V, D), (MLA_HEADS * MLA_V) ** -0.5),
        'swa_w_qkv': normal((nD, D, swa_cols), D ** -0.5),
        'swa_q_g': gain((nD, SWA_HEAD_DIM)),
        'swa_k_g': gain((nD, SWA_HEAD_DIM)),
        'swa_sink': normal((nD, SWA_Q_HEADS), 0.5),
        'swa_w_o': normal((nD, SWA_Q_HEADS * SWA_HEAD_DIM, D), (SWA_Q_HEADS * SWA_HEAD_DIM) ** -0.5),
        'moe_router': normal((DEPTH, D, N_EXPERTS), D ** -0.5),
        'moe_w1': normal((DEPTH, N_EXPERTS, D, D_FF_EXPERT), D ** -0.5),
        'moe_w3': normal((DEPTH, N_EXPERTS, D, D_FF_EXPERT), D ** -0.5),
        'moe_w2': normal((DEPTH, N_EXPERTS, D_FF_EXPERT, D), D_FF_EXPERT ** -0.5),
    }


def reference(x, c, ctx, c_ctx, norm1_g, norm2_g, ada_w, ada_b,
              na_w_qkv, na_q_g, na_k_g, na_rpb, na_w_o,
              rw_mix, rw_w_r, rw_w_k, rw_w_v, rw_w0, rw_w1, rw_w2, rw_a0, rw_a1, rw_a2,
              rw_g1, rw_g2, rw_k_k, rw_k_a, rw_r_k, rw_ln_g, rw_ln_b, rw_w_o,
              mla_w_down, mla_q_norm_g, mla_kv_norm_g, mla_w_uq, mla_w_ukv,
              mla_qn_g, mla_qr_g, mla_kn_g, mla_kr_g, mla_w_o,
              swa_w_qkv, swa_q_g, swa_k_g, swa_sink, swa_w_o,
              moe_router, moe_w1, moe_w3, moe_w2):
    n = x.shape[1]
    cos_mla, sin_mla = axial_rope(n, MLA_ROPE)
    cos_swa, sin_swa = axial_rope(n, SWA_HEAD_DIM)
    xl, xc = x, ctx
    for i in range(DEPTH):
        mixer, j = i % N_MIXERS, i // N_MIXERS
        ctx_needed = i < DEPTH - 1
        sh1, sc1, gt1, sh2, sc2, gt2 = (t[:, None, :] for t in ada_modulation(c, ada_w[i], ada_b[i]))
        csh1, csc1, cgt1, csh2, csc2, cgt2 = ada_modulation(c_ctx, ada_w[i], ada_b[i])
        hl = modulate(rms_norm(xl, norm1_g[i]), sh1, sc1)
        hc = modulate(rms_norm(xc, norm1_g[i]), csh1, csc1)
        if mixer == 0:
            oc, ol = neighbourhood_attention(hc, hl, na_w_qkv[j], na_q_g[j], na_k_g[j], na_rpb[j],
                                             na_w_o[j], ctx_needed)
        elif mixer == 1:
            oc, ol = rwkv7_bidirectional(hc, hl, rw_mix[j], rw_w_r[j], rw_w_k[j], rw_w_v[j],
                                         rw_w0[j], rw_w1[j], rw_w2[j], rw_a0[j], rw_a1[j], rw_a2[j],
                                         rw_g1[j], rw_g2[j], rw_k_k[j], rw_k_a[j], rw_r_k[j],
                                         rw_ln_g[j], rw_ln_b[j], rw_w_o[j], ctx_needed)
        elif mixer == 2:
            oc, ol = multi_head_latent_attention(hc, hl, mla_w_down[j], mla_q_norm_g[j], mla_kv_norm_g[j],
                                                 mla_w_uq[j], mla_w_ukv[j], mla_qn_g[j], mla_qr_g[j],
                                                 mla_kn_g[j], mla_kr_g[j], mla_w_o[j],
                                                 cos_mla, sin_mla, ctx_needed)
        else:
            oc, ol = window_gqa_sink(hc, hl, swa_w_qkv[j], swa_q_g[j], swa_k_g[j], swa_sink[j],
                                     swa_w_o[j], cos_swa, sin_swa, ctx_needed)
        xl = xl + gt1 * ol
        hl = modulate(rms_norm(xl, norm2_g[i]), sh2, sc2)
        xl = xl + gt2 * expert_choice_ffn(hl, moe_router[i], moe_w1[i], moe_w3[i], moe_w2[i])
        if ctx_needed:
            xc = xc + cgt1 * oc
            hc = modulate(rms_norm(xc, norm2_g[i]), csh2, csc2)
            xc = xc + cgt2 * expert_choice_ffn(hc, moe_router[i], moe_w1[i], moe_w3[i], moe_w2[i])
    return xl
```

```cpp
#include <hip/hip_runtime.h>
#include <stdint.h>

#ifndef MULTI_LAUNCH
#define MULTI_LAUNCH 1
#endif

typedef unsigned short bf16_t;
typedef short bf16x8 __attribute__((ext_vector_type(8)));
typedef short s16x4 __attribute__((ext_vector_type(4)));
typedef float f32x4 __attribute__((ext_vector_type(4)));
typedef unsigned u32x4 __attribute__((ext_vector_type(4)));
typedef unsigned u32x2 __attribute__((ext_vector_type(2)));
#define LAS __attribute__((address_space(3)))
#define DI __device__ __forceinline__

constexpr int NTHR = 512;
constexpr int D = 1024, NB = 8, SEQ = 4096, CTXL = 256;
constexpr int TL = NB * SEQ, TC = NB * CTXL, TT = TL + TC;
constexpr int NEXP = 16, CAPL = 512, CAPC = 32, EROWS = NB * CAPL + NB * CAPC;
constexpr float LOG2E = 1.4426950408889634f;

enum { I_X = 0, I_C, I_CTX, I_CCTX, I_N1G, I_N2G, I_ADAW, I_ADAB,
       I_NA_WQKV, I_NA_QG, I_NA_KG, I_NA_RPB, I_NA_WO,
       I_RW_MIX, I_RW_WR, I_RW_WK, I_RW_WV, I_RW_W0, I_RW_W1, I_RW_W2, I_RW_A0, I_RW_A1, I_RW_A2, I_RW_G1, I_RW_G2,
       I_RW_KK, I_RW_KA, I_RW_RK, I_RW_LNG, I_RW_LNB, I_RW_WO,
       I_MLA_WDOWN, I_MLA_QNG, I_MLA_KVNG, I_MLA_WUQ, I_MLA_WUKV, I_MLA_QN_G, I_MLA_QR_G, I_MLA_KN_G, I_MLA_KR_G, I_MLA_WO,
       I_SWA_WQKV, I_SWA_QG, I_SWA_KG, I_SWA_SINK, I_SWA_WO,
       I_MOE_ROUTER, I_MOE_W1, I_MOE_W3, I_MOE_W2, N_INPUTS };

constexpr size_t MiB = 1u << 20;
constexpr size_t OFF_CTL = 0;
constexpr size_t OFF_MOD = 65536;
constexpr size_t OFF_ROPE_M = OFF_MOD + 4 * 9 * 6144 * 4;
constexpr size_t OFF_ROPE_S = OFF_ROPE_M + 2 * 4096 * 16 * 4;
constexpr size_t OFF_X = 4 * MiB;
constexpr size_t OFF_WMIX = 140 * MiB;
constexpr size_t OFF_WE = 180 * MiB;
constexpr size_t OFF_MISC = 276 * MiB;
constexpr size_t OFF_WORK = 284 * MiB;
constexpr size_t USLOT = (size_t)TT * 1024 * 2;
constexpr size_t WS_NEED = OFF_WORK + 10 * USLOT;
static_assert(OFF_ROPE_S + 2 * 4096 * 32 * 4 <= OFF_X, "map");
static_assert(OFF_X + (size_t)TT * 1024 * 4 <= OFF_WMIX, "map");

constexpr size_t W_NA_QKV = 0, W_NA_WO = 3145728, W_RW_B1 = 4194304, W_RW_B2 = 11534336, W_RW_WO = 13500416,
                 W_MLA_DOWN = 14548992, W_MLA_UQ = 15335424, W_MLA_UKV = 15925248, W_MLA_WO = 16449536,
                 W_SWA_QKV = 17498112, W_SWA_WO = 19070976, W_MIX_END = 20119552;
static_assert(OFF_WMIX + W_MIX_END * 2 <= OFF_WE, "map");
static_assert(OFF_WE + 96 * MiB <= OFF_MISC, "map");
constexpr size_t OFF_AFF = OFF_MISC;
constexpr size_t OFF_AFFC = OFF_AFF + 8 * 16 * 4096 * 4;
constexpr size_t OFF_IDX = OFF_AFFC + 8 * 16 * 256 * 4;
constexpr size_t OFF_GATE = OFF_IDX + 16 * EROWS * 4;
constexpr size_t OFF_INV = OFF_GATE + 16 * EROWS * 4;
static_assert(OFF_INV + (size_t)TT * 16 * 4 <= OFF_WORK, "map");

struct Params {
    const float* in[N_INPUTS];
    float* out;
    unsigned char* ws;
};

DI unsigned f2bf(float f) { unsigned u = __float_as_uint(f); return (u + 0x7fffu + ((u >> 16) & 1u)) >> 16; }
DI unsigned pk2(float lo, float hi) { return f2bf(lo) | (f2bf(hi) << 16); }
DI float bf2f(unsigned b) { return __uint_as_float(b << 16); }
DI float bflo(unsigned w) { return __uint_as_float(w << 16); }
DI float bfhi(unsigned w) { return __uint_as_float(w & 0xffff0000u); }
DI float wave_sum(float v) {
    v += __shfl_xor(v, 32); v += __shfl_xor(v, 16); v += __shfl_xor(v, 8); v += __shfl_xor(v, 4); v += __shfl_xor(v, 2); v += __shfl_xor(v, 1); return v; }
DI float fsigmoid(float x) { return 1.0f / (1.0f + __expf(-x)); }
DI float fexp2(float x) { return __builtin_amdgcn_exp2f(x); }
DI int modrow_of(int g) { return g < TL ? (g >> 12) : 8; }
DI void unpack8(u32x4 v, float* f) { f[0] = bflo(v.x); f[1] = bfhi(v.x); f[2] = bflo(v.y); f[3] = bfhi(v.y); f[4] = bflo(v.z); f[5] = bfhi(v.z); f[6] = bflo(v.w); f[7] = bfhi(v.w); }
DI u32x4 pack8(const float* f) { u32x4 v; v.x = pk2(f[0], f[1]); v.y = pk2(f[2], f[3]); v.z = pk2(f[4], f[5]); v.w = pk2(f[6], f[7]); return v; }

struct GemmOp { const bf16_t* A; long lda; const bf16_t* Bt; long ldb; int kbeg, kend; };
constexpr int GT_LDS = 4 * 128 * 72 * 2;

template <class Epi>
DI void gemm_tile(const GemmOp& g, int row0, int col0, const Epi& epi, char* smem) {
    const int tid = threadIdx.x, lane = tid & 63, w = tid >> 6, wm = w >> 2, wn = w & 3, l15 = lane & 15, quad = lane >> 4;
    bf16_t* As = (bf16_t*)smem;
    bf16_t* Bs = As + 2 * 128 * 72;
    const int lr = tid >> 3, lc = (tid & 7) * 8;
    const bf16_t* ga0 = g.A + (long)(row0 + lr) * g.lda + g.kbeg + lc;
    const bf16_t* ga1 = ga0 + 64 * g.lda;
    const bf16_t* gb0 = g.Bt + (long)(col0 + lr) * g.ldb + g.kbeg + lc;
    const bf16_t* gb1 = gb0 + 64 * g.ldb;
    f32x4 acc[4][2];
#pragma unroll
    for (int i = 0; i < 4; ++i) { acc[i][0] = (f32x4){0.f, 0.f, 0.f, 0.f}; acc[i][1] = (f32x4){0.f, 0.f, 0.f, 0.f}; }
    u32x4 ra0 = *(const u32x4*)ga0, ra1 = *(const u32x4*)ga1, rb0 = *(const u32x4*)gb0, rb1 = *(const u32x4*)gb1;
    *(u32x4*)(As + lr * 72 + lc) = ra0; *(u32x4*)(As + (lr + 64) * 72 + lc) = ra1;
    *(u32x4*)(Bs + lr * 72 + lc) = rb0; *(u32x4*)(Bs + (lr + 64) * 72 + lc) = rb1;
    __syncthreads();
    const int nk = (g.kend - g.kbeg) >> 6;
    for (int kt = 0; kt < nk; ++kt) {
        const int cur = kt & 1;
        const bool more = (kt + 1 < nk);
        if (more) { const int ko = (kt + 1) * 64; ra0 = *(const u32x4*)(ga0 + ko); ra1 = *(const u32x4*)(ga1 + ko); rb0 = *(const u32x4*)(gb0 + ko); rb1 = *(const u32x4*)(gb1 + ko); }
        const bf16_t* a = As + cur * 128 * 72;
        const bf16_t* b = Bs + cur * 128 * 72;
#pragma unroll
        for (int ks = 0; ks < 2; ++ks) {
            bf16x8 af[4], bfr[2];
#pragma unroll
            for (int mt = 0; mt < 4; ++mt) af[mt] = *(const bf16x8*)(a + (wm * 64 + mt * 16 + l15) * 72 + ks * 32 + quad * 8);
#pragma unroll
            for (int nt = 0; nt < 2; ++nt) bfr[nt] = *(const bf16x8*)(b + (wn * 32 + nt * 16 + l15) * 72 + ks * 32 + quad * 8);
#pragma unroll
            for (int mt = 0; mt < 4; ++mt)
#pragma unroll
                for (int nt = 0; nt < 2; ++nt) acc[mt][nt] = __builtin_amdgcn_mfma_f32_16x16x32_bf16(bfr[nt], af[mt], acc[mt][nt], 0, 0, 0);
        }
        if (more) {
            bf16_t* a2 = As + (cur ^ 1) * 128 * 72; bf16_t* b2 = Bs + (cur ^ 1) * 128 * 72;
            *(u32x4*)(a2 + lr * 72 + lc) = ra0; *(u32x4*)(a2 + (lr + 64) * 72 + lc) = ra1;
            *(u32x4*)(b2 + lr * 72 + lc) = rb0; *(u32x4*)(b2 + (lr + 64) * 72 + lc) = rb1;
        }
        __syncthreads();
    }
#pragma unroll
    for (int mt = 0; mt < 4; ++mt) epi(row0 + wm * 64 + mt * 16 + l15, col0 + wn * 32 + quad * 4, acc[mt][0], acc[mt][1]);
}

template <class Epi>
DI void gemm_all(const GemmOp& g, int M, int N, const Epi& epi, char* smem) {
    const int ntn = N >> 7, nt = (M >> 7) * ntn;
    for (int t = blockIdx.x; t < nt; t += gridDim.x) gemm_tile(g, (t / ntn) * 128, (t % ntn) * 128, epi, smem);
}

DI void st_bf16x4(bf16_t* p, f32x4 a) { u32x2 v; v.x = pk2(a[0], a[1]); v.y = pk2(a[2], a[3]); *(u32x2*)p = v; }
struct EpiBf16 { bf16_t* O; long ldo;
    DI void operator()(int row, int col, f32x4 a0, f32x4 a1) const { bf16_t* p = O + (long)row * ldo + col; st_bf16x4(p, a0); st_bf16x4(p + 16, a1); } };
struct EpiF32 { float* O; long ldo;
    DI void operator()(int row, int col, f32x4 a0, f32x4 a1) const { float* p = O + (long)row * ldo + col; *(f32x4*)p = a0; *(f32x4*)(p + 16) = a1; } };
struct EpiResidual { float* X; const float* gate;
    DI void operator()(int row, int col, f32x4 a0, f32x4 a1) const {
        const float* gp = gate + (long)modrow_of(row) * 6144 + col; float* xp = X + (long)row * 1024 + col;
        f32x4 g0 = *(const f32x4*)gp, g1 = *(const f32x4*)(gp + 16), x0 = *(const f32x4*)xp, x1 = *(const f32x4*)(xp + 16);
        *(f32x4*)xp = x0 + g0 * a0; *(f32x4*)(xp + 16) = x1 + g1 * a1; } };
struct EpiSwiglu { bf16_t* O;
    DI void operator()(int row, int col, f32x4 a0, f32x4 a1) const {
        const int f = ((col >> 7) << 6) + (((col & 127) >> 5) << 4) + (col & 15);
        f32x4 h;
#pragma unroll
        for (int i = 0; i < 4; ++i) h[i] = a0[i] * fsigmoid(a0[i]) * a1[i];
        st_bf16x4(O + (long)row * 1024 + f, h); } };
struct EpiGate { bf16_t* O; const float* gate;
    DI void operator()(int row, int col, f32x4 a0, f32x4 a1) const { const float gt = gate[row]; bf16_t* p = O + (long)row * 1024 + col; st_bf16x4(p, a0 * gt); st_bf16x4(p + 16, a1 * gt); } };

template <int MODE>
DI void conv_tiles(const float* src, int K, int N, int Npad, bf16_t* dst, long ldd, int koff, int rowoff,
                   const float* mixv, float alpha, float beta, int& base, char* smem) {
    float* t = (float*)smem;
    const int tid = threadIdx.x;
    const int G = gridDim.x;
    const int ntn = Npad >> 6, ntiles = (K >> 6) * ntn;
    int first = ((int)blockIdx.x - (base % G) + G) % G;
    base += ntiles;
    for (int ti = first; ti < ntiles; ti += G) {
        const int k0 = (ti / ntn) << 6, n0 = (ti % ntn) << 6;
        {
            const int k = tid >> 3, n8 = (tid & 7) * 8;
            const float sc = mixv ? (alpha + beta * mixv[k0 + k]) : 1.0f;
            f32x4 v0 = (f32x4){0.f, 0.f, 0.f, 0.f}, v1 = v0;
            if (n0 + n8 < N) { const float* sp = src + (long)(k0 + k) * N + n0 + n8; v0 = *(const f32x4*)sp; v1 = *(const f32x4*)(sp + 4); }
            float* tp = t + k * 65 + n8;
            tp[0] = v0[0] * sc; tp[1] = v0[1] * sc; tp[2] = v0[2] * sc; tp[3] = v0[3] * sc; tp[4] = v1[0] * sc; tp[5] = v1[1] * sc; tp[6] = v1[2] * sc; tp[7] = v1[3] * sc;
        }
        __syncthreads();
        {
            const int n = tid >> 3, kc = (tid & 7) * 8;
            float f[8];
#pragma unroll
            for (int j = 0; j < 8; ++j) f[j] = t[(kc + j) * 65 + n];
            const int nn = n0 + n;
            const int r = (MODE == 1) ? (128 * (nn >> 6) + 32 * ((nn >> 4) & 3) + (nn & 15)) : nn;
            *(u32x4*)(dst + (long)(r + rowoff) * ldd + koff + k0 + kc) = pack8(f);
        }
        __syncthreads();
    }
}
DI void zero_bf16(bf16_t* dst, long n8  ) {
    for (long i = (long)blockIdx.x * NTHR + threadIdx.x; i < n8; i += (long)gridDim.x * NTHR) *(u32x4*)(dst + i * 8) = (u32x4){0u, 0u, 0u, 0u};
}

struct Bufs {
    float* MOD; float* ROPE_M; float* ROPE_S; float* X; bf16_t* WMIX; bf16_t* W13; bf16_t* W2T;
    float* AFF; float* AFFC; int* IDX; float* GATE; int* INV; unsigned char* WORK;
    DI bf16_t* slot(int i) const { return (bf16_t*)(WORK + (size_t)i * USLOT); }
};
DI Bufs make_bufs(const Params& p) {
    Bufs b; unsigned char* w = p.ws;
    b.MOD = (float*)(w + OFF_MOD); b.ROPE_M = (float*)(w + OFF_ROPE_M); b.ROPE_S = (float*)(w + OFF_ROPE_S); b.X = (float*)(w + OFF_X);
    b.WMIX = (bf16_t*)(w + OFF_WMIX); b.W13 = (bf16_t*)(w + OFF_WE); b.W2T = (bf16_t*)(w + OFF_WE + 64 * MiB);
    b.AFF = (float*)(w + OFF_AFF); b.AFFC = (float*)(w + OFF_AFFC); b.IDX = (int*)(w + OFF_IDX); b.GATE = (float*)(w + OFF_GATE); b.INV = (int*)(w + OFF_INV);
    b.WORK = w + OFF_WORK; return b;
}

DI void conv_moe_layer(const Params& p, const Bufs& B, int layer, int& base, char* smem) {
    for (int e = 0; e < NEXP; ++e) {
        const size_t wo = ((size_t)layer * NEXP + e) * 1024 * 1024;
        conv_tiles<1>(p.in[I_MOE_W1] + wo, 1024, 1024, 1024, B.W13 + (size_t)e * 2048 * 1024, 1024, 0, 0, nullptr, 0.f, 0.f, base, smem);
        conv_tiles<1>(p.in[I_MOE_W3] + wo, 1024, 1024, 1024, B.W13 + (size_t)e * 2048 * 1024, 1024, 0, 16, nullptr, 0.f, 0.f, base, smem);
        conv_tiles<0>(p.in[I_MOE_W2] + wo, 1024, 1024, 1024, B.W2T + (size_t)e * 1024 * 1024, 1024, 0, 0, nullptr, 0.f, 0.f, base, smem);
    }
}

DI void phase_prologue(const Params& p, const Bufs& B, char* smem) {
    const int tid = threadIdx.x, G = gridDim.x;
    {
        float* s = (float*)smem;
        float* red = s + 9 * 1024;
        for (int i = tid; i < 9 * 1024; i += NTHR) { const int r = i >> 10, k = i & 1023; const float x = (r < 8) ? p.in[I_C][r * 1024 + k] : p.in[I_CCTX][k]; s[i] = x * fsigmoid(x); }
        __syncthreads();
        for (int it = blockIdx.x; it < 4 * 96; it += G) {
            const int l = it / 96, cg = it % 96, cl = tid & 63, ks = tid >> 6, n = cg * 64 + cl;
            const float* wp = p.in[I_ADAW] + (size_t)l * 1024 * 6144 + (size_t)(ks * 128) * 6144 + n;
            float acc[9];
#pragma unroll
            for (int r = 0; r < 9; ++r) acc[r] = 0.f;
            for (int k = 0; k < 128; ++k) {
                const float wv = wp[(size_t)k * 6144];
#pragma unroll
                for (int r = 0; r < 9; ++r) acc[r] += s[r * 1024 + ks * 128 + k] * wv;
            }
#pragma unroll
            for (int r = 0; r < 9; ++r) red[(ks * 9 + r) * 64 + cl] = acc[r];
            __syncthreads();
            for (int o = tid; o < 9 * 64; o += NTHR) {
                const int r = o >> 6, c = o & 63; float v = 0.f;
#pragma unroll
                for (int q = 0; q < 8; ++q) v += red[(q * 9 + r) * 64 + c];
                B.MOD[((size_t)l * 9 + r) * 6144 + cg * 64 + c] = v + p.in[I_ADAB][l * 6144 + cg * 64 + c];
            }
            __syncthreads();
        }
    }
    {
        const f32x4* xs = (const f32x4*)p.in[I_X]; const f32x4* cs = (const f32x4*)p.in[I_CTX]; f32x4* xd = (f32x4*)B.X;
        const long nl = (long)TL * 256, nt = (long)TT * 256;
        for (long i = (long)blockIdx.x * NTHR + tid; i < nt; i += (long)G * NTHR) xd[i] = (i < nl) ? xs[i] : cs[i - nl];
    }
    for (int i = blockIdx.x * NTHR + tid; i < 4096 * 48; i += G * NTHR) {
        const int pos = i / 48, j = i % 48;
        const int row = pos >> 6, col = pos & 63;
        float inv, posf; float* cdst; float* sdst;
        if (j < 16) { const int m = j & 7; inv = powf(10000.0f, -(float)(2 * m) / 16.0f); posf = (j < 8) ? (float)row : (float)col; cdst = B.ROPE_M + pos * 16 + j; sdst = B.ROPE_M + 4096 * 16 + pos * 16 + j; }
        else { const int jj = j - 16, m = jj & 15; inv = powf(10000.0f, -(float)(2 * m) / 32.0f); posf = (jj < 16) ? (float)row : (float)col; cdst = B.ROPE_S + pos * 32 + jj; sdst = B.ROPE_S + 4096 * 32 + pos * 32 + jj; }
        const float ang = posf * inv;
        double tr = (double)ang * 0.15915494309189535; tr -= rint(tr);
        const float tf = (float)tr;
        *cdst = __builtin_amdgcn_cosf(tf); *sdst = __builtin_amdgcn_sinf(tf);
    }
    int base = 0;
    bf16_t* W = B.WMIX;
    conv_tiles<0>(p.in[I_NA_WQKV], 1024, 3072, 3072, W + W_NA_QKV, 1024, 0, 0, nullptr, 0.f, 0.f, base, smem);
    conv_tiles<0>(p.in[I_NA_WO], 1024, 1024, 1024, W + W_NA_WO, 1024, 0, 0, nullptr, 0.f, 0.f, base, smem);
    {
        const float* mix = p.in[I_RW_MIX];
        bf16_t* B1 = W + W_RW_B1;
        conv_tiles<0>(p.in[I_RW_WR], 1024, 1024, 1024, B1, 2048, 0, 0, mix + 0 * 1024, 1.f, -1.f, base, smem);
        conv_tiles<0>(p.in[I_RW_WR], 1024, 1024, 1024, B1, 2048, 1024, 0, mix + 0 * 1024, 0.f, 0.5f, base, smem);
        conv_tiles<0>(p.in[I_RW_WK], 1024, 1024, 1024, B1, 2048, 0, 1024, mix + 2 * 1024, 1.f, -1.f, base, smem);
        conv_tiles<0>(p.in[I_RW_WK], 1024, 1024, 1024, B1, 2048, 1024, 1024, mix + 2 * 1024, 0.f, 0.5f, base, smem);
        conv_tiles<0>(p.in[I_RW_WV], 1024, 1024, 1024, B1, 2048, 0, 2048, mix + 3 * 1024, 1.f, -1.f, base, smem);
        conv_tiles<0>(p.in[I_RW_WV], 1024, 1024, 1024, B1, 2048, 1024, 2048, mix + 3 * 1024, 0.f, 0.5f, base, smem);
        conv_tiles<0>(p.in[I_RW_G1], 1024, 128, 128, B1, 2048, 0, 3072, mix + 5 * 1024, 1.f, -1.f, base, smem);
        conv_tiles<0>(p.in[I_RW_G1], 1024, 128, 128, B1, 2048, 1024, 3072, mix + 5 * 1024, 0.f, 0.5f, base, smem);
        for (int z = 0; z < 2; ++z) {
            conv_tiles<0>(p.in[I_RW_W1] + (size_t)z * 1024 * 64, 1024, 64, 64, B1, 2048, 0, 3200 + 64 * z, mix + 1 * 1024, 1.f, -1.f, base, smem);
            conv_tiles<0>(p.in[I_RW_W1] + (size_t)z * 1024 * 64, 1024, 64, 64, B1, 2048, 1024, 3200 + 64 * z, mix + 1 * 1024, 0.f, 0.5f, base, smem);
            conv_tiles<0>(p.in[I_RW_A1] + (size_t)z * 1024 * 64, 1024, 64, 64, B1, 2048, 0, 3328 + 64 * z, mix + 4 * 1024, 1.f, -1.f, base, smem);
            conv_tiles<0>(p.in[I_RW_A1] + (size_t)z * 1024 * 64, 1024, 64, 64, B1, 2048, 1024, 3328 + 64 * z, mix + 4 * 1024, 0.f, 0.5f, base, smem);
        }
        zero_bf16(B1 + (size_t)3456 * 2048, (long)128 * 2048 / 8);
        bf16_t* B2 = W + W_RW_B2;
        conv_tiles<0>(p.in[I_RW_G2], 128, 1024, 1024, B2, 384, 0, 0, nullptr, 0.f, 0.f, base, smem);
        for (int z = 0; z < 2; ++z) {
            conv_tiles<0>(p.in[I_RW_W2] + (size_t)z * 64 * 1024, 64, 1024, 1024, B2, 384, 128 + 64 * z, 1024 + 1024 * z, nullptr, 0.f, 0.f, base, smem);
            conv_tiles<0>(p.in[I_RW_A2] + (size_t)z * 64 * 1024, 64, 1024, 1024, B2, 384, 256 + 64 * z, 3072 + 1024 * z, nullptr, 0.f, 0.f, base, smem);
        }
        conv_tiles<0>(p.in[I_RW_WO], 1024, 1024, 1024, W + W_RW_WO, 1024, 0, 0, nullptr, 0.f, 0.f, base, smem);
    }
    conv_tiles<0>(p.in[I_MLA_WDOWN], 1024, 672, 768, W + W_MLA_DOWN, 1024, 0, 0, nullptr, 0.f, 0.f, base, smem);
    conv_tiles<0>(p.in[I_MLA_WUQ], 384, 1536, 1536, W + W_MLA_UQ, 384, 0, 0, nullptr, 0.f, 0.f, base, smem);
    conv_tiles<0>(p.in[I_MLA_WUKV], 256, 2048, 2048, W + W_MLA_UKV, 256, 0, 0, nullptr, 0.f, 0.f, base, smem);
    conv_tiles<0>(p.in[I_MLA_WO], 1024, 1024, 1024, W + W_MLA_WO, 1024, 0, 0, nullptr, 0.f, 0.f, base, smem);
    conv_tiles<0>(p.in[I_SWA_WQKV], 1024, 1536, 1536, W + W_SWA_QKV, 1024, 0, 0, nullptr, 0.f, 0.f, base, smem);
    conv_tiles<0>(p.in[I_SWA_WO], 1024, 1024, 1024, W + W_SWA_WO, 1024, 0, 0, nullptr, 0.f, 0.f, base, smem);
    conv_moe_layer(p, B, 0, base, smem);
}

DI void row_load_f32(const float* row, int lane, float* v) {
#pragma unroll
    for (int i = 0; i < 4; ++i) { const f32x4 t = *(const f32x4*)(row + 256 * i + 4 * lane); v[4 * i] = t[0]; v[4 * i + 1] = t[1]; v[4 * i + 2] = t[2]; v[4 * i + 3] = t[3]; }
}
DI void row_store_bf16(bf16_t* row, int lane, const float* v) {
#pragma unroll
    for (int i = 0; i < 4; ++i) { u32x2 t; t.x = pk2(v[4 * i], v[4 * i + 1]); t.y = pk2(v[4 * i + 2], v[4 * i + 3]); *(u32x2*)(row + 256 * i + 4 * lane) = t; }
}
DI void norm_mod_row(const float* xrow, const float* gain, const float* shift, const float* scale, int lane, float* h) {
    float x[16], gg[16], sh[16], sc[16];
    row_load_f32(xrow, lane, x); row_load_f32(gain, lane, gg); row_load_f32(shift, lane, sh); row_load_f32(scale, lane, sc);
    float ss = 0.f;
#pragma unroll
    for (int e = 0; e < 16; ++e) ss += x[e] * x[e];
    ss = wave_sum(ss);
    const float r = rsqrtf(ss * (1.0f / 1024.0f) + 1e-6f);
#pragma unroll
    for (int e = 0; e < 16; ++e) h[e] = x[e] * r * gg[e] * (1.0f + sc[e]) + sh[e];
}

DI void phase_norm1(const Params& p, const Bufs& B, int layer, bf16_t* H) {
    const int lane = threadIdx.x & 63, gw = blockIdx.x * 8 + (threadIdx.x >> 6), nw = gridDim.x * 8;
    const float* gain = p.in[I_N1G] + layer * 1024;
    for (int g = gw; g < TT; g += nw) {
        const float* md = B.MOD + ((size_t)layer * 9 + modrow_of(g)) * 6144;
        float h[16];
        norm_mod_row(B.X + (size_t)g * 1024, gain, md, md + 1024, lane, h);
        row_store_bf16(H + (size_t)g * 1024, lane, h);
    }
}
DI void phase_norm1_rw(const Params& p, const Bufs& B, int layer, bf16_t* H2) {
    const int lane = threadIdx.x & 63, gw = blockIdx.x * 8 + (threadIdx.x >> 6), nw = gridDim.x * 8;
    const float* gain = p.in[I_N1G] + layer * 1024;
    for (int g = gw; g < TT; g += nw) {
        const float* md = B.MOD + ((size_t)layer * 9 + modrow_of(g)) * 6144;
        const int t = (g < TL) ? (g & 4095) : ((g - TL) & 255);
        const int len = (g < TL) ? 4096 : 256;
        float h[16], hp[16], hn[16];
        norm_mod_row(B.X + (size_t)g * 1024, gain, md, md + 1024, lane, h);
        if (t > 0) norm_mod_row(B.X + (size_t)(g - 1) * 1024, gain, md, md + 1024, lane, hp);
        else {
#pragma unroll
            for (int e = 0; e < 16; ++e) hp[e] = 0.f;
        }
        if (t < len - 1) norm_mod_row(B.X + (size_t)(g + 1) * 1024, gain, md, md + 1024, lane, hn);
        else {
#pragma unroll
            for (int e = 0; e < 16; ++e) hn[e] = 0.f;
        }
#pragma unroll
        for (int e = 0; e < 16; ++e) hp[e] += hn[e];
        row_store_bf16(H2 + (size_t)g * 2048, lane, h);
        row_store_bf16(H2 + (size_t)g * 2048 + 1024, lane, hp);
    }
}
DI void phase_norm2(const Params& p, const Bufs& B, int layer, bf16_t* H, int ntok, char* smem) {
    float* wr = (float*)smem;
    const float* rsrc = p.in[I_MOE_ROUTER] + (size_t)layer * 1024 * 16;
    for (int i = threadIdx.x; i < 1024 * 16; i += NTHR) { const int k = i >> 4, e = i & 15; wr[e * 1024 + k] = rsrc[i]; }
    __syncthreads();
    const int lane = threadIdx.x & 63, gw = blockIdx.x * 8 + (threadIdx.x >> 6), nw = gridDim.x * 8;
    const float* gain = p.in[I_N2G] + layer * 1024;
    for (int g = gw; g < ntok; g += nw) {
        const float* md = B.MOD + ((size_t)layer * 9 + modrow_of(g)) * 6144;
        float h[16];
        norm_mod_row(B.X + (size_t)g * 1024, gain, md + 3 * 1024, md + 4 * 1024, lane, h);
        row_store_bf16(H + (size_t)g * 1024, lane, h);
        float mine = -3.0e38f;
#pragma unroll 1
        for (int e = 0; e < 16; ++e) {
            float a = 0.f;
#pragma unroll
            for (int i = 0; i < 4; ++i) { const f32x4 w4 = *(const f32x4*)(wr + e * 1024 + 256 * i + 4 * lane); a += h[4 * i] * w4[0] + h[4 * i + 1] * w4[1] + h[4 * i + 2] * w4[2] + h[4 * i + 3] * w4[3]; }
            a = wave_sum(a);
            mine = (lane == e) ? a : mine;
        }
        float mx = mine;
        mx = fmaxf(mx, __shfl_xor(mx, 1)); mx = fmaxf(mx, __shfl_xor(mx, 2)); mx = fmaxf(mx, __shfl_xor(mx, 4)); mx = fmaxf(mx, __shfl_xor(mx, 8));
        const float ex = __expf(mine - mx);
        float se = ex;
        se += __shfl_xor(se, 1); se += __shfl_xor(se, 2); se += __shfl_xor(se, 4); se += __shfl_xor(se, 8);
        mine = ex / se;
        if (lane < 16) {
            if (g < TL) B.AFF[((size_t)(g >> 12) * 16 + lane) * 4096 + (g & 4095)] = mine;
            else { const int gc = g - TL; B.AFFC[((size_t)(gc >> 8) * 16 + lane) * 256 + (gc & 255)] = mine; }
            B.INV[(size_t)g * 16 + lane] = -1;
        }
    }
}

DI void ld16(const bf16_t* p, float* v) { unpack8(*(const u32x4*)p, v); unpack8(*(const u32x4*)(p + 8), v + 8); }
DI void st16(bf16_t* p, const float* v) { *(u32x4*)p = pack8(v); *(u32x4*)(p + 8) = pack8(v + 8); }
DI void headnorm64(float* v, const float* gain, int p) {
    float ss = 0.f;
#pragma unroll
    for (int e = 0; e < 16; ++e) ss += v[e] * v[e];
    ss += __shfl_xor(ss, 1); ss += __shfl_xor(ss, 2);
    const float r = rsqrtf(ss * (1.0f / 64.0f) + 1e-6f);
#pragma unroll
    for (int e = 0; e < 16; ++e) v[e] = v[e] * r * gain[16 * p + e];
}
DI void rope64(float* v, const float* cs, const float* sn, int p) {
    const int i0 = 16 * (p & 1);
#pragma unroll
    for (int e = 0; e < 16; ++e) {
        const float o = __shfl_xor(v[e], 2), c = cs[i0 + e], s = sn[i0 + e];
        v[e] = (p < 2) ? (v[e] * c - o * s) : (v[e] * c + o * s);
    }
}

DI void phase_qknorm_na(const Params& p, bf16_t* QKV) {
    const int lane = threadIdx.x & 63, gw = blockIdx.x * 8 + (threadIdx.x >> 6), nw = gridDim.x * 8, pp = lane & 3;
    const float* qg = p.in[I_NA_QG]; const float* kg = p.in[I_NA_KG];
    for (int g = gw; g < TT; g += nw) {
        bf16_t* row = QKV + (size_t)g * 3072 + 16 * lane;
        float v[16];
        ld16(row, v); headnorm64(v, qg, pp); st16(row, v);
        ld16(row + 1024, v); headnorm64(v, kg, pp); st16(row + 1024, v);
    }
}
DI void phase_qknorm_swa(const Params& p, const Bufs& B, bf16_t* QKV) {
    const int lane = threadIdx.x & 63, gw = blockIdx.x * 8 + (threadIdx.x >> 6), nw = gridDim.x * 8, pp = lane & 3;
    const float* qg = p.in[I_SWA_QG]; const float* kg = p.in[I_SWA_KG];
    for (int g = gw; g < TT; g += nw) {
        bf16_t* row = QKV + (size_t)g * 1536;
        const bool lat = g < TL;
        const int pos = g & 4095;
        const float* cs = B.ROPE_S + (size_t)(lat ? pos : 0) * 32; const float* sn = cs + 4096 * 32;
        float v[16];
        ld16(row + 16 * lane, v); headnorm64(v, qg, pp);
        if (lat) rope64(v, cs, sn, pp);
        st16(row + 16 * lane, v);
        const int kl = lane & 15;
        ld16(row + 1024 + 16 * kl, v); headnorm64(v, kg, pp);
        if (lat) rope64(v, cs, sn, pp);
        if (lane < 16) st16(row + 1024 + 16 * kl, v);
    }
}
DI void phase_mla_dnorm(const Params& p, const Bufs& B, const float* DOWN, bf16_t* CQ, bf16_t* CKV, bf16_t* KR) {
    const int lane = threadIdx.x & 63, gw = blockIdx.x * 8 + (threadIdx.x >> 6), nw = gridDim.x * 8;
    const float* qng = p.in[I_MLA_QNG]; const float* kvng = p.in[I_MLA_KVNG]; const float* krg = p.in[I_MLA_KR_G];
    for (int g = gw; g < TT; g += nw) {
        const float* d = DOWN + (size_t)g * 768;
        float a[6]; float ss = 0.f;
#pragma unroll
        for (int e = 0; e < 6; ++e) { a[e] = d[lane + 64 * e]; ss += a[e] * a[e]; }
        ss = wave_sum(ss);
        float r = rsqrtf(ss * (1.0f / 384.0f) + 1e-6f);
#pragma unroll
        for (int e = 0; e < 6; ++e) CQ[(size_t)g * 384 + lane + 64 * e] = (bf16_t)f2bf(a[e] * r * qng[lane + 64 * e]);
        ss = 0.f;
#pragma unroll
        for (int e = 0; e < 4; ++e) { a[e] = d[384 + lane + 64 * e]; ss += a[e] * a[e]; }
        ss = wave_sum(ss);
        r = rsqrtf(ss * (1.0f / 256.0f) + 1e-6f);
#pragma unroll
        for (int e = 0; e < 4; ++e) CKV[(size_t)g * 256 + lane + 64 * e] = (bf16_t)f2bf(a[e] * r * kvng[lane + 64 * e]);
        const int l31 = lane & 31;
        float x = (lane < 32) ? d[640 + l31] : 0.f;
        ss = wave_sum(x * x);
        r = rsqrtf(ss * (1.0f / 32.0f) + 1e-6f);
        x = x * r * krg[l31];
        const float o = __shfl_xor(x, 16);
        if (g < TL) {
            const int pos = g & 4095, i = lane & 15;
            const float c = B.ROPE_M[pos * 16 + i], s = B.ROPE_M[4096 * 16 + pos * 16 + i];
            x = (l31 < 16) ? (x * c - o * s) : (x * c + o * s);
        }
        if (lane < 32) KR[(size_t)g * 32 + lane] = (bf16_t)f2bf(x);
    }
}
DI void phase_mla_hnorm(const Params& p, const Bufs& B, bf16_t* Q, bf16_t* KV) {
    const int lane = threadIdx.x & 63, gw = blockIdx.x * 8 + (threadIdx.x >> 6), nw = gridDim.x * 8, pp = lane & 3, hh = lane >> 2;
    const float* qng = p.in[I_MLA_QN_G]; const float* qrg = p.in[I_MLA_QR_G]; const float* kng = p.in[I_MLA_KN_G];
    for (int g = gw; g < TT; g += nw) {
        bf16_t* q = Q + (size_t)g * 1536 + hh * 96;
        float v[16];
        ld16(q + 16 * pp, v); headnorm64(v, qng, pp); st16(q + 16 * pp, v);
        float w[8];
        unpack8(*(const u32x4*)(q + 64 + 8 * pp), w);
        float ss = 0.f;
#pragma unroll
        for (int e = 0; e < 8; ++e) ss += w[e] * w[e];
        ss += __shfl_xor(ss, 1); ss += __shfl_xor(ss, 2);
        const float r = rsqrtf(ss * (1.0f / 32.0f) + 1e-6f);
#pragma unroll
        for (int e = 0; e < 8; ++e) w[e] = w[e] * r * qrg[8 * pp + e];
        if (g < TL) {
            const int pos = g & 4095, i0 = 8 * (pp & 1);
#pragma unroll
            for (int e = 0; e < 8; ++e) {
                const float o = __shfl_xor(w[e], 2), c = B.ROPE_M[pos * 16 + i0 + e], s = B.ROPE_M[4096 * 16 + pos * 16 + i0 + e];
                w[e] = (pp < 2) ? (w[e] * c - o * s) : (w[e] * c + o * s);
            }
        }
        *(u32x4*)(q + 64 + 8 * pp) = pack8(w);
        bf16_t* k = KV + (size_t)g * 2048 + hh * 128 + 16 * pp;
        ld16(k, v); headnorm64(v, kng, pp); st16(k, v);
    }
}

typedef short v4i16_t __attribute__((ext_vector_type(4)));
DI s16x4 tr_read(const bf16_t* p) { return __builtin_bit_cast(s16x4, __builtin_amdgcn_ds_read_tr16_b64_v4i16((LAS v4i16_t*)(LAS char*)(char*)p)); }
constexpr int ATT_LDS = 64 * 104 * 2 + 64 * 72 * 2 + 2048;

template <class P>
DI void attn_unit(const P& pol, char* smem) {
    constexpr int DQK = P::DQK, KS = DQK + 8, VS = 72, NS = DQK / 32, NCH = DQK / 8;
    bf16_t* Ks = (bf16_t*)smem;
    bf16_t* Vs = (bf16_t*)(smem + 64 * 104 * 2);
    const int tid = threadIdx.x, lane = tid & 63, w = tid >> 6, l15 = lane & 15, quad = lane >> 4;
    const int q = w * 16 + l15;
    __syncthreads();
    pol.prologue(smem + 64 * 104 * 2 + 64 * 72 * 2);
    bf16x8 qf[NS];
#pragma unroll
    for (int s = 0; s < NS; ++s) qf[s] = *(const bf16x8*)pol.qptr(q, s * 4 + quad);
    f32x4 o[4];
#pragma unroll
    for (int u = 0; u < 4; ++u) o[u] = (f32x4){0.f, 0.f, 0.f, 0.f};
    float m = -1e30f, l = 0.f;
    const int k0key = (DQK == 64) ? (tid >> 3) : (tid / 12), k0ch = (DQK == 64) ? (tid & 7) : (tid % 12);
    const int k1key = (tid + 512) / 12, k1ch = (tid + 512) % 12;
    const bool k1on = (DQK == 96) && (tid < 256);
    const int vkey = tid >> 3, vch = tid & 7;
    const int nt = pol.ntiles();
    u32x4 rk0, rk1 = (u32x4){0u, 0u, 0u, 0u}, rv;
    rk0 = *(const u32x4*)pol.kptr(0, k0key, k0ch);
    if (k1on) rk1 = *(const u32x4*)pol.kptr(0, k1key, k1ch);
    rv = *(const u32x4*)pol.vptr(0, vkey, vch);
    *(u32x4*)(Ks + k0key * KS + k0ch * 8) = rk0;
    if (k1on) *(u32x4*)(Ks + k1key * KS + k1ch * 8) = rk1;
    *(u32x4*)(Vs + vkey * VS + vch * 8) = rv;
    __syncthreads();
    for (int j = 0; j < nt; ++j) {
        const bool more = (j + 1 < nt);
        if (more) {
            rk0 = *(const u32x4*)pol.kptr(j + 1, k0key, k0ch);
            if (k1on) rk1 = *(const u32x4*)pol.kptr(j + 1, k1key, k1ch);
            rv = *(const u32x4*)pol.vptr(j + 1, vkey, vch);
        }
        f32x4 sc[2][2];
#pragma unroll
        for (int g = 0; g < 2; ++g)
#pragma unroll
            for (int t = 0; t < 2; ++t) {
                f32x4 a = (f32x4){0.f, 0.f, 0.f, 0.f};
                const int key = 32 * g + 8 * (l15 >> 2) + 4 * t + (l15 & 3);
#pragma unroll
                for (int s = 0; s < NS; ++s) { const bf16x8 kf = *(const bf16x8*)(Ks + key * KS + 32 * s + 8 * quad); a = __builtin_amdgcn_mfma_f32_16x16x32_bf16(kf, qf[s], a, 0, 0, 0); }
                sc[g][t] = a;
            }
        float tmax = -3.0e38f;
#pragma unroll
        for (int g = 0; g < 2; ++g)
#pragma unroll
            for (int t = 0; t < 2; ++t)
#pragma unroll
                for (int r = 0; r < 4; ++r) { const float s2 = pol.mod(sc[g][t][r] * pol.c2, q, j, 32 * g + 8 * quad + 4 * t + r); sc[g][t][r] = s2; tmax = fmaxf(tmax, s2); }
        tmax = fmaxf(tmax, __shfl_xor(tmax, 16)); tmax = fmaxf(tmax, __shfl_xor(tmax, 32));
        const float mn = fmaxf(m, tmax), alpha = fexp2(m - mn);
        m = mn;
        float ps = 0.f;
        bf16x8 pf[2];
#pragma unroll
        for (int g = 0; g < 2; ++g) {
            float pv[8];
#pragma unroll
            for (int t = 0; t < 2; ++t)
#pragma unroll
                for (int r = 0; r < 4; ++r) { const float e = fexp2(sc[g][t][r] - mn); ps += e; pv[4 * t + r] = e; }
            pf[g] = __builtin_bit_cast(bf16x8, pack8(pv));
        }
        l = l * alpha + ps;
#pragma unroll
        for (int u = 0; u < 4; ++u) o[u] *= alpha;
#pragma unroll
        for (int u = 0; u < 4; ++u)
#pragma unroll
            for (int g = 0; g < 2; ++g) {
                const bf16_t* vb = Vs + (32 * g + 8 * quad + (l15 >> 2)) * VS + 16 * u + 4 * (l15 & 3);
                const s16x4 lo = tr_read(vb), hi = tr_read(vb + 4 * VS);
                bf16x8 vf; vf[0] = lo[0]; vf[1] = lo[1]; vf[2] = lo[2]; vf[3] = lo[3]; vf[4] = hi[0]; vf[5] = hi[1]; vf[6] = hi[2]; vf[7] = hi[3];
                o[u] = __builtin_amdgcn_mfma_f32_16x16x32_bf16(vf, pf[g], o[u], 0, 0, 0);
            }
        __syncthreads();
        if (more) {
            *(u32x4*)(Ks + k0key * KS + k0ch * 8) = rk0;
            if (k1on) *(u32x4*)(Ks + k1key * KS + k1ch * 8) = rk1;
            *(u32x4*)(Vs + vkey * VS + vch * 8) = rv;
        }
        __syncthreads();
    }
    l += __shfl_xor(l, 16); l += __shfl_xor(l, 32);
    if (P::SINK) l += fexp2(pol.sink2 - m);
    const float il = 1.0f / l;
    bf16_t* op = pol.optr(q);
#pragma unroll
    for (int u = 0; u < 4; ++u) st_bf16x4(op + 16 * u + 4 * quad, o[u] * il);
}

struct PolPlain64 {
    static constexpr int DQK = 64; static constexpr bool SINK = false;
    const bf16_t* Qb; long qs; const bf16_t* Kb; long ks; const bf16_t* Vb; long vs; bf16_t* Ob; long os; int qrow0, krow0, nt; float c2, sink2;
    DI void prologue(char*) const {}
    DI int ntiles() const { return nt; }
    DI const bf16_t* qptr(int q, int ch) const { return Qb + (long)(qrow0 + q) * qs + ch * 8; }
    DI const bf16_t* kptr(int j, int i, int ch) const { return Kb + (long)(krow0 + 64 * j + i) * ks + ch * 8; }
    DI const bf16_t* vptr(int j, int i, int ch) const { return Vb + (long)(krow0 + 64 * j + i) * vs + ch * 8; }
    DI float mod(float s2, int, int, int) const { return s2; }
    DI bf16_t* optr(int q) const { return Ob + (long)(qrow0 + q) * os; }
};
struct PolNA {
    static constexpr int DQK = 64; static constexpr bool SINK = false;
    const bf16_t* QKV; bf16_t* AO; const float* rpb; const float* bl; int b, h, rr, rbase; float c2, sink2;
    DI void prologue(char* s) const { float* t = (float*)s; for (int i = threadIdx.x; i < 465; i += NTHR) t[i] = rpb[h * 465 + i] * LOG2E; }
    DI int ntiles() const { return 13; }
    DI int qtok(int q) const { return b * 4096 + (2 * rr + (q >> 6)) * 64 + (q & 63); }
    DI int ktok(int j, int i) const { if (j < 4) return TL + b * 256 + 64 * j + i; int kr = rbase + j - 4; kr = kr > 63 ? 63 : kr; return b * 4096 + kr * 64 + i; }
    DI const bf16_t* qptr(int q, int ch) const { return QKV + (long)qtok(q) * 3072 + h * 64 + ch * 8; }
    DI const bf16_t* kptr(int j, int i, int ch) const { return QKV + (long)ktok(j, i) * 3072 + 1024 + h * 64 + ch * 8; }
    DI const bf16_t* vptr(int j, int i, int ch) const { return QKV + (long)ktok(j, i) * 3072 + 2048 + h * 64 + ch * 8; }
    DI float mod(float s2, int q, int j, int kc) const {
        if (j < 4) return s2;
        const int kr = rbase + j - 4, qr = 2 * rr + (q >> 6), qc = q & 63;
        int r0 = qr - 4; r0 = r0 < 0 ? 0 : (r0 > 56 ? 56 : r0);
        int c0 = qc - 8; c0 = c0 < 0 ? 0 : (c0 > 48 ? 48 : c0);
        const bool ok = (kr >= r0) && (kr <= r0 + 7) && (kc >= c0) && (kc < c0 + 16);
        const int idx = ok ? ((kr - qr + 7) * 31 + (kc - qc + 15)) : 0;
        return ok ? (s2 + bl[idx]) : -1e30f;
    }
    DI bf16_t* optr(int q) const { return AO + (long)qtok(q) * 1024 + h * 64; }
};
struct PolMLA {
    static constexpr int DQK = 96; static constexpr bool SINK = false;
    const bf16_t* Q; const bf16_t* KV; const bf16_t* KR; bf16_t* AO; int b, h, qrow0, nt; float c2, sink2;
    DI void prologue(char*) const {}
    DI int ntiles() const { return nt; }
    DI int ktok(int j, int i) const { return (j < 4) ? (TL + b * 256 + 64 * j + i) : (b * 4096 + 64 * (j - 4) + i); }
    DI const bf16_t* qptr(int q, int ch) const { return Q + (long)(qrow0 + q) * 1536 + h * 96 + ch * 8; }
    DI const bf16_t* kptr(int j, int i, int ch) const { const long t = ktok(j, i); return (ch < 8) ? (KV + t * 2048 + h * 128 + ch * 8) : (KR + t * 32 + (ch - 8) * 8); }
    DI const bf16_t* vptr(int j, int i, int ch) const { return KV + (long)ktok(j, i) * 2048 + h * 128 + 64 + ch * 8; }
    DI float mod(float s2, int, int, int) const { return s2; }
    DI bf16_t* optr(int q) const { return AO + (long)(qrow0 + q) * 1024 + h * 64; }
};
struct PolSWA {
    static constexpr int DQK = 64; static constexpr bool SINK = true;
    const bf16_t* QKV; bf16_t* AO; int b, hq, s0; float c2, sink2;
    DI void prologue(char*) const {}
    DI int ntiles() const { return 10; }
    DI int ktok(int j, int i) const { if (j < 4) return TL + b * 256 + 64 * j + i; int kp = s0 - 128 + 64 * (j - 4) + i; kp = kp < 0 ? 0 : (kp > 4095 ? 4095 : kp); return b * 4096 + kp; }
    DI const bf16_t* qptr(int q, int ch) const { return QKV + (long)(b * 4096 + s0 + q) * 1536 + hq * 64 + ch * 8; }
    DI const bf16_t* kptr(int j, int i, int ch) const { return QKV + (long)ktok(j, i) * 1536 + 1024 + (hq >> 2) * 64 + ch * 8; }
    DI const bf16_t* vptr(int j, int i, int ch) const { return QKV + (long)ktok(j, i) * 1536 + 1280 + (hq >> 2) * 64 + ch * 8; }
    DI float mod(float s2, int q, int j, int kc) const {
        if (j < 4) return s2;
        const int kp = s0 - 128 + 64 * (j - 4) + kc, qp = s0 + q, d = qp - kp;
        const bool ok = (kp >= 0) && (kp < 4096) && (d <= 128) && (d >= -128);
        return ok ? s2 : -1e30f;
    }
    DI bf16_t* optr(int q) const { return AO + (long)(b * 4096 + s0 + q) * 1024 + hq * 64; }
};

DI float ftanh(float x) { return 2.0f * fsigmoid(2.0f * x) - 1.0f; }
struct EpiRW1 { bf16_t* RKV; bf16_t* LORA;
    DI f32x4 act(f32x4 a, int lc) const {
        f32x4 r;
#pragma unroll
        for (int i = 0; i < 4; ++i) r[i] = (lc < 128) ? fsigmoid(a[i]) : ((lc < 256) ? ftanh(a[i]) : a[i]);
        return r; }
    DI void operator()(int row, int col, f32x4 a0, f32x4 a1) const {
        if (col < 3072) { bf16_t* p = RKV + (long)row * 3072 + col; st_bf16x4(p, a0); st_bf16x4(p + 16, a1); }
        else if (col < 3456) { const int lc = col - 3072; bf16_t* p = LORA + (long)row * 384 + lc; st_bf16x4(p, act(a0, lc)); st_bf16x4(p + 16, act(a1, lc)); }
    } };
struct EpiRW2 { int seg; bf16_t* O; const float* bias;
    DI f32x4 f(f32x4 a, const float* bp) const {
        f32x4 r;
#pragma unroll
        for (int i = 0; i < 4; ++i) { const float t = fsigmoid(a[i] + bp[i]); r[i] = (seg < 3) ? 0.6065306597126334f * t : t; }
        return r; }
    DI void operator()(int row, int col, f32x4 a0, f32x4 a1) const {
        const int n = col - 1024 * seg; bf16_t* p = O + (long)row * 1024 + n;
        if (seg == 0) { st_bf16x4(p, a0); st_bf16x4(p + 16, a1); }
        else { st_bf16x4(p, f(a0, bias + n)); st_bf16x4(p + 16, f(a1, bias + n + 16)); }
    } };

DI void phase_rw_gemm2(const Params& p, const Bufs& B, const bf16_t* LORA, bf16_t* G, bf16_t* XD0, bf16_t* XD1, bf16_t* AA0, bf16_t* AA1, char* smem) {
    const int ntm = TT >> 7, nt = ntm * 40;
    for (int t = blockIdx.x; t < nt; t += gridDim.x) {
        const int tm = t / 40, tn = t % 40, seg = tn >> 3;
        GemmOp g; g.A = LORA; g.lda = 384; g.Bt = B.WMIX + W_RW_B2; g.ldb = 384;
        g.kbeg = (seg == 0) ? 0 : (64 + 64 * seg); g.kend = (seg == 0) ? 128 : (128 + 64 * seg);
        EpiRW2 e; e.seg = seg;
        e.O = (seg == 0) ? G : (seg == 1 ? XD0 : (seg == 2 ? XD1 : (seg == 3 ? AA0 : AA1)));
        e.bias = (seg == 0) ? nullptr : ((seg < 3) ? p.in[I_RW_W0] + (seg - 1) * 1024 : p.in[I_RW_A0] + (seg - 3) * 1024);
        gemm_tile(g, tm * 128, tn * 128, e, smem);
    }
}

template <int CTRL> DI float dppmov(float x) { return __int_as_float(__builtin_amdgcn_update_dpp(0, __float_as_int(x), CTRL, 0xf, 0xf, false)); }
DI float red8(float x) { x += dppmov<0xB1>(x); x += dppmov<0x4E>(x); x += dppmov<0x141>(x); return x; }

constexpr int SCAN_LDS = 32 * 384 * 4 + 32 * 64 * 4;
DI void phase_rw_scan(const Params& p, const bf16_t* RKV, const bf16_t* XD0, const bf16_t* XD1, const bf16_t* AA0, const bf16_t* AA1, bf16_t* YF, bf16_t* YB, char* smem) {
    float* vec = (float*)smem;
    float* ybuf = vec + 32 * 384;
    const int tid = threadIdx.x, lane = tid & 63, wv = tid >> 6, il = lane >> 3, js = lane & 7, irow = 8 * wv + il;
    const int ss = tid >> 4, jg = tid & 15;
    for (int unit = blockIdx.x; unit < 256; unit += gridDim.x) {
        const int dir = unit & 1, b = unit >> 5, h = (unit >> 1) & 15;
        const bf16_t* XD = dir ? XD1 : XD0; const bf16_t* AA = dir ? AA1 : AA0; bf16_t* Y = dir ? YB : YF;
        const f32x4 kk4 = *(const f32x4*)(p.in[I_RW_KK] + h * 64 + 4 * jg), ka4 = *(const f32x4*)(p.in[I_RW_KA] + h * 64 + 4 * jg);
        float S[8];
#pragma unroll
        for (int e = 0; e < 8; ++e) S[e] = 0.f;
        u32x2 pr, pk, pv, px, pa;
        long gcur;
        {   const int n = ss; const int t = dir ? 255 - n : n; gcur = TL + b * 256 + t;
            const long o = gcur * 3072 + h * 64 + 4 * jg, o1 = gcur * 1024 + h * 64 + 4 * jg;
            pr = *(const u32x2*)(RKV + o); pk = *(const u32x2*)(RKV + o + 1024); pv = *(const u32x2*)(RKV + o + 2048); px = *(const u32x2*)(XD + o1); pa = *(const u32x2*)(AA + o1); }
        for (int c = 0; c < 136; ++c) {
            __syncthreads();
            {
                float kf[4] = {bflo(pk.x), bfhi(pk.x), bflo(pk.y), bfhi(pk.y)};
                float af[4] = {bflo(pa.x), bfhi(pa.x), bflo(pa.y), bfhi(pa.y)};
                float xf[4] = {bflo(px.x), bfhi(px.x), bflo(px.y), bfhi(px.y)};
                f32x4 kkv, kka, kt, wv4, rv4, vv4;
                float sq = 0.f;
#pragma unroll
                for (int e = 0; e < 4; ++e) { kkv[e] = kf[e] * kk4[e]; sq += kkv[e] * kkv[e]; }
                sq += __shfl_xor(sq, 1); sq += __shfl_xor(sq, 2); sq += __shfl_xor(sq, 4); sq += __shfl_xor(sq, 8);
                const float inv = 1.0f / fmaxf(sqrtf(sq), 1e-12f);
#pragma unroll
                for (int e = 0; e < 4; ++e) { kkv[e] *= inv; kka[e] = kkv[e] * af[e]; kt[e] = kf[e] * (1.0f + (af[e] - 1.0f) * ka4[e]); wv4[e] = __expf(-xf[e]); }
                rv4 = (f32x4){bflo(pr.x), bfhi(pr.x), bflo(pr.y), bfhi(pr.y)};
                vv4 = (f32x4){bflo(pv.x), bfhi(pv.x), bflo(pv.y), bfhi(pv.y)};
                float* vb = vec + ss * 384 + 4 * jg;
                *(f32x4*)(vb) = wv4; *(f32x4*)(vb + 64) = kkv; *(f32x4*)(vb + 128) = kka; *(f32x4*)(vb + 192) = kt; *(f32x4*)(vb + 256) = rv4; *(f32x4*)(vb + 320) = vv4;
            }
            const long gthis = gcur;
            __syncthreads();
            if (c + 1 < 136) {
                const int n = (c + 1) * 32 + ss;
                if (n < 256) { const int t = dir ? 255 - n : n; gcur = TL + b * 256 + t; }
                else { const int mm = n - 256; const int t = dir ? 4095 - mm : mm; gcur = (long)b * 4096 + t; }
                const long o = gcur * 3072 + h * 64 + 4 * jg, o1 = gcur * 1024 + h * 64 + 4 * jg;
                pr = *(const u32x2*)(RKV + o); pk = *(const u32x2*)(RKV + o + 1024); pv = *(const u32x2*)(RKV + o + 2048); px = *(const u32x2*)(XD + o1); pa = *(const u32x2*)(AA + o1);
            }
#pragma unroll 2
            for (int s = 0; s < 32; ++s) {
                const float* vb = vec + s * 384 + 8 * js;
                const f32x4 w0 = *(const f32x4*)(vb), w1 = *(const f32x4*)(vb + 4), k0 = *(const f32x4*)(vb + 64), k1 = *(const f32x4*)(vb + 68);
                const f32x4 a0 = *(const f32x4*)(vb + 128), a1 = *(const f32x4*)(vb + 132), t0 = *(const f32x4*)(vb + 192), t1 = *(const f32x4*)(vb + 196);
                const f32x4 r0 = *(const f32x4*)(vb + 256), r1 = *(const f32x4*)(vb + 260);
                const float vi = vec[s * 384 + 320 + irow];
                float sk = S[0] * k0[0] + S[1] * k0[1] + S[2] * k0[2] + S[3] * k0[3] + S[4] * k1[0] + S[5] * k1[1] + S[6] * k1[2] + S[7] * k1[3];
                sk = red8(sk);
#pragma unroll
                for (int e = 0; e < 4; ++e) { S[e] = S[e] * w0[e] - sk * a0[e] + vi * t0[e]; S[4 + e] = S[4 + e] * w1[e] - sk * a1[e] + vi * t1[e]; }
                float y = S[0] * r0[0] + S[1] * r0[1] + S[2] * r0[2] + S[3] * r0[3] + S[4] * r1[0] + S[5] * r1[1] + S[6] * r1[2] + S[7] * r1[3];
                y = red8(y);
                if (js == 0) ybuf[s * 64 + irow] = y;
            }
            __syncthreads();
            {
                const f32x4 yv = *(const f32x4*)(ybuf + ss * 64 + 4 * jg);
                st_bf16x4(Y + gthis * 1024 + h * 64 + 4 * jg, yv);
            }
        }
    }
}

DI void ld16f(const float* p, float* v) {
#pragma unroll
    for (int i = 0; i < 4; ++i) { const f32x4 t = *(const f32x4*)(p + 4 * i); v[4 * i] = t[0]; v[4 * i + 1] = t[1]; v[4 * i + 2] = t[2]; v[4 * i + 3] = t[3]; } }
DI void phase_rw_readout(const Params& p, const bf16_t* RKV, const bf16_t* AA0, const bf16_t* AA1, const bf16_t* G, const bf16_t* YF, const bf16_t* YB, bf16_t* Z) {
    const int lane = threadIdx.x & 63, gw = blockIdx.x * 8 + (threadIdx.x >> 6), nw = gridDim.x * 8, col = 16 * lane;
    float lng[16], lnb[16], ka[16], rk[16];
    ld16f(p.in[I_RW_LNG] + col, lng); ld16f(p.in[I_RW_LNB] + col, lnb); ld16f(p.in[I_RW_KA] + col, ka); ld16f(p.in[I_RW_RK] + col, rk);
    for (int g = gw; g < TT; g += nw) {
        float y[16], t[16], r[16], k[16], v[16], a0[16], a1[16], gg[16];
        ld16(YF + (size_t)g * 1024 + col, y); ld16(YB + (size_t)g * 1024 + col, t);
        ld16(RKV + (size_t)g * 3072 + col, r); ld16(RKV + (size_t)g * 3072 + 1024 + col, k); ld16(RKV + (size_t)g * 3072 + 2048 + col, v);
        ld16(AA0 + (size_t)g * 1024 + col, a0); ld16(AA1 + (size_t)g * 1024 + col, a1); ld16(G + (size_t)g * 1024 + col, gg);
        float sm = 0.f;
#pragma unroll
        for (int e = 0; e < 16; ++e) { y[e] += t[e]; sm += y[e]; }
        sm += __shfl_xor(sm, 1); sm += __shfl_xor(sm, 2);
        const float mu = sm * (1.0f / 64.0f);
        float sv = 0.f, bs = 0.f;
#pragma unroll
        for (int e = 0; e < 16; ++e) { y[e] -= mu; sv += y[e] * y[e];
            const float kt0 = k[e] * (1.0f + (a0[e] - 1.0f) * ka[e]), kt1 = k[e] * (1.0f + (a1[e] - 1.0f) * ka[e]);
            bs += r[e] * (kt0 + kt1) * rk[e]; }
        sv += __shfl_xor(sv, 1); sv += __shfl_xor(sv, 2); bs += __shfl_xor(bs, 1); bs += __shfl_xor(bs, 2);
        const float rs = rsqrtf(sv * (1.0f / 64.0f) + 64e-5f);
#pragma unroll
        for (int e = 0; e < 16; ++e) y[e] = (y[e] * rs * lng[e] + lnb[e] + bs * v[e]) * gg[e];
        st16(Z + (size_t)g * 1024 + col, y);
    }
}

constexpr int TOPK_LDS = 4096 * 8;
DI void phase_topk(const Bufs& B, const bf16_t* H, bf16_t* XIN, bool has_ctx, char* smem) {
    unsigned long long* keys = (unsigned long long*)smem;
    const int tid = threadIdx.x, lane = tid & 63, wv = tid >> 6;
    const int nlists = has_ctx ? 256 : 128;
    for (int u = blockIdx.x; u < nlists; u += gridDim.x) {
        const bool isc = u >= 128; const int li = u & 127, b = li >> 4, e = li & 15;
        const int n = isc ? 256 : 4096, kcap = isc ? 32 : 512;
        const float* src = isc ? (B.AFFC + (size_t)(b * 16 + e) * 256) : (B.AFF + (size_t)(b * 16 + e) * 4096);
        __syncthreads();
        for (int i = tid; i < n; i += NTHR) keys[i] = ((unsigned long long)__float_as_uint(src[i]) << 32) | (unsigned long long)(0xFFFFFFFFu - (unsigned)i);
        __syncthreads();
        for (int k2 = 2; k2 <= n; k2 <<= 1)
            for (int j = k2 >> 1; j > 0; j >>= 1) {
                for (int pi = tid; pi < (n >> 1); pi += NTHR) {
                    const int i = ((pi & ~(j - 1)) << 1) | (pi & (j - 1)), ix = i | j;
                    const bool up = (i & k2) == 0;
                    const unsigned long long a = keys[i], c = keys[ix];
                    if (up ? (a < c) : (a > c)) { keys[i] = c; keys[ix] = a; }
                }
                __syncthreads();
            }
        for (int c = tid; c < kcap; c += NTHR) {
            const unsigned long long key = keys[c];
            const int idx = (int)(0xFFFFFFFFu - (unsigned)(key & 0xFFFFFFFFull));
            const int g = isc ? (TL + b * 256 + idx) : (b * 4096 + idx);
            const int er = isc ? (4096 + b * 32 + c) : (b * 512 + c);
            B.IDX[e * EROWS + er] = g; B.GATE[e * EROWS + er] = __uint_as_float((unsigned)(key >> 32)); B.INV[(size_t)g * 16 + e] = er;
        }
        for (int c = wv; c < kcap; c += 8) {
            const unsigned long long key = keys[c];
            const int idx = (int)(0xFFFFFFFFu - (unsigned)(key & 0xFFFFFFFFull));
            const int g = isc ? (TL + b * 256 + idx) : (b * 4096 + idx);
            const int er = isc ? (4096 + b * 32 + c) : (b * 512 + c);
            const bf16_t* s = H + (size_t)g * 1024; bf16_t* d = XIN + ((size_t)e * EROWS + er) * 1024;
            *(u32x4*)(d + lane * 8) = *(const u32x4*)(s + lane * 8); *(u32x4*)(d + 512 + lane * 8) = *(const u32x4*)(s + 512 + lane * 8);
        }
    }
}
DI void phase_moe_gemm1(const Bufs& B, const bf16_t* XIN, bf16_t* HID, bool has_ctx, char* smem) {
    const int ntm = (has_ctx ? EROWS : 4096) >> 7, per = ntm * 16, nt = NEXP * per;
    for (int t = blockIdx.x; t < nt; t += gridDim.x) {
        const int e = t / per, r = t % per, tm = r >> 4, tn = r & 15;
        GemmOp g; g.A = XIN + (size_t)e * EROWS * 1024; g.lda = 1024; g.Bt = B.W13 + (size_t)e * 2048 * 1024; g.ldb = 1024; g.kbeg = 0; g.kend = 1024;
        EpiSwiglu ep; ep.O = HID + (size_t)e * EROWS * 1024;
        gemm_tile(g, tm * 128, tn * 128, ep, smem);
    }
}
DI void phase_moe_gemm2(const Bufs& B, const bf16_t* HID, bf16_t* Y, bool has_ctx, char* smem) {
    const int ntm = (has_ctx ? EROWS : 4096) >> 7, per = ntm * 8, nt = NEXP * per;
    for (int t = blockIdx.x; t < nt; t += gridDim.x) {
        const int e = t / per, r = t % per, tm = r >> 3, tn = r & 7;
        GemmOp g; g.A = HID + (size_t)e * EROWS * 1024; g.lda = 1024; g.Bt = B.W2T + (size_t)e * 1024 * 1024; g.ldb = 1024; g.kbeg = 0; g.kend = 1024;
        EpiGate ep; ep.O = Y + (size_t)e * EROWS * 1024; ep.gate = B.GATE + e * EROWS;
        gemm_tile(g, tm * 128, tn * 128, ep, smem);
    }
}
DI void phase_combine(const Params& p, const Bufs& B, int layer, const bf16_t* Y, int ntok, bool last) {
    const int lane = threadIdx.x & 63, gw = blockIdx.x * 8 + (threadIdx.x >> 6), nw = gridDim.x * 8;
    for (int g = gw; g < ntok; g += nw) {
        float acc[16];
#pragma unroll
        for (int e = 0; e < 16; ++e) acc[e] = 0.f;
        for (int e = 0; e < NEXP; ++e) {
            const int c = B.INV[(size_t)g * 16 + e];
            if (c >= 0) {
                const bf16_t* yr = Y + ((size_t)e * EROWS + c) * 1024 + 4 * lane;
#pragma unroll
                for (int i = 0; i < 4; ++i) { const u32x2 t = *(const u32x2*)(yr + 256 * i); acc[4 * i] += bflo(t.x); acc[4 * i + 1] += bfhi(t.x); acc[4 * i + 2] += bflo(t.y); acc[4 * i + 3] += bfhi(t.y); }
            }
        }
        const float* gt = B.MOD + ((size_t)layer * 9 + modrow_of(g)) * 6144 + 5 * 1024;
        float* xr = B.X + (size_t)g * 1024;
#pragma unroll
        for (int i = 0; i < 4; ++i) {
            const f32x4 gv = *(const f32x4*)(gt + 256 * i + 4 * lane); f32x4 xv = *(const f32x4*)(xr + 256 * i + 4 * lane);
            xv[0] += gv[0] * acc[4 * i]; xv[1] += gv[1] * acc[4 * i + 1]; xv[2] += gv[2] * acc[4 * i + 2]; xv[3] += gv[3] * acc[4 * i + 3];
            *(f32x4*)(xr + 256 * i + 4 * lane) = xv;
            if (last) *(f32x4*)(p.out + (size_t)g * 1024 + 256 * i + 4 * lane) = xv;
        }
    }
}

DI void phase_attn_na(const Params& p, const bf16_t* QKV, bf16_t* AO, char* smem) {
    for (int u = blockIdx.x; u < 4096 + 256; u += gridDim.x) {
        if (u < 4096) {
            PolNA pol; pol.QKV = QKV; pol.AO = AO; pol.rpb = p.in[I_NA_RPB]; pol.bl = (const float*)(smem + 64 * 104 * 2 + 64 * 72 * 2);
            pol.b = u >> 9; pol.h = (u >> 5) & 15; pol.rr = u & 31;
            int rb = 2 * pol.rr - 4; rb = rb < 0 ? 0 : (rb > 56 ? 56 : rb); pol.rbase = rb;
            pol.c2 = 0.125f * LOG2E; pol.sink2 = 0.f;
            attn_unit(pol, smem);
        } else {
            const int v = u - 4096, b = v >> 5, h = (v >> 1) & 15, half = v & 1;
            PolPlain64 pol; pol.Qb = QKV + h * 64; pol.qs = 3072; pol.Kb = QKV + 1024 + h * 64; pol.ks = 3072; pol.Vb = QKV + 2048 + h * 64; pol.vs = 3072;
            pol.Ob = AO + h * 64; pol.os = 1024; pol.qrow0 = TL + b * 256 + 128 * half; pol.krow0 = TL + b * 256; pol.nt = 4; pol.c2 = 0.125f * LOG2E; pol.sink2 = 0.f;
            attn_unit(pol, smem);
        }
    }
}
DI void phase_attn_mla(const bf16_t* Q, const bf16_t* KV, const bf16_t* KR, bf16_t* AO, char* smem) {
    for (int u = blockIdx.x; u < 4096 + 256; u += gridDim.x) {
        PolMLA pol; pol.Q = Q; pol.KV = KV; pol.KR = KR; pol.AO = AO; pol.c2 = 0.10206207261596575f * LOG2E; pol.sink2 = 0.f;
        if (u < 4096) { pol.b = u >> 9; pol.h = (u >> 5) & 15; pol.qrow0 = pol.b * 4096 + 128 * (u & 31); pol.nt = 68; }
        else { const int v = u - 4096; pol.b = v >> 5; pol.h = (v >> 1) & 15; pol.qrow0 = TL + pol.b * 256 + 128 * (v & 1); pol.nt = 4; }
        attn_unit(pol, smem);
    }
}
DI void phase_attn_swa(const Params& p, const bf16_t* QKV, bf16_t* AO, char* smem) {
    for (int u = blockIdx.x; u < 4096; u += gridDim.x) {
        PolSWA pol; pol.QKV = QKV; pol.AO = AO; pol.b = u >> 9; pol.hq = (u >> 5) & 15; pol.s0 = 128 * (u & 31);
        pol.c2 = 0.125f * LOG2E; pol.sink2 = p.in[I_SWA_SINK][pol.hq] * LOG2E;
        attn_unit(pol, smem);
    }
}

constexpr int N_PHASES = 44;
constexpr int LDS_BYTES = 73728;
static_assert(GT_LDS <= LDS_BYTES && SCAN_LDS <= LDS_BYTES && ATT_LDS <= LDS_BYTES && TOPK_LDS <= LDS_BYTES && 65536 <= LDS_BYTES, "lds");

template <int SUB>
DI void moe_phase(const Params& p, const Bufs& B, int layer, char* smem) {
    const bool has_ctx = layer < 3;
    const int ntok = has_ctx ? TT : TL;
    bf16_t* H = B.slot(0); bf16_t* XIN = B.slot(1); bf16_t* HID = B.slot(3); bf16_t* Y = B.slot(1);
    if constexpr (SUB == 0) phase_norm2(p, B, layer, H, ntok, smem);
    else if constexpr (SUB == 1) phase_topk(B, H, XIN, has_ctx, smem);
    else if constexpr (SUB == 2) phase_moe_gemm1(B, XIN, HID, has_ctx, smem);
    else if constexpr (SUB == 3) phase_moe_gemm2(B, HID, Y, has_ctx, smem);
    else { phase_combine(p, B, layer, Y, ntok, layer == 3); if (layer < 3) { int base = 0; conv_moe_layer(p, B, layer + 1, base, smem); } }
}

template <int PH>
DI void run_phase(const Params& p, char* smem) {
    const Bufs B = make_bufs(p);
    bf16_t* H = B.slot(0);
    if constexpr (PH == 0) phase_prologue(p, B, smem);
    else if constexpr (PH == 1) phase_norm1(p, B, 0, H);
    else if constexpr (PH == 2) { GemmOp g{H, 1024, B.WMIX + W_NA_QKV, 1024, 0, 1024}; EpiBf16 e{B.slot(1), 3072}; gemm_all(g, TT, 3072, e, smem); }
    else if constexpr (PH == 3) phase_qknorm_na(p, B.slot(1));
    else if constexpr (PH == 4) phase_attn_na(p, B.slot(1), B.slot(4), smem);
    else if constexpr (PH == 5) { GemmOp g{B.slot(4), 1024, B.WMIX + W_NA_WO, 1024, 0, 1024}; EpiResidual e{B.X, B.MOD + (size_t)0 * 9 * 6144 + 2 * 1024}; gemm_all(g, TT, 1024, e, smem); }
    else if constexpr (PH >= 6 && PH <= 10) moe_phase<PH - 6>(p, B, 0, smem);
    else if constexpr (PH == 11) phase_norm1_rw(p, B, 1, B.slot(0));
    else if constexpr (PH == 12) { GemmOp g{B.slot(0), 2048, B.WMIX + W_RW_B1, 2048, 0, 2048}; EpiRW1 e{B.slot(2), B.slot(5)}; gemm_all(g, TT, 3584, e, smem); }
    else if constexpr (PH == 13) phase_rw_gemm2(p, B, B.slot(5), B.slot(0), B.slot(1), B.slot(6), B.slot(7), B.slot(8), smem);
    else if constexpr (PH == 14) phase_rw_scan(p, B.slot(2), B.slot(1), B.slot(6), B.slot(7), B.slot(8), B.slot(9), B.slot(5), smem);
    else if constexpr (PH == 15) phase_rw_readout(p, B.slot(2), B.slot(7), B.slot(8), B.slot(0), B.slot(9), B.slot(5), B.slot(1));
    else if constexpr (PH == 16) { GemmOp g{B.slot(1), 1024, B.WMIX + W_RW_WO, 1024, 0, 1024}; EpiResidual e{B.X, B.MOD + (size_t)1 * 9 * 6144 + 2 * 1024}; gemm_all(g, TT, 1024, e, smem); }
    else if constexpr (PH >= 17 && PH <= 21) moe_phase<PH - 17>(p, B, 1, smem);
    else if constexpr (PH == 22) phase_norm1(p, B, 2, H);
    else if constexpr (PH == 23) { GemmOp g{H, 1024, B.WMIX + W_MLA_DOWN, 1024, 0, 1024}; EpiF32 e{(float*)B.slot(1), 768}; gemm_all(g, TT, 768, e, smem); }
    else if constexpr (PH == 24) { bf16_t* CQ = B.slot(3); phase_mla_dnorm(p, B, (const float*)B.slot(1), CQ, CQ + (size_t)TT * 384, CQ + (size_t)TT * 640); }
    else if constexpr (PH == 25) {
        bf16_t* CQ = B.slot(3);
        { GemmOp g{CQ, 384, B.WMIX + W_MLA_UQ, 384, 0, 384}; EpiBf16 e{B.slot(4), 1536}; gemm_all(g, TT, 1536, e, smem); }
        { GemmOp g{CQ + (size_t)TT * 384, 256, B.WMIX + W_MLA_UKV, 256, 0, 256}; EpiBf16 e{B.slot(6), 2048}; gemm_all(g, TT, 2048, e, smem); }
    }
    else if constexpr (PH == 26) phase_mla_hnorm(p, B, B.slot(4), B.slot(6));
    else if constexpr (PH == 27) phase_attn_mla(B.slot(4), B.slot(6), B.slot(3) + (size_t)TT * 640, B.slot(8), smem);
    else if constexpr (PH == 28) { GemmOp g{B.slot(8), 1024, B.WMIX + W_MLA_WO, 1024, 0, 1024}; EpiResidual e{B.X, B.MOD + (size_t)2 * 9 * 6144 + 2 * 1024}; gemm_all(g, TT, 1024, e, smem); }
    else if constexpr (PH >= 29 && PH <= 33) moe_phase<PH - 29>(p, B, 2, smem);
    else if constexpr (PH == 34) phase_norm1(p, B, 3, H);
    else if constexpr (PH == 35) { GemmOp g{H, 1024, B.WMIX + W_SWA_QKV, 1024, 0, 1024}; EpiBf16 e{B.slot(1), 1536}; gemm_all(g, TT, 1536, e, smem); }
    else if constexpr (PH == 36) phase_qknorm_swa(p, B, B.slot(1));
    else if constexpr (PH == 37) phase_attn_swa(p, B.slot(1), B.slot(3), smem);
    else if constexpr (PH == 38) { GemmOp g{B.slot(3), 1024, B.WMIX + W_SWA_WO, 1024, 0, 1024}; EpiResidual e{B.X, B.MOD + (size_t)3 * 9 * 6144 + 2 * 1024}; gemm_all(g, TL, 1024, e, smem); }
    else if constexpr (PH >= 39 && PH <= 43) moe_phase<PH - 39>(p, B, 3, smem);
}

template <int PH>
__global__ void __launch_bounds__(NTHR, 2) k_phase(Params p) {
    extern __shared__ __attribute__((aligned(16))) char smem[];
    run_phase<PH>(p, smem);
}

template <int PH>
static void launch_from(const Params& p, int grid, hipStream_t stream, bool setattr) {
    if constexpr (PH < N_PHASES) {
        if (setattr) (void)hipFuncSetAttribute((const void*)k_phase<PH>, hipFuncAttributeMaxDynamicSharedMemorySize, LDS_BYTES);
        else hipLaunchKernelGGL(k_phase<PH>, dim3(grid), dim3(NTHR), LDS_BYTES, stream, p);
        launch_from<PH + 1>(p, grid, stream, setattr);
    }
}

extern "C" void kernel_launch(void* const* d_in, const int* in_sizes, int n_in, void* d_out, int out_size, void* d_ws, size_t ws_size, hipStream_t stream) {
    static int grid = 0;
    Params p{};
    for (int i = 0; i < N_INPUTS; ++i) p.in[i] = (const float*)d_in[i];
    p.out = (float*)d_out; p.ws = (unsigned char*)d_ws;
    if (grid == 0) {
        if (n_in != N_INPUTS || out_size != TL * 1024 || ws_size < WS_NEED) { grid = -1; return; }
        int dev = 0, cus = 0;
        if (hipGetDevice(&dev) != hipSuccess || hipDeviceGetAttribute(&cus, hipDeviceAttributeMultiprocessorCount, dev) != hipSuccess) { grid = -1; return; }
        launch_from<0>(p, 0, stream, true);
        grid = cus > 0 ? cus : 256;
    }
    if (grid < 0) return;
    (void)hipMemsetAsync((char*)d_ws + OFF_CTL, 0, 65536, stream);
    launch_from<0>(p, grid, stream, false);
}
```

```cpp
#include <hip/hip_runtime.h>
#include <stdint.h>

#ifndef MULTI_LAUNCH
#define MULTI_LAUNCH 0
#endif

typedef unsigned short bf16_t;
typedef short bf16x8 __attribute__((ext_vector_type(8)));
typedef short s16x4 __attribute__((ext_vector_type(4)));
typedef float f32x4 __attribute__((ext_vector_type(4)));
typedef unsigned u32x4 __attribute__((ext_vector_type(4)));
typedef unsigned u32x2 __attribute__((ext_vector_type(2)));
#define LAS __attribute__((address_space(3)))
#define DI __device__ __forceinline__

constexpr int NTHR = 512;
constexpr int D = 1024, NB = 8, SEQ = 4096, CTXL = 256;
constexpr int TL = NB * SEQ, TC = NB * CTXL, TT = TL + TC;
constexpr int NEXP = 16, CAPL = 512, CAPC = 32, EROWS = NB * CAPL + NB * CAPC;
constexpr float LOG2E = 1.4426950408889634f;

enum { I_X = 0, I_C, I_CTX, I_CCTX, I_N1G, I_N2G, I_ADAW, I_ADAB,
       I_NA_WQKV, I_NA_QG, I_NA_KG, I_NA_RPB, I_NA_WO,
       I_RW_MIX, I_RW_WR, I_RW_WK, I_RW_WV, I_RW_W0, I_RW_W1, I_RW_W2, I_RW_A0, I_RW_A1, I_RW_A2, I_RW_G1, I_RW_G2,
       I_RW_KK, I_RW_KA, I_RW_RK, I_RW_LNG, I_RW_LNB, I_RW_WO,
       I_MLA_WDOWN, I_MLA_QNG, I_MLA_KVNG, I_MLA_WUQ, I_MLA_WUKV, I_MLA_QN_G, I_MLA_QR_G, I_MLA_KN_G, I_MLA_KR_G, I_MLA_WO,
       I_SWA_WQKV, I_SWA_QG, I_SWA_KG, I_SWA_SINK, I_SWA_WO,
       I_MOE_ROUTER, I_MOE_W1, I_MOE_W3, I_MOE_W2, N_INPUTS };

constexpr size_t MiB = 1u << 20;
constexpr size_t OFF_CTL = 0;
constexpr size_t OFF_MOD = 65536;
constexpr size_t OFF_ROPE_M = OFF_MOD + 4 * 9 * 6144 * 4;
constexpr size_t OFF_ROPE_S = OFF_ROPE_M + 2 * 4096 * 16 * 4;
constexpr size_t OFF_X = 4 * MiB;
constexpr size_t OFF_WMIX = 140 * MiB;
constexpr size_t OFF_WE = 180 * MiB;
constexpr size_t OFF_MISC = 276 * MiB;
constexpr size_t OFF_WORK = 284 * MiB;
constexpr size_t USLOT = (size_t)TT * 1024 * 2;
constexpr size_t WS_NEED = OFF_WORK + 10 * USLOT;
static_assert(OFF_ROPE_S + 2 * 4096 * 32 * 4 <= OFF_X, "map");
static_assert(OFF_X + (size_t)TT * 1024 * 4 <= OFF_WMIX, "map");

constexpr size_t W_NA_QKV = 0, W_NA_WO = 3145728, W_RW_B1 = 4194304, W_RW_B2 = 11534336, W_RW_WO = 13500416,
                 W_MLA_DOWN = 14548992, W_MLA_UQ = 15335424, W_MLA_UKV = 15925248, W_MLA_WO = 16449536,
                 W_SWA_QKV = 17498112, W_SWA_WO = 19070976, W_MIX_END = 20119552;
static_assert(OFF_WMIX + W_MIX_END * 2 <= OFF_WE, "map");
static_assert(OFF_WE + 96 * MiB <= OFF_MISC, "map");
constexpr size_t OFF_AFF = OFF_MISC;
constexpr size_t OFF_AFFC = OFF_AFF + 8 * 16 * 4096 * 4;
constexpr size_t OFF_IDX = OFF_AFFC + 8 * 16 * 256 * 4;
constexpr size_t OFF_GATE = OFF_IDX + 16 * EROWS * 4;
constexpr size_t OFF_INV = OFF_GATE + 16 * EROWS * 4;
static_assert(OFF_INV + (size_t)TT * 16 * 4 <= OFF_WORK, "map");

struct Params {
    const float* in[N_INPUTS];
    float* out;
    unsigned char* ws;
};

DI unsigned f2bf(float f) { unsigned u = __float_as_uint(f); return (u + 0x7fffu + ((u >> 16) & 1u)) >> 16; }
DI unsigned pk2(float lo, float hi) { return f2bf(lo) | (f2bf(hi) << 16); }
DI float bf2f(unsigned b) { return __uint_as_float(b << 16); }
DI float bflo(unsigned w) { return __uint_as_float(w << 16); }
DI float bfhi(unsigned w) { return __uint_as_float(w & 0xffff0000u); }
DI float wave_sum(float v) {
    v += __shfl_xor(v, 32); v += __shfl_xor(v, 16); v += __shfl_xor(v, 8); v += __shfl_xor(v, 4); v += __shfl_xor(v, 2); v += __shfl_xor(v, 1); return v; }
DI float fsigmoid(float x) { return 1.0f / (1.0f + __expf(-x)); }
DI float fexp2(float x) { return __builtin_amdgcn_exp2f(x); }
DI int modrow_of(int g) { return g < TL ? (g >> 12) : 8; }
DI void unpack8(u32x4 v, float* f) { f[0] = bflo(v.x); f[1] = bfhi(v.x); f[2] = bflo(v.y); f[3] = bfhi(v.y); f[4] = bflo(v.z); f[5] = bfhi(v.z); f[6] = bflo(v.w); f[7] = bfhi(v.w); }
DI u32x4 pack8(const float* f) { u32x4 v; v.x = pk2(f[0], f[1]); v.y = pk2(f[2], f[3]); v.z = pk2(f[4], f[5]); v.w = pk2(f[6], f[7]); return v; }

struct GemmOp { const bf16_t* A; long lda; const bf16_t* Bt; long ldb; int kbeg, kend; };
constexpr int GT_LDS = 4 * 128 * 72 * 2;

template <class Epi>
DI void gemm_tile(const GemmOp& g, int row0, int col0, const Epi& epi, char* smem) {
    const int tid = threadIdx.x, lane = tid & 63, w = tid >> 6, wm = w >> 2, wn = w & 3, l15 = lane & 15, quad = lane >> 4;
    bf16_t* As = (bf16_t*)smem;
    bf16_t* Bs = As + 2 * 128 * 72;
    const int lr = tid >> 3, lc = (tid & 7) * 8;
    const bf16_t* ga0 = g.A + (long)(row0 + lr) * g.lda + g.kbeg + lc;
    const bf16_t* ga1 = ga0 + 64 * g.lda;
    const bf16_t* gb0 = g.Bt + (long)(col0 + lr) * g.ldb + g.kbeg + lc;
    const bf16_t* gb1 = gb0 + 64 * g.ldb;
    f32x4 acc[4][2];
#pragma unroll
    for (int i = 0; i < 4; ++i) { acc[i][0] = (f32x4){0.f, 0.f, 0.f, 0.f}; acc[i][1] = (f32x4){0.f, 0.f, 0.f, 0.f}; }
    u32x4 ra0 = *(const u32x4*)ga0, ra1 = *(const u32x4*)ga1, rb0 = *(const u32x4*)gb0, rb1 = *(const u32x4*)gb1;
    *(u32x4*)(As + lr * 72 + lc) = ra0; *(u32x4*)(As + (lr + 64) * 72 + lc) = ra1;
    *(u32x4*)(Bs + lr * 72 + lc) = rb0; *(u32x4*)(Bs + (lr + 64) * 72 + lc) = rb1;
    __syncthreads();
    const int nk = (g.kend - g.kbeg) >> 6;
    for (int kt = 0; kt < nk; ++kt) {
        const int cur = kt & 1;
        const bool more = (kt + 1 < nk);
        if (more) { const int ko = (kt + 1) * 64; ra0 = *(const u32x4*)(ga0 + ko); ra1 = *(const u32x4*)(ga1 + ko); rb0 = *(const u32x4*)(gb0 + ko); rb1 = *(const u32x4*)(gb1 + ko); }
        const bf16_t* a = As + cur * 128 * 72;
        const bf16_t* b = Bs + cur * 128 * 72;
#pragma unroll
        for (int ks = 0; ks < 2; ++ks) {
            bf16x8 af[4], bfr[2];
#pragma unroll
            for (int mt = 0; mt < 4; ++mt) af[mt] = *(const bf16x8*)(a + (wm * 64 + mt * 16 + l15) * 72 + ks * 32 + quad * 8);
#pragma unroll
            for (int nt = 0; nt < 2; ++nt) bfr[nt] = *(const bf16x8*)(b + (wn * 32 + nt * 16 + l15) * 72 + ks * 32 + quad * 8);
#pragma unroll
            for (int mt = 0; mt < 4; ++mt)
#pragma unroll
                for (int nt = 0; nt < 2; ++nt) acc[mt][nt] = __builtin_amdgcn_mfma_f32_16x16x32_bf16(bfr[nt], af[mt], acc[mt][nt], 0, 0, 0);
        }
        if (more) {
            bf16_t* a2 = As + (cur ^ 1) * 128 * 72; bf16_t* b2 = Bs + (cur ^ 1) * 128 * 72;
            *(u32x4*)(a2 + lr * 72 + lc) = ra0; *(u32x4*)(a2 + (lr + 64) * 72 + lc) = ra1;
            *(u32x4*)(b2 + lr * 72 + lc) = rb0; *(u32x4*)(b2 + (lr + 64) * 72 + lc) = rb1;
        }
        __syncthreads();
    }
#pragma unroll
    for (int mt = 0; mt < 4; ++mt) epi(row0 + wm * 64 + mt * 16 + l15, col0 + wn * 32 + quad * 4, acc[mt][0], acc[mt][1]);
}

template <class Epi>
DI void gemm_all(const GemmOp& g, int M, int N, const Epi& epi, char* smem) {
    const int ntn = N >> 7, nt = (M >> 7) * ntn;
    for (int t = blockIdx.x; t < nt; t += gridDim.x) gemm_tile(g, (t / ntn) * 128, (t % ntn) * 128, epi, smem);
}

DI void st_bf16x4(bf16_t* p, f32x4 a) { u32x2 v; v.x = pk2(a[0], a[1]); v.y = pk2(a[2], a[3]); *(u32x2*)p = v; }
struct EpiBf16 { bf16_t* O; long ldo;
    DI void operator()(int row, int col, f32x4 a0, f32x4 a1) const { bf16_t* p = O + (long)row * ldo + col; st_bf16x4(p, a0); st_bf16x4(p + 16, a1); } };
struct EpiF32 { float* O; long ldo;
    DI void operator()(int row, int col, f32x4 a0, f32x4 a1) const { float* p = O + (long)row * ldo + col; *(f32x4*)p = a0; *(f32x4*)(p + 16) = a1; } };
struct EpiResidual { float* X; const float* gate;
    DI void operator()(int row, int col, f32x4 a0, f32x4 a1) const {
        const float* gp = gate + (long)modrow_of(row) * 6144 + col; float* xp = X + (long)row * 1024 + col;
        f32x4 g0 = *(const f32x4*)gp, g1 = *(const f32x4*)(gp + 16), x0 = *(const f32x4*)xp, x1 = *(const f32x4*)(xp + 16);
        *(f32x4*)xp = x0 + g0 * a0; *(f32x4*)(xp + 16) = x1 + g1 * a1; } };
struct EpiSwiglu { bf16_t* O;
    DI void operator()(int row, int col, f32x4 a0, f32x4 a1) const {
        const int f = ((col >> 7) << 6) + (((col & 127) >> 5) << 4) + (col & 15);
        f32x4 h;
#pragma unroll
        for (int i = 0; i < 4; ++i) h[i] = a0[i] * fsigmoid(a0[i]) * a1[i];
        st_bf16x4(O + (long)row * 1024 + f, h); } };
struct EpiGate { bf16_t* O; const float* gate;
    DI void operator()(int row, int col, f32x4 a0, f32x4 a1) const { const float gt = gate[row]; bf16_t* p = O + (long)row * 1024 + col; st_bf16x4(p, a0 * gt); st_bf16x4(p + 16, a1 * gt); } };

template <int MODE>
DI void conv_tiles(const float* src, int K, int N, int Npad, bf16_t* dst, long ldd, int koff, int rowoff,
                   const float* mixv, float alpha, float beta, int& base, char* smem) {
    float* t = (float*)smem;
    const int tid = threadIdx.x;
    const int G = gridDim.x;
    const int ntn = Npad >> 6, ntiles = (K >> 6) * ntn;
    int first = ((int)blockIdx.x - (base % G) + G) % G;
    base += ntiles;
    for (int ti = first; ti < ntiles; ti += G) {
        const int k0 = (ti / ntn) << 6, n0 = (ti % ntn) << 6;
        {
            const int k = tid >> 3, n8 = (tid & 7) * 8;
            const float sc = mixv ? (alpha + beta * mixv[k0 + k]) : 1.0f;
            f32x4 v0 = (f32x4){0.f, 0.f, 0.f, 0.f}, v1 = v0;
            if (n0 + n8 < N) { const float* sp = src + (long)(k0 + k) * N + n0 + n8; v0 = *(const f32x4*)sp; v1 = *(const f32x4*)(sp + 4); }
            float* tp = t + k * 65 + n8;
            tp[0] = v0[0] * sc; tp[1] = v0[1] * sc; tp[2] = v0[2] * sc; tp[3] = v0[3] * sc; tp[4] = v1[0] * sc; tp[5] = v1[1] * sc; tp[6] = v1[2] * sc; tp[7] = v1[3] * sc;
        }
        __syncthreads();
        {
            const int n = tid >> 3, kc = (tid & 7) * 8;
            float f[8];
#pragma unroll
            for (int j = 0; j < 8; ++j) f[j] = t[(kc + j) * 65 + n];
            const int nn = n0 + n;
            const int r = (MODE == 1) ? (128 * (nn >> 6) + 32 * ((nn >> 4) & 3) + (nn & 15)) : nn;
            *(u32x4*)(dst + (long)(r + rowoff) * ldd + koff + k0 + kc) = pack8(f);
        }
        __syncthreads();
    }
}
DI void zero_bf16(bf16_t* dst, long n8  ) {
    for (long i = (long)blockIdx.x * NTHR + threadIdx.x; i < n8; i += (long)gridDim.x * NTHR) *(u32x4*)(dst + i * 8) = (u32x4){0u, 0u, 0u, 0u};
}

struct Bufs {
    float* MOD; float* ROPE_M; float* ROPE_S; float* X; bf16_t* WMIX; bf16_t* W13; bf16_t* W2T;
    float* AFF; float* AFFC; int* IDX; float* GATE; int* INV; unsigned char* WORK;
    DI bf16_t* slot(int i) const { return (bf16_t*)(WORK + (size_t)i * USLOT); }
};
DI Bufs make_bufs(const Params& p) {
    Bufs b; unsigned char* w = p.ws;
    b.MOD = (float*)(w + OFF_MOD); b.ROPE_M = (float*)(w + OFF_ROPE_M); b.ROPE_S = (float*)(w + OFF_ROPE_S); b.X = (float*)(w + OFF_X);
    b.WMIX = (bf16_t*)(w + OFF_WMIX); b.W13 = (bf16_t*)(w + OFF_WE); b.W2T = (bf16_t*)(w + OFF_WE + 64 * MiB);
    b.AFF = (float*)(w + OFF_AFF); b.AFFC = (float*)(w + OFF_AFFC); b.IDX = (int*)(w + OFF_IDX); b.GATE = (float*)(w + OFF_GATE); b.INV = (int*)(w + OFF_INV);
    b.WORK = w + OFF_WORK; return b;
}

DI void conv_moe_layer(const Params& p, const Bufs& B, int layer, int& base, char* smem) {
    for (int e = 0; e < NEXP; ++e) {
        const size_t wo = ((size_t)layer * NEXP + e) * 1024 * 1024;
        conv_tiles<1>(p.in[I_MOE_W1] + wo, 1024, 1024, 1024, B.W13 + (size_t)e * 2048 * 1024, 1024, 0, 0, nullptr, 0.f, 0.f, base, smem);
        conv_tiles<1>(p.in[I_MOE_W3] + wo, 1024, 1024, 1024, B.W13 + (size_t)e * 2048 * 1024, 1024, 0, 16, nullptr, 0.f, 0.f, base, smem);
        conv_tiles<0>(p.in[I_MOE_W2] + wo, 1024, 1024, 1024, B.W2T + (size_t)e * 1024 * 1024, 1024, 0, 0, nullptr, 0.f, 0.f, base, smem);
    }
}

DI void phase_prologue(const Params& p, const Bufs& B, char* smem) {
    const int tid = threadIdx.x, G = gridDim.x;
    {
        float* s = (float*)smem;
        float* red = s + 9 * 1024;
        for (int i = tid; i < 9 * 1024; i += NTHR) { const int r = i >> 10, k = i & 1023; const float x = (r < 8) ? p.in[I_C][r * 1024 + k] : p.in[I_CCTX][k]; s[i] = x * fsigmoid(x); }
        __syncthreads();
        for (int it = blockIdx.x; it < 4 * 96; it += G) {
            const int l = it / 96, cg = it % 96, cl = tid & 63, ks = tid >> 6, n = cg * 64 + cl;
            const float* wp = p.in[I_ADAW] + (size_t)l * 1024 * 6144 + (size_t)(ks * 128) * 6144 + n;
            float acc[9];
#pragma unroll
            for (int r = 0; r < 9; ++r) acc[r] = 0.f;
            for (int k = 0; k < 128; ++k) {
                const float wv = wp[(size_t)k * 6144];
#pragma unroll
                for (int r = 0; r < 9; ++r) acc[r] += s[r * 1024 + ks * 128 + k] * wv;
            }
#pragma unroll
            for (int r = 0; r < 9; ++r) red[(ks * 9 + r) * 64 + cl] = acc[r];
            __syncthreads();
            for (int o = tid; o < 9 * 64; o += NTHR) {
                const int r = o >> 6, c = o & 63; float v = 0.f;
#pragma unroll
                for (int q = 0; q < 8; ++q) v += red[(q * 9 + r) * 64 + c];
                B.MOD[((size_t)l * 9 + r) * 6144 + cg * 64 + c] = v + p.in[I_ADAB][l * 6144 + cg * 64 + c];
            }
            __syncthreads();
        }
    }
    {
        const f32x4* xs = (const f32x4*)p.in[I_X]; const f32x4* cs = (const f32x4*)p.in[I_CTX]; f32x4* xd = (f32x4*)B.X;
        const long nl = (long)TL * 256, nt = (long)TT * 256;
        for (long i = (long)blockIdx.x * NTHR + tid; i < nt; i += (long)G * NTHR) xd[i] = (i < nl) ? xs[i] : cs[i - nl];
    }
    for (int i = blockIdx.x * NTHR + tid; i < 4096 * 48; i += G * NTHR) {
        const int pos = i / 48, j = i % 48;
        const int row = pos >> 6, col = pos & 63;
        float inv, posf; float* cdst; float* sdst;
        if (j < 16) { const int m = j & 7; inv = powf(10000.0f, -(float)(2 * m) / 16.0f); posf = (j < 8) ? (float)row : (float)col; cdst = B.ROPE_M + pos * 16 + j; sdst = B.ROPE_M + 4096 * 16 + pos * 16 + j; }
        else { const int jj = j - 16, m = jj & 15; inv = powf(10000.0f, -(float)(2 * m) / 32.0f); posf = (jj < 16) ? (float)row : (float)col; cdst = B.ROPE_S + pos * 32 + jj; sdst = B.ROPE_S + 4096 * 32 + pos * 32 + jj; }
        const float ang = posf * inv;
        double tr = (double)ang * 0.15915494309189535; tr -= rint(tr);
        const float tf = (float)tr;
        *cdst = __builtin_amdgcn_cosf(tf); *sdst = __builtin_amdgcn_sinf(tf);
    }
    int base = 0;
    bf16_t* W = B.WMIX;
    conv_tiles<0>(p.in[I_NA_WQKV], 1024, 3072, 3072, W + W_NA_QKV, 1024, 0, 0, nullptr, 0.f, 0.f, base, smem);
    conv_tiles<0>(p.in[I_NA_WO], 1024, 1024, 1024, W + W_NA_WO, 1024, 0, 0, nullptr, 0.f, 0.f, base, smem);
    {
        const float* mix = p.in[I_RW_MIX];
        bf16_t* B1 = W + W_RW_B1;
        conv_tiles<0>(p.in[I_RW_WR], 1024, 1024, 1024, B1, 2048, 0, 0, mix + 0 * 1024, 1.f, -1.f, base, smem);
        conv_tiles<0>(p.in[I_RW_WR], 1024, 1024, 1024, B1, 2048, 1024, 0, mix + 0 * 1024, 0.f, 0.5f, base, smem);
        conv_tiles<0>(p.in[I_RW_WK], 1024, 1024, 1024, B1, 2048, 0, 1024, mix + 2 * 1024, 1.f, -1.f, base, smem);
        conv_tiles<0>(p.in[I_RW_WK], 1024, 1024, 1024, B1, 2048, 1024, 1024, mix + 2 * 1024, 0.f, 0.5f, base, smem);
        conv_tiles<0>(p.in[I_RW_WV], 1024, 1024, 1024, B1, 2048, 0, 2048, mix + 3 * 1024, 1.f, -1.f, base, smem);
        conv_tiles<0>(p.in[I_RW_WV], 1024, 1024, 1024, B1, 2048, 1024, 2048, mix + 3 * 1024, 0.f, 0.5f, base, smem);
        conv_tiles<0>(p.in[I_RW_G1], 1024, 128, 128, B1, 2048, 0, 3072, mix + 5 * 1024, 1.f, -1.f, base, smem);
        conv_tiles<0>(p.in[I_RW_G1], 1024, 128, 128, B1, 2048, 1024, 3072, mix + 5 * 1024, 0.f, 0.5f, base, smem);
        for (int z = 0; z < 2; ++z) {
            conv_tiles<0>(p.in[I_RW_W1] + (size_t)z * 1024 * 64, 1024, 64, 64, B1, 2048, 0, 3200 + 64 * z, mix + 1 * 1024, 1.f, -1.f, base, smem);
            conv_tiles<0>(p.in[I_RW_W1] + (size_t)z * 1024 * 64, 1024, 64, 64, B1, 2048, 1024, 3200 + 64 * z, mix + 1 * 1024, 0.f, 0.5f, base, smem);
            conv_tiles<0>(p.in[I_RW_A1] + (size_t)z * 1024 * 64, 1024, 64, 64, B1, 2048, 0, 3328 + 64 * z, mix + 4 * 1024, 1.f, -1.f, base, smem);
            conv_tiles<0>(p.in[I_RW_A1] + (size_t)z * 1024 * 64, 1024, 64, 64, B1, 2048, 1024, 3328 + 64 * z, mix + 4 * 1024, 0.f, 0.5f, base, smem);
        }
        zero_bf16(B1 + (size_t)3456 * 2048, (long)128 * 2048 / 8);
        bf16_t* B2 = W + W_RW_B2;
        conv_tiles<0>(p.in[I_RW_G2], 128, 1024, 1024, B2, 384, 0, 0, nullptr, 0.f, 0.f, base, smem);
        for (int z = 0; z < 2; ++z) {
            conv_tiles<0>(p.in[I_RW_W2] + (size_t)z * 64 * 1024, 64, 1024, 1024, B2, 384, 128 + 64 * z, 1024 + 1024 * z, nullptr, 0.f, 0.f, base, smem);
            conv_tiles<0>(p.in[I_RW_A2] + (size_t)z * 64 * 1024, 64, 1024, 1024, B2, 384, 256 + 64 * z, 3072 + 1024 * z, nullptr, 0.f, 0.f, base, smem);
        }
        conv_tiles<0>(p.in[I_RW_WO], 1024, 1024, 1024, W + W_RW_WO, 1024, 0, 0, nullptr, 0.f, 0.f, base, smem);
    }
    conv_tiles<0>(p.in[I_MLA_WDOWN], 1024, 672, 768, W + W_MLA_DOWN, 1024, 0, 0, nullptr, 0.f, 0.f, base, smem);
    conv_tiles<0>(p.in[I_MLA_WUQ], 384, 1536, 1536, W + W_MLA_UQ, 384, 0, 0, nullptr, 0.f, 0.f, base, smem);
    conv_tiles<0>(p.in[I_MLA_WUKV], 256, 2048, 2048, W + W_MLA_UKV, 256, 0, 0, nullptr, 0.f, 0.f, base, smem);
    conv_tiles<0>(p.in[I_MLA_WO], 1024, 1024, 1024, W + W_MLA_WO, 1024, 0, 0, nullptr, 0.f, 0.f, base, smem);
    conv_tiles<0>(p.in[I_SWA_WQKV], 1024, 1536, 1536, W + W_SWA_QKV, 1024, 0, 0, nullptr, 0.f, 0.f, base, smem);
    conv_tiles<0>(p.in[I_SWA_WO], 1024, 1024, 1024, W + W_SWA_WO, 1024, 0, 0, nullptr, 0.f, 0.f, base, smem);
    conv_moe_layer(p, B, 0, base, smem);
}

DI void row_load_f32(const float* row, int lane, float* v) {
#pragma unroll
    for (int i = 0; i < 4; ++i) { const f32x4 t = *(const f32x4*)(row + 256 * i + 4 * lane); v[4 * i] = t[0]; v[4 * i + 1] = t[1]; v[4 * i + 2] = t[2]; v[4 * i + 3] = t[3]; }
}
DI void row_store_bf16(bf16_t* row, int lane, const float* v) {
#pragma unroll
    for (int i = 0; i < 4; ++i) { u32x2 t; t.x = pk2(v[4 * i], v[4 * i + 1]); t.y = pk2(v[4 * i + 2], v[4 * i + 3]); *(u32x2*)(row + 256 * i + 4 * lane) = t; }
}
DI void norm_mod_row(const float* xrow, const float* gain, const float* shift, const float* scale, int lane, float* h) {
    float x[16], gg[16], sh[16], sc[16];
    row_load_f32(xrow, lane, x); row_load_f32(gain, lane, gg); row_load_f32(shift, lane, sh); row_load_f32(scale, lane, sc);
    float ss = 0.f;
#pragma unroll
    for (int e = 0; e < 16; ++e) ss += x[e] * x[e];
    ss = wave_sum(ss);
    const float r = rsqrtf(ss * (1.0f / 1024.0f) + 1e-6f);
#pragma unroll
    for (int e = 0; e < 16; ++e) h[e] = x[e] * r * gg[e] * (1.0f + sc[e]) + sh[e];
}

DI void phase_norm1(const Params& p, const Bufs& B, int layer, bf16_t* H) {
    const int lane = threadIdx.x & 63, gw = blockIdx.x * 8 + (threadIdx.x >> 6), nw = gridDim.x * 8;
    const float* gain = p.in[I_N1G] + layer * 1024;
    for (int g = gw; g < TT; g += nw) {
        const float* md = B.MOD + ((size_t)layer * 9 + modrow_of(g)) * 6144;
        float h[16];
        norm_mod_row(B.X + (size_t)g * 1024, gain, md, md + 1024, lane, h);
        row_store_bf16(H + (size_t)g * 1024, lane, h);
    }
}
DI void phase_norm1_rw(const Params& p, const Bufs& B, int layer, bf16_t* H2) {
    const int lane = threadIdx.x & 63, gw = blockIdx.x * 8 + (threadIdx.x >> 6), nw = gridDim.x * 8;
    const float* gain = p.in[I_N1G] + layer * 1024;
    for (int g = gw; g < TT; g += nw) {
        const float* md = B.MOD + ((size_t)layer * 9 + modrow_of(g)) * 6144;
        const int t = (g < TL) ? (g & 4095) : ((g - TL) & 255);
        const int len = (g < TL) ? 4096 : 256;
        float h[16], hp[16], hn[16];
        norm_mod_row(B.X + (size_t)g * 1024, gain, md, md + 1024, lane, h);
        if (t > 0) norm_mod_row(B.X + (size_t)(g - 1) * 1024, gain, md, md + 1024, lane, hp);
        else {
#pragma unroll
            for (int e = 0; e < 16; ++e) hp[e] = 0.f;
        }
        if (t < len - 1) norm_mod_row(B.X + (size_t)(g + 1) * 1024, gain, md, md + 1024, lane, hn);
        else {
#pragma unroll
            for (int e = 0; e < 16; ++e) hn[e] = 0.f;
        }
#pragma unroll
        for (int e = 0; e < 16; ++e) hp[e] += hn[e];
        row_store_bf16(H2 + (size_t)g * 2048, lane, h);
        row_store_bf16(H2 + (size_t)g * 2048 + 1024, lane, hp);
    }
}
DI void phase_norm2(const Params& p, const Bufs& B, int layer, bf16_t* H, int ntok, char* smem) {
    float* wr = (float*)smem;
    const float* rsrc = p.in[I_MOE_ROUTER] + (size_t)layer * 1024 * 16;
    for (int i = threadIdx.x; i < 1024 * 16; i += NTHR) { const int k = i >> 4, e = i & 15; wr[e * 1024 + k] = rsrc[i]; }
    __syncthreads();
    const int lane = threadIdx.x & 63, gw = blockIdx.x * 8 + (threadIdx.x >> 6), nw = gridDim.x * 8;
    const float* gain = p.in[I_N2G] + layer * 1024;
    for (int g = gw; g < ntok; g += nw) {
        const float* md = B.MOD + ((size_t)layer * 9 + modrow_of(g)) * 6144;
        float h[16];
        norm_mod_row(B.X + (size_t)g * 1024, gain, md + 3 * 1024, md + 4 * 1024, lane, h);
        row_store_bf16(H + (size_t)g * 1024, lane, h);
        float mine = -3.0e38f;
#pragma unroll 1
        for (int e = 0; e < 16; ++e) {
            float a = 0.f;
#pragma unroll
            for (int i = 0; i < 4; ++i) { const f32x4 w4 = *(const f32x4*)(wr + e * 1024 + 256 * i + 4 * lane); a += h[4 * i] * w4[0] + h[4 * i + 1] * w4[1] + h[4 * i + 2] * w4[2] + h[4 * i + 3] * w4[3]; }
            a = wave_sum(a);
            mine = (lane == e) ? a : mine;
        }
        float mx = mine;
        mx = fmaxf(mx, __shfl_xor(mx, 1)); mx = fmaxf(mx, __shfl_xor(mx, 2)); mx = fmaxf(mx, __shfl_xor(mx, 4)); mx = fmaxf(mx, __shfl_xor(mx, 8));
        const float ex = __expf(mine - mx);
        float se = ex;
        se += __shfl_xor(se, 1); se += __shfl_xor(se, 2); se += __shfl_xor(se, 4); se += __shfl_xor(se, 8);
        mine = ex / se;
        if (lane < 16) {
            if (g < TL) B.AFF[((size_t)(g >> 12) * 16 + lane) * 4096 + (g & 4095)] = mine;
            else { const int gc = g - TL; B.AFFC[((size_t)(gc >> 8) * 16 + lane) * 256 + (gc & 255)] = mine; }
            B.INV[(size_t)g * 16 + lane] = -1;
        }
    }
}

DI void ld16(const bf16_t* p, float* v) { unpack8(*(const u32x4*)p, v); unpack8(*(const u32x4*)(p + 8), v + 8); }
DI void st16(bf16_t* p, const float* v) { *(u32x4*)p = pack8(v); *(u32x4*)(p + 8) = pack8(v + 8); }
DI void headnorm64(float* v, const float* gain, int p) {
    float ss = 0.f;
#pragma unroll
    for (int e = 0; e < 16; ++e) ss += v[e] * v[e];
    ss += __shfl_xor(ss, 1); ss += __shfl_xor(ss, 2);
    const float r = rsqrtf(ss * (1.0f / 64.0f) + 1e-6f);
#pragma unroll
    for (int e = 0; e < 16; ++e) v[e] = v[e] * r * gain[16 * p + e];
}
DI void rope64(float* v, const float* cs, const float* sn, int p) {
    const int i0 = 16 * (p & 1);
#pragma unroll
    for (int e = 0; e < 16; ++e) {
        const float o = __shfl_xor(v[e], 2), c = cs[i0 + e], s = sn[i0 + e];
        v[e] = (p < 2) ? (v[e] * c - o * s) : (v[e] * c + o * s);
    }
}

DI void phase_qknorm_na(const Params& p, bf16_t* QKV) {
    const int lane = threadIdx.x & 63, gw = blockIdx.x * 8 + (threadIdx.x >> 6), nw = gridDim.x * 8, pp = lane & 3;
    const float* qg = p.in[I_NA_QG]; const float* kg = p.in[I_NA_KG];
    for (int g = gw; g < TT; g += nw) {
        bf16_t* row = QKV + (size_t)g * 3072 + 16 * lane;
        float v[16];
        ld16(row, v); headnorm64(v, qg, pp); st16(row, v);
        ld16(row + 1024, v); headnorm64(v, kg, pp); st16(row + 1024, v);
    }
}
DI void phase_qknorm_swa(const Params& p, const Bufs& B, bf16_t* QKV) {
    const int lane = threadIdx.x & 63, gw = blockIdx.x * 8 + (threadIdx.x >> 6), nw = gridDim.x * 8, pp = lane & 3;
    const float* qg = p.in[I_SWA_QG]; const float* kg = p.in[I_SWA_KG];
    for (int g = gw; g < TT; g += nw) {
        bf16_t* row = QKV + (size_t)g * 1536;
        const bool lat = g < TL;
        const int pos = g & 4095;
        const float* cs = B.ROPE_S + (size_t)(lat ? pos : 0) * 32; const float* sn = cs + 4096 * 32;
        float v[16];
        ld16(row + 16 * lane, v); headnorm64(v, qg, pp);
        if (lat) rope64(v, cs, sn, pp);
        st16(row + 16 * lane, v);
        const int kl = lane & 15;
        ld16(row + 1024 + 16 * kl, v); headnorm64(v, kg, pp);
        if (lat) rope64(v, cs, sn, pp);
        if (lane < 16) st16(row + 1024 + 16 * kl, v);
    }
}
DI void phase_mla_dnorm(const Params& p, const Bufs& B, const float* DOWN, bf16_t* CQ, bf16_t* CKV, bf16_t* KR) {
    const int lane = threadIdx.x & 63, gw = blockIdx.x * 8 + (threadIdx.x >> 6), nw = gridDim.x * 8;
    const float* qng = p.in[I_MLA_QNG]; const float* kvng = p.in[I_MLA_KVNG]; const float* krg = p.in[I_MLA_KR_G];
    for (int g = gw; g < TT; g += nw) {
        const float* d = DOWN + (size_t)g * 768;
        float a[6]; float ss = 0.f;
#pragma unroll
        for (int e = 0; e < 6; ++e) { a[e] = d[lane + 64 * e]; ss += a[e] * a[e]; }
        ss = wave_sum(ss);
        float r = rsqrtf(ss * (1.0f / 384.0f) + 1e-6f);
#pragma unroll
        for (int e = 0; e < 6; ++e) CQ[(size_t)g * 384 + lane + 64 * e] = (bf16_t)f2bf(a[e] * r * qng[lane + 64 * e]);
        ss = 0.f;
#pragma unroll
        for (int e = 0; e < 4; ++e) { a[e] = d[384 + lane + 64 * e]; ss += a[e] * a[e]; }
        ss = wave_sum(ss);
        r = rsqrtf(ss * (1.0f / 256.0f) + 1e-6f);
#pragma unroll
        for (int e = 0; e < 4; ++e) CKV[(size_t)g * 256 + lane + 64 * e] = (bf16_t)f2bf(a[e] * r * kvng[lane + 64 * e]);
        const int l31 = lane & 31;
        float x = (lane < 32) ? d[640 + l31] : 0.f;
        ss = wave_sum(x * x);
        r = rsqrtf(ss * (1.0f / 32.0f) + 1e-6f);
        x = x * r * krg[l31];
        const float o = __shfl_xor(x, 16);
        if (g < TL) {
            const int pos = g & 4095, i = lane & 15;
            const float c = B.ROPE_M[pos * 16 + i], s = B.ROPE_M[4096 * 16 + pos * 16 + i];
            x = (l31 < 16) ? (x * c - o * s) : (x * c + o * s);
        }
        if (lane < 32) KR[(size_t)g * 32 + lane] = (bf16_t)f2bf(x);
    }
}
DI void phase_mla_hnorm(const Params& p, const Bufs& B, bf16_t* Q, bf16_t* KV) {
    const int lane = threadIdx.x & 63, gw = blockIdx.x * 8 + (threadIdx.x >> 6), nw = gridDim.x * 8, pp = lane & 3, hh = lane >> 2;
    const float* qng = p.in[I_MLA_QN_G]; const float* qrg = p.in[I_MLA_QR_G]; const float* kng = p.in[I_MLA_KN_G];
    for (int g = gw; g < TT; g += nw) {
        bf16_t* q = Q + (size_t)g * 1536 + hh * 96;
        float v[16];
        ld16(q + 16 * pp, v); headnorm64(v, qng, pp); st16(q + 16 * pp, v);
        float w[8];
        unpack8(*(const u32x4*)(q + 64 + 8 * pp), w);
        float ss = 0.f;
#pragma unroll
        for (int e = 0; e < 8; ++e) ss += w[e] * w[e];
        ss += __shfl_xor(ss, 1); ss += __shfl_xor(ss, 2);
        const float r = rsqrtf(ss * (1.0f / 32.0f) + 1e-6f);
#pragma unroll
        for (int e = 0; e < 8; ++e) w[e] = w[e] * r * qrg[8 * pp + e];
        if (g < TL) {
            const int pos = g & 4095, i0 = 8 * (pp & 1);
#pragma unroll
            for (int e = 0; e < 8; ++e) {
                const float o = __shfl_xor(w[e], 2), c = B.ROPE_M[pos * 16 + i0 + e], s = B.ROPE_M[4096 * 16 + pos * 16 + i0 + e];
                w[e] = (pp < 2) ? (w[e] * c - o * s) : (w[e] * c + o * s);
            }
        }
        *(u32x4*)(q + 64 + 8 * pp) = pack8(w);
        bf16_t* k = KV + (size_t)g * 2048 + hh * 128 + 16 * pp;
        ld16(k, v); headnorm64(v, kng, pp); st16(k, v);
    }
}

typedef short v4i16_t __attribute__((ext_vector_type(4)));
DI s16x4 tr_read(const bf16_t* p) { return __builtin_bit_cast(s16x4, __builtin_amdgcn_ds_read_tr16_b64_v4i16((LAS v4i16_t*)(LAS char*)(char*)p)); }
constexpr int ATT_LDS = 64 * 104 * 2 + 64 * 72 * 2 + 2048;

template <class P>
DI void attn_unit(const P& pol, char* smem) {
    constexpr int DQK = P::DQK, KS = DQK + 8, VS = 72, NS = DQK / 32, NCH = DQK / 8;
    bf16_t* Ks = (bf16_t*)smem;
    bf16_t* Vs = (bf16_t*)(smem + 64 * 104 * 2);
    const int tid = threadIdx.x, lane = tid & 63, w = tid >> 6, l15 = lane & 15, quad = lane >> 4;
    const int q = w * 16 + l15;
    __syncthreads();
    pol.prologue(smem + 64 * 104 * 2 + 64 * 72 * 2);
    bf16x8 qf[NS];
#pragma unroll
    for (int s = 0; s < NS; ++s) qf[s] = *(const bf16x8*)pol.qptr(q, s * 4 + quad);
    f32x4 o[4];
#pragma unroll
    for (int u = 0; u < 4; ++u) o[u] = (f32x4){0.f, 0.f, 0.f, 0.f};
    float m = -1e30f, l = 0.f;
    const int k0key = (DQK == 64) ? (tid >> 3) : (tid / 12), k0ch = (DQK == 64) ? (tid & 7) : (tid % 12);
    const int k1key = (tid + 512) / 12, k1ch = (tid + 512) % 12;
    const bool k1on = (DQK == 96) && (tid < 256);
    const int vkey = tid >> 3, vch = tid & 7;
    const int nt = pol.ntiles();
    u32x4 rk0, rk1 = (u32x4){0u, 0u, 0u, 0u}, rv;
    rk0 = *(const u32x4*)pol.kptr(0, k0key, k0ch);
    if (k1on) rk1 = *(const u32x4*)pol.kptr(0, k1key, k1ch);
    rv = *(const u32x4*)pol.vptr(0, vkey, vch);
    *(u32x4*)(Ks + k0key * KS + k0ch * 8) = rk0;
    if (k1on) *(u32x4*)(Ks + k1key * KS + k1ch * 8) = rk1;
    *(u32x4*)(Vs + vkey * VS + vch * 8) = rv;
    __syncthreads();
    for (int j = 0; j < nt; ++j) {
        const bool more = (j + 1 < nt);
        if (more) {
            rk0 = *(const u32x4*)pol.kptr(j + 1, k0key, k0ch);
            if (k1on) rk1 = *(const u32x4*)pol.kptr(j + 1, k1key, k1ch);
            rv = *(const u32x4*)pol.vptr(j + 1, vkey, vch);
        }
        f32x4 sc[2][2];
#pragma unroll
        for (int g = 0; g < 2; ++g)
#pragma unroll
            for (int t = 0; t < 2; ++t) {
                f32x4 a = (f32x4){0.f, 0.f, 0.f, 0.f};
                const int key = 32 * g + 8 * (l15 >> 2) + 4 * t + (l15 & 3);
#pragma unroll
                for (int s = 0; s < NS; ++s) { const bf16x8 kf = *(const bf16x8*)(Ks + key * KS + 32 * s + 8 * quad); a = __builtin_amdgcn_mfma_f32_16x16x32_bf16(kf, qf[s], a, 0, 0, 0); }
                sc[g][t] = a;
            }
        float tmax = -3.0e38f;
#pragma unroll
        for (int g = 0; g < 2; ++g)
#pragma unroll
            for (int t = 0; t < 2; ++t)
#pragma unroll
                for (int r = 0; r < 4; ++r) { const float s2 = pol.mod(sc[g][t][r] * pol.c2, q, j, 32 * g + 8 * quad + 4 * t + r); sc[g][t][r] = s2; tmax = fmaxf(tmax, s2); }
        tmax = fmaxf(tmax, __shfl_xor(tmax, 16)); tmax = fmaxf(tmax, __shfl_xor(tmax, 32));
        const float mn = fmaxf(m, tmax), alpha = fexp2(m - mn);
        m = mn;
        float ps = 0.f;
        bf16x8 pf[2];
#pragma unroll
        for (int g = 0; g < 2; ++g) {
            float pv[8];
#pragma unroll
            for (int t = 0; t < 2; ++t)
#pragma unroll
                for (int r = 0; r < 4; ++r) { const float e = fexp2(sc[g][t][r] - mn); ps += e; pv[4 * t + r] = e; }
            pf[g] = __builtin_bit_cast(bf16x8, pack8(pv));
        }
        l = l * alpha + ps;
#pragma unroll
        for (int u = 0; u < 4; ++u) o[u] *= alpha;
#pragma unroll
        for (int u = 0; u < 4; ++u)
#pragma unroll
            for (int g = 0; g < 2; ++g) {
                const bf16_t* vb = Vs + (32 * g + 8 * quad + (l15 >> 2)) * VS + 16 * u + 4 * (l15 & 3);
                const s16x4 lo = tr_read(vb), hi = tr_read(vb + 4 * VS);
                bf16x8 vf; vf[0] = lo[0]; vf[1] = lo[1]; vf[2] = lo[2]; vf[3] = lo[3]; vf[4] = hi[0]; vf[5] = hi[1]; vf[6] = hi[2]; vf[7] = hi[3];
                o[u] = __builtin_amdgcn_mfma_f32_16x16x32_bf16(vf, pf[g], o[u], 0, 0, 0);
            }
        __syncthreads();
        if (more) {
            *(u32x4*)(Ks + k0key * KS + k0ch * 8) = rk0;
            if (k1on) *(u32x4*)(Ks + k1key * KS + k1ch * 8) = rk1;
            *(u32x4*)(Vs + vkey * VS + vch * 8) = rv;
        }
        __syncthreads();
    }
    l += __shfl_xor(l, 16); l += __shfl_xor(l, 32);
    if (P::SINK) l += fexp2(pol.sink2 - m);
    const float il = 1.0f / l;
    bf16_t* op = pol.optr(q);
#pragma unroll
    for (int u = 0; u < 4; ++u) st_bf16x4(op + 16 * u + 4 * quad, o[u] * il);
}

struct PolPlain64 {
    static constexpr int DQK = 64; static constexpr bool SINK = false;
    const bf16_t* Qb; long qs; const bf16_t* Kb; long ks; const bf16_t* Vb; long vs; bf16_t* Ob; long os; int qrow0, krow0, nt; float c2, sink2;
    DI void prologue(char*) const {}
    DI int ntiles() const { return nt; }
    DI const bf16_t* qptr(int q, int ch) const { return Qb + (long)(qrow0 + q) * qs + ch * 8; }
    DI const bf16_t* kptr(int j, int i, int ch) const { return Kb + (long)(krow0 + 64 * j + i) * ks + ch * 8; }
    DI const bf16_t* vptr(int j, int i, int ch) const { return Vb + (long)(krow0 + 64 * j + i) * vs + ch * 8; }
    DI float mod(float s2, int, int, int) const { return s2; }
    DI bf16_t* optr(int q) const { return Ob + (long)(qrow0 + q) * os; }
};
struct PolNA {
    static constexpr int DQK = 64; static constexpr bool SINK = false;
    const bf16_t* QKV; bf16_t* AO; const float* rpb; const float* bl; int b, h, rr, rbase; float c2, sink2;
    DI void prologue(char* s) const { float* t = (float*)s; for (int i = threadIdx.x; i < 465; i += NTHR) t[i] = rpb[h * 465 + i] * LOG2E; }
    DI int ntiles() const { return 13; }
    DI int qtok(int q) const { return b * 4096 + (2 * rr + (q >> 6)) * 64 + (q & 63); }
    DI int ktok(int j, int i) const { if (j < 4) return TL + b * 256 + 64 * j + i; int kr = rbase + j - 4; kr = kr > 63 ? 63 : kr; return b * 4096 + kr * 64 + i; }
    DI const bf16_t* qptr(int q, int ch) const { return QKV + (long)qtok(q) * 3072 + h * 64 + ch * 8; }
    DI const bf16_t* kptr(int j, int i, int ch) const { return QKV + (long)ktok(j, i) * 3072 + 1024 + h * 64 + ch * 8; }
    DI const bf16_t* vptr(int j, int i, int ch) const { return QKV + (long)ktok(j, i) * 3072 + 2048 + h * 64 + ch * 8; }
    DI float mod(float s2, int q, int j, int kc) const {
        if (j < 4) return s2;
        const int kr = rbase + j - 4, qr = 2 * rr + (q >> 6), qc = q & 63;
        int r0 = qr - 4; r0 = r0 < 0 ? 0 : (r0 > 56 ? 56 : r0);
        int c0 = qc - 8; c0 = c0 < 0 ? 0 : (c0 > 48 ? 48 : c0);
        const bool ok = (kr >= r0) && (kr <= r0 + 7) && (kc >= c0) && (kc < c0 + 16);
        const int idx = ok ? ((kr - qr + 7) * 31 + (kc - qc + 15)) : 0;
        return ok ? (s2 + bl[idx]) : -1e30f;
    }
    DI bf16_t* optr(int q) const { return AO + (long)qtok(q) * 1024 + h * 64; }
};
struct PolMLA {
    static constexpr int DQK = 96; static constexpr bool SINK = false;
    const bf16_t* Q; const bf16_t* KV; const bf16_t* KR; bf16_t* AO; int b, h, qrow0, nt; float c2, sink2;
    DI void prologue(char*) const {}
    DI int ntiles() const { return nt; }
    DI int ktok(int j, int i) const { return (j < 4) ? (TL + b * 256 + 64 * j + i) : (b * 4096 + 64 * (j - 4) + i); }
    DI const bf16_t* qptr(int q, int ch) const { return Q + (long)(qrow0 + q) * 1536 + h * 96 + ch * 8; }
    DI const bf16_t* kptr(int j, int i, int ch) const { const long t = ktok(j, i); return (ch < 8) ? (KV + t * 2048 + h * 128 + ch * 8) : (KR + t * 32 + (ch - 8) * 8); }
    DI const bf16_t* vptr(int j, int i, int ch) const { return KV + (long)ktok(j, i) * 2048 + h * 128 + 64 + ch * 8; }
    DI float mod(float s2, int, int, int) const { return s2; }
    DI bf16_t* optr(int q) const { return AO + (long)(qrow0 + q) * 1024 + h * 64; }
};
struct PolSWA {
    static constexpr int DQK = 64; static constexpr bool SINK = true;
    const bf16_t* QKV; bf16_t* AO; int b, hq, s0; float c2, sink2;
    DI void prologue(char*) const {}
    DI int ntiles() const { return 10; }
    DI int ktok(int j, int i) const { if (j < 4) return TL + b * 256 + 64 * j + i; int kp = s0 - 128 + 64 * (j - 4) + i; kp = kp < 0 ? 0 : (kp > 4095 ? 4095 : kp); return b * 4096 + kp; }
    DI const bf16_t* qptr(int q, int ch) const { return QKV + (long)(b * 4096 + s0 + q) * 1536 + hq * 64 + ch * 8; }
    DI const bf16_t* kptr(int j, int i, int ch) const { return QKV + (long)ktok(j, i) * 1536 + 1024 + (hq >> 2) * 64 + ch * 8; }
    DI const bf16_t* vptr(int j, int i, int ch) const { return QKV + (long)ktok(j, i) * 1536 + 1280 + (hq >> 2) * 64 + ch * 8; }
    DI float mod(float s2, int q, int j, int kc) const {
        if (j < 4) return s2;
        const int kp = s0 - 128 + 64 * (j - 4) + kc, qp = s0 + q, d = qp - kp;
        const bool ok = (kp >= 0) && (kp < 4096) && (d <= 128) && (d >= -128);
        return ok ? s2 : -1e30f;
    }
    DI bf16_t* optr(int q) const { return AO + (long)(b * 4096 + s0 + q) * 1024 + hq * 64; }
};

DI float ftanh(float x) { return 2.0f * fsigmoid(2.0f * x) - 1.0f; }
struct EpiRW1 { bf16_t* RKV; bf16_t* LORA;
    DI f32x4 act(f32x4 a, int lc) const {
        f32x4 r;
#pragma unroll
        for (int i = 0; i < 4; ++i) r[i] = (lc < 128) ? fsigmoid(a[i]) : ((lc < 256) ? ftanh(a[i]) : a[i]);
        return r; }
    DI void operator()(int row, int col, f32x4 a0, f32x4 a1) const {
        if (col < 3072) { bf16_t* p = RKV + (long)row * 3072 + col; st_bf16x4(p, a0); st_bf16x4(p + 16, a1); }
        else if (col < 3456) { const int lc = col - 3072; bf16_t* p = LORA + (long)row * 384 + lc; st_bf16x4(p, act(a0, lc)); st_bf16x4(p + 16, act(a1, lc)); }
    } };
struct EpiRW2 { int seg; bf16_t* O; const float* bias;
    DI f32x4 f(f32x4 a, const float* bp) const {
        f32x4 r;
#pragma unroll
        for (int i = 0; i < 4; ++i) { const float t = fsigmoid(a[i] + bp[i]); r[i] = (seg < 3) ? 0.6065306597126334f * t : t; }
        return r; }
    DI void operator()(int row, int col, f32x4 a0, f32x4 a1) const {
        const int n = col - 1024 * seg; bf16_t* p = O + (long)row * 1024 + n;
        if (seg == 0) { st_bf16x4(p, a0); st_bf16x4(p + 16, a1); }
        else { st_bf16x4(p, f(a0, bias + n)); st_bf16x4(p + 16, f(a1, bias + n + 16)); }
    } };

DI void phase_rw_gemm2(const Params& p, const Bufs& B, const bf16_t* LORA, bf16_t* G, bf16_t* XD0, bf16_t* XD1, bf16_t* AA0, bf16_t* AA1, char* smem) {
    const int ntm = TT >> 7, nt = ntm * 40;
    for (int t = blockIdx.x; t < nt; t += gridDim.x) {
        const int tm = t / 40, tn = t % 40, seg = tn >> 3;
        GemmOp g; g.A = LORA; g.lda = 384; g.Bt = B.WMIX + W_RW_B2; g.ldb = 384;
        g.kbeg = (seg == 0) ? 0 : (64 + 64 * seg); g.kend = (seg == 0) ? 128 : (128 + 64 * seg);
        EpiRW2 e; e.seg = seg;
        e.O = (seg == 0) ? G : (seg == 1 ? XD0 : (seg == 2 ? XD1 : (seg == 3 ? AA0 : AA1)));
        e.bias = (seg == 0) ? nullptr : ((seg < 3) ? p.in[I_RW_W0] + (seg - 1) * 1024 : p.in[I_RW_A0] + (seg - 3) * 1024);
        gemm_tile(g, tm * 128, tn * 128, e, smem);
    }
}

template <int CTRL> DI float dppmov(float x) { return __int_as_float(__builtin_amdgcn_update_dpp(0, __float_as_int(x), CTRL, 0xf, 0xf, false)); }
DI float red8(float x) { x += dppmov<0xB1>(x); x += dppmov<0x4E>(x); x += dppmov<0x141>(x); return x; }

constexpr int SCAN_LDS = 32 * 384 * 4 + 32 * 64 * 4;
DI void phase_rw_scan(const Params& p, const bf16_t* RKV, const bf16_t* XD0, const bf16_t* XD1, const bf16_t* AA0, const bf16_t* AA1, bf16_t* YF, bf16_t* YB, char* smem) {
    float* vec = (float*)smem;
    float* ybuf = vec + 32 * 384;
    const int tid = threadIdx.x, lane = tid & 63, wv = tid >> 6, il = lane >> 3, js = lane & 7, irow = 8 * wv + il;
    const int ss = tid >> 4, jg = tid & 15;
    for (int unit = blockIdx.x; unit < 256; unit += gridDim.x) {
        const int dir = unit & 1, b = unit >> 5, h = (unit >> 1) & 15;
        const bf16_t* XD = dir ? XD1 : XD0; const bf16_t* AA = dir ? AA1 : AA0; bf16_t* Y = dir ? YB : YF;
        const f32x4 kk4 = *(const f32x4*)(p.in[I_RW_KK] + h * 64 + 4 * jg), ka4 = *(const f32x4*)(p.in[I_RW_KA] + h * 64 + 4 * jg);
        float S[8];
#pragma unroll
        for (int e = 0; e < 8; ++e) S[e] = 0.f;
        u32x2 pr, pk, pv, px, pa;
        long gcur;
        {   const int n = ss; const int t = dir ? 255 - n : n; gcur = TL + b * 256 + t;
            const long o = gcur * 3072 + h * 64 + 4 * jg, o1 = gcur * 1024 + h * 64 + 4 * jg;
            pr = *(const u32x2*)(RKV + o); pk = *(const u32x2*)(RKV + o + 1024); pv = *(const u32x2*)(RKV + o + 2048); px = *(const u32x2*)(XD + o1); pa = *(const u32x2*)(AA + o1); }
        for (int c = 0; c < 136; ++c) {
            __syncthreads();
            {
                float kf[4] = {bflo(pk.x), bfhi(pk.x), bflo(pk.y), bfhi(pk.y)};
                float af[4] = {bflo(pa.x), bfhi(pa.x), bflo(pa.y), bfhi(pa.y)};
                float xf[4] = {bflo(px.x), bfhi(px.x), bflo(px.y), bfhi(px.y)};
                f32x4 kkv, kka, kt, wv4, rv4, vv4;
                float sq = 0.f;
#pragma unroll
                for (int e = 0; e < 4; ++e) { kkv[e] = kf[e] * kk4[e]; sq += kkv[e] * kkv[e]; }
                sq += __shfl_xor(sq, 1); sq += __shfl_xor(sq, 2); sq += __shfl_xor(sq, 4); sq += __shfl_xor(sq, 8);
                const float inv = 1.0f / fmaxf(sqrtf(sq), 1e-12f);
#pragma unroll
                for (int e = 0; e < 4; ++e) { kkv[e] *= inv; kka[e] = kkv[e] * af[e]; kt[e] = kf[e] * (1.0f + (af[e] - 1.0f) * ka4[e]); wv4[e] = __expf(-xf[e]); }
                rv4 = (f32x4){bflo(pr.x), bfhi(pr.x), bflo(pr.y), bfhi(pr.y)};
                vv4 = (f32x4){bflo(pv.x), bfhi(pv.x), bflo(pv.y), bfhi(pv.y)};
                float* vb = vec + ss * 384 + 4 * jg;
                *(f32x4*)(vb) = wv4; *(f32x4*)(vb + 64) = kkv; *(f32x4*)(vb + 128) = kka; *(f32x4*)(vb + 192) = kt; *(f32x4*)(vb + 256) = rv4; *(f32x4*)(vb + 320) = vv4;
            }
            const long gthis = gcur;
            __syncthreads();
            if (c + 1 < 136) {
                const int n = (c + 1) * 32 + ss;
                if (n < 256) { const int t = dir ? 255 - n : n; gcur = TL + b * 256 + t; }
                else { const int mm = n - 256; const int t = dir ? 4095 - mm : mm; gcur = (long)b * 4096 + t; }
                const long o = gcur * 3072 + h * 64 + 4 * jg, o1 = gcur * 1024 + h * 64 + 4 * jg;
                pr = *(const u32x2*)(RKV + o); pk = *(const u32x2*)(RKV + o + 1024); pv = *(const u32x2*)(RKV + o + 2048); px = *(const u32x2*)(XD + o1); pa = *(const u32x2*)(AA + o1);
            }
#pragma unroll 2
            for (int s = 0; s < 32; ++s) {
                const float* vb = vec + s * 384 + 8 * js;
                const f32x4 w0 = *(const f32x4*)(vb), w1 = *(const f32x4*)(vb + 4), k0 = *(const f32x4*)(vb + 64), k1 = *(const f32x4*)(vb + 68);
                const f32x4 a0 = *(const f32x4*)(vb + 128), a1 = *(const f32x4*)(vb + 132), t0 = *(const f32x4*)(vb + 192), t1 = *(const f32x4*)(vb + 196);
                const f32x4 r0 = *(const f32x4*)(vb + 256), r1 = *(const f32x4*)(vb + 260);
                const float vi = vec[s * 384 + 320 + irow];
                float sk = S[0] * k0[0] + S[1] * k0[1] + S[2] * k0[2] + S[3] * k0[3] + S[4] * k1[0] + S[5] * k1[1] + S[6] * k1[2] + S[7] * k1[3];
                sk = red8(sk);
#pragma unroll
                for (int e = 0; e < 4; ++e) { S[e] = S[e] * w0[e] - sk * a0[e] + vi * t0[e]; S[4 + e] = S[4 + e] * w1[e] - sk * a1[e] + vi * t1[e]; }
                float y = S[0] * r0[0] + S[1] * r0[1] + S[2] * r0[2] + S[3] * r0[3] + S[4] * r1[0] + S[5] * r1[1] + S[6] * r1[2] + S[7] * r1[3];
                y = red8(y);
                if (js == 0) ybuf[s * 64 + irow] = y;
            }
            __syncthreads();
            {
                const f32x4 yv = *(const f32x4*)(ybuf + ss * 64 + 4 * jg);
                st_bf16x4(Y + gthis * 1024 + h * 64 + 4 * jg, yv);
            }
        }
    }
}

DI void ld16f(const float* p, float* v) {
#pragma unroll
    for (int i = 0; i < 4; ++i) { const f32x4 t = *(const f32x4*)(p + 4 * i); v[4 * i] = t[0]; v[4 * i + 1] = t[1]; v[4 * i + 2] = t[2]; v[4 * i + 3] = t[3]; } }
DI void phase_rw_readout(const Params& p, const bf16_t* RKV, const bf16_t* AA0, const bf16_t* AA1, const bf16_t* G, const bf16_t* YF, const bf16_t* YB, bf16_t* Z) {
    const int lane = threadIdx.x & 63, gw = blockIdx.x * 8 + (threadIdx.x >> 6), nw = gridDim.x * 8, col = 16 * lane;
    float lng[16], lnb[16], ka[16], rk[16];
    ld16f(p.in[I_RW_LNG] + col, lng); ld16f(p.in[I_RW_LNB] + col, lnb); ld16f(p.in[I_RW_KA] + col, ka); ld16f(p.in[I_RW_RK] + col, rk);
    for (int g = gw; g < TT; g += nw) {
        float y[16], t[16], r[16], k[16], v[16], a0[16], a1[16], gg[16];
        ld16(YF + (size_t)g * 1024 + col, y); ld16(YB + (size_t)g * 1024 + col, t);
        ld16(RKV + (size_t)g * 3072 + col, r); ld16(RKV + (size_t)g * 3072 + 1024 + col, k); ld16(RKV + (size_t)g * 3072 + 2048 + col, v);
        ld16(AA0 + (size_t)g * 1024 + col, a0); ld16(AA1 + (size_t)g * 1024 + col, a1); ld16(G + (size_t)g * 1024 + col, gg);
        float sm = 0.f;
#pragma unroll
        for (int e = 0; e < 16; ++e) { y[e] += t[e]; sm += y[e]; }
        sm += __shfl_xor(sm, 1); sm += __shfl_xor(sm, 2);
        const float mu = sm * (1.0f / 64.0f);
        float sv = 0.f, bs = 0.f;
#pragma unroll
        for (int e = 0; e < 16; ++e) { y[e] -= mu; sv += y[e] * y[e];
            const float kt0 = k[e] * (1.0f + (a0[e] - 1.0f) * ka[e]), kt1 = k[e] * (1.0f + (a1[e] - 1.0f) * ka[e]);
            bs += r[e] * (kt0 + kt1) * rk[e]; }
        sv += __shfl_xor(sv, 1); sv += __shfl_xor(sv, 2); bs += __shfl_xor(bs, 1); bs += __shfl_xor(bs, 2);
        const float rs = rsqrtf(sv * (1.0f / 64.0f) + 64e-5f);
#pragma unroll
        for (int e = 0; e < 16; ++e) y[e] = (y[e] * rs * lng[e] + lnb[e] + bs * v[e]) * gg[e];
        st16(Z + (size_t)g * 1024 + col, y);
    }
}

constexpr int TOPK_LDS = 4096 * 8;
DI void phase_topk(const Bufs& B, const bf16_t* H, bf16_t* XIN, bool has_ctx, char* smem) {
    unsigned long long* keys = (unsigned long long*)smem;
    const int tid = threadIdx.x, lane = tid & 63, wv = tid >> 6;
    const int nlists = has_ctx ? 256 : 128;
    for (int u = blockIdx.x; u < nlists; u += gridDim.x) {
        const bool isc = u >= 128; const int li = u & 127, b = li >> 4, e = li & 15;
        const int n = isc ? 256 : 4096, kcap = isc ? 32 : 512;
        const float* src = isc ? (B.AFFC + (size_t)(b * 16 + e) * 256) : (B.AFF + (size_t)(b * 16 + e) * 4096);
        __syncthreads();
        for (int i = tid; i < n; i += NTHR) keys[i] = ((unsigned long long)__float_as_uint(src[i]) << 32) | (unsigned long long)(0xFFFFFFFFu - (unsigned)i);
        __syncthreads();
        for (int k2 = 2; k2 <= n; k2 <<= 1)
            for (int j = k2 >> 1; j > 0; j >>= 1) {
                for (int pi = tid; pi < (n >> 1); pi += NTHR) {
                    const int i = ((pi & ~(j - 1)) << 1) | (pi & (j - 1)), ix = i | j;
                    const bool up = (i & k2) == 0;
                    const unsigned long long a = keys[i], c = keys[ix];
                    if (up ? (a < c) : (a > c)) { keys[i] = c; keys[ix] = a; }
                }
                __syncthreads();
            }
        for (int c = tid; c < kcap; c += NTHR) {
            const unsigned long long key = keys[c];
            const int idx = (int)(0xFFFFFFFFu - (unsigned)(key & 0xFFFFFFFFull));
            const int g = isc ? (TL + b * 256 + idx) : (b * 4096 + idx);
            const int er = isc ? (4096 + b * 32 + c) : (b * 512 + c);
            B.IDX[e * EROWS + er] = g; B.GATE[e * EROWS + er] = __uint_as_float((unsigned)(key >> 32)); B.INV[(size_t)g * 16 + e] = er;
        }
        for (int c = wv; c < kcap; c += 8) {
            const unsigned long long key = keys[c];
            const int idx = (int)(0xFFFFFFFFu - (unsigned)(key & 0xFFFFFFFFull));
            const int g = isc ? (TL + b * 256 + idx) : (b * 4096 + idx);
            const int er = isc ? (4096 + b * 32 + c) : (b * 512 + c);
            const bf16_t* s = H + (size_t)g * 1024; bf16_t* d = XIN + ((size_t)e * EROWS + er) * 1024;
            *(u32x4*)(d + lane * 8) = *(const u32x4*)(s + lane * 8); *(u32x4*)(d + 512 + lane * 8) = *(const u32x4*)(s + 512 + lane * 8);
        }
    }
}
DI void phase_moe_gemm1(const Bufs& B, const bf16_t* XIN, bf16_t* HID, bool has_ctx, char* smem) {
    const int ntm = (has_ctx ? EROWS : 4096) >> 7, per = ntm * 16, nt = NEXP * per;
    for (int t = blockIdx.x; t < nt; t += gridDim.x) {
        const int e = t / per, r = t % per, tm = r >> 4, tn = r & 15;
        GemmOp g; g.A = XIN + (size_t)e * EROWS * 1024; g.lda = 1024; g.Bt = B.W13 + (size_t)e * 2048 * 1024; g.ldb = 1024; g.kbeg = 0; g.kend = 1024;
        EpiSwiglu ep; ep.O = HID + (size_t)e * EROWS * 1024;
        gemm_tile(g, tm * 128, tn * 128, ep, smem);
    }
}
DI void phase_moe_gemm2(const Bufs& B, const bf16_t* HID, bf16_t* Y, bool has_ctx, char* smem) {
    const int ntm = (has_ctx ? EROWS : 4096) >> 7, per = ntm * 8, nt = NEXP * per;
    for (int t = blockIdx.x; t < nt; t += gridDim.x) {
        const int e = t / per, r = t % per, tm = r >> 3, tn = r & 7;
        GemmOp g; g.A = HID + (size_t)e * EROWS * 1024; g.lda = 1024; g.Bt = B.W2T + (size_t)e * 1024 * 1024; g.ldb = 1024; g.kbeg = 0; g.kend = 1024;
        EpiGate ep; ep.O = Y + (size_t)e * EROWS * 1024; ep.gate = B.GATE + e * EROWS;
        gemm_tile(g, tm * 128, tn * 128, ep, smem);
    }
}
DI void phase_combine(const Params& p, const Bufs& B, int layer, const bf16_t* Y, int ntok, bool last) {
    const int lane = threadIdx.x & 63, gw = blockIdx.x * 8 + (threadIdx.x >> 6), nw = gridDim.x * 8;
    for (int g = gw; g < ntok; g += nw) {
        float acc[16];
#pragma unroll
        for (int e = 0; e < 16; ++e) acc[e] = 0.f;
        for (int e = 0; e < NEXP; ++e) {
            const int c = B.INV[(size_t)g * 16 + e];
            if (c >= 0) {
                const bf16_t* yr = Y + ((size_t)e * EROWS + c) * 1024 + 4 * lane;
#pragma unroll
                for (int i = 0; i < 4; ++i) { const u32x2 t = *(const u32x2*)(yr + 256 * i); acc[4 * i] += bflo(t.x); acc[4 * i + 1] += bfhi(t.x); acc[4 * i + 2] += bflo(t.y); acc[4 * i + 3] += bfhi(t.y); }
            }
        }
        const float* gt = B.MOD + ((size_t)layer * 9 + modrow_of(g)) * 6144 + 5 * 1024;
        float* xr = B.X + (size_t)g * 1024;
#pragma unroll
        for (int i = 0; i < 4; ++i) {
            const f32x4 gv = *(const f32x4*)(gt + 256 * i + 4 * lane); f32x4 xv = *(const f32x4*)(xr + 256 * i + 4 * lane);
            xv[0] += gv[0] * acc[4 * i]; xv[1] += gv[1] * acc[4 * i + 1]; xv[2] += gv[2] * acc[4 * i + 2]; xv[3] += gv[3] * acc[4 * i + 3];
            *(f32x4*)(xr + 256 * i + 4 * lane) = xv;
            if (last) *(f32x4*)(p.out + (size_t)g * 1024 + 256 * i + 4 * lane) = xv;
        }
    }
}

DI void phase_attn_na(const Params& p, const bf16_t* QKV, bf16_t* AO, char* smem) {
    for (int u = blockIdx.x; u < 4096 + 256; u += gridDim.x) {
        if (u < 4096) {
            PolNA pol; pol.QKV = QKV; pol.AO = AO; pol.rpb = p.in[I_NA_RPB]; pol.bl = (const float*)(smem + 64 * 104 * 2 + 64 * 72 * 2);
            pol.b = u >> 9; pol.h = (u >> 5) & 15; pol.rr = u & 31;
            int rb = 2 * pol.rr - 4; rb = rb < 0 ? 0 : (rb > 56 ? 56 : rb); pol.rbase = rb;
            pol.c2 = 0.125f * LOG2E; pol.sink2 = 0.f;
            attn_unit(pol, smem);
        } else {
            const int v = u - 4096, b = v >> 5, h = (v >> 1) & 15, half = v & 1;
            PolPlain64 pol; pol.Qb = QKV + h * 64; pol.qs = 3072; pol.Kb = QKV + 1024 + h * 64; pol.ks = 3072; pol.Vb = QKV + 2048 + h * 64; pol.vs = 3072;
            pol.Ob = AO + h * 64; pol.os = 1024; pol.qrow0 = TL + b * 256 + 128 * half; pol.krow0 = TL + b * 256; pol.nt = 4; pol.c2 = 0.125f * LOG2E; pol.sink2 = 0.f;
            attn_unit(pol, smem);
        }
    }
}
DI void phase_attn_mla(const bf16_t* Q, const bf16_t* KV, const bf16_t* KR, bf16_t* AO, char* smem) {
    for (int u = blockIdx.x; u < 4096 + 256; u += gridDim.x) {
        PolMLA pol; pol.Q = Q; pol.KV = KV; pol.KR = KR; pol.AO = AO; pol.c2 = 0.10206207261596575f * LOG2E; pol.sink2 = 0.f;
        if (u < 4096) { pol.b = u >> 9; pol.h = (u >> 5) & 15; pol.qrow0 = pol.b * 4096 + 128 * (u & 31); pol.nt = 68; }
        else { const int v = u - 4096; pol.b = v >> 5; pol.h = (v >> 1) & 15; pol.qrow0 = TL + pol.b * 256 + 128 * (v & 1); pol.nt = 4; }
        attn_unit(pol, smem);
    }
}
DI void phase_attn_swa(const Params& p, const bf16_t* QKV, bf16_t* AO, char* smem) {
    for (int u = blockIdx.x; u < 4096; u += gridDim.x) {
        PolSWA pol; pol.QKV = QKV; pol.AO = AO; pol.b = u >> 9; pol.hq = (u >> 5) & 15; pol.s0 = 128 * (u & 31);
        pol.c2 = 0.125f * LOG2E; pol.sink2 = p.in[I_SWA_SINK][pol.hq] * LOG2E;
        attn_unit(pol, smem);
    }
}

constexpr int N_PHASES = 44;
constexpr int LDS_BYTES = 73728;
static_assert(GT_LDS <= LDS_BYTES && SCAN_LDS <= LDS_BYTES && ATT_LDS <= LDS_BYTES && TOPK_LDS <= LDS_BYTES && 65536 <= LDS_BYTES, "lds");

template <int SUB>
DI void moe_phase(const Params& p, const Bufs& B, int layer, char* smem) {
    const bool has_ctx = layer < 3;
    const int ntok = has_ctx ? TT : TL;
    bf16_t* H = B.slot(0); bf16_t* XIN = B.slot(1); bf16_t* HID = B.slot(3); bf16_t* Y = B.slot(1);
    if constexpr (SUB == 0) phase_norm2(p, B, layer, H, ntok, smem);
    else if constexpr (SUB == 1) phase_topk(B, H, XIN, has_ctx, smem);
    else if constexpr (SUB == 2) phase_moe_gemm1(B, XIN, HID, has_ctx, smem);
    else if constexpr (SUB == 3) phase_moe_gemm2(B, HID, Y, has_ctx, smem);
    else { phase_combine(p, B, layer, Y, ntok, layer == 3); if (layer < 3) { int base = 0; conv_moe_layer(p, B, layer + 1, base, smem); } }
}

template <int PH>
DI void run_phase(const Params& p, char* smem) {
    const Bufs B = make_bufs(p);
    bf16_t* H = B.slot(0);
    if constexpr (PH == 0) phase_prologue(p, B, smem);
    else if constexpr (PH == 1) phase_norm1(p, B, 0, H);
    else if constexpr (PH == 2) { GemmOp g{H, 1024, B.WMIX + W_NA_QKV, 1024, 0, 1024}; EpiBf16 e{B.slot(1), 3072}; gemm_all(g, TT, 3072, e, smem); }
    else if constexpr (PH == 3) phase_qknorm_na(p, B.slot(1));
    else if constexpr (PH == 4) phase_attn_na(p, B.slot(1), B.slot(4), smem);
    else if constexpr (PH == 5) { GemmOp g{B.slot(4), 1024, B.WMIX + W_NA_WO, 1024, 0, 1024}; EpiResidual e{B.X, B.MOD + (size_t)0 * 9 * 6144 + 2 * 1024}; gemm_all(g, TT, 1024, e, smem); }
    else if constexpr (PH >= 6 && PH <= 10) moe_phase<PH - 6>(p, B, 0, smem);
    else if constexpr (PH == 11) phase_norm1_rw(p, B, 1, B.slot(0));
    else if constexpr (PH == 12) { GemmOp g{B.slot(0), 2048, B.WMIX + W_RW_B1, 2048, 0, 2048}; EpiRW1 e{B.slot(2), B.slot(5)}; gemm_all(g, TT, 3584, e, smem); }
    else if constexpr (PH == 13) phase_rw_gemm2(p, B, B.slot(5), B.slot(0), B.slot(1), B.slot(6), B.slot(7), B.slot(8), smem);
    else if constexpr (PH == 14) phase_rw_scan(p, B.slot(2), B.slot(1), B.slot(6), B.slot(7), B.slot(8), B.slot(9), B.slot(5), smem);
    else if constexpr (PH == 15) phase_rw_readout(p, B.slot(2), B.slot(7), B.slot(8), B.slot(0), B.slot(9), B.slot(5), B.slot(1));
    else if constexpr (PH == 16) { GemmOp g{B.slot(1), 1024, B.WMIX + W_RW_WO, 1024, 0, 1024}; EpiResidual e{B.X, B.MOD + (size_t)1 * 9 * 6144 + 2 * 1024}; gemm_all(g, TT, 1024, e, smem); }
    else if constexpr (PH >= 17 && PH <= 21) moe_phase<PH - 17>(p, B, 1, smem);
    else if constexpr (PH == 22) phase_norm1(p, B, 2, H);
    else if constexpr (PH == 23) { GemmOp g{H, 1024, B.WMIX + W_MLA_DOWN, 1024, 0, 1024}; EpiF32 e{(float*)B.slot(1), 768}; gemm_all(g, TT, 768, e, smem); }
    else if constexpr (PH == 24) { bf16_t* CQ = B.slot(3); phase_mla_dnorm(p, B, (const float*)B.slot(1), CQ, CQ + (size_t)TT * 384, CQ + (size_t)TT * 640); }
    else if constexpr (PH == 25) {
        bf16_t* CQ = B.slot(3);
        { GemmOp g{CQ, 384, B.WMIX + W_MLA_UQ, 384, 0, 384}; EpiBf16 e{B.slot(4), 1536}; gemm_all(g, TT, 1536, e, smem); }
        { GemmOp g{CQ + (size_t)TT * 384, 256, B.WMIX + W_MLA_UKV, 256, 0, 256}; EpiBf16 e{B.slot(6), 2048}; gemm_all(g, TT, 2048, e, smem); }
    }
    else if constexpr (PH == 26) phase_mla_hnorm(p, B, B.slot(4), B.slot(6));
    else if constexpr (PH == 27) phase_attn_mla(B.slot(4), B.slot(6), B.slot(3) + (size_t)TT * 640, B.slot(8), smem);
    else if constexpr (PH == 28) { GemmOp g{B.slot(8), 1024, B.WMIX + W_MLA_WO, 1024, 0, 1024}; EpiResidual e{B.X, B.MOD + (size_t)2 * 9 * 6144 + 2 * 1024}; gemm_all(g, TT, 1024, e, smem); }
    else if constexpr (PH >= 29 && PH <= 33) moe_phase<PH - 29>(p, B, 2, smem);
    else if constexpr (PH == 34) phase_norm1(p, B, 3, H);
    else if constexpr (PH == 35) { GemmOp g{H, 1024, B.WMIX + W_SWA_QKV, 1024, 0, 1024}; EpiBf16 e{B.slot(1), 1536}; gemm_all(g, TT, 1536, e, smem); }
    else if constexpr (PH == 36) phase_qknorm_swa(p, B, B.slot(1));
    else if constexpr (PH == 37) phase_attn_swa(p, B.slot(1), B.slot(3), smem);
    else if constexpr (PH == 38) { GemmOp g{B.slot(3), 1024, B.WMIX + W_SWA_WO, 1024, 0, 1024}; EpiResidual e{B.X, B.MOD + (size_t)3 * 9 * 6144 + 2 * 1024}; gemm_all(g, TL, 1024, e, smem); }
    else if constexpr (PH >= 39 && PH <= 43) moe_phase<PH - 39>(p, B, 3, smem);
}

#define XB_TMO      128
#define XB_XCNT(j)  (256  + 64 * (j))
#define XB_XSUB(j)  (1280 + 64 * (j))
#define XB_XGEN(j)  (2304 + 64 * (j))
#define XB_TOP      3328
#define XB_TOPGEN   3392
#define XCD_BAR_WORDS 3456
#define XB_SPIN_CAP (1u << 18)

__device__ __forceinline__ unsigned xb_ld(unsigned* p)              { return __hip_atomic_load(p, __ATOMIC_RELAXED, __HIP_MEMORY_SCOPE_AGENT); }
__device__ __forceinline__ unsigned xb_add(unsigned* p, unsigned v) { return __hip_atomic_fetch_add(p, v, __ATOMIC_RELAXED, __HIP_MEMORY_SCOPE_AGENT); }
__device__ __forceinline__ unsigned xb_xcc_id() { return (unsigned)__builtin_amdgcn_s_getreg((3 << 11) | 20) & 0xFu; }
#define XB_SPIN(cond, bar) do { unsigned _sp = 0; while (cond) { __builtin_amdgcn_s_sleep(1); \
    if ((++_sp & 255u) == 0u) { if (xb_ld(&(bar)[XB_TMO])) break; if (_sp > XB_SPIN_CAP) { atomicAdd(&(bar)[XB_TMO], 1u); break; } } } } while (0)

struct XcdBarrier {
    unsigned* bar; unsigned x;
    volatile LAS unsigned* st;
};

__device__ __forceinline__ XcdBarrier xcd_barrier_post(unsigned* bar, volatile LAS unsigned* st) {
    XcdBarrier b; b.bar = bar; b.x = xb_xcc_id(); b.st = st;
    if (threadIdx.x == 0) (void)xb_add(&bar[XB_XCNT(b.x)], 1u);
    return b;
}
__device__ __forceinline__ void xcd_barrier_complete(unsigned* bar, unsigned x, unsigned& nloc, unsigned& nx) {
    const unsigned G = gridDim.x * gridDim.y * gridDim.z;
    unsigned sum, cnt, mine, sp = 0u;
    for (;;) {
        sum = 0u; cnt = 0u; mine = 0u;
#pragma unroll
        for (unsigned j = 0; j < 16; ++j) { const unsigned c = xb_ld(&bar[XB_XCNT(j)]); sum += c; cnt += (c > 0u) ? 1u : 0u; mine = (j == x) ? c : mine; }
        if (sum == G) break;
        __builtin_amdgcn_s_sleep(1);
        if ((++sp & 255u) == 0u) { if (xb_ld(&bar[XB_TMO])) break; if (sp > XB_SPIN_CAP) { atomicAdd(&bar[XB_TMO], 1u); break; } }
    }
    nloc = mine > 0u ? mine : 1u; nx = cnt > 0u ? cnt : 1u;
}

__device__ __forceinline__ void xcd_barrier(const XcdBarrier& b) {
    asm volatile("s_waitcnt vmcnt(0)" ::: "memory");
    __syncthreads();
    if (threadIdx.x == 0) {
        unsigned* bar = b.bar;
        __builtin_amdgcn_s_waitcnt(0);
        unsigned nloc = b.st[0], nx = b.st[1];
        if (nloc == 0u) { xcd_barrier_complete(bar, b.x, nloc, nx); b.st[0] = nloc; b.st[1] = nx; }
        const unsigned old = xb_add(&bar[XB_XSUB(b.x)], 1u);
        const unsigned gen = old / nloc;
        if (old + 1u == (gen + 1u) * nloc) {
            __builtin_amdgcn_fence(__ATOMIC_RELEASE, "agent");
            asm volatile("s_waitcnt vmcnt(0)" ::: "memory");
            const unsigned og = xb_add(&bar[XB_TOP], 1u);
            const unsigned tg = og / nx;
            if (og + 1u == (tg + 1u) * nx) xb_add(&bar[XB_TOPGEN], 1u);
            else XB_SPIN(xb_ld(&bar[XB_TOPGEN]) == tg, bar);
            __builtin_amdgcn_fence(__ATOMIC_ACQUIRE, "agent");
            xb_add(&bar[XB_XGEN(b.x)], 1u);
            asm volatile("s_waitcnt vmcnt(0)" ::: "memory");
        } else {
            XB_SPIN(xb_ld(&bar[XB_XGEN(b.x)]) == gen, bar);
            __builtin_amdgcn_fence(__ATOMIC_ACQUIRE, "agent");
            asm volatile("s_waitcnt vmcnt(0)" ::: "memory");
        }
    }
    __syncthreads();
}

constexpr int LDS_REQ = 98304;

#if MULTI_LAUNCH
template <int PH>
__global__ void __launch_bounds__(NTHR, 2) k_phase(Params p) {
    extern __shared__ __attribute__((aligned(16))) char smem[];
    run_phase<PH>(p, smem);
}
template <int PH>
static void launch_from(const Params& p, int grid, hipStream_t stream, bool setattr) {
    if constexpr (PH < N_PHASES) {
        if (setattr) (void)hipFuncSetAttribute((const void*)k_phase<PH>, hipFuncAttributeMaxDynamicSharedMemorySize, LDS_REQ);
        else hipLaunchKernelGGL(k_phase<PH>, dim3(grid), dim3(NTHR), LDS_REQ, stream, p);
        launch_from<PH + 1>(p, grid, stream, setattr);
    }
}
#else
template <int PH>
DI void run_all(const Params& p, char* smem, const XcdBarrier& bar) {
    if constexpr (PH < N_PHASES) {
        run_phase<PH>(p, smem);
        if constexpr (PH + 1 < N_PHASES) xcd_barrier(bar);
        run_all<PH + 1>(p, smem, bar);
    }
}
__global__ void __launch_bounds__(NTHR, 2) k_mega(Params p) {
    extern __shared__ __attribute__((aligned(16))) char smem[];
    if (threadIdx.x == 0) *(u32x4*)(smem + LDS_BYTES) = (u32x4){0u, 0u, 0u, 0u};
    __syncthreads();
    const XcdBarrier bar = xcd_barrier_post((unsigned*)(p.ws + OFF_CTL), (volatile LAS unsigned*)(LAS char*)(smem + LDS_BYTES));
    run_all<0>(p, smem, bar);
}
#endif

extern "C" void kernel_launch(void* const* d_in, const int* in_sizes, int n_in, void* d_out, int out_size, void* d_ws, size_t ws_size, hipStream_t stream) {
    static int grid = 0;
    Params p{};
    for (int i = 0; i < N_INPUTS; ++i) p.in[i] = (const float*)d_in[i];
    p.out = (float*)d_out; p.ws = (unsigned char*)d_ws;
    if (grid == 0) {
        if (n_in != N_INPUTS || out_size != TL * 1024 || ws_size < WS_NEED) { grid = -1; return; }
        int dev = 0, cus = 0;
        if (hipGetDevice(&dev) != hipSuccess || hipDeviceGetAttribute(&cus, hipDeviceAttributeMultiprocessorCount, dev) != hipSuccess) { grid = -1; return; }
#if MULTI_LAUNCH
        launch_from<0>(p, 0, stream, true);
#else
        if (hipFuncSetAttribute((const void*)k_mega, hipFuncAttributeMaxDynamicSharedMemorySize, LDS_REQ) != hipSuccess) { grid = -1; return; }
#endif
        grid = cus > 0 ? cus : 256;
    }
    if (grid < 0) return;
    (void)hipMemsetAsync((char*)d_ws + OFF_CTL, 0, 65536, stream);
#if MULTI_LAUNCH
    launch_from<0>(p, grid, stream, false);
#else
    hipLaunchKernelGGL(k_mega, dim3(grid), dim3(NTHR), LDS_REQ, stream, p);
#endif
}
```

```cpp
#include <hip/hip_runtime.h>
#include <stdint.h>

#ifndef MULTI_LAUNCH
#define MULTI_LAUNCH 0
#endif
#ifndef USE_PG8
#define USE_PG8 1
#endif
#ifndef PROBE
#define PROBE 0
#endif
#ifndef USE_SCAN2
#define USE_SCAN2 1
#endif
#ifndef ATT_SCHED_FENCE
#define ATT_SCHED_FENCE 0
#endif
#ifndef GATHER_A
#define GATHER_A 1
#endif

typedef unsigned short bf16_t;
typedef short bf16x8 __attribute__((ext_vector_type(8)));
typedef short s16x4 __attribute__((ext_vector_type(4)));
typedef float f32x4 __attribute__((ext_vector_type(4)));
typedef unsigned u32x4 __attribute__((ext_vector_type(4)));
typedef unsigned u32x2 __attribute__((ext_vector_type(2)));
#define LAS __attribute__((address_space(3)))
#define DI __device__ __forceinline__
DI int TIDX() { int t = (int)threadIdx.x; asm volatile("" : "+v"(t)); return t; }

constexpr int NTHR = 512;
constexpr int D = 1024, NB = 8, SEQ = 4096, CTXL = 256;
constexpr int TL = NB * SEQ, TC = NB * CTXL, TT = TL + TC;
constexpr int NEXP = 16, CAPL = 512, CAPC = 32, EROWS = NB * CAPL + NB * CAPC;
constexpr float LOG2E = 1.4426950408889634f;

enum { I_X = 0, I_C, I_CTX, I_CCTX, I_N1G, I_N2G, I_ADAW, I_ADAB,
       I_NA_WQKV, I_NA_QG, I_NA_KG, I_NA_RPB, I_NA_WO,
       I_RW_MIX, I_RW_WR, I_RW_WK, I_RW_WV, I_RW_W0, I_RW_W1, I_RW_W2, I_RW_A0, I_RW_A1, I_RW_A2, I_RW_G1, I_RW_G2,
       I_RW_KK, I_RW_KA, I_RW_RK, I_RW_LNG, I_RW_LNB, I_RW_WO,
       I_MLA_WDOWN, I_MLA_QNG, I_MLA_KVNG, I_MLA_WUQ, I_MLA_WUKV, I_MLA_QN_G, I_MLA_QR_G, I_MLA_KN_G, I_MLA_KR_G, I_MLA_WO,
       I_SWA_WQKV, I_SWA_QG, I_SWA_KG, I_SWA_SINK, I_SWA_WO,
       I_MOE_ROUTER, I_MOE_W1, I_MOE_W3, I_MOE_W2, N_INPUTS };

constexpr size_t MiB = 1u << 20;
constexpr size_t OFF_CTL = 0;
constexpr size_t OFF_MOD = 65536;
constexpr size_t OFF_ROPE_M = OFF_MOD + 4 * 9 * 6144 * 4;
constexpr size_t OFF_ROPE_S = OFF_ROPE_M + 2 * 4096 * 16 * 4;
constexpr size_t OFF_X = 4 * MiB;
constexpr size_t OFF_WMIX = 140 * MiB;
constexpr size_t OFF_WE = 180 * MiB;
constexpr size_t OFF_MISC = 276 * MiB;
constexpr size_t OFF_WORK = 284 * MiB;
constexpr size_t USLOT = (size_t)TT * 1024 * 2;
constexpr size_t OFF_W2TB = OFF_WORK + 10 * USLOT;
constexpr size_t WS_NEED = OFF_W2TB + 32 * MiB;
static_assert(OFF_ROPE_S + 2 * 4096 * 32 * 4 <= OFF_X, "map");
static_assert(OFF_X + (size_t)TT * 1024 * 4 <= OFF_WMIX, "map");

constexpr size_t W_NA_QKV = 0, W_NA_WO = 3145728, W_RW_B1 = 4194304, W_RW_B2 = 11534336, W_RW_WO = 13500416,
                 W_MLA_DOWN = 14548992, W_MLA_UQ = 15335424, W_MLA_UKV = 15925248, W_MLA_WO = 16449536,
                 W_SWA_QKV = 17498112, W_SWA_WO = 19070976, W_MIX_END = 20119552;
static_assert(OFF_WMIX + W_MIX_END * 2 <= OFF_WE, "map");
static_assert(OFF_WE + 96 * MiB <= OFF_MISC, "map");
constexpr size_t OFF_AFF = OFF_MISC;
constexpr size_t OFF_AFFC = OFF_AFF + 8 * 16 * 4096 * 4;
constexpr size_t OFF_IDX = OFF_AFFC + 8 * 16 * 256 * 4;
constexpr size_t OFF_GATE = OFF_IDX + 16 * EROWS * 4;
constexpr size_t OFF_INV = OFF_GATE + 16 * EROWS * 4;
static_assert(OFF_INV + (size_t)TT * 16 * 4 <= OFF_WORK, "map");

struct Params {
    const float* in[N_INPUTS];
    float* out;
    unsigned char* ws;
};

DI unsigned f2bf(float f) { unsigned u = __float_as_uint(f); return (u + 0x7fffu + ((u >> 16) & 1u)) >> 16; }
typedef float f32x2_t __attribute__((ext_vector_type(2)));
typedef __bf16 bf16x2_t __attribute__((ext_vector_type(2)));
DI unsigned pk2(float lo, float hi) { const f32x2_t v = {lo, hi}; const bf16x2_t b = __builtin_convertvector(v, bf16x2_t); return __builtin_bit_cast(unsigned, b); }
DI float bf2f(unsigned b) { return __uint_as_float(b << 16); }
DI float bflo(unsigned w) { return __uint_as_float(w << 16); }
DI float bfhi(unsigned w) { return __uint_as_float(w & 0xffff0000u); }
DI float wave_sum(float v) {
    v += __shfl_xor(v, 32); v += __shfl_xor(v, 16); v += __shfl_xor(v, 8); v += __shfl_xor(v, 4); v += __shfl_xor(v, 2); v += __shfl_xor(v, 1); return v; }
DI float fsigmoid(float x) { return 1.0f / (1.0f + __expf(-x)); }
DI float fexp2(float x) { return __builtin_amdgcn_exp2f(x); }
DI int modrow_of(int g) { return g < TL ? (g >> 12) : 8; }
DI void unpack8(u32x4 v, float* f) { f[0] = bflo(v.x); f[1] = bfhi(v.x); f[2] = bflo(v.y); f[3] = bfhi(v.y); f[4] = bflo(v.z); f[5] = bfhi(v.z); f[6] = bflo(v.w); f[7] = bfhi(v.w); }
DI u32x4 pack8(const float* f) { u32x4 v; v.x = pk2(f[0], f[1]); v.y = pk2(f[2], f[3]); v.z = pk2(f[4], f[5]); v.w = pk2(f[6], f[7]); return v; }

struct GemmOp { const bf16_t* A; long lda; const bf16_t* Bt; long ldb; int kbeg, kend; };
constexpr int GT_LDS = 4 * 128 * 72 * 2;

template <class Epi>
DI void gemm_tile(const GemmOp& g, int row0, int col0, const Epi& epi, char* smem) {
    const int tid = TIDX(), lane = tid & 63, w = tid >> 6, wm = w >> 2, wn = w & 3, l15 = lane & 15, quad = lane >> 4;
    bf16_t* As = (bf16_t*)smem;
    bf16_t* Bs = As + 2 * 128 * 72;
    const int lr = tid >> 3, lc = (tid & 7) * 8;
    const bf16_t* ga0 = g.A + (long)(row0 + lr) * g.lda + g.kbeg + lc;
    const bf16_t* ga1 = ga0 + 64 * g.lda;
    const bf16_t* gb0 = g.Bt + (long)(col0 + lr) * g.ldb + g.kbeg + lc;
    const bf16_t* gb1 = gb0 + 64 * g.ldb;
    f32x4 acc[4][2];
#pragma unroll
    for (int i = 0; i < 4; ++i) { acc[i][0] = (f32x4){0.f, 0.f, 0.f, 0.f}; acc[i][1] = (f32x4){0.f, 0.f, 0.f, 0.f}; }
    u32x4 ra0 = *(const u32x4*)ga0, ra1 = *(const u32x4*)ga1, rb0 = *(const u32x4*)gb0, rb1 = *(const u32x4*)gb1;
    *(u32x4*)(As + lr * 72 + lc) = ra0; *(u32x4*)(As + (lr + 64) * 72 + lc) = ra1;
    *(u32x4*)(Bs + lr * 72 + lc) = rb0; *(u32x4*)(Bs + (lr + 64) * 72 + lc) = rb1;
    __syncthreads();
    const int nk = (g.kend - g.kbeg) >> 6;
    for (int kt = 0; kt < nk; ++kt) {
        const int cur = kt & 1;
        const bool more = (kt + 1 < nk);
        if (more) { const int ko = (kt + 1) * 64; ra0 = *(const u32x4*)(ga0 + ko); ra1 = *(const u32x4*)(ga1 + ko); rb0 = *(const u32x4*)(gb0 + ko); rb1 = *(const u32x4*)(gb1 + ko); }
        const bf16_t* a = As + cur * 128 * 72;
        const bf16_t* b = Bs + cur * 128 * 72;
#pragma unroll
        for (int ks = 0; ks < 2; ++ks) {
            bf16x8 af[4], bfr[2];
#pragma unroll
            for (int mt = 0; mt < 4; ++mt) af[mt] = *(const bf16x8*)(a + (wm * 64 + mt * 16 + l15) * 72 + ks * 32 + quad * 8);
#pragma unroll
            for (int nt = 0; nt < 2; ++nt) bfr[nt] = *(const bf16x8*)(b + (wn * 32 + nt * 16 + l15) * 72 + ks * 32 + quad * 8);
#pragma unroll
            for (int mt = 0; mt < 4; ++mt)
#pragma unroll
                for (int nt = 0; nt < 2; ++nt) acc[mt][nt] = __builtin_amdgcn_mfma_f32_16x16x32_bf16(bfr[nt], af[mt], acc[mt][nt], 0, 0, 0);
        }
        if (more) {
            bf16_t* a2 = As + (cur ^ 1) * 128 * 72; bf16_t* b2 = Bs + (cur ^ 1) * 128 * 72;
            *(u32x4*)(a2 + lr * 72 + lc) = ra0; *(u32x4*)(a2 + (lr + 64) * 72 + lc) = ra1;
            *(u32x4*)(b2 + lr * 72 + lc) = rb0; *(u32x4*)(b2 + (lr + 64) * 72 + lc) = rb1;
        }
        __syncthreads();
    }
#pragma unroll
    for (int mt = 0; mt < 4; ++mt) epi(row0 + wm * 64 + mt * 16 + l15, col0 + wn * 32 + quad * 4, acc[mt][0], acc[mt][1]);
}

template <class Epi>
DI void gemm_all(const GemmOp& g, int M, int N, const Epi& epi, char* smem) {
    const int ntn = N >> 7, nt = (M >> 7) * ntn;
    for (int t = blockIdx.x; t < nt; t += gridDim.x) gemm_tile(g, (t / ntn) * 128, (t % ntn) * 128, epi, smem);
}

DI void st_bf16x4(bf16_t* p, f32x4 a) { u32x2 v; v.x = pk2(a[0], a[1]); v.y = pk2(a[2], a[3]); *(u32x2*)p = v; }
struct EpiBf16 { bf16_t* O; long ldo;
    DI void operator()(int row, int col, f32x4 a0, f32x4 a1) const { bf16_t* p = O + (long)row * ldo + col; st_bf16x4(p, a0); st_bf16x4(p + 16, a1); } };
struct EpiF32 { float* O; long ldo;
    DI void operator()(int row, int col, f32x4 a0, f32x4 a1) const { float* p = O + (long)row * ldo + col; *(f32x4*)p = a0; *(f32x4*)(p + 16) = a1; } };
struct EpiResidual { float* X; const float* gate;
    DI void operator()(int row, int col, f32x4 a0, f32x4 a1) const {
        const float* gp = gate + (long)modrow_of(row) * 6144 + col; float* xp = X + (long)row * 1024 + col;
        f32x4 g0 = *(const f32x4*)gp, g1 = *(const f32x4*)(gp + 16), x0 = *(const f32x4*)xp, x1 = *(const f32x4*)(xp + 16);
        *(f32x4*)xp = x0 + g0 * a0; *(f32x4*)(xp + 16) = x1 + g1 * a1; } };
struct EpiResidualCtx { float* Xout; const float* Xin; const float* gate;
    DI void operator()(int row, int col, f32x4 a0, f32x4 a1) const {
        const float* gp = gate + col; const float* ip = Xin + (long)row * 1024 + col; float* xp = Xout + (long)row * 1024 + col;
        const f32x4 g0 = *(const f32x4*)gp, g1 = *(const f32x4*)(gp + 16), x0 = *(const f32x4*)ip, x1 = *(const f32x4*)(ip + 16);
        *(f32x4*)xp = x0 + g0 * a0; *(f32x4*)(xp + 16) = x1 + g1 * a1; } };
struct EpiSwiglu { bf16_t* O;
    DI void operator()(int row, int col, f32x4 a0, f32x4 a1) const {
        const int f = ((col >> 7) << 6) + (((col & 127) >> 5) << 4) + (col & 15);
        f32x4 h;
#pragma unroll
        for (int i = 0; i < 4; ++i) h[i] = a0[i] * fsigmoid(a0[i]) * a1[i];
        st_bf16x4(O + (long)row * 1024 + f, h); } };
struct EpiGate { bf16_t* O; const float* gate;
    DI void operator()(int row, int col, f32x4 a0, f32x4 a1) const { const float gt = gate[row]; bf16_t* p = O + (long)row * 1024 + col; st_bf16x4(p, a0 * gt); st_bf16x4(p + 16, a1 * gt); } };


DI float quad_max(float v) {
    auto a = __builtin_amdgcn_permlane16_swap(__float_as_uint(v), __float_as_uint(v), false, false); v = fmaxf(__uint_as_float(a[0]), __uint_as_float(a[1]));
    auto b = __builtin_amdgcn_permlane32_swap(__float_as_uint(v), __float_as_uint(v), false, false); return fmaxf(__uint_as_float(b[0]), __uint_as_float(b[1]));
}
DI float quad_sum(float v) {
    auto a = __builtin_amdgcn_permlane16_swap(__float_as_uint(v), __float_as_uint(v), false, false); v = __uint_as_float(a[0]) + __uint_as_float(a[1]);
    auto b = __builtin_amdgcn_permlane32_swap(__float_as_uint(v), __float_as_uint(v), false, false); return __uint_as_float(b[0]) + __uint_as_float(b[1]);
}

namespace pg8 {
#define PG8_LAS __attribute__((address_space(3)))
typedef unsigned short bf16_t;
typedef short bf16x8 __attribute__((ext_vector_type(8)));
typedef float f32x4 __attribute__((ext_vector_type(4)));
typedef unsigned u32x4 __attribute__((ext_vector_type(4)));
constexpr int BM = 256, BK = 64, HALF = 128, HTB = HALF * BK * 2  , STAGE_BYTES = 8 * HTB, NXCD = 8, WGM = 8;

__host__ __device__ __forceinline__ int lds_byte(int r, int c) { const int st = (r >> 4) * 2 + (c >> 5), rr = r & 15, cc = c & 31, ob = rr * 64 + cc * 2; return st * 1024 + (ob ^ (((ob >> 9) & 1) << 5)); }
__host__ __device__ __forceinline__ void stage_rc(int b, int& R, int& C) { const int st = b / 1024, sb = b % 1024, swz = sb ^ (((sb >> 9) & 1) << 5); R = (st >> 1) * 16 + swz / 64; C = (st & 1) * 32 + (swz % 64) / 2; }
__host__ __device__ __forceinline__ int perm32(int rho) { const int n = rho >> 4, i = rho & 15; return 8 * (i >> 2) + 4 * n + (i & 3); }

struct Unit { int pm, pn; };
struct Gemm { const bf16_t* A; const bf16_t* Bt; int M, N, K; };

struct StaticOrder {
    int nM, nN, nwg, G, c;
    __host__ __device__ void init(int M, int N, int G_, int c_) { nM = M / BM; nN = N / BM; nwg = nM * nN; G = G_; c = c_; }
    __host__ __device__ bool next(int i, Unit& u) const {
        const long L = (long)i * G + c; if (L >= nwg) return false;
        int wgid = (int)L; { const int q = nwg / NXCD, r = nwg % NXCD, xcd = wgid % NXCD, off = wgid / NXCD; wgid = (xcd < r ? xcd * (q + 1) : r * (q + 1) + (xcd - r) * q) + off; }
        const int nig = WGM * nN, gid = wgid / nig, fm = gid * WGM, gsz = (nM - fm) < WGM ? (nM - fm) : WGM;
        u.pm = fm + ((wgid % nig) % gsz); u.pn = (wgid % nig) / gsz; return true;
    }
    __device__ __forceinline__ void a_ready(const Unit&) const {}
    __device__ __forceinline__ void done(const Unit&) const {}
};
__device__ __forceinline__ unsigned cvt_pk_bf16(float lo, float hi) { return ::pk2(lo, hi); }
__device__ __forceinline__ u32x4 pk8(f32x4 v0, f32x4 v1) { u32x4 w; w.x = cvt_pk_bf16(v0[0], v0[1]); w.y = cvt_pk_bf16(v0[2], v0[3]); w.z = cvt_pk_bf16(v1[0], v1[1]); w.w = cvt_pk_bf16(v1[2], v1[3]); return w; }
struct PEpiBf16 {
    static constexpr bool PERM = true, AFTER_DRAIN = false;
    bf16_t* O; long ldo;
    __device__ __forceinline__ void operator()(const f32x4 (&acc)[2][2][4][2], const Unit& u, int wr, int wc, int fr, int fq) const {
        const int row0 = u.pm * BM + wr * 64 + fr, col0 = u.pn * BM + wc * 32 + 8 * fq;
#pragma unroll
        for (int ai = 0; ai < 2; ++ai)
#pragma unroll
            for (int m = 0; m < 4; ++m) { bf16_t* rowp = O + (long)(row0 + ai * HALF + m * 16) * ldo + col0;
#pragma unroll
                for (int bj = 0; bj < 2; ++bj) *(u32x4*)(rowp + bj * HALF) = pk8(acc[ai][bj][m][0], acc[ai][bj][m][1]); }
    }
};
struct PEpiF32 {
    static constexpr bool PERM = false, AFTER_DRAIN = false;
    float* C; long ldc;
    __device__ __forceinline__ void operator()(const f32x4 (&acc)[2][2][4][2], const Unit& u, int wr, int wc, int fr, int fq) const {
        const int row0 = u.pm * BM + wr * 64 + fr, col0 = u.pn * BM + wc * 32 + 4 * fq;
#pragma unroll
        for (int ai = 0; ai < 2; ++ai)
#pragma unroll
            for (int m = 0; m < 4; ++m) { float* rowp = C + (long)(row0 + ai * HALF + m * 16) * ldc + col0;
#pragma unroll
                for (int bj = 0; bj < 2; ++bj)
#pragma unroll
                    for (int n = 0; n < 2; ++n) *(f32x4*)(rowp + bj * HALF + n * 16) = acc[ai][bj][m][n]; }
    }
};
struct PEpiResidual {
    static constexpr bool PERM = false, AFTER_DRAIN = false;
    float* X; const float* gate; const float* Xl; const float* Xc;
    __device__ __forceinline__ void operator()(const f32x4 (&acc)[2][2][4][2], const Unit& u, int wr, int wc, int fr, int fq) const {
        const int row0 = u.pm * BM + wr * 64 + fr, col0 = u.pn * BM + wc * 32 + 4 * fq;
        const float* gp = gate + (long)((row0 < 32768) ? (row0 >> 12) : 8) * 6144 + col0;
        f32x4 gv[2][2];
#pragma unroll
        for (int bj = 0; bj < 2; ++bj)
#pragma unroll
            for (int n = 0; n < 2; ++n) gv[bj][n] = *(const f32x4*)(gp + bj * HALF + n * 16);
#pragma unroll
        for (int ai = 0; ai < 2; ++ai)
#pragma unroll
            for (int m = 0; m < 4; ++m) { const long row = row0 + ai * HALF + m * 16; float* rowp = X + row * 1024 + col0;
                const float* inp = ((row0 < 32768) ? (Xl + row * 1024) : (Xc + (row - 32768) * 1024)) + col0;
#pragma unroll
                for (int bj = 0; bj < 2; ++bj)
#pragma unroll
                    for (int n = 0; n < 2; ++n) { const f32x4 x = *(const f32x4*)(inp + bj * HALF + n * 16); *(f32x4*)(rowp + bj * HALF + n * 16) = x + gv[bj][n] * acc[ai][bj][m][n]; }
                asm volatile("" ::: "memory"); }
    }
};
struct PEpiSwiglu {
    static constexpr bool PERM = true, AFTER_DRAIN = false;
    bf16_t* O;
    __device__ __forceinline__ void operator()(const f32x4 (&acc)[2][2][4][2], const Unit& u, int wr, int wc, int fr, int fq) const {
        const int row0 = u.pm * BM + wr * 64 + fr, f0 = (u.pn & 7) * HALF + wc * 32 + 8 * fq;
#pragma unroll
        for (int ai = 0; ai < 2; ++ai)
#pragma unroll
            for (int m = 0; m < 4; ++m) {
                f32x4 h0, h1;
#pragma unroll
                for (int i = 0; i < 4; ++i) { const float a = acc[ai][0][m][0][i], b = acc[ai][0][m][1][i];
                    h0[i] = a * __builtin_amdgcn_rcpf(1.0f + __expf(-a)) * acc[ai][1][m][0][i]; h1[i] = b * __builtin_amdgcn_rcpf(1.0f + __expf(-b)) * acc[ai][1][m][1][i]; }
                *(u32x4*)(O + (long)(row0 + ai * HALF + m * 16) * 1024 + f0) = pk8(h0, h1); }
    }
};
struct PEpiGate {
    static constexpr bool PERM = true, AFTER_DRAIN = false;
    bf16_t* O; const float* gate;
    __device__ __forceinline__ void operator()(const f32x4 (&acc)[2][2][4][2], const Unit& u, int wr, int wc, int fr, int fq) const {
        const int row0 = u.pm * BM + wr * 64 + fr, col0 = (u.pn & 3) * BM + wc * 32 + 8 * fq;
#pragma unroll
        for (int ai = 0; ai < 2; ++ai)
#pragma unroll
            for (int m = 0; m < 4; ++m) { const int row = row0 + ai * HALF + m * 16; const float gt = gate[row]; bf16_t* rowp = O + (long)row * 1024 + col0;
#pragma unroll
                for (int bj = 0; bj < 2; ++bj) *(u32x4*)(rowp + bj * HALF) = pk8(acc[ai][bj][m][0] * gt, acc[ai][bj][m][1] * gt); }
    }
};
struct PEpiQKNorm {
    static constexpr bool PERM = true, AFTER_DRAIN = false;
    bf16_t* O; long ldo; int nq, nk; const float* qg; const float* kg; const float* rope;
    __device__ __forceinline__ void operator()(const f32x4 (&acc)[2][2][4][2], const Unit& u, int wr, int wc, int fr, int fq) const {
        const int row0 = u.pm * BM + wr * 64 + fr, cb = u.pn * BM + 64 * wc + 8 * fq;
        const int kind = (u.pn < nq) ? 0 : ((u.pn < nk) ? 1 : 2);
        f32x4 gn[2][2];
        if (kind < 2) { const float* g = kind ? kg : qg;
#pragma unroll
            for (int bj = 0; bj < 2; ++bj)
#pragma unroll
                for (int n = 0; n < 2; ++n) gn[bj][n] = *(const f32x4*)(g + 32 * bj + 8 * fq + 4 * n); }
#pragma unroll
        for (int ai = 0; ai < 2; ++ai)
#pragma unroll
            for (int m = 0; m < 4; ++m) {
                const int row = row0 + ai * HALF + m * 16;
                f32x4 x[2][2];
#pragma unroll
                for (int bj = 0; bj < 2; ++bj)
#pragma unroll
                    for (int n = 0; n < 2; ++n) x[bj][n] = acc[ai][bj][m][n];
                if (kind < 2) {
                    float ss = 0.f;
#pragma unroll
                    for (int bj = 0; bj < 2; ++bj)
#pragma unroll
                        for (int n = 0; n < 2; ++n) ss += (x[bj][n][0] * x[bj][n][0] + x[bj][n][1] * x[bj][n][1]) + (x[bj][n][2] * x[bj][n][2] + x[bj][n][3] * x[bj][n][3]);
                    ss = ::quad_sum(ss);
                    const float r = rsqrtf(ss * (1.0f / 64.0f) + 1e-6f);
#pragma unroll
                    for (int bj = 0; bj < 2; ++bj)
#pragma unroll
                        for (int n = 0; n < 2; ++n) x[bj][n] = x[bj][n] * r * gn[bj][n];
                    if (rope != nullptr && row < 32768) {
                        const float* cs = rope + (long)(row & 4095) * 32 + 8 * fq; const float* sn = cs + 4096 * 32;
#pragma unroll
                        for (int n = 0; n < 2; ++n) { const f32x4 c = *(const f32x4*)(cs + 4 * n), sv = *(const f32x4*)(sn + 4 * n);
                            const f32x4 a = x[0][n], b = x[1][n]; x[0][n] = a * c - b * sv; x[1][n] = b * c + a * sv; }
                    }
                }
                bf16_t* rowp = O + (long)row * ldo + cb;
#pragma unroll
                for (int bj = 0; bj < 2; ++bj) *(u32x4*)(rowp + 32 * bj) = pk8(x[bj][0], x[bj][1]);
            }
    }
};
struct PEpiRW1 {
    static constexpr bool PERM = true, AFTER_DRAIN = false;
    bf16_t* RKV; bf16_t* LORA;
    __device__ __forceinline__ void operator()(const f32x4 (&acc)[2][2][4][2], const Unit& u, int wr, int wc, int fr, int fq) const {
        const int row0 = u.pm * BM + wr * 64 + fr, cw = wc * 32 + 8 * fq;
#pragma unroll
        for (int ai = 0; ai < 2; ++ai)
#pragma unroll
            for (int m = 0; m < 4; ++m) { const long row = row0 + ai * HALF + m * 16;
#pragma unroll
                for (int bj = 0; bj < 2; ++bj) {
                    f32x4 v0 = acc[ai][bj][m][0], v1 = acc[ai][bj][m][1];
                    if (u.pn < 12) *(u32x4*)(RKV + row * 3072 + u.pn * BM + bj * HALF + cw) = pk8(v0, v1);
                    else {
                        const int cls = (u.pn - 12) * 2 + bj;
                        if (cls == 0) {
#pragma unroll
                            for (int i = 0; i < 4; ++i) { v0[i] = __builtin_amdgcn_rcpf(1.0f + __expf(-v0[i])); v1[i] = __builtin_amdgcn_rcpf(1.0f + __expf(-v1[i])); } }
                        if (cls == 1) {
#pragma unroll
                            for (int i = 0; i < 4; ++i) { v0[i] = 2.0f * __builtin_amdgcn_rcpf(1.0f + __expf(-2.0f * v0[i])) - 1.0f; v1[i] = 2.0f * __builtin_amdgcn_rcpf(1.0f + __expf(-2.0f * v1[i])) - 1.0f; } }
                        if (cls < 3) *(u32x4*)(LORA + row * 384 + cls * HALF + cw) = pk8(v0, v1);
                    } } }
    }
};
struct GroupedOrder {
    int P, NT, G, c;
    __device__ __forceinline__ bool next(int i, Unit& u) const {
        const int per = P * NT;
        if (G == 256) {
            const int x = c & 7, Lx = i * 32 + (c >> 3); if (Lx >= 2 * per) return false;
            const int e = 2 * x + Lx / per, rem = Lx % per, nig = 8 * NT, gid = rem / nig, fm = gid * 8, gsz = (P - fm) < 8 ? (P - fm) : 8, ri = rem % nig;
            u.pm = e * 17 + fm + (ri % gsz); u.pn = e * NT + (ri / gsz); return true;
        }
        const long L = (long)i * G + c; if (L >= (long)16 * per) return false;
        const int e = (int)(L / per), r = (int)(L % per); u.pm = e * 17 + (r % P); u.pn = e * NT + (r / P); return true; }
    __device__ __forceinline__ void a_ready(const Unit&) const {}
    __device__ __forceinline__ void done(const Unit&) const {}
};

template <class Epi, class Sched, bool STAMP = false>
__device__ __forceinline__ void gemm_phase(PG8_LAS unsigned char* lds, const Gemm g, const Sched& S, const Epi& E, unsigned long long* stamps) {
    const int tid = TIDX(), wid = __builtin_amdgcn_readfirstlane(tid >> 6), lane = tid & 63, wr = wid >> 2, wc = wid & 3, fr = lane & 15, fq = lane >> 4;
    const int K = g.K, nt = K / BK;
    int ts_lo = 0, ts_hi = 0, nts = 0; const unsigned long long rt_entry = STAMP ? (unsigned long long)wall_clock64() : 0ull;
#define PG8_STAMP() do { if (STAMP && wid == 0 && nts < 64) { const unsigned long long _c = (unsigned long long)clock64(); \
        ts_lo = (lane == nts) ? (int)(unsigned)_c : ts_lo; ts_hi = (lane == nts) ? (int)(unsigned)(_c >> 32) : ts_hi; ++nts; } } while (0)
    PG8_STAMP();
    unsigned voffA[2], voffB[2];
#pragma unroll
    for (int i = 0; i < 2; ++i) { int R, C; stage_rc(tid * 16 + i * 8192, R, C); const int Rb = Epi::PERM ? ((R & ~31) + perm32(R & 31)) : R;
        voffA[i] = (unsigned)(R * K + C) * 2u; voffB[i] = (unsigned)(Rb * K + C) * 2u; }
    const size_t kstep = (size_t)(BK * 2);
    const size_t hstep = (size_t)HALF * K * 2;
    const size_t tstep = 2 * hstep;
    const unsigned ldsw = (unsigned)wid * 1024u;
    const int aoff = lds_byte(wr * 64 + fr, fq * 8), boff = lds_byte(wc * 32 + fr, fq * 8);
#define PG8_SA(b, h) (((b) * 2 + (h)) * HTB)
#define PG8_SB(b, h) ((4 + (b) * 2 + (h)) * HTB)
#define PG8_STAGE(bufoff, gbase, voff) do { _Pragma("unroll") for (int _i = 0; _i < 2; ++_i) \
        __builtin_amdgcn_global_load_lds((const unsigned*)((const char*)(gbase) + (voff)[_i]), (PG8_LAS unsigned*)(lds + (bufoff) + ldsw + _i * 8192), 16, 0, 0); } while (0)
#define PG8_LDA(dst, b, h) do { _Pragma("unroll") for (int m = 0; m < 4; ++m) _Pragma("unroll") for (int k = 0; k < 2; ++k) dst[m][k] = *(const PG8_LAS bf16x8*)(lds + PG8_SA(b, h) + aoff + m * 2048 + k * 1024); } while (0)
#define PG8_LDB(dst, b, h) do { _Pragma("unroll") for (int n = 0; n < 2; ++n) _Pragma("unroll") for (int k = 0; k < 2; ++k) dst[n][k] = *(const PG8_LAS bf16x8*)(lds + PG8_SB(b, h) + boff + n * 2048 + k * 1024); } while (0)
#define PG8_MMA(ai, bj, At, Bt) do { __builtin_amdgcn_s_setprio(1); _Pragma("unroll") for (int m = 0; m < 4; ++m) _Pragma("unroll") for (int n = 0; n < 2; ++n) _Pragma("unroll") for (int k = 0; k < 2; ++k) \
        acc[ai][bj][m][n] = __builtin_amdgcn_mfma_f32_16x16x32_bf16(Bt[n][k], At[m][k], acc[ai][bj][m][n], 0, 0, 0); __builtin_amdgcn_s_setprio(0); } while (0)
#define PG8_WAIT_V(n) asm volatile("s_waitcnt vmcnt(" #n ")" ::: "memory")
#define PG8_WAIT_L(n) asm volatile("s_waitcnt lgkmcnt(" #n ")" ::: "memory")
#define PG8_BAR __builtin_amdgcn_s_barrier()
#define PG8_SCHED __builtin_amdgcn_sched_barrier(0)
    Unit cur, nxt; int ui = 0;
    if (!S.next(0, cur)) return;
    f32x4 acc[2][2][4][2];
#pragma unroll
    for (int a = 0; a < 2; ++a)
#pragma unroll
        for (int b = 0; b < 2; ++b)
#pragma unroll
            for (int m = 0; m < 4; ++m)
#pragma unroll
                for (int n = 0; n < 2; ++n) acc[a][b][m][n] = (f32x4){0.f, 0.f, 0.f, 0.f};
    bf16x8 At[4][2], B0[2][2], B1[2][2];
    const char* cA = (const char*)g.A + (size_t)cur.pm * tstep; const char* cB = (const char*)g.Bt + (size_t)cur.pn * tstep;
    S.a_ready(cur);
    PG8_STAGE(PG8_SB(0, 0), cB, voffB); PG8_STAGE(PG8_SA(0, 0), cA, voffA); PG8_STAGE(PG8_SB(0, 1), cB + hstep, voffB); PG8_STAGE(PG8_SA(0, 1), cA + hstep, voffA);
    if (wr == 1) PG8_BAR;
    PG8_WAIT_V(4); PG8_BAR;
    PG8_STAGE(PG8_SB(1, 0), cB + kstep, voffB); PG8_STAGE(PG8_SA(1, 0), cA + kstep, voffA); PG8_STAGE(PG8_SB(1, 1), cB + hstep + kstep, voffB);
    PG8_WAIT_V(6); PG8_BAR;
    PG8_STAMP();
    for (;;) {
        const bool has_next = S.next(ui + 1, nxt);
        const char* nA = has_next ? (const char*)g.A + (size_t)nxt.pm * tstep : cA; const char* nB = has_next ? (const char*)g.Bt + (size_t)nxt.pn * tstep : cB;
        for (int t = 0; t < nt; t += 2) {
            const bool last = (t == nt - 2);
            const char* a1 = cA + (size_t)(t + 1) * kstep;
            const char* a2 = last ? nA : cA + (size_t)(t + 2) * kstep; const char* b2 = last ? nB : cB + (size_t)(t + 2) * kstep;
            const char* a3 = a2 + kstep; const char* b3 = b2 + kstep;
            if (last && has_next) S.a_ready(nxt);
            PG8_LDB(B0, 0, 0); PG8_SCHED; PG8_LDA(At, 0, 0); PG8_STAGE(PG8_SA(1, 1), a1 + hstep, voffA);
            PG8_WAIT_L(8); PG8_BAR; PG8_WAIT_L(0); PG8_MMA(0, 0, At, B0); PG8_BAR; PG8_SCHED;
            PG8_LDB(B1, 0, 1); PG8_STAGE(PG8_SB(0, 0), b2, voffB);
            PG8_BAR; PG8_WAIT_L(0); PG8_MMA(0, 1, At, B1); PG8_BAR;
            PG8_LDA(At, 0, 1); PG8_STAGE(PG8_SA(0, 0), a2, voffA);
            PG8_BAR; PG8_WAIT_L(0); PG8_MMA(1, 0, At, B0); PG8_BAR; PG8_SCHED;
            PG8_STAGE(PG8_SB(0, 1), b2 + hstep, voffB);
            PG8_WAIT_V(6); PG8_BAR; PG8_MMA(1, 1, At, B1); PG8_BAR;
            PG8_LDB(B0, 1, 0); PG8_SCHED; PG8_LDA(At, 1, 0); PG8_STAGE(PG8_SA(0, 1), a2 + hstep, voffA);
            PG8_WAIT_L(8); PG8_BAR; PG8_WAIT_L(0); PG8_MMA(0, 0, At, B0); PG8_BAR; PG8_SCHED;
            PG8_LDB(B1, 1, 1); PG8_STAGE(PG8_SB(1, 0), b3, voffB);
            PG8_BAR; PG8_WAIT_L(0); PG8_MMA(0, 1, At, B1); PG8_BAR;
            PG8_LDA(At, 1, 1); PG8_STAGE(PG8_SA(1, 0), a3, voffA);
            PG8_BAR; PG8_WAIT_L(0); PG8_MMA(1, 0, At, B0); PG8_BAR; PG8_SCHED;
            PG8_STAGE(PG8_SB(1, 1), b3 + hstep, voffB);
            PG8_WAIT_V(6); PG8_BAR; PG8_MMA(1, 1, At, B1); PG8_BAR;
        }
        PG8_STAMP();
        if constexpr (!Epi::AFTER_DRAIN) { E(acc, cur, wr, wc, fr, fq); S.done(cur); }
        PG8_STAMP();
        if (!has_next) break;
#pragma unroll
        for (int a = 0; a < 2; ++a)
#pragma unroll
            for (int b = 0; b < 2; ++b)
#pragma unroll
                for (int m = 0; m < 4; ++m)
#pragma unroll
                    for (int n = 0; n < 2; ++n) acc[a][b][m][n] = (f32x4){0.f, 0.f, 0.f, 0.f};
        cur = nxt; cA = nA; cB = nB; ++ui;
    }
    PG8_WAIT_V(0);
    if (wr == 0) PG8_BAR;
    PG8_BAR;
    if constexpr (Epi::AFTER_DRAIN) { E.fused(acc, cur, wr, wc, fr, fq, lds, wid, lane); S.done(cur); }
    PG8_STAMP();
    if (STAMP && wid == 0) { stamps[lane] = lane < nts ? (((unsigned long long)(unsigned)ts_hi << 32) | (unsigned)ts_lo) : 0ull;
        if (lane == 62) stamps[62] = rt_entry; if (lane == 63) stamps[63] = (unsigned long long)wall_clock64(); }
#undef PG8_STAMP
#undef PG8_SA
#undef PG8_SB
#undef PG8_STAGE
#undef PG8_LDA
#undef PG8_LDB
#undef PG8_MMA
#undef PG8_WAIT_V
#undef PG8_WAIT_L
#undef PG8_BAR
#undef PG8_SCHED
}
template <class Epi, class Sched>
__device__ __forceinline__ void gemm_phase_gather(PG8_LAS unsigned char* lds, const Gemm g, const Sched& S, const Epi& E, const int* idx) {
    constexpr bool STAMP = false; unsigned long long* stamps = nullptr;
    const int tid = TIDX(), wid = __builtin_amdgcn_readfirstlane(tid >> 6), lane = tid & 63, wr = wid >> 2, wc = wid & 3, fr = lane & 15, fq = lane >> 4;
    const int K = g.K, nt = K / BK;
    int ts_lo = 0, ts_hi = 0, nts = 0; const unsigned long long rt_entry = STAMP ? (unsigned long long)wall_clock64() : 0ull;
#define PG8_STAMP() do { if (STAMP && wid == 0 && nts < 64) { const unsigned long long _c = (unsigned long long)clock64(); \
        ts_lo = (lane == nts) ? (int)(unsigned)_c : ts_lo; ts_hi = (lane == nts) ? (int)(unsigned)(_c >> 32) : ts_hi; ++nts; } } while (0)
    PG8_STAMP();
    unsigned voffB[2]; int rowA[2]; unsigned colA[2];
#pragma unroll
    for (int i = 0; i < 2; ++i) { int R, C; stage_rc(tid * 16 + i * 8192, R, C); const int Rb = Epi::PERM ? ((R & ~31) + perm32(R & 31)) : R;
        rowA[i] = R; colA[i] = (unsigned)C * 2u; voffB[i] = (unsigned)(Rb * K + C) * 2u; }
    unsigned vc0[2], vc1[2], vn0[2], vn1[2];
#define PG8_GIDX(u, o0, o1) do { const int* ip = idx + (long)(u).pm * BM; const int g00 = ip[rowA[0]], g01 = ip[rowA[1]], g10 = ip[HALF + rowA[0]], g11 = ip[HALF + rowA[1]]; \
        asm volatile("s_waitcnt vmcnt(0)" ::: "memory"); \
        o0[0] = (unsigned)g00 * (unsigned)(K * 2) + colA[0]; o0[1] = (unsigned)g01 * (unsigned)(K * 2) + colA[1]; o1[0] = (unsigned)g10 * (unsigned)(K * 2) + colA[0]; o1[1] = (unsigned)g11 * (unsigned)(K * 2) + colA[1]; } while (0)
    const size_t kstep = (size_t)(BK * 2);
    const size_t hstep = (size_t)HALF * K * 2;
    const size_t tstep = 2 * hstep;
    const unsigned ldsw = (unsigned)wid * 1024u;
    const int aoff = lds_byte(wr * 64 + fr, fq * 8), boff = lds_byte(wc * 32 + fr, fq * 8);
#define PG8_SA(b, h) (((b) * 2 + (h)) * HTB)
#define PG8_SB(b, h) ((4 + (b) * 2 + (h)) * HTB)
#define PG8_STAGE(bufoff, gbase, voff) do { _Pragma("unroll") for (int _i = 0; _i < 2; ++_i) \
        __builtin_amdgcn_global_load_lds((const unsigned*)((const char*)(gbase) + (voff)[_i]), (PG8_LAS unsigned*)(lds + (bufoff) + ldsw + _i * 8192), 16, 0, 0); } while (0)
#define PG8_LDA(dst, b, h) do { _Pragma("unroll") for (int m = 0; m < 4; ++m) _Pragma("unroll") for (int k = 0; k < 2; ++k) dst[m][k] = *(const PG8_LAS bf16x8*)(lds + PG8_SA(b, h) + aoff + m * 2048 + k * 1024); } while (0)
#define PG8_LDB(dst, b, h) do { _Pragma("unroll") for (int n = 0; n < 2; ++n) _Pragma("unroll") for (int k = 0; k < 2; ++k) dst[n][k] = *(const PG8_LAS bf16x8*)(lds + PG8_SB(b, h) + boff + n * 2048 + k * 1024); } while (0)
#define PG8_MMA(ai, bj, At, Bt) do { __builtin_amdgcn_s_setprio(1); _Pragma("unroll") for (int m = 0; m < 4; ++m) _Pragma("unroll") for (int n = 0; n < 2; ++n) _Pragma("unroll") for (int k = 0; k < 2; ++k) \
        acc[ai][bj][m][n] = __builtin_amdgcn_mfma_f32_16x16x32_bf16(Bt[n][k], At[m][k], acc[ai][bj][m][n], 0, 0, 0); __builtin_amdgcn_s_setprio(0); } while (0)
#define PG8_WAIT_V(n) asm volatile("s_waitcnt vmcnt(" #n ")" ::: "memory")
#define PG8_WAIT_L(n) asm volatile("s_waitcnt lgkmcnt(" #n ")" ::: "memory")
#define PG8_BAR __builtin_amdgcn_s_barrier()
#define PG8_SCHED __builtin_amdgcn_sched_barrier(0)
    Unit cur, nxt; int ui = 0;
    if (!S.next(0, cur)) return;
    f32x4 acc[2][2][4][2];
#pragma unroll
    for (int a = 0; a < 2; ++a)
#pragma unroll
        for (int b = 0; b < 2; ++b)
#pragma unroll
            for (int m = 0; m < 4; ++m)
#pragma unroll
                for (int n = 0; n < 2; ++n) acc[a][b][m][n] = (f32x4){0.f, 0.f, 0.f, 0.f};
    bf16x8 At[4][2], B0[2][2], B1[2][2];
    const char* AB = (const char*)g.A; const char* cB = (const char*)g.Bt + (size_t)cur.pn * tstep;
    S.a_ready(cur);
    PG8_GIDX(cur, vc0, vc1);
    PG8_STAGE(PG8_SB(0, 0), cB, voffB); PG8_STAGE(PG8_SA(0, 0), AB, vc0); PG8_STAGE(PG8_SB(0, 1), cB + hstep, voffB); PG8_STAGE(PG8_SA(0, 1), AB, vc1);
    if (wr == 1) PG8_BAR;
    PG8_WAIT_V(4); PG8_BAR;
    PG8_STAGE(PG8_SB(1, 0), cB + kstep, voffB); PG8_STAGE(PG8_SA(1, 0), AB + kstep, vc0); PG8_STAGE(PG8_SB(1, 1), cB + hstep + kstep, voffB);
    PG8_WAIT_V(6); PG8_BAR;
    PG8_STAMP();
    for (;;) {
        const bool has_next = S.next(ui + 1, nxt);
        const char* nB = has_next ? (const char*)g.Bt + (size_t)nxt.pn * tstep : cB;
        for (int t = 0; t < nt; t += 2) {
            const bool last = (t == nt - 2);
            const char* a1 = AB + (size_t)(t + 1) * kstep;
            const char* b2 = last ? nB : cB + (size_t)(t + 2) * kstep;
            const char* b3 = b2 + kstep;
            if (last) { if (has_next) { S.a_ready(nxt); PG8_GIDX(nxt, vn0, vn1); } else { vn0[0] = vc0[0]; vn0[1] = vc0[1]; vn1[0] = vc1[0]; vn1[1] = vc1[1]; } }
            const char* a2 = last ? AB : AB + (size_t)(t + 2) * kstep; const char* a3 = a2 + kstep;
            unsigned w0[2], w1[2];
            w0[0] = last ? vn0[0] : vc0[0]; w0[1] = last ? vn0[1] : vc0[1]; w1[0] = last ? vn1[0] : vc1[0]; w1[1] = last ? vn1[1] : vc1[1];
            PG8_LDB(B0, 0, 0); PG8_SCHED; PG8_LDA(At, 0, 0); PG8_STAGE(PG8_SA(1, 1), a1, vc1);
            PG8_WAIT_L(8); PG8_BAR; PG8_WAIT_L(0); PG8_MMA(0, 0, At, B0); PG8_BAR; PG8_SCHED;
            PG8_LDB(B1, 0, 1); PG8_STAGE(PG8_SB(0, 0), b2, voffB);
            PG8_BAR; PG8_WAIT_L(0); PG8_MMA(0, 1, At, B1); PG8_BAR;
            PG8_LDA(At, 0, 1); PG8_STAGE(PG8_SA(0, 0), a2, w0);
            PG8_BAR; PG8_WAIT_L(0); PG8_MMA(1, 0, At, B0); PG8_BAR; PG8_SCHED;
            PG8_STAGE(PG8_SB(0, 1), b2 + hstep, voffB);
            PG8_WAIT_V(6); PG8_BAR; PG8_MMA(1, 1, At, B1); PG8_BAR;
            PG8_LDB(B0, 1, 0); PG8_SCHED; PG8_LDA(At, 1, 0); PG8_STAGE(PG8_SA(0, 1), a2, w1);
            PG8_WAIT_L(8); PG8_BAR; PG8_WAIT_L(0); PG8_MMA(0, 0, At, B0); PG8_BAR; PG8_SCHED;
            PG8_LDB(B1, 1, 1); PG8_STAGE(PG8_SB(1, 0), b3, voffB);
            PG8_BAR; PG8_WAIT_L(0); PG8_MMA(0, 1, At, B1); PG8_BAR;
            PG8_LDA(At, 1, 1); PG8_STAGE(PG8_SA(1, 0), a3, w0);
            PG8_BAR; PG8_WAIT_L(0); PG8_MMA(1, 0, At, B0); PG8_BAR; PG8_SCHED;
            PG8_STAGE(PG8_SB(1, 1), b3 + hstep, voffB);
            PG8_WAIT_V(6); PG8_BAR; PG8_MMA(1, 1, At, B1); PG8_BAR;
        }
        PG8_STAMP();
        if constexpr (!Epi::AFTER_DRAIN) { E(acc, cur, wr, wc, fr, fq); S.done(cur); }
        PG8_STAMP();
        if (!has_next) break;
#pragma unroll
        for (int a = 0; a < 2; ++a)
#pragma unroll
            for (int b = 0; b < 2; ++b)
#pragma unroll
                for (int m = 0; m < 4; ++m)
#pragma unroll
                    for (int n = 0; n < 2; ++n) acc[a][b][m][n] = (f32x4){0.f, 0.f, 0.f, 0.f};
        cur = nxt; cB = nB; ++ui; vc0[0] = vn0[0]; vc0[1] = vn0[1]; vc1[0] = vn1[0]; vc1[1] = vn1[1];
    }
    PG8_WAIT_V(0);
    if (wr == 0) PG8_BAR;
    PG8_BAR;
    if constexpr (Epi::AFTER_DRAIN) { E.fused(acc, cur, wr, wc, fr, fq, lds, wid, lane); S.done(cur); }
    PG8_STAMP();
    if (STAMP && wid == 0) { stamps[lane] = lane < nts ? (((unsigned long long)(unsigned)ts_hi << 32) | (unsigned)ts_lo) : 0ull;
        if (lane == 62) stamps[62] = rt_entry; if (lane == 63) stamps[63] = (unsigned long long)wall_clock64(); }
#undef PG8_STAMP
#undef PG8_SA
#undef PG8_SB
#undef PG8_STAGE
#undef PG8_LDA
#undef PG8_LDB
#undef PG8_MMA
#undef PG8_WAIT_V
#undef PG8_WAIT_L
#undef PG8_BAR
#undef PG8_SCHED
#undef PG8_GIDX
}
}

constexpr int CONV_NPAR = 4;
template <int MODE>
DI void conv_tiles(const float* src, int K, int N, int Npad, bf16_t* dst, long ldd, int koff, int rowoff,
                   const float* mixv, float alpha, float beta, int& base, char* smem, int rank = -1, int G = 0) {
    float* t = (float*)smem;
    const int tid = TIDX();
    if (G == 0) { G = gridDim.x; rank = (int)blockIdx.x; }
    const int ntn = Npad >> 6, ntiles = (K >> 6) * ntn;
    int first = (rank - (base % G) + G) % G;
    base += ntiles;
    for (int ti0 = first; ti0 < ntiles; ti0 += CONV_NPAR * G) {
        f32x4 v0[CONV_NPAR], v1[CONV_NPAR]; float sc[CONV_NPAR];
        const int k = tid >> 3, n8 = (tid & 7) * 8;
#pragma unroll
        for (int q = 0; q < CONV_NPAR; ++q) {
            const int ti = ti0 + q * G;
            v0[q] = (f32x4){0.f, 0.f, 0.f, 0.f}; v1[q] = v0[q]; sc[q] = 1.0f;
            if (ti < ntiles) {
                const int k0 = (ti / ntn) << 6, n0 = (ti % ntn) << 6;
                sc[q] = mixv ? (alpha + beta * mixv[k0 + k]) : 1.0f;
                if (n0 + n8 < N) { const float* sp = src + (long)(k0 + k) * N + n0 + n8; v0[q] = *(const f32x4*)sp; v1[q] = *(const f32x4*)(sp + 4); }
            }
        }
#pragma unroll
        for (int q = 0; q < CONV_NPAR; ++q) {
            float* tp = t + q * (64 * 65) + k * 65 + n8;
            tp[0] = v0[q][0] * sc[q]; tp[1] = v0[q][1] * sc[q]; tp[2] = v0[q][2] * sc[q]; tp[3] = v0[q][3] * sc[q]; tp[4] = v1[q][0] * sc[q]; tp[5] = v1[q][1] * sc[q]; tp[6] = v1[q][2] * sc[q]; tp[7] = v1[q][3] * sc[q];
        }
        __syncthreads();
#pragma unroll
        for (int q = 0; q < CONV_NPAR; ++q) {
            const int ti = ti0 + q * G;
            if (ti < ntiles) {
                const int k0 = (ti / ntn) << 6, n0 = (ti % ntn) << 6;
                const int n = tid >> 3, kc = (tid & 7) * 8;
                float f[8];
#pragma unroll
                for (int j = 0; j < 8; ++j) f[j] = t[q * (64 * 65) + (kc + j) * 65 + n];
                const int nn = n0 + n;
                const int r = (MODE == 1) ? (128 * (nn >> 6) + 32 * ((nn >> 4) & 3) + (nn & 15)) : ((MODE == 2) ? (256 * (nn >> 7) + (nn & 127)) : ((MODE == 3) ? ((nn & ~255) + 128 * ((nn >> 5) & 1) + 32 * ((nn >> 6) & 3) + (nn & 31)) : nn));
                *(u32x4*)(dst + (long)(r + rowoff) * ldd + koff + k0 + kc) = pack8(f);
            }
        }
        __syncthreads();
    }
}
DI void zero_bf16(bf16_t* dst, long n8  ) {
    for (long i = (long)blockIdx.x * NTHR + TIDX(); i < n8; i += (long)gridDim.x * NTHR) *(u32x4*)(dst + i * 8) = (u32x4){0u, 0u, 0u, 0u};
}

struct Bufs {
    float* MOD; float* ROPE_M; float* ROPE_S; float* X; bf16_t* WMIX; bf16_t* W13; bf16_t* W2T; bf16_t* W2TB;
    DI bf16_t* w2t(int layer) const { return (layer & 1) ? W2TB : W2T; }
    float* AFF; float* AFFC; int* IDX; float* GATE; int* INV; unsigned char* WORK;
    DI bf16_t* slot(int i) const { return (bf16_t*)(WORK + (size_t)i * USLOT); }
};
DI Bufs make_bufs(const Params& p) {
    Bufs b; unsigned char* w = p.ws;
    b.MOD = (float*)(w + OFF_MOD); b.ROPE_M = (float*)(w + OFF_ROPE_M); b.ROPE_S = (float*)(w + OFF_ROPE_S); b.X = (float*)(w + OFF_X);
    b.WMIX = (bf16_t*)(w + OFF_WMIX); b.W13 = (bf16_t*)(w + OFF_WE); b.W2T = (bf16_t*)(w + OFF_WE + 64 * MiB); b.W2TB = (bf16_t*)(w + OFF_W2TB);
    b.AFF = (float*)(w + OFF_AFF); b.AFFC = (float*)(w + OFF_AFFC); b.IDX = (int*)(w + OFF_IDX); b.GATE = (float*)(w + OFF_GATE); b.INV = (int*)(w + OFF_INV);
    b.WORK = w + OFF_WORK; return b;
}

DI void conv_moe_layer(const Params& p, const Bufs& B, int layer, int& base, char* smem, int part = 0, int rank = -1, int G = 0) {
    for (int e = 0; e < NEXP; ++e) {
        const size_t wo = ((size_t)layer * NEXP + e) * 1024 * 1024;
        if (part != 2) {
            conv_tiles<USE_PG8 ? 2 : 1>(p.in[I_MOE_W1] + wo, 1024, 1024, 1024, B.W13 + (size_t)e * 2048 * 1024, 1024, 0, 0, nullptr, 0.f, 0.f, base, smem, rank, G);
            conv_tiles<USE_PG8 ? 2 : 1>(p.in[I_MOE_W3] + wo, 1024, 1024, 1024, B.W13 + (size_t)e * 2048 * 1024, 1024, 0, USE_PG8 ? 128 : 16, nullptr, 0.f, 0.f, base, smem, rank, G);
        }
        if (part != 1) conv_tiles<0>(p.in[I_MOE_W2] + wo, 1024, 1024, 1024, B.w2t(layer) + (size_t)e * 1024 * 1024, 1024, 0, 0, nullptr, 0.f, 0.f, base, smem, rank, G);
    }
}

DI void phase_prologue(const Params& p, const Bufs& B, char* smem) {
    const int tid = TIDX(), G = gridDim.x;
    {
        float* s = (float*)smem;
        float* red = s + 9 * 1024;
        for (int i = tid; i < 9 * 1024; i += NTHR) { const int r = i >> 10, k = i & 1023; const float x = (r < 8) ? p.in[I_C][r * 1024 + k] : p.in[I_CCTX][k]; s[i] = x * fsigmoid(x); }
        __syncthreads();
        for (int it = blockIdx.x; it < 4 * 96; it += G) {
            const int l = it / 96, cg = it % 96, cl = tid & 63, ks = tid >> 6, n = cg * 64 + cl;
            const float* wp = p.in[I_ADAW] + (size_t)l * 1024 * 6144 + (size_t)(ks * 128) * 6144 + n;
            float acc[9];
#pragma unroll
            for (int r = 0; r < 9; ++r) acc[r] = 0.f;
            for (int k = 0; k < 128; ++k) {
                const float wv = wp[(size_t)k * 6144];
#pragma unroll
                for (int r = 0; r < 9; ++r) acc[r] += s[r * 1024 + ks * 128 + k] * wv;
            }
#pragma unroll
            for (int r = 0; r < 9; ++r) red[(ks * 9 + r) * 64 + cl] = acc[r];
            __syncthreads();
            for (int o = tid; o < 9 * 64; o += NTHR) {
                const int r = o >> 6, c = o & 63; float v = 0.f;
#pragma unroll
                for (int q = 0; q < 8; ++q) v += red[(q * 9 + r) * 64 + c];
                B.MOD[((size_t)l * 9 + r) * 6144 + cg * 64 + c] = v + p.in[I_ADAB][l * 6144 + cg * 64 + c];
            }
            __syncthreads();
        }
    }
    for (int i = blockIdx.x * NTHR + tid; i < 4096 * 48; i += G * NTHR) {
        const int pos = i / 48, j = i % 48;
        const int row = pos >> 6, col = pos & 63;
        float inv, posf; float* cdst; float* sdst;
        if (j < 16) { const int m = j & 7; inv = powf(10000.0f, -(float)(2 * m) / 16.0f); posf = (j < 8) ? (float)row : (float)col; cdst = B.ROPE_M + pos * 16 + j; sdst = B.ROPE_M + 4096 * 16 + pos * 16 + j; }
        else { const int jj = j - 16, m = jj & 15; inv = powf(10000.0f, -(float)(2 * m) / 32.0f); posf = (jj < 16) ? (float)row : (float)col; cdst = B.ROPE_S + pos * 32 + jj; sdst = B.ROPE_S + 4096 * 32 + pos * 32 + jj; }
        const float ang = posf * inv;
        double tr = (double)ang * 0.15915494309189535; tr -= rint(tr);
        const float tf = (float)tr;
        *cdst = __builtin_amdgcn_cosf(tf); *sdst = __builtin_amdgcn_sinf(tf);
    }
    int base = 0;
    bf16_t* W = B.WMIX;
    conv_tiles<3>(p.in[I_NA_WQKV], 1024, 3072, 3072, W + W_NA_QKV, 1024, 0, 0, nullptr, 0.f, 0.f, base, smem);
    conv_tiles<0>(p.in[I_NA_WO], 1024, 1024, 1024, W + W_NA_WO, 1024, 0, 0, nullptr, 0.f, 0.f, base, smem);
    {
        const float* mix = p.in[I_RW_MIX];
        bf16_t* B1 = W + W_RW_B1;
        conv_tiles<0>(p.in[I_RW_WR], 1024, 1024, 1024, B1, 2048, 0, 0, mix + 0 * 1024, 1.f, -1.f, base, smem);
        conv_tiles<0>(p.in[I_RW_WR], 1024, 1024, 1024, B1, 2048, 1024, 0, mix + 0 * 1024, 0.f, 0.5f, base, smem);
        conv_tiles<0>(p.in[I_RW_WK], 1024, 1024, 1024, B1, 2048, 0, 1024, mix + 2 * 1024, 1.f, -1.f, base, smem);
        conv_tiles<0>(p.in[I_RW_WK], 1024, 1024, 1024, B1, 2048, 1024, 1024, mix + 2 * 1024, 0.f, 0.5f, base, smem);
        conv_tiles<0>(p.in[I_RW_WV], 1024, 1024, 1024, B1, 2048, 0, 2048, mix + 3 * 1024, 1.f, -1.f, base, smem);
        conv_tiles<0>(p.in[I_RW_WV], 1024, 1024, 1024, B1, 2048, 1024, 2048, mix + 3 * 1024, 0.f, 0.5f, base, smem);
        conv_tiles<0>(p.in[I_RW_G1], 1024, 128, 128, B1, 2048, 0, 3072, mix + 5 * 1024, 1.f, -1.f, base, smem);
        conv_tiles<0>(p.in[I_RW_G1], 1024, 128, 128, B1, 2048, 1024, 3072, mix + 5 * 1024, 0.f, 0.5f, base, smem);
        for (int z = 0; z < 2; ++z) {
            conv_tiles<0>(p.in[I_RW_W1] + (size_t)z * 1024 * 64, 1024, 64, 64, B1, 2048, 0, 3200 + 64 * z, mix + 1 * 1024, 1.f, -1.f, base, smem);
            conv_tiles<0>(p.in[I_RW_W1] + (size_t)z * 1024 * 64, 1024, 64, 64, B1, 2048, 1024, 3200 + 64 * z, mix + 1 * 1024, 0.f, 0.5f, base, smem);
            conv_tiles<0>(p.in[I_RW_A1] + (size_t)z * 1024 * 64, 1024, 64, 64, B1, 2048, 0, 3328 + 64 * z, mix + 4 * 1024, 1.f, -1.f, base, smem);
            conv_tiles<0>(p.in[I_RW_A1] + (size_t)z * 1024 * 64, 1024, 64, 64, B1, 2048, 1024, 3328 + 64 * z, mix + 4 * 1024, 0.f, 0.5f, base, smem);
        }
        zero_bf16(B1 + (size_t)3456 * 2048, (long)128 * 2048 / 8);
        bf16_t* B2 = W + W_RW_B2;
        conv_tiles<0>(p.in[I_RW_G2], 128, 1024, 1024, B2, 384, 0, 0, nullptr, 0.f, 0.f, base, smem);
        for (int z = 0; z < 2; ++z) {
            conv_tiles<0>(p.in[I_RW_W2] + (size_t)z * 64 * 1024, 64, 1024, 1024, B2, 384, 128 + 64 * z, 1024 + 1024 * z, nullptr, 0.f, 0.f, base, smem);
            conv_tiles<0>(p.in[I_RW_A2] + (size_t)z * 64 * 1024, 64, 1024, 1024, B2, 384, 256 + 64 * z, 3072 + 1024 * z, nullptr, 0.f, 0.f, base, smem);
        }
        conv_tiles<0>(p.in[I_RW_WO], 1024, 1024, 1024, W + W_RW_WO, 1024, 0, 0, nullptr, 0.f, 0.f, base, smem);
    }
    conv_tiles<0>(p.in[I_MLA_WDOWN], 1024, 672, 768, W + W_MLA_DOWN, 1024, 0, 0, nullptr, 0.f, 0.f, base, smem);
    conv_tiles<0>(p.in[I_MLA_WUQ], 384, 1536, 1536, W + W_MLA_UQ, 384, 0, 0, nullptr, 0.f, 0.f, base, smem);
    conv_tiles<0>(p.in[I_MLA_WUKV], 256, 2048, 2048, W + W_MLA_UKV, 256, 0, 0, nullptr, 0.f, 0.f, base, smem);
    conv_tiles<0>(p.in[I_MLA_WO], 1024, 1024, 1024, W + W_MLA_WO, 1024, 0, 0, nullptr, 0.f, 0.f, base, smem);
    conv_tiles<3>(p.in[I_SWA_WQKV], 1024, 1536, 1536, W + W_SWA_QKV, 1024, 0, 0, nullptr, 0.f, 0.f, base, smem);
    conv_tiles<0>(p.in[I_SWA_WO], 1024, 1024, 1024, W + W_SWA_WO, 1024, 0, 0, nullptr, 0.f, 0.f, base, smem);
    conv_moe_layer(p, B, 0, base, smem);
}

DI void row_load_f32(const float* row, int lane, float* v) {
#pragma unroll
    for (int i = 0; i < 4; ++i) { const f32x4 t = *(const f32x4*)(row + 256 * i + 4 * lane); v[4 * i] = t[0]; v[4 * i + 1] = t[1]; v[4 * i + 2] = t[2]; v[4 * i + 3] = t[3]; }
}
DI void row_store_bf16(bf16_t* row, int lane, const float* v) {
#pragma unroll
    for (int i = 0; i < 4; ++i) { u32x2 t; t.x = pk2(v[4 * i], v[4 * i + 1]); t.y = pk2(v[4 * i + 2], v[4 * i + 3]); *(u32x2*)(row + 256 * i + 4 * lane) = t; }
}
DI void norm_mod_row(const float* xrow, const float* gain, const float* shift, const float* scale, int lane, float* h) {
    float x[16], gg[16], sh[16], sc[16];
    row_load_f32(xrow, lane, x); row_load_f32(gain, lane, gg); row_load_f32(shift, lane, sh); row_load_f32(scale, lane, sc);
    float ss = 0.f;
#pragma unroll
    for (int e = 0; e < 16; ++e) ss += x[e] * x[e];
    ss = wave_sum(ss);
    const float r = rsqrtf(ss * (1.0f / 1024.0f) + 1e-6f);
#pragma unroll
    for (int e = 0; e < 16; ++e) h[e] = x[e] * r * gg[e] * (1.0f + sc[e]) + sh[e];
}

DI void phase_norm1(const Params& p, const Bufs& B, int layer, bf16_t* H) {
    const int lane = TIDX() & 63, gw = blockIdx.x * 8 + (TIDX() >> 6), nw = gridDim.x * 8;
    const float* gain = p.in[I_N1G] + layer * 1024;
    for (int g = gw; g < TT; g += nw) {
        const float* md = B.MOD + ((size_t)layer * 9 + modrow_of(g)) * 6144;
        float h[16];
        const float* xrow = (layer == 0) ? ((g < TL) ? p.in[I_X] + (size_t)g * 1024 : p.in[I_CTX] + (size_t)(g - TL) * 1024) : (B.X + (size_t)g * 1024);
        norm_mod_row(xrow, gain, md, md + 1024, lane, h);
        row_store_bf16(H + (size_t)g * 1024, lane, h);
    }
}
DI void phase_norm1_rw(const Params& p, const Bufs& B, int layer, bf16_t* H2) {
    const int lane = TIDX() & 63, gw = blockIdx.x * 8 + (TIDX() >> 6), nw = gridDim.x * 8;
    const float* gain = p.in[I_N1G] + layer * 1024;
    for (int g = gw; g < TT; g += nw) {
        const float* md = B.MOD + ((size_t)layer * 9 + modrow_of(g)) * 6144;
        const int t = (g < TL) ? (g & 4095) : ((g - TL) & 255);
        const int len = (g < TL) ? 4096 : 256;
        float h[16], hp[16], hn[16];
        norm_mod_row(B.X + (size_t)g * 1024, gain, md, md + 1024, lane, h);
        if (t > 0) norm_mod_row(B.X + (size_t)(g - 1) * 1024, gain, md, md + 1024, lane, hp);
        else {
#pragma unroll
            for (int e = 0; e < 16; ++e) hp[e] = 0.f;
        }
        if (t < len - 1) norm_mod_row(B.X + (size_t)(g + 1) * 1024, gain, md, md + 1024, lane, hn);
        else {
#pragma unroll
            for (int e = 0; e < 16; ++e) hn[e] = 0.f;
        }
#pragma unroll
        for (int e = 0; e < 16; ++e) hp[e] += hn[e];
        row_store_bf16(H2 + (size_t)g * 2048, lane, h);
        row_store_bf16(H2 + (size_t)g * 2048 + 1024, lane, hp);
    }
}
template <int CTRL> DI float dpp_mv(float x) { return __int_as_float(__builtin_amdgcn_update_dpp(0, __float_as_int(x), CTRL, 0xf, 0xf, false)); }
DI float lx_xor1(float x) { return dpp_mv<0xB1>(x); }
DI float lx_xor2(float x) { return dpp_mv<0x4E>(x); }
DI float lx_xor4(float x) { return dpp_mv<0x1B>(dpp_mv<0x141>(x)); }
DI float lx_xor8(float x) { return dpp_mv<0x128>(x); }
DI float fold32(float p, float q) { auto r = __builtin_amdgcn_permlane32_swap(__float_as_uint(p), __float_as_uint(q), false, false); return __uint_as_float(r[0]) + __uint_as_float(r[1]); }
DI float fold16(float p, float q) { auto r = __builtin_amdgcn_permlane16_swap(__float_as_uint(p), __float_as_uint(q), false, false); return __uint_as_float(r[0]) + __uint_as_float(r[1]); }
DI float wsum_fast(float x) {
    x += lx_xor1(x); x += lx_xor2(x); x += dpp_mv<0x141>(x); x += dpp_mv<0x140>(x);
    const int xi = __float_as_int(x);
    return (__int_as_float(__builtin_amdgcn_readlane(xi, 0)) + __int_as_float(__builtin_amdgcn_readlane(xi, 16))) + (__int_as_float(__builtin_amdgcn_readlane(xi, 32)) + __int_as_float(__builtin_amdgcn_readlane(xi, 48)));
}
DI void norm2_token(const float* x, const float* A, const float* Bv, const float* wr, int g, int lane, bf16_t* H, const Bufs& B) {
    float ss = 0.f;
#pragma unroll
    for (int e = 0; e < 16; ++e) ss += x[e] * x[e];
    ss = wsum_fast(ss);
    const float r = rsqrtf(ss * (1.0f / 1024.0f) + 1e-6f);
    float h[16];
#pragma unroll
    for (int e = 0; e < 16; ++e) h[e] = x[e] * r * A[e] + Bv[e];
    row_store_bf16(H + (size_t)g * 1024, lane, h);
    float a[16];
#pragma unroll
    for (int e = 0; e < 16; ++e) {
        float acc = 0.f;
#pragma unroll
        for (int i = 0; i < 4; ++i) { const f32x4 w4 = *(const f32x4*)(wr + e * 1024 + 256 * i + 4 * lane); acc += h[4 * i] * w4[0] + h[4 * i + 1] * w4[1] + h[4 * i + 2] * w4[2] + h[4 * i + 3] * w4[3]; }
        a[e] = acc;
        if ((e & 3) == 3) asm volatile("" ::: "memory");
    }
    float b8[8], c4[4], d2[2];
    const bool h8 = (lane & 8) != 0, h4 = (lane & 4) != 0;
#pragma unroll
    for (int e = 0; e < 8; ++e) b8[e] = fold32(a[e], a[e + 8]);
#pragma unroll
    for (int e = 0; e < 4; ++e) c4[e] = fold16(b8[e], b8[e + 4]);
#pragma unroll
    for (int e = 0; e < 2; ++e) { const float send = h8 ? c4[e] : c4[e + 2], keep = h8 ? c4[e + 2] : c4[e]; d2[e] = keep + lx_xor8(send); }
    float lg;
    { const float send = h4 ? d2[0] : d2[1], keep = h4 ? d2[1] : d2[0]; lg = keep + lx_xor4(send); }
    lg += lx_xor2(lg); lg += lx_xor1(lg);
    float mx = lg;
    mx = fmaxf(mx, lx_xor4(mx)); mx = fmaxf(mx, lx_xor8(mx));
    { auto r = __builtin_amdgcn_permlane16_swap(__float_as_uint(mx), __float_as_uint(mx), false, false); mx = fmaxf(__uint_as_float(r[0]), __uint_as_float(r[1])); }
    { auto r = __builtin_amdgcn_permlane32_swap(__float_as_uint(mx), __float_as_uint(mx), false, false); mx = fmaxf(__uint_as_float(r[0]), __uint_as_float(r[1])); }
    const float ex = __expf(lg - mx);
    float se = ex;
    se += lx_xor4(se); se += lx_xor8(se);
    se = fold16(se, se); se = fold32(se, se);
    const float aff = ex / se;
    if ((lane & 3) == 0) {
        const int e = lane >> 2;
        if (g < TL) B.AFF[((size_t)(g >> 12) * 16 + e) * 4096 + (g & 4095)] = aff;
        else { const int gc = g - TL; B.AFFC[((size_t)(gc >> 8) * 16 + e) * 256 + (gc & 255)] = aff; }
        B.INV[(size_t)g * 16 + e] = -1;
    }
}
DI void phase_norm2(const Params& p, const Bufs& B, int layer, bf16_t* H, int ntok, char* smem) {
    float* wr = (float*)smem;
    const float* rsrc = p.in[I_MOE_ROUTER] + (size_t)layer * 1024 * 16;
    for (int i = TIDX(); i < 1024 * 16; i += NTHR) { const int k = i >> 4, e = i & 15; wr[e * 1024 + k] = rsrc[i]; }
    __syncthreads();
    const int lane = TIDX() & 63, gw = blockIdx.x * 8 + (TIDX() >> 6);
    float gain[16];
    row_load_f32(p.in[I_N2G] + layer * 1024, lane, gain);
    const int nr = (ntok > TL) ? 9 : 8;
    float x0[16], x1[16];
    row_load_f32(B.X + (size_t)gw * 1024, lane, x0); row_load_f32(B.X + (size_t)(gw + 2048) * 1024, lane, x1);
    for (int r = 0; r < nr; ++r) {
        float n0[16], n1[16];
        if (r + 1 < nr) {
            const int gb = (r + 1 < 8) ? (r + 1) * 4096 : TL;
            row_load_f32(B.X + (size_t)(gb + gw) * 1024, lane, n0);
            if (r + 1 < 8) row_load_f32(B.X + (size_t)(gb + gw + 2048) * 1024, lane, n1);
        }
        const float* md = B.MOD + ((size_t)layer * 9 + r) * 6144;
        float A[16], Bv[16];
        row_load_f32(md + 4 * 1024, lane, A); row_load_f32(md + 3 * 1024, lane, Bv);
#pragma unroll
        for (int e = 0; e < 16; ++e) A[e] = gain[e] * (1.0f + A[e]);
        const int gb = (r < 8) ? r * 4096 : TL;
        norm2_token(x0, A, Bv, wr, gb + gw, lane, H, B);
        if (r < 8) norm2_token(x1, A, Bv, wr, gb + gw + 2048, lane, H, B);
#pragma unroll
        for (int e = 0; e < 16; ++e) { x0[e] = n0[e]; x1[e] = n1[e]; }
    }
}

DI void ld16(const bf16_t* p, float* v) { unpack8(*(const u32x4*)p, v); unpack8(*(const u32x4*)(p + 8), v + 8); }
DI void st16(bf16_t* p, const float* v) { *(u32x4*)p = pack8(v); *(u32x4*)(p + 8) = pack8(v + 8); }
DI void headnorm64(float* v, const float* gain, int p) {
    float ss = 0.f;
#pragma unroll
    for (int e = 0; e < 16; ++e) ss += v[e] * v[e];
    ss += __shfl_xor(ss, 1); ss += __shfl_xor(ss, 2);
    const float r = rsqrtf(ss * (1.0f / 64.0f) + 1e-6f);
#pragma unroll
    for (int e = 0; e < 16; ++e) v[e] = v[e] * r * gain[16 * p + e];
}
DI void rope64(float* v, const float* cs, const float* sn, int p) {
    const int i0 = 16 * (p & 1);
#pragma unroll
    for (int e = 0; e < 16; ++e) {
        const float o = __shfl_xor(v[e], 2), c = cs[i0 + e], s = sn[i0 + e];
        v[e] = (p < 2) ? (v[e] * c - o * s) : (v[e] * c + o * s);
    }
}

DI void phase_qknorm_na(const Params& p, bf16_t* QKV) {
    const int lane = TIDX() & 63, gw = blockIdx.x * 8 + (TIDX() >> 6), nw = gridDim.x * 8, pp = lane & 3;
    const float* qg = p.in[I_NA_QG]; const float* kg = p.in[I_NA_KG];
    for (int g = gw; g < TT; g += nw) {
        bf16_t* row = QKV + (size_t)g * 3072 + 16 * lane;
        float v[16];
        ld16(row, v); headnorm64(v, qg, pp); st16(row, v);
        ld16(row + 1024, v); headnorm64(v, kg, pp); st16(row + 1024, v);
    }
}
DI void phase_qknorm_swa(const Params& p, const Bufs& B, bf16_t* QKV) {
    const int lane = TIDX() & 63, gw = blockIdx.x * 8 + (TIDX() >> 6), nw = gridDim.x * 8, pp = lane & 3;
    const float* qg = p.in[I_SWA_QG]; const float* kg = p.in[I_SWA_KG];
    for (int g = gw; g < TT; g += nw) {
        bf16_t* row = QKV + (size_t)g * 1536;
        const bool lat = g < TL;
        const int pos = g & 4095;
        const float* cs = B.ROPE_S + (size_t)(lat ? pos : 0) * 32; const float* sn = cs + 4096 * 32;
        float v[16];
        ld16(row + 16 * lane, v); headnorm64(v, qg, pp);
        if (lat) rope64(v, cs, sn, pp);
        st16(row + 16 * lane, v);
        const int kl = lane & 15;
        ld16(row + 1024 + 16 * kl, v); headnorm64(v, kg, pp);
        if (lat) rope64(v, cs, sn, pp);
        if (lane < 16) st16(row + 1024 + 16 * kl, v);
    }
}
DI void phase_mla_dnorm(const Params& p, const Bufs& B, const bf16_t* DOWN, bf16_t* CQ, bf16_t* CKV, bf16_t* KR) {
    const int lane = TIDX() & 63, gw = blockIdx.x * 8 + (TIDX() >> 6), nw = gridDim.x * 8;
    float gq[6], gkv[4];
#pragma unroll
    for (int e = 0; e < 6; ++e) gq[e] = p.in[I_MLA_QNG][6 * lane + e];
#pragma unroll
    for (int e = 0; e < 4; ++e) gkv[e] = p.in[I_MLA_KVNG][4 * lane + e];
    const int l31 = lane & 31;
    const float gkr = p.in[I_MLA_KR_G][l31];
    for (int g = gw; g < TT; g += nw) {
        const bf16_t* d = DOWN + (size_t)g * 768;
        const unsigned q0 = *(const unsigned*)(d + 6 * lane), q1 = *(const unsigned*)(d + 6 * lane + 2), q2 = *(const unsigned*)(d + 6 * lane + 4);
        const u32x2 kv = *(const u32x2*)(d + 384 + 4 * lane);
        const unsigned short krw = d[640 + l31];
        float a[6] = {bflo(q0), bfhi(q0), bflo(q1), bfhi(q1), bflo(q2), bfhi(q2)};
        float ss = 0.f;
#pragma unroll
        for (int e = 0; e < 6; ++e) ss += a[e] * a[e];
        ss = wave_sum(ss);
        float r = rsqrtf(ss * (1.0f / 384.0f) + 1e-6f);
        bf16_t* cq = CQ + (size_t)g * 384 + 6 * lane;
        *(unsigned*)(cq) = pk2(a[0] * r * gq[0], a[1] * r * gq[1]); *(unsigned*)(cq + 2) = pk2(a[2] * r * gq[2], a[3] * r * gq[3]); *(unsigned*)(cq + 4) = pk2(a[4] * r * gq[4], a[5] * r * gq[5]);
        float c[4] = {bflo(kv.x), bfhi(kv.x), bflo(kv.y), bfhi(kv.y)};
        ss = (c[0] * c[0] + c[1] * c[1]) + (c[2] * c[2] + c[3] * c[3]);
        ss = wave_sum(ss);
        r = rsqrtf(ss * (1.0f / 256.0f) + 1e-6f);
        u32x2 o; o.x = pk2(c[0] * r * gkv[0], c[1] * r * gkv[1]); o.y = pk2(c[2] * r * gkv[2], c[3] * r * gkv[3]);
        *(u32x2*)(CKV + (size_t)g * 256 + 4 * lane) = o;
        float x = (lane < 32) ? bf2f(krw) : 0.f;
        ss = wave_sum(x * x);
        r = rsqrtf(ss * (1.0f / 32.0f) + 1e-6f);
        x = x * r * gkr;
        const float ox = __shfl_xor(x, 16);
        if (g < TL) {
            const int pos = g & 4095, ii = lane & 15;
            const float cc = B.ROPE_M[pos * 16 + ii], sn = B.ROPE_M[4096 * 16 + pos * 16 + ii];
            x = (l31 < 16) ? (x * cc - ox * sn) : (x * cc + ox * sn);
        }
        if (lane < 32) KR[(size_t)g * 32 + lane] = (bf16_t)f2bf(x);
    }
}
DI void phase_mla_hnorm(const Params& p, const Bufs& B, bf16_t* Q, bf16_t* KV) {
    const int lane = TIDX() & 63, gw = blockIdx.x * 8 + (TIDX() >> 6), nw = gridDim.x * 8, pp = lane & 3, hh = lane >> 2;
    const float* qng = p.in[I_MLA_QN_G]; const float* qrg = p.in[I_MLA_QR_G]; const float* kng = p.in[I_MLA_KN_G];
    for (int g = gw; g < TT; g += nw) {
        bf16_t* q = Q + (size_t)g * 1536 + hh * 96;
        float v[16];
        ld16(q + 16 * pp, v); headnorm64(v, qng, pp); st16(q + 16 * pp, v);
        float w[8];
        unpack8(*(const u32x4*)(q + 64 + 8 * pp), w);
        float ss = 0.f;
#pragma unroll
        for (int e = 0; e < 8; ++e) ss += w[e] * w[e];
        ss += __shfl_xor(ss, 1); ss += __shfl_xor(ss, 2);
        const float r = rsqrtf(ss * (1.0f / 32.0f) + 1e-6f);
#pragma unroll
        for (int e = 0; e < 8; ++e) w[e] = w[e] * r * qrg[8 * pp + e];
        if (g < TL) {
            const int pos = g & 4095, i0 = 8 * (pp & 1);
#pragma unroll
            for (int e = 0; e < 8; ++e) {
                const float o = __shfl_xor(w[e], 2), c = B.ROPE_M[pos * 16 + i0 + e], s = B.ROPE_M[4096 * 16 + pos * 16 + i0 + e];
                w[e] = (pp < 2) ? (w[e] * c - o * s) : (w[e] * c + o * s);
            }
        }
        *(u32x4*)(q + 64 + 8 * pp) = pack8(w);
        bf16_t* k = KV + (size_t)g * 2048 + hh * 128 + 16 * pp;
        ld16(k, v); headnorm64(v, kng, pp); st16(k, v);
    }
}

typedef short v4i16_t __attribute__((ext_vector_type(4)));
DI s16x4 tr_read(const bf16_t* p) { return __builtin_bit_cast(s16x4, __builtin_amdgcn_ds_read_tr16_b64_v4i16((LAS v4i16_t*)(LAS char*)(char*)p)); }
constexpr int ATT_LDS = 64 * 104 * 2 + 64 * 72 * 2 + 2048;

template <class P>
DI void attn_unit(const P& pol, char* smem) {
    constexpr int DQK = P::DQK, KS = DQK + 8, VS = 72, NS = DQK / 32, NCH = DQK / 8;
    bf16_t* Ks = (bf16_t*)smem;
    bf16_t* Vs = (bf16_t*)(smem + 64 * 104 * 2);
    const int tid = TIDX(), lane = tid & 63, w = tid >> 6, l15 = lane & 15, quad = lane >> 4;
    const int q = w * 16 + l15;
    __syncthreads();
    pol.prologue(smem + 64 * 104 * 2 + 64 * 72 * 2);
    bf16x8 qf[NS];
#pragma unroll
    for (int s = 0; s < NS; ++s) qf[s] = *(const bf16x8*)pol.qptr(q, s * 4 + quad);
    f32x4 o[4];
#pragma unroll
    for (int u = 0; u < 4; ++u) o[u] = (f32x4){0.f, 0.f, 0.f, 0.f};
    float m = -1e30f, l = 0.f;
    const int k0key = (DQK == 64) ? (tid >> 3) : (tid / 12), k0ch = (DQK == 64) ? (tid & 7) : (tid % 12);
    const int k1key = (tid + 512) / 12, k1ch = (tid + 512) % 12;
    const bool k1on = (DQK == 96) && (tid < 256);
    const int vkey = tid >> 3, vch = tid & 7;
    const int nt = pol.ntiles();
    u32x4 rk0, rk1 = (u32x4){0u, 0u, 0u, 0u}, rv;
    rk0 = *(const u32x4*)pol.kptr(0, k0key, k0ch);
    if (k1on) rk1 = *(const u32x4*)pol.kptr(0, k1key, k1ch);
    rv = *(const u32x4*)pol.vptr(0, vkey, vch);
    *(u32x4*)(Ks + k0key * KS + k0ch * 8) = rk0;
    if (k1on) *(u32x4*)(Ks + k1key * KS + k1ch * 8) = rk1;
    *(u32x4*)(Vs + vkey * VS + vch * 8) = rv;
    __syncthreads();
    for (int j = 0; j < nt; ++j) {
        const bool more = (j + 1 < nt);
        if (more) {
            rk0 = *(const u32x4*)pol.kptr(j + 1, k0key, k0ch);
            if (k1on) rk1 = *(const u32x4*)pol.kptr(j + 1, k1key, k1ch);
            rv = *(const u32x4*)pol.vptr(j + 1, vkey, vch);
        }
        f32x4 sc[2][2];
#pragma unroll
        for (int g = 0; g < 2; ++g)
#pragma unroll
            for (int t = 0; t < 2; ++t) {
                f32x4 a = (f32x4){0.f, 0.f, 0.f, 0.f};
                const int key = 32 * g + 8 * (l15 >> 2) + 4 * t + (l15 & 3);
#pragma unroll
                for (int s = 0; s < NS; ++s) { const bf16x8 kf = *(const bf16x8*)(Ks + key * KS + 32 * s + 8 * quad); a = __builtin_amdgcn_mfma_f32_16x16x32_bf16(kf, qf[s], a, 0, 0, 0); }
                sc[g][t] = a;
            }
        float tmax = -3.0e38f;
#pragma unroll
        for (int g = 0; g < 2; ++g)
#pragma unroll
            for (int t = 0; t < 2; ++t)
#pragma unroll
                for (int r = 0; r < 4; ++r) { const float s2 = pol.mod(sc[g][t][r] * pol.c2, q, j, 32 * g + 8 * quad + 4 * t + r); sc[g][t][r] = s2; tmax = fmaxf(tmax, s2); }
        tmax = fmaxf(tmax, __shfl_xor(tmax, 16)); tmax = fmaxf(tmax, __shfl_xor(tmax, 32));
        const float mn = fmaxf(m, tmax), alpha = fexp2(m - mn);
        m = mn;
        float ps = 0.f;
        bf16x8 pf[2];
#pragma unroll
        for (int g = 0; g < 2; ++g) {
            float pv[8];
#pragma unroll
            for (int t = 0; t < 2; ++t)
#pragma unroll
                for (int r = 0; r < 4; ++r) { const float e = fexp2(sc[g][t][r] - mn); ps += e; pv[4 * t + r] = e; }
            pf[g] = __builtin_bit_cast(bf16x8, pack8(pv));
        }
        l = l * alpha + ps;
#pragma unroll
        for (int u = 0; u < 4; ++u) o[u] *= alpha;
#pragma unroll
        for (int u = 0; u < 4; ++u)
#pragma unroll
            for (int g = 0; g < 2; ++g) {
                const bf16_t* vb = Vs + (32 * g + 8 * quad + (l15 >> 2)) * VS + 16 * u + 4 * (l15 & 3);
                const s16x4 lo = tr_read(vb), hi = tr_read(vb + 4 * VS);
                bf16x8 vf; vf[0] = lo[0]; vf[1] = lo[1]; vf[2] = lo[2]; vf[3] = lo[3]; vf[4] = hi[0]; vf[5] = hi[1]; vf[6] = hi[2]; vf[7] = hi[3];
                o[u] = __builtin_amdgcn_mfma_f32_16x16x32_bf16(vf, pf[g], o[u], 0, 0, 0);
            }
        __syncthreads();
        if (more) {
            *(u32x4*)(Ks + k0key * KS + k0ch * 8) = rk0;
            if (k1on) *(u32x4*)(Ks + k1key * KS + k1ch * 8) = rk1;
            *(u32x4*)(Vs + vkey * VS + vch * 8) = rv;
        }
        __syncthreads();
    }
    l += __shfl_xor(l, 16); l += __shfl_xor(l, 32);
    if (P::SINK) l += fexp2(pol.sink2 - m);
    const float il = 1.0f / l;
    bf16_t* op = pol.optr(q);
#pragma unroll
    for (int u = 0; u < 4; ++u) st_bf16x4(op + 16 * u + 4 * quad, o[u] * il);
}

struct PolPlain64 {
    static constexpr int DQK = 64; static constexpr bool SINK = false;
    const bf16_t* Qb; long qs; const bf16_t* Kb; long ks; const bf16_t* Vb; long vs; bf16_t* Ob; long os; int qrow0, krow0, nt; float c2, sink2;
    DI void prologue(char*) const {}
    DI int ntiles() const { return nt; }
    DI const bf16_t* qptr(int q, int ch) const { return Qb + (long)(qrow0 + q) * qs + ch * 8; }
    DI const bf16_t* kptr(int j, int i, int ch) const { return Kb + (long)(krow0 + 64 * j + i) * ks + ch * 8; }
    DI const bf16_t* vptr(int j, int i, int ch) const { return Vb + (long)(krow0 + 64 * j + i) * vs + ch * 8; }
    DI float mod(float s2, int, int, int) const { return s2; }
    DI bf16_t* optr(int q) const { return Ob + (long)(qrow0 + q) * os; }
};
struct PolNA {
    static constexpr int DQK = 64; static constexpr bool SINK = false;
    const bf16_t* QKV; bf16_t* AO; const float* rpb; const float* bl; int b, h, rr, rbase; float c2, sink2;
    DI void prologue(char* s) const { float* t = (float*)s; for (int i = TIDX(); i < 465; i += NTHR) t[i] = rpb[h * 465 + i] * LOG2E; }
    DI int ntiles() const { return 13; }
    DI int qtok(int q) const { return b * 4096 + (2 * rr + (q >> 6)) * 64 + (q & 63); }
    DI int ktok(int j, int i) const { if (j < 4) return TL + b * 256 + 64 * j + i; int kr = rbase + j - 4; kr = kr > 63 ? 63 : kr; return b * 4096 + kr * 64 + i; }
    DI const bf16_t* qptr(int q, int ch) const { return QKV + (long)qtok(q) * 3072 + h * 64 + ch * 8; }
    DI const bf16_t* kptr(int j, int i, int ch) const { return QKV + (long)ktok(j, i) * 3072 + 1024 + h * 64 + ch * 8; }
    DI const bf16_t* vptr(int j, int i, int ch) const { return QKV + (long)ktok(j, i) * 3072 + 2048 + h * 64 + ch * 8; }
    DI float mod(float s2, int q, int j, int kc) const {
        if (j < 4) return s2;
        const int kr = rbase + j - 4, qr = 2 * rr + (q >> 6), qc = q & 63;
        int r0 = qr - 4; r0 = r0 < 0 ? 0 : (r0 > 56 ? 56 : r0);
        int c0 = qc - 8; c0 = c0 < 0 ? 0 : (c0 > 48 ? 48 : c0);
        const bool ok = (kr >= r0) && (kr <= r0 + 7) && (kc >= c0) && (kc < c0 + 16);
        const int idx = ok ? ((kr - qr + 7) * 31 + (kc - qc + 15)) : 0;
        return ok ? (s2 + bl[idx]) : -1e30f;
    }
    DI bf16_t* optr(int q) const { return AO + (long)qtok(q) * 1024 + h * 64; }
};
struct PolMLA {
    static constexpr int DQK = 96; static constexpr bool SINK = false;
    const bf16_t* Q; const bf16_t* KV; const bf16_t* KR; bf16_t* AO; int b, h, qrow0, nt; float c2, sink2;
    DI void prologue(char*) const {}
    DI int ntiles() const { return nt; }
    DI int ktok(int j, int i) const { return (j < 4) ? (TL + b * 256 + 64 * j + i) : (b * 4096 + 64 * (j - 4) + i); }
    DI const bf16_t* qptr(int q, int ch) const { return Q + (long)(qrow0 + q) * 1536 + h * 96 + ch * 8; }
    DI const bf16_t* kptr(int j, int i, int ch) const { const long t = ktok(j, i); return (ch < 8) ? (KV + t * 2048 + h * 128 + ch * 8) : (KR + t * 32 + (ch - 8) * 8); }
    DI const bf16_t* vptr(int j, int i, int ch) const { return KV + (long)ktok(j, i) * 2048 + h * 128 + 64 + ch * 8; }
    DI float mod(float s2, int, int, int) const { return s2; }
    DI bf16_t* optr(int q) const { return AO + (long)(qrow0 + q) * 1024 + h * 64; }
};
struct PolSWA {
    static constexpr int DQK = 64; static constexpr bool SINK = true;
    const bf16_t* QKV; bf16_t* AO; int b, hq, s0; float c2, sink2;
    DI void prologue(char*) const {}
    DI int ntiles() const { return 10; }
    DI int ktok(int j, int i) const { if (j < 4) return TL + b * 256 + 64 * j + i; int kp = s0 - 128 + 64 * (j - 4) + i; kp = kp < 0 ? 0 : (kp > 4095 ? 4095 : kp); return b * 4096 + kp; }
    DI const bf16_t* qptr(int q, int ch) const { return QKV + (long)(b * 4096 + s0 + q) * 1536 + hq * 64 + ch * 8; }
    DI const bf16_t* kptr(int j, int i, int ch) const { return QKV + (long)ktok(j, i) * 1536 + 1024 + (hq >> 2) * 64 + ch * 8; }
    DI const bf16_t* vptr(int j, int i, int ch) const { return QKV + (long)ktok(j, i) * 1536 + 1280 + (hq >> 2) * 64 + ch * 8; }
    DI float mod(float s2, int q, int j, int kc) const {
        if (j < 4) return s2;
        const int kp = s0 - 128 + 64 * (j - 4) + kc, qp = s0 + q, d = qp - kp;
        const bool ok = (kp >= 0) && (kp < 4096) && (d <= 128) && (d >= -128);
        return ok ? s2 : -1e30f;
    }
    DI bf16_t* optr(int q) const { return AO + (long)(b * 4096 + s0 + q) * 1024 + hq * 64; }
};

DI float ftanh(float x) { return 2.0f * fsigmoid(2.0f * x) - 1.0f; }
struct EpiRW1 { bf16_t* RKV; bf16_t* LORA;
    DI f32x4 act(f32x4 a, int lc) const {
        f32x4 r;
#pragma unroll
        for (int i = 0; i < 4; ++i) r[i] = (lc < 128) ? fsigmoid(a[i]) : ((lc < 256) ? ftanh(a[i]) : a[i]);
        return r; }
    DI void operator()(int row, int col, f32x4 a0, f32x4 a1) const {
        if (col < 3072) { bf16_t* p = RKV + (long)row * 3072 + col; st_bf16x4(p, a0); st_bf16x4(p + 16, a1); }
        else if (col < 3456) { const int lc = col - 3072; bf16_t* p = LORA + (long)row * 384 + lc; st_bf16x4(p, act(a0, lc)); st_bf16x4(p + 16, act(a1, lc)); }
    } };
struct EpiRW2 { int seg; bf16_t* O; const float* bias;
    DI f32x4 f(f32x4 a, const float* bp) const {
        f32x4 r;
#pragma unroll
        for (int i = 0; i < 4; ++i) { const float t = fsigmoid(a[i] + bp[i]); r[i] = (seg < 3) ? 0.6065306597126334f * t : t; }
        return r; }
    DI void operator()(int row, int col, f32x4 a0, f32x4 a1) const {
        const int n = col - 1024 * seg; bf16_t* p = O + (long)row * 1024 + n;
        if (seg == 0) { st_bf16x4(p, a0); st_bf16x4(p + 16, a1); }
        else { st_bf16x4(p, f(a0, bias + n)); st_bf16x4(p + 16, f(a1, bias + n + 16)); }
    } };

DI void phase_rw_gemm2(const Params& p, const Bufs& B, const bf16_t* LORA, bf16_t* G, bf16_t* XD0, bf16_t* XD1, bf16_t* AA0, bf16_t* AA1, char* smem) {
    const int ntm = TT >> 7, nt = ntm * 40;
    for (int t = blockIdx.x; t < nt; t += gridDim.x) {
        const int tm = t / 40, tn = t % 40, seg = tn >> 3;
        GemmOp g; g.A = LORA; g.lda = 384; g.Bt = B.WMIX + W_RW_B2; g.ldb = 384;
        g.kbeg = (seg == 0) ? 0 : (64 + 64 * seg); g.kend = (seg == 0) ? 128 : (128 + 64 * seg);
        EpiRW2 e; e.seg = seg;
        e.O = (seg == 0) ? G : (seg == 1 ? XD0 : (seg == 2 ? XD1 : (seg == 3 ? AA0 : AA1)));
        e.bias = (seg == 0) ? nullptr : ((seg < 3) ? p.in[I_RW_W0] + (seg - 1) * 1024 : p.in[I_RW_A0] + (seg - 3) * 1024);
        gemm_tile(g, tm * 128, tn * 128, e, smem);
    }
}

template <int CTRL> DI float dppmov(float x) { return __int_as_float(__builtin_amdgcn_update_dpp(0, __float_as_int(x), CTRL, 0xf, 0xf, false)); }
DI float red8(float x) { x += dppmov<0xB1>(x); x += dppmov<0x4E>(x); x += dppmov<0x141>(x); return x; }
DI float wave_sum_dpp(float x) {
    x += dppmov<0xB1>(x); x += dppmov<0x4E>(x); x += dppmov<0x141>(x); x += dppmov<0x140>(x);
    const int xi = __float_as_int(x);
    const float s0 = __int_as_float(__builtin_amdgcn_readlane(xi, 0)), s1 = __int_as_float(__builtin_amdgcn_readlane(xi, 16)), s2 = __int_as_float(__builtin_amdgcn_readlane(xi, 32)), s3 = __int_as_float(__builtin_amdgcn_readlane(xi, 48));
    return (s0 + s1) + (s2 + s3);
}

constexpr int SCAN_LDS = 32 * 384 * 4 + 32 * 64 * 4;
DI void phase_rw_scan(const Params& p, const bf16_t* RKV, const bf16_t* XD0, const bf16_t* XD1, const bf16_t* AA0, const bf16_t* AA1, bf16_t* YF, bf16_t* YB, char* smem) {
    float* vec = (float*)smem;
    float* ybuf = vec + 32 * 384;
    const int tid = TIDX(), lane = tid & 63, wv = tid >> 6, il = lane >> 3, js = lane & 7, irow = 8 * wv + il;
    const int ss = tid >> 4, jg = tid & 15;
    for (int unit = blockIdx.x; unit < 256; unit += gridDim.x) {
        const int dir = unit & 1, b = unit >> 5, h = (unit >> 1) & 15;
        const bf16_t* XD = dir ? XD1 : XD0; const bf16_t* AA = dir ? AA1 : AA0; bf16_t* Y = dir ? YB : YF;
        const f32x4 kk4 = *(const f32x4*)(p.in[I_RW_KK] + h * 64 + 4 * jg), ka4 = *(const f32x4*)(p.in[I_RW_KA] + h * 64 + 4 * jg);
        float S[8];
#pragma unroll
        for (int e = 0; e < 8; ++e) S[e] = 0.f;
        u32x2 pr, pk, pv, px, pa;
        long gcur;
        {   const int n = ss; const int t = dir ? 255 - n : n; gcur = TL + b * 256 + t;
            const long o = gcur * 3072 + h * 64 + 4 * jg, o1 = gcur * 1024 + h * 64 + 4 * jg;
            pr = *(const u32x2*)(RKV + o); pk = *(const u32x2*)(RKV + o + 1024); pv = *(const u32x2*)(RKV + o + 2048); px = *(const u32x2*)(XD + o1); pa = *(const u32x2*)(AA + o1); }
        for (int c = 0; c < 136; ++c) {
            __syncthreads();
            {
                float kf[4] = {bflo(pk.x), bfhi(pk.x), bflo(pk.y), bfhi(pk.y)};
                float af[4] = {bflo(pa.x), bfhi(pa.x), bflo(pa.y), bfhi(pa.y)};
                float xf[4] = {bflo(px.x), bfhi(px.x), bflo(px.y), bfhi(px.y)};
                f32x4 kkv, kka, kt, wv4, rv4, vv4;
                float sq = 0.f;
#pragma unroll
                for (int e = 0; e < 4; ++e) { kkv[e] = kf[e] * kk4[e]; sq += kkv[e] * kkv[e]; }
                sq += __shfl_xor(sq, 1); sq += __shfl_xor(sq, 2); sq += __shfl_xor(sq, 4); sq += __shfl_xor(sq, 8);
                const float inv = 1.0f / fmaxf(sqrtf(sq), 1e-12f);
#pragma unroll
                for (int e = 0; e < 4; ++e) { kkv[e] *= inv; kka[e] = kkv[e] * af[e]; kt[e] = kf[e] * (1.0f + (af[e] - 1.0f) * ka4[e]); wv4[e] = __expf(-xf[e]); }
                rv4 = (f32x4){bflo(pr.x), bfhi(pr.x), bflo(pr.y), bfhi(pr.y)};
                vv4 = (f32x4){bflo(pv.x), bfhi(pv.x), bflo(pv.y), bfhi(pv.y)};
                float* vb = vec + ss * 384 + 4 * jg;
                *(f32x4*)(vb) = wv4; *(f32x4*)(vb + 64) = kkv; *(f32x4*)(vb + 128) = kka; *(f32x4*)(vb + 192) = kt; *(f32x4*)(vb + 256) = rv4; *(f32x4*)(vb + 320) = vv4;
            }
            const long gthis = gcur;
            __syncthreads();
            if (c + 1 < 136) {
                const int n = (c + 1) * 32 + ss;
                if (n < 256) { const int t = dir ? 255 - n : n; gcur = TL + b * 256 + t; }
                else { const int mm = n - 256; const int t = dir ? 4095 - mm : mm; gcur = (long)b * 4096 + t; }
                const long o = gcur * 3072 + h * 64 + 4 * jg, o1 = gcur * 1024 + h * 64 + 4 * jg;
                pr = *(const u32x2*)(RKV + o); pk = *(const u32x2*)(RKV + o + 1024); pv = *(const u32x2*)(RKV + o + 2048); px = *(const u32x2*)(XD + o1); pa = *(const u32x2*)(AA + o1);
            }
            {
                typedef float f32x2 __attribute__((ext_vector_type(2)));
                float yk[4] = {0.f, 0.f, 0.f, 0.f};
                const float* vb0 = vec + 8 * js;
                f32x4 cw0 = *(const f32x4*)(vb0), cw1 = *(const f32x4*)(vb0 + 4), ck0 = *(const f32x4*)(vb0 + 64), ck1 = *(const f32x4*)(vb0 + 68);
                f32x4 ca0 = *(const f32x4*)(vb0 + 128), ca1 = *(const f32x4*)(vb0 + 132), ct0 = *(const f32x4*)(vb0 + 192), ct1 = *(const f32x4*)(vb0 + 196);
                f32x4 cr0 = *(const f32x4*)(vb0 + 256), cr1 = *(const f32x4*)(vb0 + 260);
                float cvi = vec[320 + irow];
#pragma unroll
                for (int s = 0; s < 32; ++s) {
                    f32x4 nw0 = cw0, nw1 = cw1, nk0 = ck0, nk1 = ck1, na0 = ca0, na1 = ca1, nt0 = ct0, nt1 = ct1, nr0 = cr0, nr1 = cr1; float nvi = cvi;
                    if (s + 1 < 32) {
                        const float* vb = vec + (s + 1) * 384 + 8 * js;
                        nw0 = *(const f32x4*)(vb); nw1 = *(const f32x4*)(vb + 4); nk0 = *(const f32x4*)(vb + 64); nk1 = *(const f32x4*)(vb + 68);
                        na0 = *(const f32x4*)(vb + 128); na1 = *(const f32x4*)(vb + 132); nt0 = *(const f32x4*)(vb + 192); nt1 = *(const f32x4*)(vb + 196);
                        nr0 = *(const f32x4*)(vb + 256); nr1 = *(const f32x4*)(vb + 260); nvi = vec[(s + 1) * 384 + 320 + irow];
                    }
                    f32x2 S0 = {S[0], S[1]}, S1 = {S[2], S[3]}, S2 = {S[4], S[5]}, S3 = {S[6], S[7]};
                    const f32x2 d2 = (S0 * (f32x2){ck0[0], ck0[1]} + S1 * (f32x2){ck0[2], ck0[3]}) + (S2 * (f32x2){ck1[0], ck1[1]} + S3 * (f32x2){ck1[2], ck1[3]});
                    const float sk = red8(d2.x + d2.y);
                    const f32x2 nsk = {-sk, -sk}, vv = {cvi, cvi};
                    S0 = S0 * (f32x2){cw0[0], cw0[1]} + nsk * (f32x2){ca0[0], ca0[1]} + vv * (f32x2){ct0[0], ct0[1]};
                    S1 = S1 * (f32x2){cw0[2], cw0[3]} + nsk * (f32x2){ca0[2], ca0[3]} + vv * (f32x2){ct0[2], ct0[3]};
                    S2 = S2 * (f32x2){cw1[0], cw1[1]} + nsk * (f32x2){ca1[0], ca1[1]} + vv * (f32x2){ct1[0], ct1[1]};
                    S3 = S3 * (f32x2){cw1[2], cw1[3]} + nsk * (f32x2){ca1[2], ca1[3]} + vv * (f32x2){ct1[2], ct1[3]};
                    const f32x2 y2 = (S0 * (f32x2){cr0[0], cr0[1]} + S1 * (f32x2){cr0[2], cr0[3]}) + (S2 * (f32x2){cr1[0], cr1[1]} + S3 * (f32x2){cr1[2], cr1[3]});
                    const float y = red8(y2.x + y2.y);
                    yk[s >> 3] = (js == (s & 7)) ? y : yk[s >> 3];
                    S[0] = S0.x; S[1] = S0.y; S[2] = S1.x; S[3] = S1.y; S[4] = S2.x; S[5] = S2.y; S[6] = S3.x; S[7] = S3.y;
                    cw0 = nw0; cw1 = nw1; ck0 = nk0; ck1 = nk1; ca0 = na0; ca1 = na1; ct0 = nt0; ct1 = nt1; cr0 = nr0; cr1 = nr1; cvi = nvi;
                }
#pragma unroll
                for (int k = 0; k < 4; ++k) ybuf[(8 * k + js) * 64 + irow] = yk[k];
            }
            __syncthreads();
            {
                const f32x4 yv = *(const f32x4*)(ybuf + ss * 64 + 4 * jg);
                st_bf16x4(Y + gthis * 1024 + h * 64 + 4 * jg, yv);
            }
        }
    }
}


constexpr int CS_L1 = 68, CS_L2 = 20;
constexpr int CS_AT = 0, CS_RT = 2176, CS_BL = 4352, CS_KL = 6528, CS_BH = 8704, CS_KH = 11264, CS_VT = 13824, CS_GL = 16384, CS_P1 = 16640;
constexpr int CS_NT = 0, CS_AK = 1024, CS_RB = 1664, CS_RK = 2304, CS_P2 = 2944;
constexpr int SCAN2_LDS = 3 * CS_P1 + 2 * CS_P2;
DI bf16x8 mk8(u32x2 lo, u32x2 hi) { u32x4 v; v.x = lo.x; v.y = lo.y; v.z = hi.x; v.w = hi.y; return __builtin_bit_cast(bf16x8, v); }
DI long scan_token(int b, int dir, int n) {
    if (n < 256) return (long)TL + b * 256 + (dir ? 255 - n : n);
    const int m = n - 256; return (long)b * 4096 + (dir ? 4095 - m : m);
}
struct ScanRaw { unsigned rx[16], xo[4], rk[4], rr[4], ra[4], rv[4]; };
DI unsigned ld16_async(const bf16_t* q) { unsigned r; asm volatile("global_load_ushort %0, %1, off" : "=v"(r) : "v"(q) : "memory"); return r; }
DI void scan_wait_raw(ScanRaw& R) {
    asm volatile("s_waitcnt vmcnt(36)" : "+v"(R.rx[0]), "+v"(R.rx[1]), "+v"(R.rx[2]), "+v"(R.rx[3]), "+v"(R.rx[4]), "+v"(R.rx[5]), "+v"(R.rx[6]), "+v"(R.rx[7]),
                 "+v"(R.rx[8]), "+v"(R.rx[9]), "+v"(R.rx[10]), "+v"(R.rx[11]) :: "memory");
    asm volatile("" : "+v"(R.rx[12]), "+v"(R.rx[13]), "+v"(R.rx[14]), "+v"(R.rx[15]), "+v"(R.xo[0]), "+v"(R.xo[1]), "+v"(R.xo[2]), "+v"(R.xo[3]),
                 "+v"(R.rk[0]), "+v"(R.rk[1]), "+v"(R.rk[2]), "+v"(R.rk[3]) :: "memory");
    asm volatile("" : "+v"(R.rr[0]), "+v"(R.rr[1]), "+v"(R.rr[2]), "+v"(R.rr[3]), "+v"(R.ra[0]), "+v"(R.ra[1]), "+v"(R.ra[2]), "+v"(R.ra[3]),
                 "+v"(R.rv[0]), "+v"(R.rv[1]), "+v"(R.rv[2]), "+v"(R.rv[3]) :: "memory");
}
DI void scan_chunk_tokens(int b, int dir, int chunk, int& g0, int& step) {
    const int n0 = chunk * 16; step = dir ? -1 : 1;
    if (n0 < 256) g0 = TL + b * 256 + (dir ? 255 - n0 : n0); else g0 = b * 4096 + (dir ? 4095 - (n0 - 256) : (n0 - 256));
}
DI void scan_load_raw(ScanRaw& R, const bf16_t* RKV, const bf16_t* XD, const bf16_t* AA, int b, int dir, int h, int j, int pw, int chunk) {
    int g0, step; scan_chunk_tokens(b, dir, chunk, g0, step);
    const bf16_t* px = XD + (long)g0 * 1024 + h * 64; const long sx = (long)step * 1024;
#pragma unroll
    for (int s = 0; s < 16; ++s) R.rx[s] = ld16_async(px + (s * sx + j));
    const int t0 = 4 * pw;
    const bf16_t* pr = RKV + (long)(g0 + t0 * step) * 3072 + h * 64; const bf16_t* pa = AA + (long)(g0 + t0 * step) * 1024 + h * 64; const bf16_t* pxo = px + t0 * sx;
    const long s3 = (long)step * 3072;
#pragma unroll
    for (int q = 0; q < 4; ++q) { R.rr[q] = ld16_async(pr + (q * s3 + j)); R.rk[q] = ld16_async(pr + (q * s3 + 1024 + j)); R.rv[q] = ld16_async(pr + (q * s3 + 2048 + j)); R.ra[q] = ld16_async(pa + (q * sx + j)); R.xo[q] = ld16_async(pxo + (q * sx + j)); }
}
DI void scan_p1(const ScanRaw& R, char* st, int pw, int j, float kkj, float kaj) {
    float before = 0.f, total = 0.f;
#pragma unroll
    for (int s = 0; s < 16; ++s) { const float xv = bf2f(R.rx[s]); total += xv; before += (s < 4 * pw) ? xv : 0.f; }
    float gprev = __expf(-before);
    const float gL = __expf(-total);
    unsigned bhk[4], khk[4];
#pragma unroll
    for (int q = 0; q < 4; ++q) {
        const int t = 4 * pw + q;
        const float gt = gprev * __expf(-bf2f(R.xo[q]));
        const float ig = __builtin_amdgcn_rcpf(gt), gl = gL * ig;
        const float kf = bf2f(R.rk[q]), af = bf2f(R.ra[q]), rf = bf2f(R.rr[q]);
        const float kkraw = kf * kkj;
        const float kk = kkraw * __builtin_amdgcn_rsqf(fmaxf(wave_sum_dpp(kkraw * kkraw), 1e-24f));
        const float bb = kk * af, ktv = kf * (1.0f + (af - 1.0f) * kaj);
        const unsigned p0 = pk2(-kk * gprev, rf * gt), p1 = pk2(bb * ig, ktv * ig);
        ((bf16_t*)(st + CS_AT))[t * CS_L1 + j] = (bf16_t)(p0 & 0xffffu);
        ((bf16_t*)(st + CS_RT))[t * CS_L1 + j] = (bf16_t)(p0 >> 16);
        ((bf16_t*)(st + CS_BL))[t * CS_L1 + j] = (bf16_t)(p1 & 0xffffu);
        ((bf16_t*)(st + CS_KL))[t * CS_L1 + j] = (bf16_t)(p1 >> 16);
        const unsigned p2 = pk2(bb * gl, ktv * gl);
        bhk[q] = p2 & 0xffffu; khk[q] = p2 >> 16;
        gprev = gt;
    }
    u32x2 w2;
    w2.x = bhk[0] | (bhk[1] << 16); w2.y = bhk[2] | (bhk[3] << 16); *(u32x2*)(st + CS_BH + (j * CS_L2 + 4 * pw) * 2) = w2;
    w2.x = khk[0] | (khk[1] << 16); w2.y = khk[2] | (khk[3] << 16); *(u32x2*)(st + CS_KH + (j * CS_L2 + 4 * pw) * 2) = w2;
    w2.x = (unsigned)R.rv[0] | ((unsigned)R.rv[1] << 16); w2.y = (unsigned)R.rv[2] | ((unsigned)R.rv[3] << 16); *(u32x2*)(st + CS_VT + (j * CS_L2 + 4 * pw) * 2) = w2;
    if (pw == 0) ((float*)(st + CS_GL))[j] = gL;
}
DI void scan_p2(const char* s1, char* s2, int pw, int l15, int quad) {
    const bf16_t* Am = (const bf16_t*)(s1 + ((pw < 2) ? CS_AT : CS_RT));
    const bf16_t* Bm = (const bf16_t*)(s1 + ((pw & 1) ? CS_KL : CS_BL));
    f32x4 d = (f32x4){0.f, 0.f, 0.f, 0.f};
#pragma unroll
    for (int ks = 0; ks < 2; ++ks) {
        const bf16_t* ap = Am + l15 * CS_L1 + 32 * ks + 8 * quad; const bf16_t* bp = Bm + l15 * CS_L1 + 32 * ks + 8 * quad;
        const bf16x8 af = mk8(*(const u32x2*)ap, *(const u32x2*)(ap + 4)), bf = mk8(*(const u32x2*)bp, *(const u32x2*)(bp + 4));
        d = __builtin_amdgcn_mfma_f32_16x16x32_bf16(af, bf, d, 0, 0, 0);
    }
#pragma unroll
    for (int r = 0; r < 4; ++r) { const int t = 4 * quad + r; const bool keep = (pw < 2) ? (l15 < t) : (l15 <= t); d[r] = keep ? d[r] : 0.f; }
    if (pw == 0) *(f32x4*)(s2 + CS_NT + (l15 * 16 + 4 * quad) * 4) = d;
    else {
        bf16_t* O = (bf16_t*)(s2 + (pw == 1 ? CS_AK : (pw == 2 ? CS_RB : CS_RK)));
        const unsigned q0 = pk2(d[0], d[1]), q1 = pk2(d[2], d[3]);
        O[(4 * quad + 0) * CS_L2 + l15] = (bf16_t)(q0 & 0xffffu); O[(4 * quad + 1) * CS_L2 + l15] = (bf16_t)(q0 >> 16);
        O[(4 * quad + 2) * CS_L2 + l15] = (bf16_t)(q1 & 0xffffu); O[(4 * quad + 3) * CS_L2 + l15] = (bf16_t)(q1 >> 16);
    }
}
DI void phase_rw_scan2(const Params& p, const bf16_t* RKV, const bf16_t* XD0, const bf16_t* XD1, const bf16_t* AA0, const bf16_t* AA1, bf16_t* YF, bf16_t* YB, char* smem) {
    const int tid = TIDX(), lane = tid & 63, wv = __builtin_amdgcn_readfirstlane(tid >> 6), l15 = lane & 15, quad = lane >> 4;
    constexpr int NCH = 272;
    const u32x2 z2 = (u32x2){0u, 0u};
    for (int unit = blockIdx.x; unit < 256; unit += gridDim.x) {
        const int dir = unit & 1, b = unit >> 5, h = (unit >> 1) & 15;
        const bf16_t* XD = dir ? XD1 : XD0; const bf16_t* AA = dir ? AA1 : AA0; bf16_t* Y = dir ? YB : YF;
        __syncthreads();
        if (wv >= 4) {
            const int pw = wv - 4, j = lane;
            float kkj = p.in[I_RW_KK][h * 64 + j], kaj = p.in[I_RW_KA][h * 64 + j];
            asm volatile("s_waitcnt vmcnt(0)" : "+v"(kkj), "+v"(kaj) :: "memory");
            ScanRaw RA, RB_;
            scan_load_raw(RA, RKV, XD, AA, b, dir, h, j, pw, 0);
            scan_load_raw(RB_, RKV, XD, AA, b, dir, h, j, pw, 1);
            for (int c = -2; c < NCH; c += 2) {
#pragma unroll
                for (int half = 0; half < 2; ++half) {
                    const int cc = c + half, c2 = cc + 2, c1 = cc + 1;
                    if (c2 < NCH) {
                        const int cn = (c2 + 2 < NCH) ? c2 + 2 : NCH - 1;
                        if (half == 0) { scan_wait_raw(RA); scan_p1(RA, smem + (c2 % 3) * CS_P1, pw, j, kkj, kaj); scan_load_raw(RA, RKV, XD, AA, b, dir, h, j, pw, cn); }
                        else { scan_wait_raw(RB_); scan_p1(RB_, smem + (c2 % 3) * CS_P1, pw, j, kkj, kaj); scan_load_raw(RB_, RKV, XD, AA, b, dir, h, j, pw, cn); }
                    }
                    if (c1 >= 0 && c1 < NCH) scan_p2(smem + (c1 % 3) * CS_P1, smem + 3 * CS_P1 + (c1 & 1) * CS_P2, pw, l15, quad);
                    __syncthreads();
                }
            }
            asm volatile("s_waitcnt vmcnt(0)" ::: "memory");
        } else {
            const int w = wv;
            f32x4 ST[4];
#pragma unroll
            for (int jt = 0; jt < 4; ++jt) ST[jt] = (f32x4){0.f, 0.f, 0.f, 0.f};
            for (int c = -2; c < NCH; ++c) {
                if (c >= 0) {
                    int g0, step; scan_chunk_tokens(b, dir, c, g0, step);
                    const long ystep = (long)step * 1024;
                    bf16_t* yp = Y + (long)(g0 + 4 * quad * step) * 1024 + h * 64 + 16 * w + l15;
                    const char* s1 = smem + (c % 3) * CS_P1;
                    const char* s2 = smem + 3 * CS_P1 + (c & 1) * CS_P2;
                    const bf16_t* AT = (const bf16_t*)(s1 + CS_AT); const bf16_t* RT = (const bf16_t*)(s1 + CS_RT);
                    const bf16_t* BH = (const bf16_t*)(s1 + CS_BH); const bf16_t* KH = (const bf16_t*)(s1 + CS_KH); const bf16_t* VT = (const bf16_t*)(s1 + CS_VT);
                    const float* GL = (const float*)(s1 + CS_GL);
                    const float* NT = (const float*)(s2 + CS_NT); const bf16_t* AK = (const bf16_t*)(s2 + CS_AK);
                    const bf16_t* RB = (const bf16_t*)(s2 + CS_RB); const bf16_t* RK = (const bf16_t*)(s2 + CS_RK);
                    float Tr[16];
#pragma unroll
                    for (int u = 0; u < 16; ++u) Tr[u] = (u == l15) ? 1.0f : 0.f;
#pragma unroll
                    for (int s = 14; s >= 0; --s) {
                        float a0 = 0.f, a1 = 0.f;
#pragma unroll
                        for (int u4 = 0; u4 < 4; ++u4) {
                            if (4 * u4 + 3 > s) {
                                const f32x4 nv = *(const f32x4*)(NT + s * 16 + 4 * u4);
#pragma unroll
                                for (int e = 0; e < 4; ++e) if (4 * u4 + e > s) { if (e & 1) a1 += Tr[4 * u4 + e] * nv[e]; else a0 += Tr[4 * u4 + e] * nv[e]; }
                            }
                        }
                        Tr[s] = (s < l15) ? (a0 + a1) : Tr[s];
                    }
                    u32x2 th, tl;
                    {
                        float tq[4];
                        const float m0 = (quad == 0) ? 1.0f : 0.f, m1 = (quad == 1) ? 1.0f : 0.f, m2 = (quad == 2) ? 1.0f : 0.f, m3 = (quad == 3) ? 1.0f : 0.f;
#pragma unroll
                        for (int e = 0; e < 4; ++e) tq[e] = (m0 * Tr[e] + m1 * Tr[4 + e]) + (m2 * Tr[8 + e] + m3 * Tr[12 + e]);
                        th.x = pk2(tq[0], tq[1]); th.y = pk2(tq[2], tq[3]);
                        tl.x = pk2(tq[0] - bflo(th.x), tq[1] - bfhi(th.x)); tl.y = pk2(tq[2] - bflo(th.y), tq[3] - bfhi(th.y));
                    }
                    bf16x8 sf[2];
#pragma unroll
                    for (int ks = 0; ks < 2; ++ks) { u32x2 lo, hi; lo.x = pk2(ST[2 * ks][0], ST[2 * ks][1]); lo.y = pk2(ST[2 * ks][2], ST[2 * ks][3]); hi.x = pk2(ST[2 * ks + 1][0], ST[2 * ks + 1][1]); hi.y = pk2(ST[2 * ks + 1][2], ST[2 * ks + 1][3]); sf[ks] = mk8(lo, hi); }
                    const u32x2 vfr = *(const u32x2*)(VT + (16 * w + l15) * CS_L2 + 4 * quad);
                    f32x4 X = (f32x4){0.f, 0.f, 0.f, 0.f}, Yv = X;
#pragma unroll
                    for (int ks = 0; ks < 2; ++ks) {
                        const bf16x8 af = mk8(*(const u32x2*)(AT + l15 * CS_L1 + 32 * ks + 4 * quad), *(const u32x2*)(AT + l15 * CS_L1 + 32 * ks + 16 + 4 * quad));
                        const bf16x8 rf = mk8(*(const u32x2*)(RT + l15 * CS_L1 + 32 * ks + 4 * quad), *(const u32x2*)(RT + l15 * CS_L1 + 32 * ks + 16 + 4 * quad));
                        X = __builtin_amdgcn_mfma_f32_16x16x32_bf16(af, sf[ks], X, 0, 0, 0);
                        Yv = __builtin_amdgcn_mfma_f32_16x16x32_bf16(rf, sf[ks], Yv, 0, 0, 0);
                    }
                    X = __builtin_amdgcn_mfma_f32_16x16x32_bf16(mk8(*(const u32x2*)(AK + l15 * CS_L2 + 4 * quad), z2), mk8(vfr, z2), X, 0, 0, 0);
                    u32x2 xh, xl;
                    {
                        xh.x = pk2(X[0], X[1]); xh.y = pk2(X[2], X[3]);
                        const float r0 = X[0] - bflo(xh.x), r1 = X[1] - bfhi(xh.x), r2 = X[2] - bflo(xh.y), r3 = X[3] - bfhi(xh.y);
                        xl.x = pk2(r0, r1); xl.y = pk2(r2, r3);
                    }
                    f32x4 U = (f32x4){0.f, 0.f, 0.f, 0.f};
                    U = __builtin_amdgcn_mfma_f32_16x16x32_bf16(mk8(th, tl), mk8(xh, xh), U, 0, 0, 0);
                    U = __builtin_amdgcn_mfma_f32_16x16x32_bf16(mk8(th, z2), mk8(xl, z2), U, 0, 0, 0);
                    u32x2 uf; uf.x = pk2(U[0], U[1]); uf.y = pk2(U[2], U[3]);
                    const bf16x8 uv = mk8(uf, vfr);
                    Yv = __builtin_amdgcn_mfma_f32_16x16x32_bf16(mk8(*(const u32x2*)(RB + l15 * CS_L2 + 4 * quad), *(const u32x2*)(RK + l15 * CS_L2 + 4 * quad)), uv, Yv, 0, 0, 0);
#pragma unroll
                    for (int jt = 0; jt < 4; ++jt) {
                        const f32x4 gl = *(const f32x4*)(GL + 16 * jt + 4 * quad);
                        const bf16x8 af = mk8(*(const u32x2*)(BH + (16 * jt + l15) * CS_L2 + 4 * quad), *(const u32x2*)(KH + (16 * jt + l15) * CS_L2 + 4 * quad));
                        ST[jt] = __builtin_amdgcn_mfma_f32_16x16x32_bf16(af, uv, ST[jt] * gl, 0, 0, 0);
                    }
#pragma unroll
                    for (int r = 0; r < 4; r += 2) { const unsigned yq = pk2(Yv[r], Yv[r + 1]); yp[(long)r * ystep] = (bf16_t)(yq & 0xffffu); yp[(long)(r + 1) * ystep] = (bf16_t)(yq >> 16); }
                }
                __syncthreads();
            }
        }
    }
}

DI void ld16f(const float* p, float* v) {
#pragma unroll
    for (int i = 0; i < 4; ++i) { const f32x4 t = *(const f32x4*)(p + 4 * i); v[4 * i] = t[0]; v[4 * i + 1] = t[1]; v[4 * i + 2] = t[2]; v[4 * i + 3] = t[3]; } }
DI void phase_rw_readout(const Params& p, const bf16_t* RKV, const bf16_t* AA0, const bf16_t* AA1, const bf16_t* G, const bf16_t* YF, const bf16_t* YB, bf16_t* Z) {
    const int lane = TIDX() & 63, gw = blockIdx.x * 8 + (TIDX() >> 6), nw = gridDim.x * 8, col = 16 * lane;
    float lng[16], lnb[16], ka[16], rk[16];
    ld16f(p.in[I_RW_LNG] + col, lng); ld16f(p.in[I_RW_LNB] + col, lnb); ld16f(p.in[I_RW_KA] + col, ka); ld16f(p.in[I_RW_RK] + col, rk);
    for (int g = gw; g < TT; g += nw) {
        float y[16], t[16], r[16], k[16], v[16], a0[16], a1[16], gg[16];
        ld16(YF + (size_t)g * 1024 + col, y); ld16(YB + (size_t)g * 1024 + col, t);
        ld16(RKV + (size_t)g * 3072 + col, r); ld16(RKV + (size_t)g * 3072 + 1024 + col, k); ld16(RKV + (size_t)g * 3072 + 2048 + col, v);
        ld16(AA0 + (size_t)g * 1024 + col, a0); ld16(AA1 + (size_t)g * 1024 + col, a1); ld16(G + (size_t)g * 1024 + col, gg);
        float sm = 0.f;
#pragma unroll
        for (int e = 0; e < 16; ++e) { y[e] += t[e]; sm += y[e]; }
        sm += __shfl_xor(sm, 1); sm += __shfl_xor(sm, 2);
        const float mu = sm * (1.0f / 64.0f);
        float sv = 0.f, bs = 0.f;
#pragma unroll
        for (int e = 0; e < 16; ++e) { y[e] -= mu; sv += y[e] * y[e];
            const float kt0 = k[e] * (1.0f + (a0[e] - 1.0f) * ka[e]), kt1 = k[e] * (1.0f + (a1[e] - 1.0f) * ka[e]);
            bs += r[e] * (kt0 + kt1) * rk[e]; }
        sv += __shfl_xor(sv, 1); sv += __shfl_xor(sv, 2); bs += __shfl_xor(bs, 1); bs += __shfl_xor(bs, 2);
        const float rs = rsqrtf(sv * (1.0f / 64.0f) + 64e-5f);
#pragma unroll
        for (int e = 0; e < 16; ++e) y[e] = (y[e] * rs * lng[e] + lnb[e] + bs * v[e]) * gg[e];
        st16(Z + (size_t)g * 1024 + col, y);
    }
}

DI void topk_sort(unsigned long long* keys, const float* src, int n) {
    const int tid = TIDX();
    __syncthreads();
    for (int i = tid; i < n; i += NTHR) keys[i] = ((unsigned long long)__float_as_uint(src[i]) << 32) | (unsigned long long)(0xFFFFFFFFu - (unsigned)i);
    __syncthreads();
    for (int k2 = 2; k2 <= n; k2 <<= 1)
        for (int j = k2 >> 1; j > 0; j >>= 1) {
            for (int pi = tid; pi < (n >> 1); pi += NTHR) {
                const int i = ((pi & ~(j - 1)) << 1) | (pi & (j - 1)), ix = i | j;
                const bool up = (i & k2) == 0;
                const unsigned long long a = keys[i], c = keys[ix];
                if (up ? (a < c) : (a > c)) { keys[i] = c; keys[ix] = a; }
            }
            __syncthreads();
        }
}
DI void topk_emit(const Bufs& B, const unsigned long long* keys, const bf16_t* H, bf16_t* XIN, int b, int e, bool isc, int c0, int cstep, int kcap) {
    const int tid = TIDX(), lane = tid & 63, wv = tid >> 6;
    for (int c = c0 + tid * cstep; c < kcap; c += NTHR * cstep) {
        const unsigned long long key = keys[c];
        const int idx = (int)(0xFFFFFFFFu - (unsigned)(key & 0xFFFFFFFFull));
        const int g = isc ? (TL + b * 256 + idx) : (b * 4096 + idx);
        const int er = isc ? (4096 + b * 32 + c) : (b * 512 + c);
        B.IDX[e * EROWS + er] = g; B.GATE[e * EROWS + er] = __uint_as_float((unsigned)(key >> 32)); B.INV[(size_t)g * 16 + e] = er;
    }
    for (int cb = c0 + wv * cstep; !GATHER_A && cb < kcap; cb += 32 * cstep) {
        u32x4 v0[4], v1[4];
#pragma unroll
        for (int k = 0; k < 4; ++k) {
            const int c = cb + 8 * cstep * k;
            if (c < kcap) {
                const int idx = (int)(0xFFFFFFFFu - (unsigned)(keys[c] & 0xFFFFFFFFull));
                const bf16_t* s = H + (size_t)(isc ? (TL + b * 256 + idx) : (b * 4096 + idx)) * 1024;
                v0[k] = *(const u32x4*)(s + lane * 8); v1[k] = *(const u32x4*)(s + 512 + lane * 8);
            }
        }
#pragma unroll
        for (int k = 0; k < 4; ++k) {
            const int c = cb + 8 * cstep * k;
            if (c < kcap) {
                const int er = isc ? (4096 + b * 32 + c) : (b * 512 + c);
                bf16_t* d = XIN + ((size_t)e * EROWS + er) * 1024;
                *(u32x4*)(d + lane * 8) = v0[k]; *(u32x4*)(d + 512 + lane * 8) = v1[k];
            }
        }
    }
}
constexpr int TOPK_LDS = 4096 * 8;
DI void topk_select(const Bufs& B, const float* src, int n, int kcap, int b, int e, bool isc, char* smem) {
    unsigned* hist = (unsigned*)smem; unsigned* scan = hist + 2048; unsigned* bc = scan + 512;
    const int tid = TIDX();
    const bool act = tid * 8 < n;
    unsigned v[8];
    {
        u32x4 a = (u32x4){0u, 0u, 0u, 0u}, c = a;
        if (act) { a = *(const u32x4*)(src + tid * 8); c = *(const u32x4*)(src + tid * 8 + 4); }
        v[0] = a.x; v[1] = a.y; v[2] = a.z; v[3] = a.w; v[4] = c.x; v[5] = c.y; v[6] = c.z; v[7] = c.w;
    }
    unsigned pval = 0u, pmask = 0u; int krem = kcap;
#pragma unroll
    for (int pass = 0; pass < 3; ++pass) {
        const int shift = (pass == 0) ? 21 : ((pass == 1) ? 10 : 0);
        const unsigned nb = (pass == 2) ? 1024u : 2048u;
        __syncthreads();
        for (unsigned i = tid; i < nb; i += NTHR) hist[i] = 0u;
        __syncthreads();
        if (act) {
#pragma unroll
            for (int i = 0; i < 8; ++i) if ((v[i] & pmask) == pval) atomicAdd(&hist[(v[i] >> shift) & (nb - 1u)], 1u);
        }
        __syncthreads();
        unsigned h4[4] = {0u, 0u, 0u, 0u};
        if ((unsigned)tid * 4u < nb) { const u32x4 hv = *(const u32x4*)(hist + tid * 4); h4[0] = hv.x; h4[1] = hv.y; h4[2] = hv.z; h4[3] = hv.w; }
        const unsigned sown = h4[0] + h4[1] + h4[2] + h4[3];
        scan[tid] = sown;
        __syncthreads();
        for (int d = 1; d < NTHR; d <<= 1) {
            const unsigned x = (tid + d < NTHR) ? scan[tid + d] : 0u;
            __syncthreads();
            scan[tid] += x;
            __syncthreads();
        }
        const unsigned sincl = scan[tid], sexcl = sincl - sown;
        if (sexcl < (unsigned)krem && (unsigned)krem <= sincl) {
            unsigned c = sexcl;
#pragma unroll
            for (int bi = 3; bi >= 0; --bi) {
                if (c < (unsigned)krem && c + h4[bi] >= (unsigned)krem) { bc[0] = (unsigned)(tid * 4 + bi); bc[1] = c; }
                c += h4[bi];
            }
        }
        __syncthreads();
        const unsigned beta = bc[0], above = bc[1];
        pval |= beta << shift; pmask |= (nb - 1u) << shift; krem -= (int)above;
    }
    unsigned ngt = 0u, neq = 0u;
    if (act) {
#pragma unroll
        for (int i = 0; i < 8; ++i) { ngt += (v[i] > pval) ? 1u : 0u; neq += (v[i] == pval) ? 1u : 0u; }
    }
    const unsigned packed = ngt | (neq << 16);
    __syncthreads();
    scan[tid] = packed;
    __syncthreads();
    for (int d = 1; d < NTHR; d <<= 1) {
        const unsigned x = (tid >= d) ? scan[tid - d] : 0u;
        __syncthreads();
        scan[tid] += x;
        __syncthreads();
    }
    const unsigned excl = scan[tid] - packed;
    unsigned g_before = excl & 0xffffu, e_before = excl >> 16;
    if (act) {
#pragma unroll
        for (int i = 0; i < 8; ++i) {
            const bool gt = v[i] > pval, eq = v[i] == pval;
            const bool take = gt || (eq && e_before < (unsigned)krem);
            if (take) {
                const unsigned eb = e_before < (unsigned)krem ? e_before : (unsigned)krem;
                const int slot = (int)(g_before + eb);
                const int idx = tid * 8 + i;
                const int g = isc ? (TL + b * 256 + idx) : (b * 4096 + idx);
                const int er = isc ? (4096 + b * 32 + slot) : (b * 512 + slot);
                B.IDX[e * EROWS + er] = g; B.GATE[e * EROWS + er] = __uint_as_float(v[i]); B.INV[(size_t)g * 16 + e] = er;
            }
            g_before += gt ? 1u : 0u; e_before += eq ? 1u : 0u;
        }
    }
}
#if GATHER_A
DI void phase_topk(const Bufs& B, const bf16_t* H, bf16_t* XIN, bool has_ctx, char* smem) {
    const int nl = has_ctx ? 256 : 128;
    for (int u = blockIdx.x; u < nl; u += gridDim.x) {
        const bool isc = u >= 128; const int li = u & 127, b = li >> 4, e = li & 15;
        if (!isc) topk_select(B, B.AFF + (size_t)(b * 16 + e) * 4096, 4096, 512, b, e, false, smem);
        else topk_select(B, B.AFFC + (size_t)(b * 16 + e) * 256, 256, 32, b, e, true, smem);
    }
}
#else
DI void phase_topk(const Bufs& B, const bf16_t* H, bf16_t* XIN, bool has_ctx, char* smem) {
    unsigned long long* keys = (unsigned long long*)smem;
    for (int u = blockIdx.x; u < 256; u += gridDim.x) {
        const int li = u & 127, b = li >> 4, e = li & 15, half = u >> 7;
        topk_sort(keys, B.AFF + (size_t)(b * 16 + e) * 4096, 4096);
        topk_emit(B, keys, H, XIN, b, e, false, half, 2, 512);
    }
    if (has_ctx) {
        for (int u = blockIdx.x; u < 128; u += gridDim.x) {
            const int b = u >> 4, e = u & 15;
            topk_sort(keys, B.AFFC + (size_t)(b * 16 + e) * 256, 256);
            topk_emit(B, keys, H, XIN, b, e, true, 0, 1, 32);
        }
    }
}
#endif
DI void phase_moe_gemm1(const Bufs& B, const bf16_t* XIN, bf16_t* HID, bool has_ctx, char* smem) {
#if USE_PG8
    pg8::Gemm g; g.A = GATHER_A ? B.slot(0) : XIN; g.Bt = B.W13; g.M = 16 * EROWS; g.N = 16 * 2048; g.K = 1024;
    pg8::GroupedOrder S; S.P = has_ctx ? 17 : 16; S.NT = 8; S.G = (int)gridDim.x; S.c = (int)blockIdx.x;
    pg8::PEpiSwiglu ep; ep.O = HID;
#if GATHER_A
    pg8::gemm_phase_gather<pg8::PEpiSwiglu, pg8::GroupedOrder>((LAS unsigned char*)smem, g, S, ep, B.IDX);
#else
    pg8::gemm_phase<pg8::PEpiSwiglu, pg8::GroupedOrder, false>((LAS unsigned char*)smem, g, S, ep, nullptr);
#endif
#else
    const int ntm = (has_ctx ? EROWS : 4096) >> 7, per = ntm * 16, nt = NEXP * per;
    for (int t = blockIdx.x; t < nt; t += gridDim.x) {
        const int e = t / per, r = t % per, tm = r >> 4, tn = r & 15;
        GemmOp g; g.A = XIN + (size_t)e * EROWS * 1024; g.lda = 1024; g.Bt = B.W13 + (size_t)e * 2048 * 1024; g.ldb = 1024; g.kbeg = 0; g.kend = 1024;
        EpiSwiglu ep; ep.O = HID + (size_t)e * EROWS * 1024;
        gemm_tile(g, tm * 128, tn * 128, ep, smem);
    }
#endif
}
DI void phase_moe_gemm2(const Bufs& B, const bf16_t* HID, bf16_t* Y, bool has_ctx, char* smem, int layer) {
#if USE_PG8
    pg8::Gemm g; g.A = HID; g.Bt = B.w2t(layer); g.M = 16 * EROWS; g.N = 16 * 1024; g.K = 1024;
    pg8::GroupedOrder S; S.P = has_ctx ? 17 : 16; S.NT = 4; S.G = (int)gridDim.x; S.c = (int)blockIdx.x;
    pg8::PEpiGate ep; ep.O = Y; ep.gate = B.GATE;
    pg8::gemm_phase<pg8::PEpiGate, pg8::GroupedOrder, false>((LAS unsigned char*)smem, g, S, ep, nullptr);
#else
    const int ntm = (has_ctx ? EROWS : 4096) >> 7, per = ntm * 8, nt = NEXP * per;
    for (int t = blockIdx.x; t < nt; t += gridDim.x) {
        const int e = t / per, r = t % per, tm = r >> 3, tn = r & 7;
        GemmOp g; g.A = HID + (size_t)e * EROWS * 1024; g.lda = 1024; g.Bt = B.w2t(layer) + (size_t)e * 1024 * 1024; g.ldb = 1024; g.kbeg = 0; g.kend = 1024;
        EpiGate ep; ep.O = Y + (size_t)e * EROWS * 1024; ep.gate = B.GATE + e * EROWS;
        gemm_tile(g, tm * 128, tn * 128, ep, smem);
    }
#endif
}
DI void phase_combine(const Params& p, const Bufs& B, int layer, const bf16_t* Y, int ntok, bool last, bool fuse_next, bf16_t* H) {
    const int lane = TIDX() & 63, gw = blockIdx.x * 8 + (TIDX() >> 6), nw = gridDim.x * 8;
    for (int g = gw; g < ntok; g += nw) {
        float acc[16];
#pragma unroll
        for (int e = 0; e < 16; ++e) acc[e] = 0.f;
        const int myc = B.INV[(size_t)g * 16 + (lane & 15)];
        unsigned sel = (unsigned)(__ballot(myc >= 0) & 0xFFFFull);
        while (sel) {
            const int e = __builtin_ctz(sel); sel &= sel - 1;
            const int c = __builtin_amdgcn_readlane(myc, e);
            const bf16_t* yr = Y + ((size_t)e * EROWS + c) * 1024 + 4 * lane;
#pragma unroll
            for (int i = 0; i < 4; ++i) { const u32x2 t = *(const u32x2*)(yr + 256 * i); acc[4 * i] += bflo(t.x); acc[4 * i + 1] += bfhi(t.x); acc[4 * i + 2] += bflo(t.y); acc[4 * i + 3] += bfhi(t.y); }
        }
        const float* gt = B.MOD + ((size_t)layer * 9 + modrow_of(g)) * 6144 + 5 * 1024;
        float* xr = B.X + (size_t)g * 1024;
#pragma unroll
        for (int i = 0; i < 4; ++i) {
            const f32x4 gv = *(const f32x4*)(gt + 256 * i + 4 * lane); f32x4 xv = *(const f32x4*)(xr + 256 * i + 4 * lane);
            xv[0] += gv[0] * acc[4 * i]; xv[1] += gv[1] * acc[4 * i + 1]; xv[2] += gv[2] * acc[4 * i + 2]; xv[3] += gv[3] * acc[4 * i + 3];
            if (last) *(f32x4*)(p.out + (size_t)g * 1024 + 256 * i + 4 * lane) = xv;
            else *(f32x4*)(xr + 256 * i + 4 * lane) = xv;
            acc[4 * i] = xv[0]; acc[4 * i + 1] = xv[1]; acc[4 * i + 2] = xv[2]; acc[4 * i + 3] = xv[3];
        }
        if (fuse_next) {
            const float* md = B.MOD + ((size_t)(layer + 1) * 9 + modrow_of(g)) * 6144;
            float gg[16], sh[16], sc[16];
            row_load_f32(p.in[I_N1G] + (layer + 1) * 1024, lane, gg); row_load_f32(md, lane, sh); row_load_f32(md + 1024, lane, sc);
            float ss = 0.f;
#pragma unroll
            for (int e = 0; e < 16; ++e) ss += acc[e] * acc[e];
            ss = wave_sum(ss);
            const float r = rsqrtf(ss * (1.0f / 1024.0f) + 1e-6f);
#pragma unroll
            for (int e = 0; e < 16; ++e) acc[e] = acc[e] * r * gg[e] * (1.0f + sc[e]) + sh[e];
            row_store_bf16(H + (size_t)g * 1024, lane, acc);
        }
    }
}


constexpr int AT2_STAGE = 64 * 104 * 2 + 64 * 72 * 2;
constexpr int AT2_BIAS = 2 * AT2_STAGE;
constexpr int ATT2_LDS = 2 * AT2_STAGE + 2048;
template <class P>
DI void attn_unit2(const P& pol, char* smem) {
    constexpr int DQK = P::DQK, KS = DQK + 8, VS = 72, NS = DQK / 32;
    const int tid = TIDX(), lane = tid & 63, w = tid >> 6, l15 = lane & 15, quad = lane >> 4;
    __syncthreads();
    pol.prologue(smem + AT2_BIAS);
    bf16x8 qf[2][NS];
#pragma unroll
    for (int qg = 0; qg < 2; ++qg)
#pragma unroll
        for (int s = 0; s < NS; ++s) qf[qg][s] = *(const bf16x8*)pol.qptr(32 * w + 16 * qg + l15, s * 4 + quad);
    f32x4 o[2][4];
#pragma unroll
    for (int qg = 0; qg < 2; ++qg)
#pragma unroll
        for (int u = 0; u < 4; ++u) o[qg][u] = (f32x4){0.f, 0.f, 0.f, 0.f};
    float m[2] = {-1e30f, -1e30f}, l[2] = {0.f, 0.f};
    const int k0key = (DQK == 64) ? (tid >> 3) : (tid / 12), k0ch = (DQK == 64) ? (tid & 7) : (tid % 12);
    const int k1key = (tid + 512) / 12, k1ch = (tid + 512) % 12;
    const bool k1on = (DQK == 96) && (tid < 256);
    const int vkey = tid >> 3, vch = tid & 7;
    const int nt = pol.ntiles();
    u32x4 rk0, rk1 = (u32x4){0u, 0u, 0u, 0u}, rv;
    rk0 = *(const u32x4*)pol.kptr(0, k0key, k0ch);
    if (k1on) rk1 = *(const u32x4*)pol.kptr(0, k1key, k1ch);
    rv = *(const u32x4*)pol.vptr(0, vkey, vch);
    {
        bf16_t* Ks = (bf16_t*)smem; bf16_t* Vs = (bf16_t*)(smem + 64 * 104 * 2);
        *(u32x4*)(Ks + k0key * KS + k0ch * 8) = rk0;
        if (k1on) *(u32x4*)(Ks + k1key * KS + k1ch * 8) = rk1;
        *(u32x4*)(Vs + vkey * VS + vch * 8) = rv;
    }
    __syncthreads();
    for (int j = 0; j < nt; ++j) {
        const bool more = (j + 1 < nt);
        if (more) {
            rk0 = *(const u32x4*)pol.kptr(j + 1, k0key, k0ch);
            if (k1on) rk1 = *(const u32x4*)pol.kptr(j + 1, k1key, k1ch);
            rv = *(const u32x4*)pol.vptr(j + 1, vkey, vch);
        }
        const bf16_t* Ks = (const bf16_t*)(smem + (j & 1) * AT2_STAGE);
        const bf16_t* Vs = (const bf16_t*)(smem + (j & 1) * AT2_STAGE + 64 * 104 * 2);
        if (pol.needed(j, w)) {
            f32x4 sc[2][2][2];
            __builtin_amdgcn_s_setprio(1);
#pragma unroll
            for (int g = 0; g < 2; ++g)
#pragma unroll
                for (int t = 0; t < 2; ++t) {
                    f32x4 a0 = (f32x4){0.f, 0.f, 0.f, 0.f}, a1 = a0;
                    const int key = 32 * g + 8 * (l15 >> 2) + 4 * t + (l15 & 3);
#pragma unroll
                    for (int s = 0; s < NS; ++s) {
                        const bf16x8 kf = *(const bf16x8*)(Ks + key * KS + 32 * s + 8 * quad);
                        a0 = __builtin_amdgcn_mfma_f32_16x16x32_bf16(kf, qf[0][s], a0, 0, 0, 0);
                        a1 = __builtin_amdgcn_mfma_f32_16x16x32_bf16(kf, qf[1][s], a1, 0, 0, 0);
                    }
                    sc[0][g][t] = a0; sc[1][g][t] = a1;
                    if (t == 1) __builtin_amdgcn_sched_barrier(0);
                }
            __builtin_amdgcn_s_setprio(0);
            asm volatile("" ::: "memory");
            const bool plain = pol.plain(j);
            bf16x8 pf[2][2];
#pragma unroll
            for (int qg = 0; qg < 2; ++qg) {
                if (P::CANFIX && pol.fixed) {
                    if (!plain) {
#pragma unroll
                        for (int g = 0; g < 2; ++g)
#pragma unroll
                            for (int t = 0; t < 2; ++t)
#pragma unroll
                                for (int r = 0; r < 4; ++r) sc[qg][g][t][r] = pol.mod(sc[qg][g][t][r], 32 * w + 16 * qg + l15, j, 32 * g + 8 * quad + 4 * t + r);
                    }
                    const float c2f = plain ? pol.c2 : 1.0f;
                    float ps = 0.f;
#pragma unroll
                    for (int g = 0; g < 2; ++g) {
                        float pv[8];
#pragma unroll
                        for (int t = 0; t < 2; ++t)
#pragma unroll
                            for (int r = 0; r < 4; ++r) { const float e = fexp2(sc[qg][g][t][r] * c2f - pol.mfix); ps += e; pv[4 * t + r] = e; }
                        pf[qg][g] = __builtin_bit_cast(bf16x8, pack8(pv));
                    }
                    l[qg] += ps; m[qg] = pol.mfix;
                } else {
                float tmax = -3.0e38f;
                if (!plain) {
#pragma unroll
                    for (int g = 0; g < 2; ++g)
#pragma unroll
                        for (int t = 0; t < 2; ++t)
#pragma unroll
                            for (int r = 0; r < 4; ++r) sc[qg][g][t][r] = pol.mod(sc[qg][g][t][r], 32 * w + 16 * qg + l15, j, 32 * g + 8 * quad + 4 * t + r);
                }
#pragma unroll
                for (int g = 0; g < 2; ++g)
#pragma unroll
                    for (int t = 0; t < 2; ++t) tmax = fmaxf(fmaxf(tmax, fmaxf(sc[qg][g][t][0], sc[qg][g][t][1])), fmaxf(sc[qg][g][t][2], sc[qg][g][t][3]));
                tmax = quad_max(tmax);
                const float c2 = plain ? pol.c2 : 1.0f;
                const float mn = fmaxf(m[qg], tmax * c2);
                const float alpha = fexp2(m[qg] - mn);
                m[qg] = mn;
                float ps = 0.f;
#pragma unroll
                for (int g = 0; g < 2; ++g) {
                    float pv[8];
#pragma unroll
                    for (int t = 0; t < 2; ++t)
#pragma unroll
                        for (int r = 0; r < 4; ++r) { const float e = fexp2(sc[qg][g][t][r] * c2 - mn); ps += e; pv[4 * t + r] = e; }
                    pf[qg][g] = __builtin_bit_cast(bf16x8, pack8(pv));
                }
                l[qg] = l[qg] * alpha + ps;
                if (__any(alpha != 1.0f)) {
#pragma unroll
                    for (int u = 0; u < 4; ++u) o[qg][u] *= alpha;
                }
                }
            }
            asm volatile("" ::: "memory");
            __builtin_amdgcn_s_setprio(1);
#pragma unroll
            for (int u = 0; u < 4; ++u)
#pragma unroll
                for (int g = 0; g < 2; ++g) {
                    const bf16_t* vb = Vs + (32 * g + 8 * quad + (l15 >> 2)) * VS + 16 * u + 4 * (l15 & 3);
                    const s16x4 lo = tr_read(vb), hi = tr_read(vb + 4 * VS);
                    bf16x8 vf; vf[0] = lo[0]; vf[1] = lo[1]; vf[2] = lo[2]; vf[3] = lo[3]; vf[4] = hi[0]; vf[5] = hi[1]; vf[6] = hi[2]; vf[7] = hi[3];
                    o[0][u] = __builtin_amdgcn_mfma_f32_16x16x32_bf16(vf, pf[0][g], o[0][u], 0, 0, 0);
                    o[1][u] = __builtin_amdgcn_mfma_f32_16x16x32_bf16(vf, pf[1][g], o[1][u], 0, 0, 0);
                }
            __builtin_amdgcn_s_setprio(0);
            asm volatile("" ::: "memory");
        }
        if (more) {
            bf16_t* Kn = (bf16_t*)(smem + ((j + 1) & 1) * AT2_STAGE); bf16_t* Vn = (bf16_t*)(smem + ((j + 1) & 1) * AT2_STAGE + 64 * 104 * 2);
            *(u32x4*)(Kn + k0key * KS + k0ch * 8) = rk0;
            if (k1on) *(u32x4*)(Kn + k1key * KS + k1ch * 8) = rk1;
            *(u32x4*)(Vn + vkey * VS + vch * 8) = rv;
        }
        __syncthreads();
    }
#pragma unroll
    for (int qg = 0; qg < 2; ++qg) {
        float lt = l[qg];
        lt = quad_sum(lt);
        if (P::SINK) lt += fexp2(pol.sink2 - m[qg]);
        const float il = 1.0f / lt;
        bf16_t* op = pol.optr(32 * w + 16 * qg + l15);
#pragma unroll
        for (int u = 0; u < 4; ++u) st_bf16x4(op + 16 * u + 4 * quad, o[qg][u] * il);
    }
}

struct Pol2Plain64 {
    static constexpr int DQK = 64; static constexpr bool SINK = false; static constexpr bool CANFIX = true;
    const bf16_t* Qb; long qs; const bf16_t* Kb; long ks; const bf16_t* Vb; long vs; bf16_t* Ob; long os; int qrow0, krow0, nt; float c2, sink2, mfix; bool fixed;
    DI void prologue(char*) const {}
    DI int ntiles() const { return nt; }
    DI bool needed(int, int) const { return true; }
    DI bool plain(int) const { return true; }
    DI const bf16_t* qptr(int q, int ch) const { return Qb + (long)(qrow0 + q) * qs + ch * 8; }
    DI const bf16_t* kptr(int j, int i, int ch) const { return Kb + (long)(krow0 + 64 * j + i) * ks + ch * 8; }
    DI const bf16_t* vptr(int j, int i, int ch) const { return Vb + (long)(krow0 + 64 * j + i) * vs + ch * 8; }
    DI float mod(float s, int, int, int) const { return s * c2; }
    DI bf16_t* optr(int q) const { return Ob + (long)(qrow0 + q) * os; }
};
struct Pol2NA {
    static constexpr int DQK = 64; static constexpr bool SINK = false; static constexpr bool CANFIX = true;
    const bf16_t* QKV; bf16_t* AO; const float* rpb; const float* bl; int b, h, rq, rbase; float c2, sink2, mfix; bool fixed;
    DI void prologue(char* s) const { float* t = (float*)s; for (int i = TIDX(); i < 465; i += NTHR) t[i] = rpb[h * 465 + i] * LOG2E; }
    DI int ntiles() const { return 15; }
    DI bool plain(int j) const { return j < 4; }
    DI bool needed(int j, int w) const {
        if (j < 4) return true;
        const int kr = rbase + j - 4, qr = 4 * rq + (w >> 1);
        int r0 = qr - 4; r0 = r0 < 0 ? 0 : (r0 > 56 ? 56 : r0);
        return (kr >= r0) && (kr <= r0 + 7);
    }
    DI int qtok(int q) const { return b * 4096 + (4 * rq + (q >> 6)) * 64 + (q & 63); }
    DI int ktok(int j, int i) const { if (j < 4) return TL + b * 256 + 64 * j + i; int kr = rbase + j - 4; kr = kr > 63 ? 63 : kr; return b * 4096 + kr * 64 + i; }
    DI const bf16_t* qptr(int q, int ch) const { return QKV + (long)qtok(q) * 3072 + h * 64 + ch * 8; }
    DI const bf16_t* kptr(int j, int i, int ch) const { return QKV + (long)ktok(j, i) * 3072 + 1024 + h * 64 + ch * 8; }
    DI const bf16_t* vptr(int j, int i, int ch) const { return QKV + (long)ktok(j, i) * 3072 + 2048 + h * 64 + ch * 8; }
    DI float mod(float s, int q, int j, int kc) const {
        const int kr = rbase + j - 4, qr = 4 * rq + (q >> 6), qc = q & 63;
        int c0 = qc - 8; c0 = c0 < 0 ? 0 : (c0 > 48 ? 48 : c0);
        const bool ok = (kc >= c0) && (kc < c0 + 16);
        const int idx = ok ? ((kr - qr + 7) * 31 + (kc - qc + 15)) : 0;
        return ok ? (s * c2 + bl[idx]) : -1e30f;
    }
    DI bf16_t* optr(int q) const { return AO + (long)qtok(q) * 1024 + h * 64; }
};
struct Pol2MLA {
    static constexpr int DQK = 96; static constexpr bool SINK = false; static constexpr bool CANFIX = true;
    const bf16_t* Q; const bf16_t* KV; const bf16_t* KR; bf16_t* AO; int b, h, qrow0, nt; float c2, sink2, mfix; bool fixed;
    DI void prologue(char*) const {}
    DI int ntiles() const { return nt; }
    DI bool needed(int, int) const { return true; }
    DI bool plain(int) const { return true; }
    DI int ktok(int j, int i) const { return (j < 4) ? (TL + b * 256 + 64 * j + i) : (b * 4096 + 64 * (j - 4) + i); }
    DI const bf16_t* qptr(int q, int ch) const { return Q + (long)(qrow0 + q) * 1536 + h * 96 + ch * 8; }
    DI const bf16_t* kptr(int j, int i, int ch) const { const long t = ktok(j, i); return (ch < 8) ? (KV + t * 2048 + h * 128 + ch * 8) : (KR + t * 32 + (ch - 8) * 8); }
    DI const bf16_t* vptr(int j, int i, int ch) const { return KV + (long)ktok(j, i) * 2048 + h * 128 + 64 + ch * 8; }
    DI float mod(float s, int, int, int) const { return s * c2; }
    DI bf16_t* optr(int q) const { return AO + (long)(qrow0 + q) * 1024 + h * 64; }
};
struct Pol2SWA {
    static constexpr int DQK = 64; static constexpr bool SINK = true; static constexpr bool CANFIX = true;
    const bf16_t* QKV; bf16_t* AO; int b, hq, s0; float c2, sink2, mfix; bool fixed;
    DI void prologue(char*) const {}
    DI int ntiles() const { return 12; }
    DI bool plain(int j) const { return j < 4; }
    DI bool needed(int j, int w) const { if (j < 4) return true; const int jj = j - 4; return (64 * jj + 63 >= 32 * w) && (64 * jj <= 32 * w + 287); }
    DI int ktok(int j, int i) const { if (j < 4) return TL + b * 256 + 64 * j + i; int kp = s0 - 128 + 64 * (j - 4) + i; kp = kp < 0 ? 0 : (kp > 4095 ? 4095 : kp); return b * 4096 + kp; }
    DI const bf16_t* qptr(int q, int ch) const { return QKV + (long)(b * 4096 + s0 + q) * 1536 + hq * 64 + ch * 8; }
    DI const bf16_t* kptr(int j, int i, int ch) const { return QKV + (long)ktok(j, i) * 1536 + 1024 + (hq >> 2) * 64 + ch * 8; }
    DI const bf16_t* vptr(int j, int i, int ch) const { return QKV + (long)ktok(j, i) * 1536 + 1280 + (hq >> 2) * 64 + ch * 8; }
    DI float mod(float s, int q, int j, int kc) const {
        const int kp = s0 - 128 + 64 * (j - 4) + kc, d = s0 + q - kp;
        const bool ok = (kp >= 0) && (kp < 4096) && (d <= 128) && (d >= -128);
        return ok ? s * c2 : -1e30f;
    }
    DI bf16_t* optr(int q) const { return AO + (long)(b * 4096 + s0 + q) * 1024 + hq * 64; }
};
DI int attn_unit_xcd(int i, int units_per_pair  , bool ctx_units) {
    if (gridDim.x != 256) { const int u = i * (int)gridDim.x + (int)blockIdx.x; return (u < 2048 + (ctx_units ? 128 : 0)) ? u : -1; }
    const int x = blockIdx.x & 7, Lx = i * 32 + ((int)blockIdx.x >> 3);
    if (Lx < 256) return (16 * x + (Lx >> 4)) * 16 + (Lx & 15);
    if (ctx_units && Lx < 272) return 2048 + 16 * x + (Lx - 256);
    return -1;
}
DI float head64_score_bound(const float* qg, const float* kg) {
    float a = 0.f, b = 0.f;
    for (int i = 0; i < 64; ++i) { a = fmaxf(a, fabsf(qg[i])); b = fmaxf(b, fabsf(kg[i])); }
    return 1.02f * 0.125f * LOG2E * 64.0f * a * b;
}
DI void phase_attn2_na(const Params& p, const bf16_t* QKV, bf16_t* AO, char* smem) {
    float bmax = 0.f;
    {
        float* red = (float*)smem;
        float v = 0.f;
        for (int i = TIDX(); i < 16 * 465; i += NTHR) v = fmaxf(v, fabsf(p.in[I_NA_RPB][i]));
        __syncthreads();
        red[TIDX()] = v;
        __syncthreads();
        for (int i = 0; i < NTHR; ++i) bmax = fmaxf(bmax, red[i]);
        __syncthreads();
    }
    const float sb = head64_score_bound(p.in[I_NA_QG], p.in[I_NA_KG]);
    const float mfix_l = sb + bmax * LOG2E, mfix_c = sb;
    const bool fixed = mfix_l < 60.0f;
    for (int it = 0;; ++it) {
        const int u = attn_unit_xcd(it, 16, true); if (u < 0) break;
        if (u < 2048) {
            Pol2NA pol; pol.QKV = QKV; pol.AO = AO; pol.rpb = p.in[I_NA_RPB]; pol.bl = (const float*)(smem + AT2_BIAS);
            pol.b = u >> 8; pol.h = (u >> 4) & 15; pol.rq = u & 15;
            int rb = 4 * pol.rq - 4; rb = rb < 0 ? 0 : (rb > 56 ? 56 : rb); pol.rbase = rb;
            pol.c2 = 0.125f * LOG2E; pol.sink2 = 0.f; pol.mfix = mfix_l; pol.fixed = fixed;
            attn_unit2(pol, smem);
        } else {
            const int v = u - 2048, b = v >> 4, h = v & 15;
            Pol2Plain64 pol; pol.Qb = QKV + h * 64; pol.qs = 3072; pol.Kb = QKV + 1024 + h * 64; pol.ks = 3072; pol.Vb = QKV + 2048 + h * 64; pol.vs = 3072;
            pol.Ob = AO + h * 64; pol.os = 1024; pol.qrow0 = TL + b * 256; pol.krow0 = TL + b * 256; pol.nt = 4; pol.c2 = 0.125f * LOG2E; pol.sink2 = 0.f; pol.mfix = mfix_c; pol.fixed = fixed;
            attn_unit2(pol, smem);
        }
    }
}
DI void phase_attn2_mla(const Params& p, const bf16_t* Q, const bf16_t* KV, const bf16_t* KR, bf16_t* AO, char* smem) {
    float gq = 0.f, gqr = 0.f, gk = 0.f, gkr = 0.f;
    for (int i = 0; i < 64; ++i) { gq = fmaxf(gq, fabsf(p.in[I_MLA_QN_G][i])); gk = fmaxf(gk, fabsf(p.in[I_MLA_KN_G][i])); }
    for (int i = 0; i < 32; ++i) { gqr = fmaxf(gqr, fabsf(p.in[I_MLA_QR_G][i])); gkr = fmaxf(gkr, fabsf(p.in[I_MLA_KR_G][i])); }
    const float mfix = 1.02f * 0.10206207261596575f * LOG2E * sqrtf(64.f * gq * gq + 32.f * gqr * gqr) * sqrtf(64.f * gk * gk + 32.f * gkr * gkr);
    const bool fixed = mfix < 60.0f;
    for (int it = 0;; ++it) {
        const int u = attn_unit_xcd(it, 16, true); if (u < 0) break;
        Pol2MLA pol; pol.Q = Q; pol.KV = KV; pol.KR = KR; pol.AO = AO; pol.c2 = 0.10206207261596575f * LOG2E; pol.sink2 = 0.f;
        pol.mfix = mfix; pol.fixed = fixed;
        if (u < 2048) { pol.b = u >> 8; pol.h = (u >> 4) & 15; pol.qrow0 = pol.b * 4096 + 256 * (u & 15); pol.nt = 68; }
        else { const int v = u - 2048; pol.b = v >> 4; pol.h = v & 15; pol.qrow0 = TL + pol.b * 256; pol.nt = 4; }
        attn_unit2(pol, smem);
    }
}
DI void phase_attn2_swa(const Params& p, const bf16_t* QKV, bf16_t* AO, char* smem) {
    const float mfix = head64_score_bound(p.in[I_SWA_QG], p.in[I_SWA_KG]);
    const bool fixed = mfix < 60.0f;
    for (int it = 0;; ++it) {
        const int u = attn_unit_xcd(it, 16, false); if (u < 0) break;
        Pol2SWA pol; pol.QKV = QKV; pol.AO = AO; pol.b = u >> 8; pol.hq = (u >> 4) & 15; pol.s0 = 256 * (u & 15);
        pol.c2 = 0.125f * LOG2E; pol.sink2 = p.in[I_SWA_SINK][pol.hq] * LOG2E; pol.mfix = mfix; pol.fixed = fixed;
        attn_unit2(pol, smem);
    }
}

template <class Epi>
DI void pg8_gemm(const bf16_t* A, const bf16_t* Bt, int M, int N, int K, const Epi& e, char* smem) {
    pg8::Gemm g; g.A = A; g.Bt = Bt; g.M = M; g.N = N; g.K = K;
    pg8::StaticOrder S; S.init(M, N, (int)gridDim.x, (int)blockIdx.x);
    pg8::gemm_phase<Epi, pg8::StaticOrder, false>((LAS unsigned char*)smem, g, S, e, nullptr);
}

DI void phase_attn_na(const Params& p, const bf16_t* QKV, bf16_t* AO, char* smem) {
    for (int u = blockIdx.x; u < 4096 + 256; u += gridDim.x) {
        if (u < 4096) {
            PolNA pol; pol.QKV = QKV; pol.AO = AO; pol.rpb = p.in[I_NA_RPB]; pol.bl = (const float*)(smem + 64 * 104 * 2 + 64 * 72 * 2);
            pol.b = u >> 9; pol.h = (u >> 5) & 15; pol.rr = u & 31;
            int rb = 2 * pol.rr - 4; rb = rb < 0 ? 0 : (rb > 56 ? 56 : rb); pol.rbase = rb;
            pol.c2 = 0.125f * LOG2E; pol.sink2 = 0.f;
            attn_unit(pol, smem);
        } else {
            const int v = u - 4096, b = v >> 5, h = (v >> 1) & 15, half = v & 1;
            PolPlain64 pol; pol.Qb = QKV + h * 64; pol.qs = 3072; pol.Kb = QKV + 1024 + h * 64; pol.ks = 3072; pol.Vb = QKV + 2048 + h * 64; pol.vs = 3072;
            pol.Ob = AO + h * 64; pol.os = 1024; pol.qrow0 = TL + b * 256 + 128 * half; pol.krow0 = TL + b * 256; pol.nt = 4; pol.c2 = 0.125f * LOG2E; pol.sink2 = 0.f;
            attn_unit(pol, smem);
        }
    }
}
DI void phase_attn_mla(const bf16_t* Q, const bf16_t* KV, const bf16_t* KR, bf16_t* AO, char* smem) {
    for (int u = blockIdx.x; u < 4096 + 256; u += gridDim.x) {
        PolMLA pol; pol.Q = Q; pol.KV = KV; pol.KR = KR; pol.AO = AO; pol.c2 = 0.10206207261596575f * LOG2E; pol.sink2 = 0.f;
        if (u < 4096) { pol.b = u >> 9; pol.h = (u >> 5) & 15; pol.qrow0 = pol.b * 4096 + 128 * (u & 31); pol.nt = 68; }
        else { const int v = u - 4096; pol.b = v >> 5; pol.h = (v >> 1) & 15; pol.qrow0 = TL + pol.b * 256 + 128 * (v & 1); pol.nt = 4; }
        attn_unit(pol, smem);
    }
}
DI void phase_attn_swa(const Params& p, const bf16_t* QKV, bf16_t* AO, char* smem) {
    for (int u = blockIdx.x; u < 4096; u += gridDim.x) {
        PolSWA pol; pol.QKV = QKV; pol.AO = AO; pol.b = u >> 9; pol.hq = (u >> 5) & 15; pol.s0 = 128 * (u & 31);
        pol.c2 = 0.125f * LOG2E; pol.sink2 = p.in[I_SWA_SINK][pol.hq] * LOG2E;
        attn_unit(pol, smem);
    }
}


DI void wo_phase(const Params& p, const Bufs& B, int layer, const bf16_t* A, const bf16_t* Wt, char* smem) {
    const float* gate = B.MOD + (size_t)layer * 9 * 6144 + 2 * 1024;
    pg8::PEpiResidual e; e.X = B.X; e.gate = gate;
    e.Xl = (layer == 0) ? p.in[I_X] : B.X; e.Xc = (layer == 0) ? p.in[I_CTX] : (B.X + (size_t)TL * 1024);
    pg8_gemm(A, Wt, TL, 1024, 1024, e, smem);
    __syncthreads();
    GemmOp g; g.A = A + (size_t)TL * 1024; g.lda = 1024; g.Bt = Wt; g.ldb = 1024; g.kbeg = 0; g.kend = 1024;
    EpiResidualCtx ec; ec.Xout = B.X + (size_t)TL * 1024; ec.Xin = (layer == 0) ? p.in[I_CTX] : (B.X + (size_t)TL * 1024); ec.gate = gate + (size_t)8 * 6144;
    gemm_all(g, TC, 1024, ec, smem);
}

constexpr int N_PHASES = 44;
constexpr int LDS_BYTES = 131072;
static_assert(GT_LDS <= LDS_BYTES && SCAN_LDS <= LDS_BYTES && ATT_LDS <= LDS_BYTES && TOPK_LDS <= LDS_BYTES && 65536 <= LDS_BYTES, "lds");

template <int SUB>
DI void moe_phase(const Params& p, const Bufs& B, int layer, char* smem) {
    const bool has_ctx = layer < 3;
    const int ntok = has_ctx ? TT : TL;
    bf16_t* H = B.slot(0); bf16_t* XIN = B.slot(1); bf16_t* HID = B.slot(3); bf16_t* Y = B.slot(1);
    if constexpr (SUB == 0) phase_norm2(p, B, layer, H, ntok, smem);
    else if constexpr (SUB == 1) phase_topk(B, H, XIN, has_ctx, smem);
    else if constexpr (SUB == 2) {
        phase_moe_gemm1(B, XIN, HID, has_ctx, smem);
        if (USE_PG8 && layer < 3) {
            const bool split = (gridDim.x == 256);
            const int li = (int)blockIdx.x >> 3;
            if (!split || li >= 16) { __syncthreads(); int base = 0; conv_moe_layer(p, B, layer + 1, base, smem, 2, split ? (li - 16) * 8 + ((int)blockIdx.x & 7) : -1, split ? 128 : 0); }
        }
    }
    else if constexpr (SUB == 3) {
        phase_moe_gemm2(B, HID, Y, has_ctx, smem, layer);
        if (USE_PG8 && layer < 3) {
            const bool split = (gridDim.x == 256);
            const int li = (int)blockIdx.x >> 3;
            if (!split || li >= 8) { __syncthreads(); int base = 0; conv_moe_layer(p, B, layer + 1, base, smem, 1, split ? (li - 8) * 8 + ((int)blockIdx.x & 7) : -1, split ? 192 : 0); }
        }
    }
    else { phase_combine(p, B, layer, Y, ntok, layer == 3, layer == 1 || layer == 2, H); if (!USE_PG8 && layer < 3) { int base = 0; conv_moe_layer(p, B, layer + 1, base, smem, 0); } }
}

template <int PH>
DI void run_phase(const Params& p, char* smem) {
    const Bufs B = make_bufs(p);
    bf16_t* H = B.slot(0);
    if constexpr (PH == 0) phase_prologue(p, B, smem);
    else if constexpr (PH == 1) phase_norm1(p, B, 0, H);
    else if constexpr (PH == 2) { pg8::PEpiQKNorm e; e.O = B.slot(1); e.ldo = 3072; e.nq = 4; e.nk = 8; e.qg = p.in[I_NA_QG]; e.kg = p.in[I_NA_KG]; e.rope = nullptr; pg8_gemm(H, B.WMIX + W_NA_QKV, TT, 3072, 1024, e, smem); }
    else if constexpr (PH == 3) {   }
    else if constexpr (PH == 4) phase_attn2_na(p, B.slot(1), B.slot(4), smem);
    else if constexpr (PH == 5) wo_phase(p, B, 0, B.slot(4), B.WMIX + W_NA_WO, smem);
    else if constexpr (PH >= 6 && PH <= 10) moe_phase<PH - 6>(p, B, 0, smem);
    else if constexpr (PH == 11) phase_norm1_rw(p, B, 1, B.slot(0));
    else if constexpr (PH == 12) { pg8::PEpiRW1 e; e.RKV = B.slot(2); e.LORA = B.slot(5); pg8_gemm(B.slot(0), B.WMIX + W_RW_B1, TT, 3584, 2048, e, smem); }
    else if constexpr (PH == 13) phase_rw_gemm2(p, B, B.slot(5), B.slot(0), B.slot(1), B.slot(6), B.slot(7), B.slot(8), smem);
    else if constexpr (PH == 14) {
#if USE_SCAN2
        phase_rw_scan2(p, B.slot(2), B.slot(1), B.slot(6), B.slot(7), B.slot(8), B.slot(9), B.slot(5), smem);
#else
        phase_rw_scan(p, B.slot(2), B.slot(1), B.slot(6), B.slot(7), B.slot(8), B.slot(9), B.slot(5), smem);
#endif
    }
    else if constexpr (PH == 15) phase_rw_readout(p, B.slot(2), B.slot(7), B.slot(8), B.slot(0), B.slot(9), B.slot(5), B.slot(1));
    else if constexpr (PH == 16) wo_phase(p, B, 1, B.slot(1), B.WMIX + W_RW_WO, smem);
    else if constexpr (PH >= 17 && PH <= 21) moe_phase<PH - 17>(p, B, 1, smem);
    else if constexpr (PH == 22) {   }
    else if constexpr (PH == 23) { pg8::PEpiBf16 e; e.O = B.slot(1); e.ldo = 768; pg8_gemm(H, B.WMIX + W_MLA_DOWN, TT, 768, 1024, e, smem); }
    else if constexpr (PH == 24) { bf16_t* CQ = B.slot(3); phase_mla_dnorm(p, B, B.slot(1), CQ, CQ + (size_t)TT * 384, CQ + (size_t)TT * 640); }
    else if constexpr (PH == 25) {
        bf16_t* CQ = B.slot(3);
        { pg8::PEpiBf16 e; e.O = B.slot(4); e.ldo = 1536; pg8_gemm(CQ, B.WMIX + W_MLA_UQ, TT, 1536, 384, e, smem); }
        { pg8::PEpiBf16 e; e.O = B.slot(6); e.ldo = 2048; pg8_gemm(CQ + (size_t)TT * 384, B.WMIX + W_MLA_UKV, TT, 2048, 256, e, smem); }
    }
    else if constexpr (PH == 26) phase_mla_hnorm(p, B, B.slot(4), B.slot(6));
    else if constexpr (PH == 27) phase_attn2_mla(p, B.slot(4), B.slot(6), B.slot(3) + (size_t)TT * 640, B.slot(8), smem);
    else if constexpr (PH == 28) wo_phase(p, B, 2, B.slot(8), B.WMIX + W_MLA_WO, smem);
    else if constexpr (PH >= 29 && PH <= 33) moe_phase<PH - 29>(p, B, 2, smem);
    else if constexpr (PH == 34) {   }
    else if constexpr (PH == 35) { pg8::PEpiQKNorm e; e.O = B.slot(1); e.ldo = 1536; e.nq = 4; e.nk = 5; e.qg = p.in[I_SWA_QG]; e.kg = p.in[I_SWA_KG]; e.rope = B.ROPE_S; pg8_gemm(H, B.WMIX + W_SWA_QKV, TT, 1536, 1024, e, smem); }
    else if constexpr (PH == 36) {   }
    else if constexpr (PH == 37) phase_attn2_swa(p, B.slot(1), B.slot(3), smem);
    else if constexpr (PH == 38) { pg8::PEpiResidual e; e.X = B.X; e.Xl = B.X; e.Xc = B.X + (size_t)TL * 1024; e.gate = B.MOD + (size_t)3 * 9 * 6144 + 2 * 1024; pg8_gemm(B.slot(3), B.WMIX + W_SWA_WO, TL, 1024, 1024, e, smem); }
    else if constexpr (PH >= 39 && PH <= 43) moe_phase<PH - 39>(p, B, 3, smem);
}

#define XB_TMO      128
#define XB_XCNT(j)  (256  + 64 * (j))
#define XB_XSUB(j)  (1280 + 64 * (j))
#define XB_XGEN(j)  (2304 + 64 * (j))
#define XB_TOP      3328
#define XB_TOPGEN   3392
#define XCD_BAR_WORDS 3456
#define XB_SPIN_CAP (1u << 18)

__device__ __forceinline__ unsigned xb_ld(unsigned* p)              { return __hip_atomic_load(p, __ATOMIC_RELAXED, __HIP_MEMORY_SCOPE_AGENT); }
__device__ __forceinline__ unsigned xb_add(unsigned* p, unsigned v) { return __hip_atomic_fetch_add(p, v, __ATOMIC_RELAXED, __HIP_MEMORY_SCOPE_AGENT); }
__device__ __forceinline__ unsigned xb_xcc_id() { return (unsigned)__builtin_amdgcn_s_getreg((3 << 11) | 20) & 0xFu; }
#define XB_SPIN(cond, bar) do { unsigned _sp = 0; while (cond) { __builtin_amdgcn_s_sleep(1); \
    if ((++_sp & 255u) == 0u) { if (xb_ld(&(bar)[XB_TMO])) break; if (_sp > XB_SPIN_CAP) { atomicAdd(&(bar)[XB_TMO], 1u); break; } } } } while (0)

struct XcdBarrier {
    unsigned* bar; unsigned x;
    volatile LAS unsigned* st;
};

__device__ __forceinline__ XcdBarrier xcd_barrier_post(unsigned* bar, volatile LAS unsigned* st) {
    XcdBarrier b; b.bar = bar; b.x = xb_xcc_id(); b.st = st;
    if (TIDX() == 0) (void)xb_add(&bar[XB_XCNT(b.x)], 1u);
    return b;
}
__device__ __forceinline__ void xcd_barrier_complete(unsigned* bar, unsigned x, unsigned& nloc, unsigned& nx) {
    const unsigned G = gridDim.x * gridDim.y * gridDim.z;
    unsigned sum, cnt, mine, sp = 0u;
    for (;;) {
        sum = 0u; cnt = 0u; mine = 0u;
#pragma unroll
        for (unsigned j = 0; j < 16; ++j) { const unsigned c = xb_ld(&bar[XB_XCNT(j)]); sum += c; cnt += (c > 0u) ? 1u : 0u; mine = (j == x) ? c : mine; }
        if (sum == G) break;
        __builtin_amdgcn_s_sleep(1);
        if ((++sp & 255u) == 0u) { if (xb_ld(&bar[XB_TMO])) break; if (sp > XB_SPIN_CAP) { atomicAdd(&bar[XB_TMO], 1u); break; } }
    }
    nloc = mine > 0u ? mine : 1u; nx = cnt > 0u ? cnt : 1u;
}

__device__ __forceinline__ void xcd_barrier(const XcdBarrier& b) {
    asm volatile("s_waitcnt vmcnt(0)" ::: "memory");
    __syncthreads();
    if (TIDX() == 0) {
        unsigned* bar = b.bar;
        __builtin_amdgcn_s_waitcnt(0);
        unsigned nloc = b.st[0], nx = b.st[1];
        if (nloc == 0u) { xcd_barrier_complete(bar, b.x, nloc, nx); b.st[0] = nloc; b.st[1] = nx; }
        const unsigned old = xb_add(&bar[XB_XSUB(b.x)], 1u);
        const unsigned gen = old / nloc;
        if (old + 1u == (gen + 1u) * nloc) {
            __builtin_amdgcn_fence(__ATOMIC_RELEASE, "agent");
            asm volatile("s_waitcnt vmcnt(0)" ::: "memory");
            const unsigned og = xb_add(&bar[XB_TOP], 1u);
            const unsigned tg = og / nx;
            if (og + 1u == (tg + 1u) * nx) xb_add(&bar[XB_TOPGEN], 1u);
            else XB_SPIN(xb_ld(&bar[XB_TOPGEN]) == tg, bar);
            __builtin_amdgcn_fence(__ATOMIC_ACQUIRE, "agent");
            xb_add(&bar[XB_XGEN(b.x)], 1u);
            asm volatile("s_waitcnt vmcnt(0)" ::: "memory");
        } else {
            XB_SPIN(xb_ld(&bar[XB_XGEN(b.x)]) == gen, bar);
            __builtin_amdgcn_fence(__ATOMIC_ACQUIRE, "agent");
            asm volatile("s_waitcnt vmcnt(0)" ::: "memory");
        }
    }
    __syncthreads();
}

constexpr int LDS_REQ = 147456;

#if MULTI_LAUNCH
template <int PH>
__global__ void __launch_bounds__(NTHR, 2) k_phase(Params p) {
    extern __shared__ __attribute__((aligned(16))) char smem[];
    run_phase<PH>(p, smem);
}
template <int PH>
static void launch_from(const Params& p, int grid, hipStream_t stream, bool setattr) {
    if constexpr (PH < N_PHASES) {
        if (setattr) (void)hipFuncSetAttribute((const void*)k_phase<PH>, hipFuncAttributeMaxDynamicSharedMemorySize, LDS_REQ);
        else hipLaunchKernelGGL(k_phase<PH>, dim3(grid), dim3(NTHR), LDS_REQ, stream, p);
        launch_from<PH + 1>(p, grid, stream, setattr);
    }
}
#else
constexpr int LDS_PARAMS = LDS_BYTES + 64;
DI unsigned long long lds_u64_uniform(const char* lp, int i) {
    const u32x2 v = *(const u32x2*)(lp + 8 * i);
    const unsigned lo = __builtin_amdgcn_readfirstlane(v.x), hi = __builtin_amdgcn_readfirstlane(v.y);
    return ((unsigned long long)hi << 32) | lo;
}
DI Params load_params(const char* lp) {
    Params p;
#pragma unroll
    for (int i = 0; i < N_INPUTS; ++i) p.in[i] = (const float*)lds_u64_uniform(lp, i);
    p.out = (float*)lds_u64_uniform(lp, N_INPUTS); p.ws = (unsigned char*)lds_u64_uniform(lp, N_INPUTS + 1);
    return p;
}
#ifndef PH_LO
#define PH_LO 0
#define PH_HI N_PHASES
#endif
constexpr int dup_start(int ph) {
    if (PROBE == 1) { if (ph == 9) return 6; if (ph == 20) return 17; if (ph == 32) return 29; if (ph == 42) return 39; }
    if (PROBE == 2) { if (ph == 4) return 1; if (ph == 27) return 22; if (ph == 37) return 34; }
    if (PROBE == 3) { if (ph == 15) return 11; }
    if (PROBE == 4) { if (ph == 4) return 4; if (ph == 27) return 27; if (ph == 37) return 37; }
    if (PROBE == 5) { if (ph == 14) return 14; }
    if (PROBE == 7) { if (ph == 0) return 0; }
    if (PROBE == 8) { if (ph == 1 || ph == 11 || ph == 22 || ph == 34 || ph == 6 || ph == 17 || ph == 29 || ph == 39) return ph; }
    if (PROBE == 9) { if (ph == 9) return 8; if (ph == 20) return 19; if (ph == 32) return 31; if (ph == 42) return 41; }
    if (PROBE == 10) { if (ph == 2 || ph == 12 || ph == 13 || ph == 23 || ph == 25 || ph == 35) return ph; }
    return -1;
}
template <int A, int B>
DI void run_range(char* smem, const XcdBarrier& bar) {
    if constexpr (A <= B) { { const Params p = load_params(smem + LDS_PARAMS); run_phase<A>(p, smem); } xcd_barrier(bar); run_range<A + 1, B>(smem, bar); }
}
template <int PH>
DI void run_all(char* smem, const XcdBarrier& bar) {
    if constexpr (PH < N_PHASES) {
        constexpr bool empty = (PH == 22 || PH == 34 || PH == 3 || PH == 36);
        if constexpr (!empty && PH >= PH_LO && PH < PH_HI) { const Params p = load_params(smem + LDS_PARAMS); run_phase<PH>(p, smem); }
        if constexpr (!empty && PH + 1 < N_PHASES) xcd_barrier(bar);
        if constexpr (dup_start(PH) >= 0) run_range<dup_start(PH), PH>(smem, bar);
        run_all<PH + 1>(smem, bar);
    }
}
__global__ void __launch_bounds__(NTHR, 2) k_mega(Params p) {
    extern __shared__ __attribute__((aligned(16))) char smem[];
    if (TIDX() == 0) {
        *(u32x4*)(smem + LDS_BYTES) = (u32x4){0u, 0u, 0u, 0u};
        unsigned long long* lp = (unsigned long long*)(smem + LDS_PARAMS);
#pragma unroll
        for (int i = 0; i < N_INPUTS; ++i) lp[i] = (unsigned long long)p.in[i];
        lp[N_INPUTS] = (unsigned long long)p.out; lp[N_INPUTS + 1] = (unsigned long long)p.ws;
    }
    __syncthreads();
    const XcdBarrier bar = xcd_barrier_post((unsigned*)(p.ws + OFF_CTL), (volatile LAS unsigned*)(LAS char*)(smem + LDS_BYTES));
    run_all<0>(smem, bar);
}
#endif

extern "C" void kernel_launch(void* const* d_in, const int* in_sizes, int n_in, void* d_out, int out_size, void* d_ws, size_t ws_size, hipStream_t stream) {
    static int grid = 0;
    Params p{};
    for (int i = 0; i < N_INPUTS; ++i) p.in[i] = (const float*)d_in[i];
    p.out = (float*)d_out; p.ws = (unsigned char*)d_ws;
    if (grid == 0) {
        if (n_in != N_INPUTS || out_size != TL * 1024 || ws_size < WS_NEED) { grid = -1; return; }
        int dev = 0, cus = 0;
        if (hipGetDevice(&dev) != hipSuccess || hipDeviceGetAttribute(&cus, hipDeviceAttributeMultiprocessorCount, dev) != hipSuccess) { grid = -1; return; }
#if MULTI_LAUNCH
        launch_from<0>(p, 0, stream, true);
#else
        if (hipFuncSetAttribute((const void*)k_mega, hipFuncAttributeMaxDynamicSharedMemorySize, LDS_REQ) != hipSuccess) { grid = -1; return; }
#endif
        grid = cus > 0 ? cus : 256;
    }
    if (grid < 0) return;
    (void)hipMemsetAsync((char*)d_ws + OFF_CTL, 0, 65536, stream);
#if MULTI_LAUNCH
    launch_from<0>(p, grid, stream, false);
#else
    hipLaunchKernelGGL(k_mega, dim3(grid), dim3(NTHR), LDS_REQ, stream, p);
#endif
}
```

```cpp
#include <hip/hip_runtime.h>
#include <stdint.h>

#ifndef MULTI_LAUNCH
#define MULTI_LAUNCH 0
#endif
#ifndef USE_PG8
#define USE_PG8 1
#endif
#ifndef PROBE
#define PROBE 0
#endif
#ifndef USE_SCAN2
#define USE_SCAN2 1
#endif
#ifndef ATT_SCHED_FENCE
#define ATT_SCHED_FENCE 0
#endif
#ifndef GATHER_A
#define GATHER_A 1
#endif

typedef unsigned short bf16_t;
typedef short bf16x8 __attribute__((ext_vector_type(8)));
typedef short s16x4 __attribute__((ext_vector_type(4)));
typedef float f32x4 __attribute__((ext_vector_type(4)));
typedef unsigned u32x4 __attribute__((ext_vector_type(4)));
typedef unsigned u32x2 __attribute__((ext_vector_type(2)));
#define LAS __attribute__((address_space(3)))
#define DI __device__ __forceinline__
DI int TIDX() { int t = (int)threadIdx.x; asm volatile("" : "+v"(t)); return t; }

constexpr int NTHR = 512;
constexpr int D = 1024, NB = 8, SEQ = 4096, CTXL = 256;
constexpr int TL = NB * SEQ, TC = NB * CTXL, TT = TL + TC;
constexpr int NEXP = 16, CAPL = 512, CAPC = 32, EROWS = NB * CAPL + NB * CAPC;
constexpr float LOG2E = 1.4426950408889634f;

enum { I_X = 0, I_C, I_CTX, I_CCTX, I_N1G, I_N2G, I_ADAW, I_ADAB,
       I_NA_WQKV, I_NA_QG, I_NA_KG, I_NA_RPB, I_NA_WO,
       I_RW_MIX, I_RW_WR, I_RW_WK, I_RW_WV, I_RW_W0, I_RW_W1, I_RW_W2, I_RW_A0, I_RW_A1, I_RW_A2, I_RW_G1, I_RW_G2,
       I_RW_KK, I_RW_KA, I_RW_RK, I_RW_LNG, I_RW_LNB, I_RW_WO,
       I_MLA_WDOWN, I_MLA_QNG, I_MLA_KVNG, I_MLA_WUQ, I_MLA_WUKV, I_MLA_QN_G, I_MLA_QR_G, I_MLA_KN_G, I_MLA_KR_G, I_MLA_WO,
       I_SWA_WQKV, I_SWA_QG, I_SWA_KG, I_SWA_SINK, I_SWA_WO,
       I_MOE_ROUTER, I_MOE_W1, I_MOE_W3, I_MOE_W2, N_INPUTS };

constexpr size_t MiB = 1u << 20;
constexpr size_t OFF_CTL = 0;
constexpr size_t OFF_MOD = 65536;
constexpr size_t OFF_ROPE_M = OFF_MOD + 4 * 9 * 6144 * 4;
constexpr size_t OFF_ROPE_S = OFF_ROPE_M + 2 * 4096 * 16 * 4;
constexpr size_t OFF_X = 4 * MiB;
constexpr size_t OFF_WMIX = 140 * MiB;
constexpr size_t OFF_WE = 180 * MiB;
constexpr size_t OFF_MISC = 276 * MiB;
constexpr size_t OFF_WORK = 284 * MiB;
constexpr size_t USLOT = (size_t)TT * 1024 * 2;
constexpr size_t OFF_W2TB = OFF_WORK + 10 * USLOT;
constexpr size_t WS_NEED = OFF_W2TB + 32 * MiB;
static_assert(OFF_ROPE_S + 2 * 4096 * 32 * 4 <= OFF_X, "map");
static_assert(OFF_X + (size_t)TT * 1024 * 4 <= OFF_WMIX, "map");

constexpr size_t W_NA_QKV = 0, W_NA_WO = 3145728, W_RW_B1 = 4194304, W_RW_B2 = 11534336, W_RW_WO = 13500416,
                 W_MLA_DOWN = 14548992, W_MLA_UQ = 15335424, W_MLA_UKV = 15925248, W_MLA_WO = 16449536,
                 W_SWA_QKV = 17498112, W_SWA_WO = 19070976, W_MIX_END = 20119552;
static_assert(OFF_WMIX + W_MIX_END * 2 <= OFF_WE, "map");
static_assert(OFF_WE + 96 * MiB <= OFF_MISC, "map");
constexpr size_t OFF_AFF = OFF_MISC;
constexpr size_t OFF_AFFC = OFF_AFF + 8 * 16 * 4096 * 4;
constexpr size_t OFF_IDX = OFF_AFFC + 8 * 16 * 256 * 4;
constexpr size_t OFF_GATE = OFF_IDX + 16 * EROWS * 4;
constexpr size_t OFF_INV = OFF_GATE + 16 * EROWS * 4;
static_assert(OFF_INV + (size_t)TT * 16 * 4 <= OFF_WORK, "map");

struct Params {
    const float* in[N_INPUTS];
    float* out;
    unsigned char* ws;
};

DI unsigned f2bf(float f) { unsigned u = __float_as_uint(f); return (u + 0x7fffu + ((u >> 16) & 1u)) >> 16; }
typedef float f32x2_t __attribute__((ext_vector_type(2)));
typedef __bf16 bf16x2_t __attribute__((ext_vector_type(2)));
DI unsigned pk2(float lo, float hi) { const f32x2_t v = {lo, hi}; const bf16x2_t b = __builtin_convertvector(v, bf16x2_t); return __builtin_bit_cast(unsigned, b); }
DI float bf2f(unsigned b) { return __uint_as_float(b << 16); }
DI float bflo(unsigned w) { return __uint_as_float(w << 16); }
DI float bfhi(unsigned w) { return __uint_as_float(w & 0xffff0000u); }
DI float wave_sum(float v) {
    v += __shfl_xor(v, 32); v += __shfl_xor(v, 16); v += __shfl_xor(v, 8); v += __shfl_xor(v, 4); v += __shfl_xor(v, 2); v += __shfl_xor(v, 1); return v; }
DI float fsigmoid(float x) { return 1.0f / (1.0f + __expf(-x)); }
DI float fexp2(float x) { return __builtin_amdgcn_exp2f(x); }
DI int modrow_of(int g) { return g < TL ? (g >> 12) : 8; }
DI void unpack8(u32x4 v, float* f) { f[0] = bflo(v.x); f[1] = bfhi(v.x); f[2] = bflo(v.y); f[3] = bfhi(v.y); f[4] = bflo(v.z); f[5] = bfhi(v.z); f[6] = bflo(v.w); f[7] = bfhi(v.w); }
DI u32x4 pack8(const float* f) { u32x4 v; v.x = pk2(f[0], f[1]); v.y = pk2(f[2], f[3]); v.z = pk2(f[4], f[5]); v.w = pk2(f[6], f[7]); return v; }

struct GemmOp { const bf16_t* A; long lda; const bf16_t* Bt; long ldb; int kbeg, kend; };
constexpr int GT_LDS = 4 * 128 * 72 * 2;

template <class Epi>
DI void gemm_tile(const GemmOp& g, int row0, int col0, const Epi& epi, char* smem) {
    const int tid = TIDX(), lane = tid & 63, w = tid >> 6, wm = w >> 2, wn = w & 3, l15 = lane & 15, quad = lane >> 4;
    bf16_t* As = (bf16_t*)smem;
    bf16_t* Bs = As + 2 * 128 * 72;
    const int lr = tid >> 3, lc = (tid & 7) * 8;
    const bf16_t* ga0 = g.A + (long)(row0 + lr) * g.lda + g.kbeg + lc;
    const bf16_t* ga1 = ga0 + 64 * g.lda;
    const bf16_t* gb0 = g.Bt + (long)(col0 + lr) * g.ldb + g.kbeg + lc;
    const bf16_t* gb1 = gb0 + 64 * g.ldb;
    f32x4 acc[4][2];
#pragma unroll
    for (int i = 0; i < 4; ++i) { acc[i][0] = (f32x4){0.f, 0.f, 0.f, 0.f}; acc[i][1] = (f32x4){0.f, 0.f, 0.f, 0.f}; }
    u32x4 ra0 = *(const u32x4*)ga0, ra1 = *(const u32x4*)ga1, rb0 = *(const u32x4*)gb0, rb1 = *(const u32x4*)gb1;
    *(u32x4*)(As + lr * 72 + lc) = ra0; *(u32x4*)(As + (lr + 64) * 72 + lc) = ra1;
    *(u32x4*)(Bs + lr * 72 + lc) = rb0; *(u32x4*)(Bs + (lr + 64) * 72 + lc) = rb1;
    __syncthreads();
    const int nk = (g.kend - g.kbeg) >> 6;
    for (int kt = 0; kt < nk; ++kt) {
        const int cur = kt & 1;
        const bool more = (kt + 1 < nk);
        if (more) { const int ko = (kt + 1) * 64; ra0 = *(const u32x4*)(ga0 + ko); ra1 = *(const u32x4*)(ga1 + ko); rb0 = *(const u32x4*)(gb0 + ko); rb1 = *(const u32x4*)(gb1 + ko); }
        const bf16_t* a = As + cur * 128 * 72;
        const bf16_t* b = Bs + cur * 128 * 72;
#pragma unroll
        for (int ks = 0; ks < 2; ++ks) {
            bf16x8 af[4], bfr[2];
#pragma unroll
            for (int mt = 0; mt < 4; ++mt) af[mt] = *(const bf16x8*)(a + (wm * 64 + mt * 16 + l15) * 72 + ks * 32 + quad * 8);
#pragma unroll
            for (int nt = 0; nt < 2; ++nt) bfr[nt] = *(const bf16x8*)(b + (wn * 32 + nt * 16 + l15) * 72 + ks * 32 + quad * 8);
#pragma unroll
            for (int mt = 0; mt < 4; ++mt)
#pragma unroll
                for (int nt = 0; nt < 2; ++nt) acc[mt][nt] = __builtin_amdgcn_mfma_f32_16x16x32_bf16(bfr[nt], af[mt], acc[mt][nt], 0, 0, 0);
        }
        if (more) {
            bf16_t* a2 = As + (cur ^ 1) * 128 * 72; bf16_t* b2 = Bs + (cur ^ 1) * 128 * 72;
            *(u32x4*)(a2 + lr * 72 + lc) = ra0; *(u32x4*)(a2 + (lr + 64) * 72 + lc) = ra1;
            *(u32x4*)(b2 + lr * 72 + lc) = rb0; *(u32x4*)(b2 + (lr + 64) * 72 + lc) = rb1;
        }
        __syncthreads();
    }
#pragma unroll
    for (int mt = 0; mt < 4; ++mt) epi(row0 + wm * 64 + mt * 16 + l15, col0 + wn * 32 + quad * 4, acc[mt][0], acc[mt][1]);
}

template <class Epi>
DI void gemm_all(const GemmOp& g, int M, int N, const Epi& epi, char* smem) {
    const int ntn = N >> 7, nt = (M >> 7) * ntn;
    for (int t = blockIdx.x; t < nt; t += gridDim.x) gemm_tile(g, (t / ntn) * 128, (t % ntn) * 128, epi, smem);
}

DI void st_bf16x4(bf16_t* p, f32x4 a) { u32x2 v; v.x = pk2(a[0], a[1]); v.y = pk2(a[2], a[3]); *(u32x2*)p = v; }
struct EpiBf16 { bf16_t* O; long ldo;
    DI void operator()(int row, int col, f32x4 a0, f32x4 a1) const { bf16_t* p = O + (long)row * ldo + col; st_bf16x4(p, a0); st_bf16x4(p + 16, a1); } };
struct EpiF32 { float* O; long ldo;
    DI void operator()(int row, int col, f32x4 a0, f32x4 a1) const { float* p = O + (long)row * ldo + col; *(f32x4*)p = a0; *(f32x4*)(p + 16) = a1; } };
struct EpiResidual { float* X; const float* gate;
    DI void operator()(int row, int col, f32x4 a0, f32x4 a1) const {
        const float* gp = gate + (long)modrow_of(row) * 6144 + col; float* xp = X + (long)row * 1024 + col;
        f32x4 g0 = *(const f32x4*)gp, g1 = *(const f32x4*)(gp + 16), x0 = *(const f32x4*)xp, x1 = *(const f32x4*)(xp + 16);
        *(f32x4*)xp = x0 + g0 * a0; *(f32x4*)(xp + 16) = x1 + g1 * a1; } };
struct EpiResidualCtx { float* Xout; const float* Xin; const float* gate;
    DI void operator()(int row, int col, f32x4 a0, f32x4 a1) const {
        const float* gp = gate + col; const float* ip = Xin + (long)row * 1024 + col; float* xp = Xout + (long)row * 1024 + col;
        const f32x4 g0 = *(const f32x4*)gp, g1 = *(const f32x4*)(gp + 16), x0 = *(const f32x4*)ip, x1 = *(const f32x4*)(ip + 16);
        *(f32x4*)xp = x0 + g0 * a0; *(f32x4*)(xp + 16) = x1 + g1 * a1; } };
struct EpiSwiglu { bf16_t* O;
    DI void operator()(int row, int col, f32x4 a0, f32x4 a1) const {
        const int f = ((col >> 7) << 6) + (((col & 127) >> 5) << 4) + (col & 15);
        f32x4 h;
#pragma unroll
        for (int i = 0; i < 4; ++i) h[i] = a0[i] * fsigmoid(a0[i]) * a1[i];
        st_bf16x4(O + (long)row * 1024 + f, h); } };
struct EpiGate { bf16_t* O; const float* gate;
    DI void operator()(int row, int col, f32x4 a0, f32x4 a1) const { const float gt = gate[row]; bf16_t* p = O + (long)row * 1024 + col; st_bf16x4(p, a0 * gt); st_bf16x4(p + 16, a1 * gt); } };


DI float quad_max(float v) {
    auto a = __builtin_amdgcn_permlane16_swap(__float_as_uint(v), __float_as_uint(v), false, false); v = fmaxf(__uint_as_float(a[0]), __uint_as_float(a[1]));
    auto b = __builtin_amdgcn_permlane32_swap(__float_as_uint(v), __float_as_uint(v), false, false); return fmaxf(__uint_as_float(b[0]), __uint_as_float(b[1]));
}
DI float quad_sum(float v) {
    auto a = __builtin_amdgcn_permlane16_swap(__float_as_uint(v), __float_as_uint(v), false, false); v = __uint_as_float(a[0]) + __uint_as_float(a[1]);
    auto b = __builtin_amdgcn_permlane32_swap(__float_as_uint(v), __float_as_uint(v), false, false); return __uint_as_float(b[0]) + __uint_as_float(b[1]);
}

namespace pg8 {
#define PG8_LAS __attribute__((address_space(3)))
typedef unsigned short bf16_t;
typedef short bf16x8 __attribute__((ext_vector_type(8)));
typedef float f32x4 __attribute__((ext_vector_type(4)));
typedef unsigned u32x4 __attribute__((ext_vector_type(4)));
constexpr int BM = 256, BK = 64, HALF = 128, HTB = HALF * BK * 2  , STAGE_BYTES = 8 * HTB, NXCD = 8, WGM = 8;

__host__ __device__ __forceinline__ int lds_byte(int r, int c) { const int st = (r >> 4) * 2 + (c >> 5), rr = r & 15, cc = c & 31, ob = rr * 64 + cc * 2; return st * 1024 + (ob ^ (((ob >> 9) & 1) << 5)); }
__host__ __device__ __forceinline__ void stage_rc(int b, int& R, int& C) { const int st = b / 1024, sb = b % 1024, swz = sb ^ (((sb >> 9) & 1) << 5); R = (st >> 1) * 16 + swz / 64; C = (st & 1) * 32 + (swz % 64) / 2; }
__host__ __device__ __forceinline__ int perm32(int rho) { const int n = rho >> 4, i = rho & 15; return 8 * (i >> 2) + 4 * n + (i & 3); }

struct Unit { int pm, pn; };
struct Gemm { const bf16_t* A; const bf16_t* Bt; int M, N, K; };

struct StaticOrder {
    int nM, nN, nwg, G, c;
    __host__ __device__ void init(int M, int N, int G_, int c_) { nM = M / BM; nN = N / BM; nwg = nM * nN; G = G_; c = c_; }
    __host__ __device__ bool next(int i, Unit& u) const {
        const long L = (long)i * G + c; if (L >= nwg) return false;
        int wgid = (int)L; { const int q = nwg / NXCD, r = nwg % NXCD, xcd = wgid % NXCD, off = wgid / NXCD; wgid = (xcd < r ? xcd * (q + 1) : r * (q + 1) + (xcd - r) * q) + off; }
        const int nig = WGM * nN, gid = wgid / nig, fm = gid * WGM, gsz = (nM - fm) < WGM ? (nM - fm) : WGM;
        u.pm = fm + ((wgid % nig) % gsz); u.pn = (wgid % nig) / gsz; return true;
    }
    __device__ __forceinline__ void a_ready(const Unit&) const {}
    __device__ __forceinline__ void done(const Unit&) const {}
};
__device__ __forceinline__ unsigned cvt_pk_bf16(float lo, float hi) { return ::pk2(lo, hi); }
__device__ __forceinline__ u32x4 pk8(f32x4 v0, f32x4 v1) { u32x4 w; w.x = cvt_pk_bf16(v0[0], v0[1]); w.y = cvt_pk_bf16(v0[2], v0[3]); w.z = cvt_pk_bf16(v1[0], v1[1]); w.w = cvt_pk_bf16(v1[2], v1[3]); return w; }
struct PEpiBf16 {
    static constexpr bool PERM = true, AFTER_DRAIN = false;
    bf16_t* O; long ldo;
    __device__ __forceinline__ void operator()(const f32x4 (&acc)[2][2][4][2], const Unit& u, int wr, int wc, int fr, int fq) const {
        const int row0 = u.pm * BM + wr * 64 + fr, col0 = u.pn * BM + wc * 32 + 8 * fq;
#pragma unroll
        for (int ai = 0; ai < 2; ++ai)
#pragma unroll
            for (int m = 0; m < 4; ++m) { bf16_t* rowp = O + (long)(row0 + ai * HALF + m * 16) * ldo + col0;
#pragma unroll
                for (int bj = 0; bj < 2; ++bj) *(u32x4*)(rowp + bj * HALF) = pk8(acc[ai][bj][m][0], acc[ai][bj][m][1]); }
    }
};
struct PEpiF32 {
    static constexpr bool PERM = false, AFTER_DRAIN = false;
    float* C; long ldc;
    __device__ __forceinline__ void operator()(const f32x4 (&acc)[2][2][4][2], const Unit& u, int wr, int wc, int fr, int fq) const {
        const int row0 = u.pm * BM + wr * 64 + fr, col0 = u.pn * BM + wc * 32 + 4 * fq;
#pragma unroll
        for (int ai = 0; ai < 2; ++ai)
#pragma unroll
            for (int m = 0; m < 4; ++m) { float* rowp = C + (long)(row0 + ai * HALF + m * 16) * ldc + col0;
#pragma unroll
                for (int bj = 0; bj < 2; ++bj)
#pragma unroll
                    for (int n = 0; n < 2; ++n) *(f32x4*)(rowp + bj * HALF + n * 16) = acc[ai][bj][m][n]; }
    }
};
struct PEpiResidual {
    static constexpr bool PERM = false, AFTER_DRAIN = false;
    float* X; const float* gate; const float* Xl; const float* Xc;
    __device__ __forceinline__ void operator()(const f32x4 (&acc)[2][2][4][2], const Unit& u, int wr, int wc, int fr, int fq) const {
        const int row0 = u.pm * BM + wr * 64 + fr, col0 = u.pn * BM + wc * 32 + 4 * fq;
        const float* gp = gate + (long)((row0 < 32768) ? (row0 >> 12) : 8) * 6144 + col0;
        f32x4 gv[2][2];
#pragma unroll
        for (int bj = 0; bj < 2; ++bj)
#pragma unroll
            for (int n = 0; n < 2; ++n) gv[bj][n] = *(const f32x4*)(gp + bj * HALF + n * 16);
#pragma unroll
        for (int ai = 0; ai < 2; ++ai)
#pragma unroll
            for (int m = 0; m < 4; ++m) { const long row = row0 + ai * HALF + m * 16; float* rowp = X + row * 1024 + col0;
                const float* inp = ((row0 < 32768) ? (Xl + row * 1024) : (Xc + (row - 32768) * 1024)) + col0;
#pragma unroll
                for (int bj = 0; bj < 2; ++bj)
#pragma unroll
                    for (int n = 0; n < 2; ++n) { const f32x4 x = *(const f32x4*)(inp + bj * HALF + n * 16); *(f32x4*)(rowp + bj * HALF + n * 16) = x + gv[bj][n] * acc[ai][bj][m][n]; }
                asm volatile("" ::: "memory"); }
    }
};
struct PEpiSwiglu {
    static constexpr bool PERM = true, AFTER_DRAIN = false;
    bf16_t* O;
    __device__ __forceinline__ void operator()(const f32x4 (&acc)[2][2][4][2], const Unit& u, int wr, int wc, int fr, int fq) const {
        const int row0 = u.pm * BM + wr * 64 + fr, f0 = (u.pn & 7) * HALF + wc * 32 + 8 * fq;
#pragma unroll
        for (int ai = 0; ai < 2; ++ai)
#pragma unroll
            for (int m = 0; m < 4; ++m) {
                f32x4 h0, h1;
#pragma unroll
                for (int i = 0; i < 4; ++i) { const float a = acc[ai][0][m][0][i], b = acc[ai][0][m][1][i];
                    h0[i] = a * __builtin_amdgcn_rcpf(1.0f + __expf(-a)) * acc[ai][1][m][0][i]; h1[i] = b * __builtin_amdgcn_rcpf(1.0f + __expf(-b)) * acc[ai][1][m][1][i]; }
                *(u32x4*)(O + (long)(row0 + ai * HALF + m * 16) * 1024 + f0) = pk8(h0, h1); }
    }
};
struct PEpiGate {
    static constexpr bool PERM = true, AFTER_DRAIN = false;
    bf16_t* O; const float* gate;
    __device__ __forceinline__ void operator()(const f32x4 (&acc)[2][2][4][2], const Unit& u, int wr, int wc, int fr, int fq) const {
        const int row0 = u.pm * BM + wr * 64 + fr, col0 = (u.pn & 3) * BM + wc * 32 + 8 * fq;
#pragma unroll
        for (int ai = 0; ai < 2; ++ai)
#pragma unroll
            for (int m = 0; m < 4; ++m) { const int row = row0 + ai * HALF + m * 16; const float gt = gate[row]; bf16_t* rowp = O + (long)row * 1024 + col0;
#pragma unroll
                for (int bj = 0; bj < 2; ++bj) *(u32x4*)(rowp + bj * HALF) = pk8(acc[ai][bj][m][0] * gt, acc[ai][bj][m][1] * gt); }
    }
};
struct PEpiQKNorm {
    static constexpr bool PERM = true, AFTER_DRAIN = false;
    bf16_t* O; long ldo; int nq, nk; const float* qg; const float* kg; const float* rope;
    __device__ __forceinline__ void operator()(const f32x4 (&acc)[2][2][4][2], const Unit& u, int wr, int wc, int fr, int fq) const {
        const int row0 = u.pm * BM + wr * 64 + fr, cb = u.pn * BM + 64 * wc + 8 * fq;
        const int kind = (u.pn < nq) ? 0 : ((u.pn < nk) ? 1 : 2);
        f32x4 gn[2][2];
        if (kind < 2) { const float* g = kind ? kg : qg;
#pragma unroll
            for (int bj = 0; bj < 2; ++bj)
#pragma unroll
                for (int n = 0; n < 2; ++n) gn[bj][n] = *(const f32x4*)(g + 32 * bj + 8 * fq + 4 * n); }
#pragma unroll
        for (int ai = 0; ai < 2; ++ai)
#pragma unroll
            for (int m = 0; m < 4; ++m) {
                const int row = row0 + ai * HALF + m * 16;
                f32x4 x[2][2];
#pragma unroll
                for (int bj = 0; bj < 2; ++bj)
#pragma unroll
                    for (int n = 0; n < 2; ++n) x[bj][n] = acc[ai][bj][m][n];
                if (kind < 2) {
                    float ss = 0.f;
#pragma unroll
                    for (int bj = 0; bj < 2; ++bj)
#pragma unroll
                        for (int n = 0; n < 2; ++n) ss += (x[bj][n][0] * x[bj][n][0] + x[bj][n][1] * x[bj][n][1]) + (x[bj][n][2] * x[bj][n][2] + x[bj][n][3] * x[bj][n][3]);
                    ss = ::quad_sum(ss);
                    const float r = rsqrtf(ss * (1.0f / 64.0f) + 1e-6f);
#pragma unroll
                    for (int bj = 0; bj < 2; ++bj)
#pragma unroll
                        for (int n = 0; n < 2; ++n) x[bj][n] = x[bj][n] * r * gn[bj][n];
                    if (rope != nullptr && row < 32768) {
                        const float* cs = rope + (long)(row & 4095) * 32 + 8 * fq; const float* sn = cs + 4096 * 32;
#pragma unroll
                        for (int n = 0; n < 2; ++n) { const f32x4 c = *(const f32x4*)(cs + 4 * n), sv = *(const f32x4*)(sn + 4 * n);
                            const f32x4 a = x[0][n], b = x[1][n]; x[0][n] = a * c - b * sv; x[1][n] = b * c + a * sv; }
                    }
                }
                bf16_t* rowp = O + (long)row * ldo + cb;
#pragma unroll
                for (int bj = 0; bj < 2; ++bj) *(u32x4*)(rowp + 32 * bj) = pk8(x[bj][0], x[bj][1]);
            }
    }
};
struct PEpiRW1 {
    static constexpr bool PERM = true, AFTER_DRAIN = false;
    bf16_t* RKV; bf16_t* LORA;
    __device__ __forceinline__ void operator()(const f32x4 (&acc)[2][2][4][2], const Unit& u, int wr, int wc, int fr, int fq) const {
        const int row0 = u.pm * BM + wr * 64 + fr, cw = wc * 32 + 8 * fq;
#pragma unroll
        for (int ai = 0; ai < 2; ++ai)
#pragma unroll
            for (int m = 0; m < 4; ++m) { const long row = row0 + ai * HALF + m * 16;
#pragma unroll
                for (int bj = 0; bj < 2; ++bj) {
                    f32x4 v0 = acc[ai][bj][m][0], v1 = acc[ai][bj][m][1];
                    if (u.pn < 12) *(u32x4*)(RKV + row * 3072 + u.pn * BM + bj * HALF + cw) = pk8(v0, v1);
                    else {
                        const int cls = (u.pn - 12) * 2 + bj;
                        if (cls == 0) {
#pragma unroll
                            for (int i = 0; i < 4; ++i) { v0[i] = __builtin_amdgcn_rcpf(1.0f + __expf(-v0[i])); v1[i] = __builtin_amdgcn_rcpf(1.0f + __expf(-v1[i])); } }
                        if (cls == 1) {
#pragma unroll
                            for (int i = 0; i < 4; ++i) { v0[i] = 2.0f * __builtin_amdgcn_rcpf(1.0f + __expf(-2.0f * v0[i])) - 1.0f; v1[i] = 2.0f * __builtin_amdgcn_rcpf(1.0f + __expf(-2.0f * v1[i])) - 1.0f; } }
                        if (cls < 3) *(u32x4*)(LORA + row * 384 + cls * HALF + cw) = pk8(v0, v1);
                    } } }
    }
};
struct GroupedOrder {
    int P, NT, G, c;
    __device__ __forceinline__ bool next(int i, Unit& u) const {
        const int per = P * NT;
        if (G == 256) {
            const int x = c & 7, Lx = i * 32 + (c >> 3); if (Lx >= 2 * per) return false;
            const int e = 2 * x + Lx / per, rem = Lx % per, nig = 8 * NT, gid = rem / nig, fm = gid * 8, gsz = (P - fm) < 8 ? (P - fm) : 8, ri = rem % nig;
            u.pm = e * 17 + fm + (ri % gsz); u.pn = e * NT + (ri / gsz); return true;
        }
        const long L = (long)i * G + c; if (L >= (long)16 * per) return false;
        const int e = (int)(L / per), r = (int)(L % per); u.pm = e * 17 + (r % P); u.pn = e * NT + (r / P); return true; }
    __device__ __forceinline__ void a_ready(const Unit&) const {}
    __device__ __forceinline__ void done(const Unit&) const {}
};

template <class Epi, class Sched, bool STAMP = false>
__device__ __forceinline__ void gemm_phase(PG8_LAS unsigned char* lds, const Gemm g, const Sched& S, const Epi& E, unsigned long long* stamps) {
    const int tid = TIDX(), wid = __builtin_amdgcn_readfirstlane(tid >> 6), lane = tid & 63, wr = wid >> 2, wc = wid & 3, fr = lane & 15, fq = lane >> 4;
    const int K = g.K, nt = K / BK;
    int ts_lo = 0, ts_hi = 0, nts = 0; const unsigned long long rt_entry = STAMP ? (unsigned long long)wall_clock64() : 0ull;
#define PG8_STAMP() do { if (STAMP && wid == 0 && nts < 64) { const unsigned long long _c = (unsigned long long)clock64(); \
        ts_lo = (lane == nts) ? (int)(unsigned)_c : ts_lo; ts_hi = (lane == nts) ? (int)(unsigned)(_c >> 32) : ts_hi; ++nts; } } while (0)
    PG8_STAMP();
    unsigned voffA[2], voffB[2];
#pragma unroll
    for (int i = 0; i < 2; ++i) { int R, C; stage_rc(tid * 16 + i * 8192, R, C); const int Rb = Epi::PERM ? ((R & ~31) + perm32(R & 31)) : R;
        voffA[i] = (unsigned)(R * K + C) * 2u; voffB[i] = (unsigned)(Rb * K + C) * 2u; }
    const size_t kstep = (size_t)(BK * 2);
    const size_t hstep = (size_t)HALF * K * 2;
    const size_t tstep = 2 * hstep;
    const unsigned ldsw = (unsigned)wid * 1024u;
    const int aoff = lds_byte(wr * 64 + fr, fq * 8), boff = lds_byte(wc * 32 + fr, fq * 8);
#define PG8_SA(b, h) (((b) * 2 + (h)) * HTB)
#define PG8_SB(b, h) ((4 + (b) * 2 + (h)) * HTB)
#define PG8_STAGE(bufoff, gbase, voff) do { _Pragma("unroll") for (int _i = 0; _i < 2; ++_i) \
        __builtin_amdgcn_global_load_lds((const unsigned*)((const char*)(gbase) + (voff)[_i]), (PG8_LAS unsigned*)(lds + (bufoff) + ldsw + _i * 8192), 16, 0, 0); } while (0)
#define PG8_LDA(dst, b, h) do { _Pragma("unroll") for (int m = 0; m < 4; ++m) _Pragma("unroll") for (int k = 0; k < 2; ++k) dst[m][k] = *(const PG8_LAS bf16x8*)(lds + PG8_SA(b, h) + aoff + m * 2048 + k * 1024); } while (0)
#define PG8_LDB(dst, b, h) do { _Pragma("unroll") for (int n = 0; n < 2; ++n) _Pragma("unroll") for (int k = 0; k < 2; ++k) dst[n][k] = *(const PG8_LAS bf16x8*)(lds + PG8_SB(b, h) + boff + n * 2048 + k * 1024); } while (0)
#define PG8_MMA(ai, bj, At, Bt) do { __builtin_amdgcn_s_setprio(1); _Pragma("unroll") for (int m = 0; m < 4; ++m) _Pragma("unroll") for (int n = 0; n < 2; ++n) _Pragma("unroll") for (int k = 0; k < 2; ++k) \
        acc[ai][bj][m][n] = __builtin_amdgcn_mfma_f32_16x16x32_bf16(Bt[n][k], At[m][k], acc[ai][bj][m][n], 0, 0, 0); __builtin_amdgcn_s_setprio(0); } while (0)
#define PG8_WAIT_V(n) asm volatile("s_waitcnt vmcnt(" #n ")" ::: "memory")
#define PG8_WAIT_L(n) asm volatile("s_waitcnt lgkmcnt(" #n ")" ::: "memory")
#define PG8_BAR __builtin_amdgcn_s_barrier()
#define PG8_SCHED __builtin_amdgcn_sched_barrier(0)
    Unit cur, nxt; int ui = 0;
    if (!S.next(0, cur)) return;
    f32x4 acc[2][2][4][2];
#pragma unroll
    for (int a = 0; a < 2; ++a)
#pragma unroll
        for (int b = 0; b < 2; ++b)
#pragma unroll
            for (int m = 0; m < 4; ++m)
#pragma unroll
                for (int n = 0; n < 2; ++n) acc[a][b][m][n] = (f32x4){0.f, 0.f, 0.f, 0.f};
    bf16x8 At[4][2], B0[2][2], B1[2][2];
    const char* cA = (const char*)g.A + (size_t)cur.pm * tstep; const char* cB = (const char*)g.Bt + (size_t)cur.pn * tstep;
    S.a_ready(cur);
    PG8_STAGE(PG8_SB(0, 0), cB, voffB); PG8_STAGE(PG8_SA(0, 0), cA, voffA); PG8_STAGE(PG8_SB(0, 1), cB + hstep, voffB); PG8_STAGE(PG8_SA(0, 1), cA + hstep, voffA);
    if (wr == 1) PG8_BAR;
    PG8_WAIT_V(4); PG8_BAR;
    PG8_STAGE(PG8_SB(1, 0), cB + kstep, voffB); PG8_STAGE(PG8_SA(1, 0), cA + kstep, voffA); PG8_STAGE(PG8_SB(1, 1), cB + hstep + kstep, voffB);
    PG8_WAIT_V(6); PG8_BAR;
    PG8_STAMP();
    for (;;) {
        const bool has_next = S.next(ui + 1, nxt);
        const char* nA = has_next ? (const char*)g.A + (size_t)nxt.pm * tstep : cA; const char* nB = has_next ? (const char*)g.Bt + (size_t)nxt.pn * tstep : cB;
        for (int t = 0; t < nt; t += 2) {
            const bool last = (t == nt - 2);
            const char* a1 = cA + (size_t)(t + 1) * kstep;
            const char* a2 = last ? nA : cA + (size_t)(t + 2) * kstep; const char* b2 = last ? nB : cB + (size_t)(t + 2) * kstep;
            const char* a3 = a2 + kstep; const char* b3 = b2 + kstep;
            if (last && has_next) S.a_ready(nxt);
            PG8_LDB(B0, 0, 0); PG8_SCHED; PG8_LDA(At, 0, 0); PG8_STAGE(PG8_SA(1, 1), a1 + hstep, voffA);
            PG8_WAIT_L(8); PG8_BAR; PG8_WAIT_L(0); PG8_MMA(0, 0, At, B0); PG8_BAR; PG8_SCHED;
            PG8_LDB(B1, 0, 1); PG8_STAGE(PG8_SB(0, 0), b2, voffB);
            PG8_BAR; PG8_WAIT_L(0); PG8_MMA(0, 1, At, B1); PG8_BAR;
            PG8_LDA(At, 0, 1); PG8_STAGE(PG8_SA(0, 0), a2, voffA);
            PG8_BAR; PG8_WAIT_L(0); PG8_MMA(1, 0, At, B0); PG8_BAR; PG8_SCHED;
            PG8_STAGE(PG8_SB(0, 1), b2 + hstep, voffB);
            PG8_WAIT_V(6); PG8_BAR; PG8_MMA(1, 1, At, B1); PG8_BAR;
            PG8_LDB(B0, 1, 0); PG8_SCHED; PG8_LDA(At, 1, 0); PG8_STAGE(PG8_SA(0, 1), a2 + hstep, voffA);
            PG8_WAIT_L(8); PG8_BAR; PG8_WAIT_L(0); PG8_MMA(0, 0, At, B0); PG8_BAR; PG8_SCHED;
            PG8_LDB(B1, 1, 1); PG8_STAGE(PG8_SB(1, 0), b3, voffB);
            PG8_BAR; PG8_WAIT_L(0); PG8_MMA(0, 1, At, B1); PG8_BAR;
            PG8_LDA(At, 1, 1); PG8_STAGE(PG8_SA(1, 0), a3, voffA);
            PG8_BAR; PG8_WAIT_L(0); PG8_MMA(1, 0, At, B0); PG8_BAR; PG8_SCHED;
            PG8_STAGE(PG8_SB(1, 1), b3 + hstep, voffB);
            PG8_WAIT_V(6); PG8_BAR; PG8_MMA(1, 1, At, B1); PG8_BAR;
        }
        PG8_STAMP();
        if constexpr (!Epi::AFTER_DRAIN) { E(acc, cur, wr, wc, fr, fq); S.done(cur); }
        PG8_STAMP();
        if (!has_next) break;
#pragma unroll
        for (int a = 0; a < 2; ++a)
#pragma unroll
            for (int b = 0; b < 2; ++b)
#pragma unroll
                for (int m = 0; m < 4; ++m)
#pragma unroll
                    for (int n = 0; n < 2; ++n) acc[a][b][m][n] = (f32x4){0.f, 0.f, 0.f, 0.f};
        cur = nxt; cA = nA; cB = nB; ++ui;
    }
    PG8_WAIT_V(0);
    if (wr == 0) PG8_BAR;
    PG8_BAR;
    if constexpr (Epi::AFTER_DRAIN) { E.fused(acc, cur, wr, wc, fr, fq, lds, wid, lane); S.done(cur); }
    PG8_STAMP();
    if (STAMP && wid == 0) { stamps[lane] = lane < nts ? (((unsigned long long)(unsigned)ts_hi << 32) | (unsigned)ts_lo) : 0ull;
        if (lane == 62) stamps[62] = rt_entry; if (lane == 63) stamps[63] = (unsigned long long)wall_clock64(); }
#undef PG8_STAMP
#undef PG8_SA
#undef PG8_SB
#undef PG8_STAGE
#undef PG8_LDA
#undef PG8_LDB
#undef PG8_MMA
#undef PG8_WAIT_V
#undef PG8_WAIT_L
#undef PG8_BAR
#undef PG8_SCHED
}
template <class Epi, class Sched>
__device__ __forceinline__ void gemm_phase_gather(PG8_LAS unsigned char* lds, const Gemm g, const Sched& S, const Epi& E, const int* idx) {
    constexpr bool STAMP = false; unsigned long long* stamps = nullptr;
    const int tid = TIDX(), wid = __builtin_amdgcn_readfirstlane(tid >> 6), lane = tid & 63, wr = wid >> 2, wc = wid & 3, fr = lane & 15, fq = lane >> 4;
    const int K = g.K, nt = K / BK;
    int ts_lo = 0, ts_hi = 0, nts = 0; const unsigned long long rt_entry = STAMP ? (unsigned long long)wall_clock64() : 0ull;
#define PG8_STAMP() do { if (STAMP && wid == 0 && nts < 64) { const unsigned long long _c = (unsigned long long)clock64(); \
        ts_lo = (lane == nts) ? (int)(unsigned)_c : ts_lo; ts_hi = (lane == nts) ? (int)(unsigned)(_c >> 32) : ts_hi; ++nts; } } while (0)
    PG8_STAMP();
    unsigned voffB[2]; int rowA[2]; unsigned colA[2];
#pragma unroll
    for (int i = 0; i < 2; ++i) { int R, C; stage_rc(tid * 16 + i * 8192, R, C); const int Rb = Epi::PERM ? ((R & ~31) + perm32(R & 31)) : R;
        rowA[i] = R; colA[i] = (unsigned)C * 2u; voffB[i] = (unsigned)(Rb * K + C) * 2u; }
    unsigned vc0[2], vc1[2], vn0[2], vn1[2];
#define PG8_GIDX(u, o0, o1) do { const int* ip = idx + (long)(u).pm * BM; const int g00 = ip[rowA[0]], g01 = ip[rowA[1]], g10 = ip[HALF + rowA[0]], g11 = ip[HALF + rowA[1]]; \
        asm volatile("s_waitcnt vmcnt(0)" ::: "memory"); \
        o0[0] = (unsigned)g00 * (unsigned)(K * 2) + colA[0]; o0[1] = (unsigned)g01 * (unsigned)(K * 2) + colA[1]; o1[0] = (unsigned)g10 * (unsigned)(K * 2) + colA[0]; o1[1] = (unsigned)g11 * (unsigned)(K * 2) + colA[1]; } while (0)
    const size_t kstep = (size_t)(BK * 2);
    const size_t hstep = (size_t)HALF * K * 2;
    const size_t tstep = 2 * hstep;
    const unsigned ldsw = (unsigned)wid * 1024u;
    const int aoff = lds_byte(wr * 64 + fr, fq * 8), boff = lds_byte(wc * 32 + fr, fq * 8);
#define PG8_SA(b, h) (((b) * 2 + (h)) * HTB)
#define PG8_SB(b, h) ((4 + (b) * 2 + (h)) * HTB)
#define PG8_STAGE(bufoff, gbase, voff) do { _Pragma("unroll") for (int _i = 0; _i < 2; ++_i) \
        __builtin_amdgcn_global_load_lds((const unsigned*)((const char*)(gbase) + (voff)[_i]), (PG8_LAS unsigned*)(lds + (bufoff) + ldsw + _i * 8192), 16, 0, 0); } while (0)
#define PG8_LDA(dst, b, h) do { _Pragma("unroll") for (int m = 0; m < 4; ++m) _Pragma("unroll") for (int k = 0; k < 2; ++k) dst[m][k] = *(const PG8_LAS bf16x8*)(lds + PG8_SA(b, h) + aoff + m * 2048 + k * 1024); } while (0)
#define PG8_LDB(dst, b, h) do { _Pragma("unroll") for (int n = 0; n < 2; ++n) _Pragma("unroll") for (int k = 0; k < 2; ++k) dst[n][k] = *(const PG8_LAS bf16x8*)(lds + PG8_SB(b, h) + boff + n * 2048 + k * 1024); } while (0)
#define PG8_MMA(ai, bj, At, Bt) do { __builtin_amdgcn_s_setprio(1); _Pragma("unroll") for (int m = 0; m < 4; ++m) _Pragma("unroll") for (int n = 0; n < 2; ++n) _Pragma("unroll") for (int k = 0; k < 2; ++k) \
        acc[ai][bj][m][n] = __builtin_amdgcn_mfma_f32_16x16x32_bf16(Bt[n][k], At[m][k], acc[ai][bj][m][n], 0, 0, 0); __builtin_amdgcn_s_setprio(0); } while (0)
#define PG8_WAIT_V(n) asm volatile("s_waitcnt vmcnt(" #n ")" ::: "memory")
#define PG8_WAIT_L(n) asm volatile("s_waitcnt lgkmcnt(" #n ")" ::: "memory")
#define PG8_BAR __builtin_amdgcn_s_barrier()
#define PG8_SCHED __builtin_amdgcn_sched_barrier(0)
    Unit cur, nxt; int ui = 0;
    if (!S.next(0, cur)) return;
    f32x4 acc[2][2][4][2];
#pragma unroll
    for (int a = 0; a < 2; ++a)
#pragma unroll
        for (int b = 0; b < 2; ++b)
#pragma unroll
            for (int m = 0; m < 4; ++m)
#pragma unroll
                for (int n = 0; n < 2; ++n) acc[a][b][m][n] = (f32x4){0.f, 0.f, 0.f, 0.f};
    bf16x8 At[4][2], B0[2][2], B1[2][2];
    const char* AB = (const char*)g.A; const char* cB = (const char*)g.Bt + (size_t)cur.pn * tstep;
    S.a_ready(cur);
    PG8_GIDX(cur, vc0, vc1);
    PG8_STAGE(PG8_SB(0, 0), cB, voffB); PG8_STAGE(PG8_SA(0, 0), AB, vc0); PG8_STAGE(PG8_SB(0, 1), cB + hstep, voffB); PG8_STAGE(PG8_SA(0, 1), AB, vc1);
    if (wr == 1) PG8_BAR;
    PG8_WAIT_V(4); PG8_BAR;
    PG8_STAGE(PG8_SB(1, 0), cB + kstep, voffB); PG8_STAGE(PG8_SA(1, 0), AB + kstep, vc0); PG8_STAGE(PG8_SB(1, 1), cB + hstep + kstep, voffB);
    PG8_WAIT_V(6); PG8_BAR;
    PG8_STAMP();
    for (;;) {
        const bool has_next = S.next(ui + 1, nxt);
        const char* nB = has_next ? (const char*)g.Bt + (size_t)nxt.pn * tstep : cB;
        for (int t = 0; t < nt; t += 2) {
            const bool last = (t == nt - 2);
            const char* a1 = AB + (size_t)(t + 1) * kstep;
            const char* b2 = last ? nB : cB + (size_t)(t + 2) * kstep;
            const char* b3 = b2 + kstep;
            if (last) { if (has_next) { S.a_ready(nxt); PG8_GIDX(nxt, vn0, vn1); } else { vn0[0] = vc0[0]; vn0[1] = vc0[1]; vn1[0] = vc1[0]; vn1[1] = vc1[1]; } }
            const char* a2 = last ? AB : AB + (size_t)(t + 2) * kstep; const char* a3 = a2 + kstep;
            unsigned w0[2], w1[2];
            w0[0] = last ? vn0[0] : vc0[0]; w0[1] = last ? vn0[1] : vc0[1]; w1[0] = last ? vn1[0] : vc1[0]; w1[1] = last ? vn1[1] : vc1[1];
            PG8_LDB(B0, 0, 0); PG8_SCHED; PG8_LDA(At, 0, 0); PG8_STAGE(PG8_SA(1, 1), a1, vc1);
            PG8_WAIT_L(8); PG8_BAR; PG8_WAIT_L(0); PG8_MMA(0, 0, At, B0); PG8_BAR; PG8_SCHED;
            PG8_LDB(B1, 0, 1); PG8_STAGE(PG8_SB(0, 0), b2, voffB);
            PG8_BAR; PG8_WAIT_L(0); PG8_MMA(0, 1, At, B1); PG8_BAR;
            PG8_LDA(At, 0, 1); PG8_STAGE(PG8_SA(0, 0), a2, w0);
            PG8_BAR; PG8_WAIT_L(0); PG8_MMA(1, 0, At, B0); PG8_BAR; PG8_SCHED;
            PG8_STAGE(PG8_SB(0, 1), b2 + hstep, voffB);
            PG8_WAIT_V(6); PG8_BAR; PG8_MMA(1, 1, At, B1); PG8_BAR;
            PG8_LDB(B0, 1, 0); PG8_SCHED; PG8_LDA(At, 1, 0); PG8_STAGE(PG8_SA(0, 1), a2, w1);
            PG8_WAIT_L(8); PG8_BAR; PG8_WAIT_L(0); PG8_MMA(0, 0, At, B0); PG8_BAR; PG8_SCHED;
            PG8_LDB(B1, 1, 1); PG8_STAGE(PG8_SB(1, 0), b3, voffB);
            PG8_BAR; PG8_WAIT_L(0); PG8_MMA(0, 1, At, B1); PG8_BAR;
            PG8_LDA(At, 1, 1); PG8_STAGE(PG8_SA(1, 0), a3, w0);
            PG8_BAR; PG8_WAIT_L(0); PG8_MMA(1, 0, At, B0); PG8_BAR; PG8_SCHED;
            PG8_STAGE(PG8_SB(1, 1), b3 + hstep, voffB);
            PG8_WAIT_V(6); PG8_BAR; PG8_MMA(1, 1, At, B1); PG8_BAR;
        }
        PG8_STAMP();
        if constexpr (!Epi::AFTER_DRAIN) { E(acc, cur, wr, wc, fr, fq); S.done(cur); }
        PG8_STAMP();
        if (!has_next) break;
#pragma unroll
        for (int a = 0; a < 2; ++a)
#pragma unroll
            for (int b = 0; b < 2; ++b)
#pragma unroll
                for (int m = 0; m < 4; ++m)
#pragma unroll
                    for (int n = 0; n < 2; ++n) acc[a][b][m][n] = (f32x4){0.f, 0.f, 0.f, 0.f};
        cur = nxt; cB = nB; ++ui; vc0[0] = vn0[0]; vc0[1] = vn0[1]; vc1[0] = vn1[0]; vc1[1] = vn1[1];
    }
    PG8_WAIT_V(0);
    if (wr == 0) PG8_BAR;
    PG8_BAR;
    if constexpr (Epi::AFTER_DRAIN) { E.fused(acc, cur, wr, wc, fr, fq, lds, wid, lane); S.done(cur); }
    PG8_STAMP();
    if (STAMP && wid == 0) { stamps[lane] = lane < nts ? (((unsigned long long)(unsigned)ts_hi << 32) | (unsigned)ts_lo) : 0ull;
        if (lane == 62) stamps[62] = rt_entry; if (lane == 63) stamps[63] = (unsigned long long)wall_clock64(); }
#undef PG8_STAMP
#undef PG8_SA
#undef PG8_SB
#undef PG8_STAGE
#undef PG8_LDA
#undef PG8_LDB
#undef PG8_MMA
#undef PG8_WAIT_V
#undef PG8_WAIT_L
#undef PG8_BAR
#undef PG8_SCHED
#undef PG8_GIDX
}
}

constexpr int CONV_NPAR = 4;
template <int MODE>
DI void conv_tiles(const float* src, int K, int N, int Npad, bf16_t* dst, long ldd, int koff, int rowoff,
                   const float* mixv, float alpha, float beta, int& base, char* smem, int rank = -1, int G = 0) {
    float* t = (float*)smem;
    const int tid = TIDX();
    if (G == 0) { G = gridDim.x; rank = (int)blockIdx.x; }
    const int ntn = Npad >> 6, ntiles = (K >> 6) * ntn;
    int first = (rank - (base % G) + G) % G;
    base += ntiles;
    for (int ti0 = first; ti0 < ntiles; ti0 += CONV_NPAR * G) {
        f32x4 v0[CONV_NPAR], v1[CONV_NPAR]; float sc[CONV_NPAR];
        const int k = tid >> 3, n8 = (tid & 7) * 8;
#pragma unroll
        for (int q = 0; q < CONV_NPAR; ++q) {
            const int ti = ti0 + q * G;
            v0[q] = (f32x4){0.f, 0.f, 0.f, 0.f}; v1[q] = v0[q]; sc[q] = 1.0f;
            if (ti < ntiles) {
                const int k0 = (ti / ntn) << 6, n0 = (ti % ntn) << 6;
                sc[q] = mixv ? (alpha + beta * mixv[k0 + k]) : 1.0f;
                if (n0 + n8 < N) { const float* sp = src + (long)(k0 + k) * N + n0 + n8; v0[q] = *(const f32x4*)sp; v1[q] = *(const f32x4*)(sp + 4); }
            }
        }
#pragma unroll
        for (int q = 0; q < CONV_NPAR; ++q) {
            float* tp = t + q * (64 * 65) + k * 65 + n8;
            tp[0] = v0[q][0] * sc[q]; tp[1] = v0[q][1] * sc[q]; tp[2] = v0[q][2] * sc[q]; tp[3] = v0[q][3] * sc[q]; tp[4] = v1[q][0] * sc[q]; tp[5] = v1[q][1] * sc[q]; tp[6] = v1[q][2] * sc[q]; tp[7] = v1[q][3] * sc[q];
        }
        __syncthreads();
#pragma unroll
        for (int q = 0; q < CONV_NPAR; ++q) {
            const int ti = ti0 + q * G;
            if (ti < ntiles) {
                const int k0 = (ti / ntn) << 6, n0 = (ti % ntn) << 6;
                const int n = tid >> 3, kc = (tid & 7) * 8;
                float f[8];
#pragma unroll
                for (int j = 0; j < 8; ++j) f[j] = t[q * (64 * 65) + (kc + j) * 65 + n];
                const int nn = n0 + n;
                const int r = (MODE == 1) ? (128 * (nn >> 6) + 32 * ((nn >> 4) & 3) + (nn & 15)) : ((MODE == 2) ? (256 * (nn >> 7) + (nn & 127)) : ((MODE == 3) ? ((nn & ~255) + 128 * ((nn >> 5) & 1) + 32 * ((nn >> 6) & 3) + (nn & 31)) : nn));
                *(u32x4*)(dst + (long)(r + rowoff) * ldd + koff + k0 + kc) = pack8(f);
            }
        }
        __syncthreads();
    }
}
DI void zero_bf16(bf16_t* dst, long n8  ) {
    for (long i = (long)blockIdx.x * NTHR + TIDX(); i < n8; i += (long)gridDim.x * NTHR) *(u32x4*)(dst + i * 8) = (u32x4){0u, 0u, 0u, 0u};
}

struct Bufs {
    float* MOD; float* ROPE_M; float* ROPE_S; float* X; bf16_t* WMIX; bf16_t* W13; bf16_t* W2T; bf16_t* W2TB;
    DI bf16_t* w2t(int layer) const { return (layer & 1) ? W2TB : W2T; }
    float* AFF; float* AFFC; int* IDX; float* GATE; int* INV; unsigned char* WORK;
    DI bf16_t* slot(int i) const { return (bf16_t*)(WORK + (size_t)i * USLOT); }
};
DI Bufs make_bufs(const Params& p) {
    Bufs b; unsigned char* w = p.ws;
    b.MOD = (float*)(w + OFF_MOD); b.ROPE_M = (float*)(w + OFF_ROPE_M); b.ROPE_S = (float*)(w + OFF_ROPE_S); b.X = (float*)(w + OFF_X);
    b.WMIX = (bf16_t*)(w + OFF_WMIX); b.W13 = (bf16_t*)(w + OFF_WE); b.W2T = (bf16_t*)(w + OFF_WE + 64 * MiB); b.W2TB = (bf16_t*)(w + OFF_W2TB);
    b.AFF = (float*)(w + OFF_AFF); b.AFFC = (float*)(w + OFF_AFFC); b.IDX = (int*)(w + OFF_IDX); b.GATE = (float*)(w + OFF_GATE); b.INV = (int*)(w + OFF_INV);
    b.WORK = w + OFF_WORK; return b;
}

DI void conv_moe_layer(const Params& p, const Bufs& B, int layer, int& base, char* smem, int part = 0, int rank = -1, int G = 0) {
    for (int e = 0; e < NEXP; ++e) {
        const size_t wo = ((size_t)layer * NEXP + e) * 1024 * 1024;
        if (part != 2) {
            conv_tiles<USE_PG8 ? 2 : 1>(p.in[I_MOE_W1] + wo, 1024, 1024, 1024, B.W13 + (size_t)e * 2048 * 1024, 1024, 0, 0, nullptr, 0.f, 0.f, base, smem, rank, G);
            conv_tiles<USE_PG8 ? 2 : 1>(p.in[I_MOE_W3] + wo, 1024, 1024, 1024, B.W13 + (size_t)e * 2048 * 1024, 1024, 0, USE_PG8 ? 128 : 16, nullptr, 0.f, 0.f, base, smem, rank, G);
        }
        if (part != 1) conv_tiles<0>(p.in[I_MOE_W2] + wo, 1024, 1024, 1024, B.w2t(layer) + (size_t)e * 1024 * 1024, 1024, 0, 0, nullptr, 0.f, 0.f, base, smem, rank, G);
    }
}

DI void phase_prologue(const Params& p, const Bufs& B, char* smem) {
    const int tid = TIDX(), G = gridDim.x;
    {
        float* s = (float*)smem;
        float* red = s + 9 * 1024;
        for (int i = tid; i < 9 * 1024; i += NTHR) { const int r = i >> 10, k = i & 1023; const float x = (r < 8) ? p.in[I_C][r * 1024 + k] : p.in[I_CCTX][k]; s[i] = x * fsigmoid(x); }
        __syncthreads();
        for (int it = blockIdx.x; it < 4 * 96; it += G) {
            const int l = it / 96, cg = it % 96, cl = tid & 63, ks = tid >> 6, n = cg * 64 + cl;
            const float* wp = p.in[I_ADAW] + (size_t)l * 1024 * 6144 + (size_t)(ks * 128) * 6144 + n;
            float acc[9];
#pragma unroll
            for (int r = 0; r < 9; ++r) acc[r] = 0.f;
            for (int k = 0; k < 128; ++k) {
                const float wv = wp[(size_t)k * 6144];
#pragma unroll
                for (int r = 0; r < 9; ++r) acc[r] += s[r * 1024 + ks * 128 + k] * wv;
            }
#pragma unroll
            for (int r = 0; r < 9; ++r) red[(ks * 9 + r) * 64 + cl] = acc[r];
            __syncthreads();
            for (int o = tid; o < 9 * 64; o += NTHR) {
                const int r = o >> 6, c = o & 63; float v = 0.f;
#pragma unroll
                for (int q = 0; q < 8; ++q) v += red[(q * 9 + r) * 64 + c];
                B.MOD[((size_t)l * 9 + r) * 6144 + cg * 64 + c] = v + p.in[I_ADAB][l * 6144 + cg * 64 + c];
            }
            __syncthreads();
        }
    }
    for (int i = blockIdx.x * NTHR + tid; i < 4096 * 48; i += G * NTHR) {
        const int pos = i / 48, j = i % 48;
        const int row = pos >> 6, col = pos & 63;
        float inv, posf; float* cdst; float* sdst;
        if (j < 16) { const int m = j & 7; inv = powf(10000.0f, -(float)(2 * m) / 16.0f); posf = (j < 8) ? (float)row : (float)col; cdst = B.ROPE_M + pos * 16 + j; sdst = B.ROPE_M + 4096 * 16 + pos * 16 + j; }
        else { const int jj = j - 16, m = jj & 15; inv = powf(10000.0f, -(float)(2 * m) / 32.0f); posf = (jj < 16) ? (float)row : (float)col; cdst = B.ROPE_S + pos * 32 + jj; sdst = B.ROPE_S + 4096 * 32 + pos * 32 + jj; }
        const float ang = posf * inv;
        double tr = (double)ang * 0.15915494309189535; tr -= rint(tr);
        const float tf = (float)tr;
        *cdst = __builtin_amdgcn_cosf(tf); *sdst = __builtin_amdgcn_sinf(tf);
    }
    int base = 0;
    bf16_t* W = B.WMIX;
    conv_tiles<3>(p.in[I_NA_WQKV], 1024, 3072, 3072, W + W_NA_QKV, 1024, 0, 0, nullptr, 0.f, 0.f, base, smem);
    conv_tiles<0>(p.in[I_NA_WO], 1024, 1024, 1024, W + W_NA_WO, 1024, 0, 0, nullptr, 0.f, 0.f, base, smem);
    {
        const float* mix = p.in[I_RW_MIX];
        bf16_t* B1 = W + W_RW_B1;
        conv_tiles<0>(p.in[I_RW_WR], 1024, 1024, 1024, B1, 2048, 0, 0, mix + 0 * 1024, 1.f, -1.f, base, smem);
        conv_tiles<0>(p.in[I_RW_WR], 1024, 1024, 1024, B1, 2048, 1024, 0, mix + 0 * 1024, 0.f, 0.5f, base, smem);
        conv_tiles<0>(p.in[I_RW_WK], 1024, 1024, 1024, B1, 2048, 0, 1024, mix + 2 * 1024, 1.f, -1.f, base, smem);
        conv_tiles<0>(p.in[I_RW_WK], 1024, 1024, 1024, B1, 2048, 1024, 1024, mix + 2 * 1024, 0.f, 0.5f, base, smem);
        conv_tiles<0>(p.in[I_RW_WV], 1024, 1024, 1024, B1, 2048, 0, 2048, mix + 3 * 1024, 1.f, -1.f, base, smem);
        conv_tiles<0>(p.in[I_RW_WV], 1024, 1024, 1024, B1, 2048, 1024, 2048, mix + 3 * 1024, 0.f, 0.5f, base, smem);
        conv_tiles<0>(p.in[I_RW_G1], 1024, 128, 128, B1, 2048, 0, 3072, mix + 5 * 1024, 1.f, -1.f, base, smem);
        conv_tiles<0>(p.in[I_RW_G1], 1024, 128, 128, B1, 2048, 1024, 3072, mix + 5 * 1024, 0.f, 0.5f, base, smem);
        for (int z = 0; z < 2; ++z) {
            conv_tiles<0>(p.in[I_RW_W1] + (size_t)z * 1024 * 64, 1024, 64, 64, B1, 2048, 0, 3200 + 64 * z, mix + 1 * 1024, 1.f, -1.f, base, smem);
            conv_tiles<0>(p.in[I_RW_W1] + (size_t)z * 1024 * 64, 1024, 64, 64, B1, 2048, 1024, 3200 + 64 * z, mix + 1 * 1024, 0.f, 0.5f, base, smem);
            conv_tiles<0>(p.in[I_RW_A1] + (size_t)z * 1024 * 64, 1024, 64, 64, B1, 2048, 0, 3328 + 64 * z, mix + 4 * 1024, 1.f, -1.f, base, smem);
            conv_tiles<0>(p.in[I_RW_A1] + (size_t)z * 1024 * 64, 1024, 64, 64, B1, 2048, 1024, 3328 + 64 * z, mix + 4 * 1024, 0.f, 0.5f, base, smem);
        }
        zero_bf16(B1 + (size_t)3456 * 2048, (long)128 * 2048 / 8);
        bf16_t* B2 = W + W_RW_B2;
        conv_tiles<0>(p.in[I_RW_G2], 128, 1024, 1024, B2, 384, 0, 0, nullptr, 0.f, 0.f, base, smem);
        for (int z = 0; z < 2; ++z) {
            conv_tiles<0>(p.in[I_RW_W2] + (size_t)z * 64 * 1024, 64, 1024, 1024, B2, 384, 128 + 64 * z, 1024 + 1024 * z, nullptr, 0.f, 0.f, base, smem);
            conv_tiles<0>(p.in[I_RW_A2] + (size_t)z * 64 * 1024, 64, 1024, 1024, B2, 384, 256 + 64 * z, 3072 + 1024 * z, nullptr, 0.f, 0.f, base, smem);
        }
        conv_tiles<0>(p.in[I_RW_WO], 1024, 1024, 1024, W + W_RW_WO, 1024, 0, 0, nullptr, 0.f, 0.f, base, smem);
    }
    conv_tiles<0>(p.in[I_MLA_WDOWN], 1024, 672, 768, W + W_MLA_DOWN, 1024, 0, 0, nullptr, 0.f, 0.f, base, smem);
    conv_tiles<0>(p.in[I_MLA_WUQ], 384, 1536, 1536, W + W_MLA_UQ, 384, 0, 0, nullptr, 0.f, 0.f, base, smem);
    conv_tiles<0>(p.in[I_MLA_WUKV], 256, 2048, 2048, W + W_MLA_UKV, 256, 0, 0, nullptr, 0.f, 0.f, base, smem);
    conv_tiles<0>(p.in[I_MLA_WO], 1024, 1024, 1024, W + W_MLA_WO, 1024, 0, 0, nullptr, 0.f, 0.f, base, smem);
    conv_tiles<3>(p.in[I_SWA_WQKV], 1024, 1536, 1536, W + W_SWA_QKV, 1024, 0, 0, nullptr, 0.f, 0.f, base, smem);
    conv_tiles<0>(p.in[I_SWA_WO], 1024, 1024, 1024, W + W_SWA_WO, 1024, 0, 0, nullptr, 0.f, 0.f, base, smem);
    conv_moe_layer(p, B, 0, base, smem);
}

DI void row_load_f32(const float* row, int lane, float* v) {
#pragma unroll
    for (int i = 0; i < 4; ++i) { const f32x4 t = *(const f32x4*)(row + 256 * i + 4 * lane); v[4 * i] = t[0]; v[4 * i + 1] = t[1]; v[4 * i + 2] = t[2]; v[4 * i + 3] = t[3]; }
}
DI void row_store_bf16(bf16_t* row, int lane, const float* v) {
#pragma unroll
    for (int i = 0; i < 4; ++i) { u32x2 t; t.x = pk2(v[4 * i], v[4 * i + 1]); t.y = pk2(v[4 * i + 2], v[4 * i + 3]); *(u32x2*)(row + 256 * i + 4 * lane) = t; }
}
DI void norm_mod_row(const float* xrow, const float* gain, const float* shift, const float* scale, int lane, float* h) {
    float x[16], gg[16], sh[16], sc[16];
    row_load_f32(xrow, lane, x); row_load_f32(gain, lane, gg); row_load_f32(shift, lane, sh); row_load_f32(scale, lane, sc);
    float ss = 0.f;
#pragma unroll
    for (int e = 0; e < 16; ++e) ss += x[e] * x[e];
    ss = wave_sum(ss);
    const float r = rsqrtf(ss * (1.0f / 1024.0f) + 1e-6f);
#pragma unroll
    for (int e = 0; e < 16; ++e) h[e] = x[e] * r * gg[e] * (1.0f + sc[e]) + sh[e];
}

DI void phase_norm1(const Params& p, const Bufs& B, int layer, bf16_t* H) {
    const int lane = TIDX() & 63, gw = blockIdx.x * 8 + (TIDX() >> 6), nw = gridDim.x * 8;
    const float* gain = p.in[I_N1G] + layer * 1024;
    for (int g = gw; g < TT; g += nw) {
        const float* md = B.MOD + ((size_t)layer * 9 + modrow_of(g)) * 6144;
        float h[16];
        const float* xrow = (layer == 0) ? ((g < TL) ? p.in[I_X] + (size_t)g * 1024 : p.in[I_CTX] + (size_t)(g - TL) * 1024) : (B.X + (size_t)g * 1024);
        norm_mod_row(xrow, gain, md, md + 1024, lane, h);
        row_store_bf16(H + (size_t)g * 1024, lane, h);
    }
}
DI void phase_norm1_rw(const Params& p, const Bufs& B, int layer, bf16_t* H2) {
    const int lane = TIDX() & 63, gw = blockIdx.x * 8 + (TIDX() >> 6), nw = gridDim.x * 8;
    const float* gain = p.in[I_N1G] + layer * 1024;
    for (int g = gw; g < TT; g += nw) {
        const float* md = B.MOD + ((size_t)layer * 9 + modrow_of(g)) * 6144;
        const int t = (g < TL) ? (g & 4095) : ((g - TL) & 255);
        const int len = (g < TL) ? 4096 : 256;
        float h[16], hp[16], hn[16];
        norm_mod_row(B.X + (size_t)g * 1024, gain, md, md + 1024, lane, h);
        if (t > 0) norm_mod_row(B.X + (size_t)(g - 1) * 1024, gain, md, md + 1024, lane, hp);
        else {
#pragma unroll
            for (int e = 0; e < 16; ++e) hp[e] = 0.f;
        }
        if (t < len - 1) norm_mod_row(B.X + (size_t)(g + 1) * 1024, gain, md, md + 1024, lane, hn);
        else {
#pragma unroll
            for (int e = 0; e < 16; ++e) hn[e] = 0.f;
        }
#pragma unroll
        for (int e = 0; e < 16; ++e) hp[e] += hn[e];
        row_store_bf16(H2 + (size_t)g * 2048, lane, h);
        row_store_bf16(H2 + (size_t)g * 2048 + 1024, lane, hp);
    }
}
template <int CTRL> DI float dpp_mv(float x) { return __int_as_float(__builtin_amdgcn_update_dpp(0, __float_as_int(x), CTRL, 0xf, 0xf, false)); }
DI float lx_xor1(float x) { return dpp_mv<0xB1>(x); }
DI float lx_xor2(float x) { return dpp_mv<0x4E>(x); }
DI float lx_xor4(float x) { return dpp_mv<0x1B>(dpp_mv<0x141>(x)); }
DI float lx_xor8(float x) { return dpp_mv<0x128>(x); }
DI float fold32(float p, float q) { auto r = __builtin_amdgcn_permlane32_swap(__float_as_uint(p), __float_as_uint(q), false, false); return __uint_as_float(r[0]) + __uint_as_float(r[1]); }
DI float fold16(float p, float q) { auto r = __builtin_amdgcn_permlane16_swap(__float_as_uint(p), __float_as_uint(q), false, false); return __uint_as_float(r[0]) + __uint_as_float(r[1]); }
DI float wsum_fast(float x) {
    x += lx_xor1(x); x += lx_xor2(x); x += dpp_mv<0x141>(x); x += dpp_mv<0x140>(x);
    const int xi = __float_as_int(x);
    return (__int_as_float(__builtin_amdgcn_readlane(xi, 0)) + __int_as_float(__builtin_amdgcn_readlane(xi, 16))) + (__int_as_float(__builtin_amdgcn_readlane(xi, 32)) + __int_as_float(__builtin_amdgcn_readlane(xi, 48)));
}
DI void norm2_token(const float* x, const float* A, const float* Bv, const float* wr, int g, int lane, bf16_t* H, const Bufs& B) {
    float ss = 0.f;
#pragma unroll
    for (int e = 0; e < 16; ++e) ss += x[e] * x[e];
    ss = wsum_fast(ss);
    const float r = rsqrtf(ss * (1.0f / 1024.0f) + 1e-6f);
    float h[16];
#pragma unroll
    for (int e = 0; e < 16; ++e) h[e] = x[e] * r * A[e] + Bv[e];
    row_store_bf16(H + (size_t)g * 1024, lane, h);
    float a[16];
#pragma unroll
    for (int e = 0; e < 16; ++e) {
        float acc = 0.f;
#pragma unroll
        for (int i = 0; i < 4; ++i) { const f32x4 w4 = *(const f32x4*)(wr + e * 1024 + 256 * i + 4 * lane); acc += h[4 * i] * w4[0] + h[4 * i + 1] * w4[1] + h[4 * i + 2] * w4[2] + h[4 * i + 3] * w4[3]; }
        a[e] = acc;
        if ((e & 3) == 3) asm volatile("" ::: "memory");
    }
    float b8[8], c4[4], d2[2];
    const bool h8 = (lane & 8) != 0, h4 = (lane & 4) != 0;
#pragma unroll
    for (int e = 0; e < 8; ++e) b8[e] = fold32(a[e], a[e + 8]);
#pragma unroll
    for (int e = 0; e < 4; ++e) c4[e] = fold16(b8[e], b8[e + 4]);
#pragma unroll
    for (int e = 0; e < 2; ++e) { const float send = h8 ? c4[e] : c4[e + 2], keep = h8 ? c4[e + 2] : c4[e]; d2[e] = keep + lx_xor8(send); }
    float lg;
    { const float send = h4 ? d2[0] : d2[1], keep = h4 ? d2[1] : d2[0]; lg = keep + lx_xor4(send); }
    lg += lx_xor2(lg); lg += lx_xor1(lg);
    float mx = lg;
    mx = fmaxf(mx, lx_xor4(mx)); mx = fmaxf(mx, lx_xor8(mx));
    { auto r = __builtin_amdgcn_permlane16_swap(__float_as_uint(mx), __float_as_uint(mx), false, false); mx = fmaxf(__uint_as_float(r[0]), __uint_as_float(r[1])); }
    { auto r = __builtin_amdgcn_permlane32_swap(__float_as_uint(mx), __float_as_uint(mx), false, false); mx = fmaxf(__uint_as_float(r[0]), __uint_as_float(r[1])); }
    const float ex = __expf(lg - mx);
    float se = ex;
    se += lx_xor4(se); se += lx_xor8(se);
    se = fold16(se, se); se = fold32(se, se);
    const float aff = ex / se;
    if ((lane & 3) == 0) {
        const int e = lane >> 2;
        if (g < TL) B.AFF[((size_t)(g >> 12) * 16 + e) * 4096 + (g & 4095)] = aff;
        else { const int gc = g - TL; B.AFFC[((size_t)(gc >> 8) * 16 + e) * 256 + (gc & 255)] = aff; }
        B.INV[(size_t)g * 16 + e] = -1;
    }
}
DI void phase_norm2(const Params& p, const Bufs& B, int layer, bf16_t* H, int ntok, char* smem) {
    float* wr = (float*)smem;
    const float* rsrc = p.in[I_MOE_ROUTER] + (size_t)layer * 1024 * 16;
    for (int i = TIDX(); i < 1024 * 16; i += NTHR) { const int k = i >> 4, e = i & 15; wr[e * 1024 + k] = rsrc[i]; }
    __syncthreads();
    const int lane = TIDX() & 63, gw = blockIdx.x * 8 + (TIDX() >> 6);
    float gain[16];
    row_load_f32(p.in[I_N2G] + layer * 1024, lane, gain);
    const int nr = (ntok > TL) ? 9 : 8;
    float x0[16], x1[16];
    row_load_f32(B.X + (size_t)gw * 1024, lane, x0); row_load_f32(B.X + (size_t)(gw + 2048) * 1024, lane, x1);
    for (int r = 0; r < nr; ++r) {
        float n0[16], n1[16];
        if (r + 1 < nr) {
            const int gb = (r + 1 < 8) ? (r + 1) * 4096 : TL;
            row_load_f32(B.X + (size_t)(gb + gw) * 1024, lane, n0);
            if (r + 1 < 8) row_load_f32(B.X + (size_t)(gb + gw + 2048) * 1024, lane, n1);
        }
        const float* md = B.MOD + ((size_t)layer * 9 + r) * 6144;
        float A[16], Bv[16];
        row_load_f32(md + 4 * 1024, lane, A); row_load_f32(md + 3 * 1024, lane, Bv);
#pragma unroll
        for (int e = 0; e < 16; ++e) A[e] = gain[e] * (1.0f + A[e]);
        const int gb = (r < 8) ? r * 4096 : TL;
        norm2_token(x0, A, Bv, wr, gb + gw, lane, H, B);
        if (r < 8) norm2_token(x1, A, Bv, wr, gb + gw + 2048, lane, H, B);
#pragma unroll
        for (int e = 0; e < 16; ++e) { x0[e] = n0[e]; x1[e] = n1[e]; }
    }
}

DI void ld16(const bf16_t* p, float* v) { unpack8(*(const u32x4*)p, v); unpack8(*(const u32x4*)(p + 8), v + 8); }
DI void st16(bf16_t* p, const float* v) { *(u32x4*)p = pack8(v); *(u32x4*)(p + 8) = pack8(v + 8); }
DI void headnorm64(float* v, const float* gain, int p) {
    float ss = 0.f;
#pragma unroll
    for (int e = 0; e < 16; ++e) ss += v[e] * v[e];
    ss += __shfl_xor(ss, 1); ss += __shfl_xor(ss, 2);
    const float r = rsqrtf(ss * (1.0f / 64.0f) + 1e-6f);
#pragma unroll
    for (int e = 0; e < 16; ++e) v[e] = v[e] * r * gain[16 * p + e];
}
DI void rope64(float* v, const float* cs, const float* sn, int p) {
    const int i0 = 16 * (p & 1);
#pragma unroll
    for (int e = 0; e < 16; ++e) {
        const float o = __shfl_xor(v[e], 2), c = cs[i0 + e], s = sn[i0 + e];
        v[e] = (p < 2) ? (v[e] * c - o * s) : (v[e] * c + o * s);
    }
}

DI void phase_qknorm_na(const Params& p, bf16_t* QKV) {
    const int lane = TIDX() & 63, gw = blockIdx.x * 8 + (TIDX() >> 6), nw = gridDim.x * 8, pp = lane & 3;
    const float* qg = p.in[I_NA_QG]; const float* kg = p.in[I_NA_KG];
    for (int g = gw; g < TT; g += nw) {
        bf16_t* row = QKV + (size_t)g * 3072 + 16 * lane;
        float v[16];
        ld16(row, v); headnorm64(v, qg, pp); st16(row, v);
        ld16(row + 1024, v); headnorm64(v, kg, pp); st16(row + 1024, v);
    }
}
DI void phase_qknorm_swa(const Params& p, const Bufs& B, bf16_t* QKV) {
    const int lane = TIDX() & 63, gw = blockIdx.x * 8 + (TIDX() >> 6), nw = gridDim.x * 8, pp = lane & 3;
    const float* qg = p.in[I_SWA_QG]; const float* kg = p.in[I_SWA_KG];
    for (int g = gw; g < TT; g += nw) {
        bf16_t* row = QKV + (size_t)g * 1536;
        const bool lat = g < TL;
        const int pos = g & 4095;
        const float* cs = B.ROPE_S + (size_t)(lat ? pos : 0) * 32; const float* sn = cs + 4096 * 32;
        float v[16];
        ld16(row + 16 * lane, v); headnorm64(v, qg, pp);
        if (lat) rope64(v, cs, sn, pp);
        st16(row + 16 * lane, v);
        const int kl = lane & 15;
        ld16(row + 1024 + 16 * kl, v); headnorm64(v, kg, pp);
        if (lat) rope64(v, cs, sn, pp);
        if (lane < 16) st16(row + 1024 + 16 * kl, v);
    }
}
DI void phase_mla_dnorm(const Params& p, const Bufs& B, const bf16_t* DOWN, bf16_t* CQ, bf16_t* CKV, bf16_t* KR) {
    const int lane = TIDX() & 63, gw = blockIdx.x * 8 + (TIDX() >> 6), nw = gridDim.x * 8;
    float gq[6], gkv[4];
#pragma unroll
    for (int e = 0; e < 6; ++e) gq[e] = p.in[I_MLA_QNG][6 * lane + e];
#pragma unroll
    for (int e = 0; e < 4; ++e) gkv[e] = p.in[I_MLA_KVNG][4 * lane + e];
    const int l31 = lane & 31;
    const float gkr = p.in[I_MLA_KR_G][l31];
    for (int g = gw; g < TT; g += nw) {
        const bf16_t* d = DOWN + (size_t)g * 768;
        const unsigned q0 = *(const unsigned*)(d + 6 * lane), q1 = *(const unsigned*)(d + 6 * lane + 2), q2 = *(const unsigned*)(d + 6 * lane + 4);
        const u32x2 kv = *(const u32x2*)(d + 384 + 4 * lane);
        const unsigned short krw = d[640 + l31];
        float a[6] = {bflo(q0), bfhi(q0), bflo(q1), bfhi(q1), bflo(q2), bfhi(q2)};
        float ss = 0.f;
#pragma unroll
        for (int e = 0; e < 6; ++e) ss += a[e] * a[e];
        ss = wave_sum(ss);
        float r = rsqrtf(ss * (1.0f / 384.0f) + 1e-6f);
        bf16_t* cq = CQ + (size_t)g * 384 + 6 * lane;
        *(unsigned*)(cq) = pk2(a[0] * r * gq[0], a[1] * r * gq[1]); *(unsigned*)(cq + 2) = pk2(a[2] * r * gq[2], a[3] * r * gq[3]); *(unsigned*)(cq + 4) = pk2(a[4] * r * gq[4], a[5] * r * gq[5]);
        float c[4] = {bflo(kv.x), bfhi(kv.x), bflo(kv.y), bfhi(kv.y)};
        ss = (c[0] * c[0] + c[1] * c[1]) + (c[2] * c[2] + c[3] * c[3]);
        ss = wave_sum(ss);
        r = rsqrtf(ss * (1.0f / 256.0f) + 1e-6f);
        u32x2 o; o.x = pk2(c[0] * r * gkv[0], c[1] * r * gkv[1]); o.y = pk2(c[2] * r * gkv[2], c[3] * r * gkv[3]);
        *(u32x2*)(CKV + (size_t)g * 256 + 4 * lane) = o;
        float x = (lane < 32) ? bf2f(krw) : 0.f;
        ss = wave_sum(x * x);
        r = rsqrtf(ss * (1.0f / 32.0f) + 1e-6f);
        x = x * r * gkr;
        const float ox = __shfl_xor(x, 16);
        if (g < TL) {
            const int pos = g & 4095, ii = lane & 15;
            const float cc = B.ROPE_M[pos * 16 + ii], sn = B.ROPE_M[4096 * 16 + pos * 16 + ii];
            x = (l31 < 16) ? (x * cc - ox * sn) : (x * cc + ox * sn);
        }
        if (lane < 32) KR[(size_t)g * 32 + lane] = (bf16_t)f2bf(x);
    }
}
DI void phase_mla_hnorm(const Params& p, const Bufs& B, bf16_t* Q, bf16_t* KV) {
    const int lane = TIDX() & 63, gw = blockIdx.x * 8 + (TIDX() >> 6), nw = gridDim.x * 8, pp = lane & 3, hh = lane >> 2;
    const float* qng = p.in[I_MLA_QN_G]; const float* qrg = p.in[I_MLA_QR_G]; const float* kng = p.in[I_MLA_KN_G];
    for (int g = gw; g < TT; g += nw) {
        bf16_t* q = Q + (size_t)g * 1536 + hh * 96;
        float v[16];
        ld16(q + 16 * pp, v); headnorm64(v, qng, pp); st16(q + 16 * pp, v);
        float w[8];
        unpack8(*(const u32x4*)(q + 64 + 8 * pp), w);
        float ss = 0.f;
#pragma unroll
        for (int e = 0; e < 8; ++e) ss += w[e] * w[e];
        ss += __shfl_xor(ss, 1); ss += __shfl_xor(ss, 2);
        const float r = rsqrtf(ss * (1.0f / 32.0f) + 1e-6f);
#pragma unroll
        for (int e = 0; e < 8; ++e) w[e] = w[e] * r * qrg[8 * pp + e];
        if (g < TL) {
            const int pos = g & 4095, i0 = 8 * (pp & 1);
#pragma unroll
            for (int e = 0; e < 8; ++e) {
                const float o = __shfl_xor(w[e], 2), c = B.ROPE_M[pos * 16 + i0 + e], s = B.ROPE_M[4096 * 16 + pos * 16 + i0 + e];
                w[e] = (pp < 2) ? (w[e] * c - o * s) : (w[e] * c + o * s);
            }
        }
        *(u32x4*)(q + 64 + 8 * pp) = pack8(w);
        bf16_t* k = KV + (size_t)g * 2048 + hh * 128 + 16 * pp;
        ld16(k, v); headnorm64(v, kng, pp); st16(k, v);
    }
}

typedef short v4i16_t __attribute__((ext_vector_type(4)));
DI s16x4 tr_read(const bf16_t* p) { return __builtin_bit_cast(s16x4, __builtin_amdgcn_ds_read_tr16_b64_v4i16((LAS v4i16_t*)(LAS char*)(char*)p)); }
constexpr int ATT_LDS = 64 * 104 * 2 + 64 * 72 * 2 + 2048;

template <class P>
DI void attn_unit(const P& pol, char* smem) {
    constexpr int DQK = P::DQK, KS = DQK + 8, VS = 72, NS = DQK / 32, NCH = DQK / 8;
    bf16_t* Ks = (bf16_t*)smem;
    bf16_t* Vs = (bf16_t*)(smem + 64 * 104 * 2);
    const int tid = TIDX(), lane = tid & 63, w = tid >> 6, l15 = lane & 15, quad = lane >> 4;
    const int q = w * 16 + l15;
    __syncthreads();
    pol.prologue(smem + 64 * 104 * 2 + 64 * 72 * 2);
    bf16x8 qf[NS];
#pragma unroll
    for (int s = 0; s < NS; ++s) qf[s] = *(const bf16x8*)pol.qptr(q, s * 4 + quad);
    f32x4 o[4];
#pragma unroll
    for (int u = 0; u < 4; ++u) o[u] = (f32x4){0.f, 0.f, 0.f, 0.f};
    float m = -1e30f, l = 0.f;
    const int k0key = (DQK == 64) ? (tid >> 3) : (tid / 12), k0ch = (DQK == 64) ? (tid & 7) : (tid % 12);
    const int k1key = (tid + 512) / 12, k1ch = (tid + 512) % 12;
    const bool k1on = (DQK == 96) && (tid < 256);
    const int vkey = tid >> 3, vch = tid & 7;
    const int nt = pol.ntiles();
    u32x4 rk0, rk1 = (u32x4){0u, 0u, 0u, 0u}, rv;
    rk0 = *(const u32x4*)pol.kptr(0, k0key, k0ch);
    if (k1on) rk1 = *(const u32x4*)pol.kptr(0, k1key, k1ch);
    rv = *(const u32x4*)pol.vptr(0, vkey, vch);
    *(u32x4*)(Ks + k0key * KS + k0ch * 8) = rk0;
    if (k1on) *(u32x4*)(Ks + k1key * KS + k1ch * 8) = rk1;
    *(u32x4*)(Vs + vkey * VS + vch * 8) = rv;
    __syncthreads();
    for (int j = 0; j < nt; ++j) {
        const bool more = (j + 1 < nt);
        if (more) {
            rk0 = *(const u32x4*)pol.kptr(j + 1, k0key, k0ch);
            if (k1on) rk1 = *(const u32x4*)pol.kptr(j + 1, k1key, k1ch);
            rv = *(const u32x4*)pol.vptr(j + 1, vkey, vch);
        }
        f32x4 sc[2][2];
#pragma unroll
        for (int g = 0; g < 2; ++g)
#pragma unroll
            for (int t = 0; t < 2; ++t) {
                f32x4 a = (f32x4){0.f, 0.f, 0.f, 0.f};
                const int key = 32 * g + 8 * (l15 >> 2) + 4 * t + (l15 & 3);
#pragma unroll
                for (int s = 0; s < NS; ++s) { const bf16x8 kf = *(const bf16x8*)(Ks + key * KS + 32 * s + 8 * quad); a = __builtin_amdgcn_mfma_f32_16x16x32_bf16(kf, qf[s], a, 0, 0, 0); }
                sc[g][t] = a;
            }
        float tmax = -3.0e38f;
#pragma unroll
        for (int g = 0; g < 2; ++g)
#pragma unroll
            for (int t = 0; t < 2; ++t)
#pragma unroll
                for (int r = 0; r < 4; ++r) { const float s2 = pol.mod(sc[g][t][r] * pol.c2, q, j, 32 * g + 8 * quad + 4 * t + r); sc[g][t][r] = s2; tmax = fmaxf(tmax, s2); }
        tmax = fmaxf(tmax, __shfl_xor(tmax, 16)); tmax = fmaxf(tmax, __shfl_xor(tmax, 32));
        const float mn = fmaxf(m, tmax), alpha = fexp2(m - mn);
        m = mn;
        float ps = 0.f;
        bf16x8 pf[2];
#pragma unroll
        for (int g = 0; g < 2; ++g) {
            float pv[8];
#pragma unroll
            for (int t = 0; t < 2; ++t)
#pragma unroll
                for (int r = 0; r < 4; ++r) { const float e = fexp2(sc[g][t][r] - mn); ps += e; pv[4 * t + r] = e; }
            pf[g] = __builtin_bit_cast(bf16x8, pack8(pv));
        }
        l = l * alpha + ps;
#pragma unroll
        for (int u = 0; u < 4; ++u) o[u] *= alpha;
#pragma unroll
        for (int u = 0; u < 4; ++u)
#pragma unroll
            for (int g = 0; g < 2; ++g) {
                const bf16_t* vb = Vs + (32 * g + 8 * quad + (l15 >> 2)) * VS + 16 * u + 4 * (l15 & 3);
                const s16x4 lo = tr_read(vb), hi = tr_read(vb + 4 * VS);
                bf16x8 vf; vf[0] = lo[0]; vf[1] = lo[1]; vf[2] = lo[2]; vf[3] = lo[3]; vf[4] = hi[0]; vf[5] = hi[1]; vf[6] = hi[2]; vf[7] = hi[3];
                o[u] = __builtin_amdgcn_mfma_f32_16x16x32_bf16(vf, pf[g], o[u], 0, 0, 0);
            }
        __syncthreads();
        if (more) {
            *(u32x4*)(Ks + k0key * KS + k0ch * 8) = rk0;
            if (k1on) *(u32x4*)(Ks + k1key * KS + k1ch * 8) = rk1;
            *(u32x4*)(Vs + vkey * VS + vch * 8) = rv;
        }
        __syncthreads();
    }
    l += __shfl_xor(l, 16); l += __shfl_xor(l, 32);
    if (P::SINK) l += fexp2(pol.sink2 - m);
    const float il = 1.0f / l;
    bf16_t* op = pol.optr(q);
#pragma unroll
    for (int u = 0; u < 4; ++u) st_bf16x4(op + 16 * u + 4 * quad, o[u] * il);
}

struct PolPlain64 {
    static constexpr int DQK = 64; static constexpr bool SINK = false;
    const bf16_t* Qb; long qs; const bf16_t* Kb; long ks; const bf16_t* Vb; long vs; bf16_t* Ob; long os; int qrow0, krow0, nt; float c2, sink2;
    DI void prologue(char*) const {}
    DI int ntiles() const { return nt; }
    DI const bf16_t* qptr(int q, int ch) const { return Qb + (long)(qrow0 + q) * qs + ch * 8; }
    DI const bf16_t* kptr(int j, int i, int ch) const { return Kb + (long)(krow0 + 64 * j + i) * ks + ch * 8; }
    DI const bf16_t* vptr(int j, int i, int ch) const { return Vb + (long)(krow0 + 64 * j + i) * vs + ch * 8; }
    DI float mod(float s2, int, int, int) const { return s2; }
    DI bf16_t* optr(int q) const { return Ob + (long)(qrow0 + q) * os; }
};
struct PolNA {
    static constexpr int DQK = 64; static constexpr bool SINK = false;
    const bf16_t* QKV; bf16_t* AO; const float* rpb; const float* bl; int b, h, rr, rbase; float c2, sink2;
    DI void prologue(char* s) const { float* t = (float*)s; for (int i = TIDX(); i < 465; i += NTHR) t[i] = rpb[h * 465 + i] * LOG2E; }
    DI int ntiles() const { return 13; }
    DI int qtok(int q) const { return b * 4096 + (2 * rr + (q >> 6)) * 64 + (q & 63); }
    DI int ktok(int j, int i) const { if (j < 4) return TL + b * 256 + 64 * j + i; int kr = rbase + j - 4; kr = kr > 63 ? 63 : kr; return b * 4096 + kr * 64 + i; }
    DI const bf16_t* qptr(int q, int ch) const { return QKV + (long)qtok(q) * 3072 + h * 64 + ch * 8; }
    DI const bf16_t* kptr(int j, int i, int ch) const { return QKV + (long)ktok(j, i) * 3072 + 1024 + h * 64 + ch * 8; }
    DI const bf16_t* vptr(int j, int i, int ch) const { return QKV + (long)ktok(j, i) * 3072 + 2048 + h * 64 + ch * 8; }
    DI float mod(float s2, int q, int j, int kc) const {
        if (j < 4) return s2;
        const int kr = rbase + j - 4, qr = 2 * rr + (q >> 6), qc = q & 63;
        int r0 = qr - 4; r0 = r0 < 0 ? 0 : (r0 > 56 ? 56 : r0);
        int c0 = qc - 8; c0 = c0 < 0 ? 0 : (c0 > 48 ? 48 : c0);
        const bool ok = (kr >= r0) && (kr <= r0 + 7) && (kc >= c0) && (kc < c0 + 16);
        const int idx = ok ? ((kr - qr + 7) * 31 + (kc - qc + 15)) : 0;
        return ok ? (s2 + bl[idx]) : -1e30f;
    }
    DI bf16_t* optr(int q) const { return AO + (long)qtok(q) * 1024 + h * 64; }
};
struct PolMLA {
    static constexpr int DQK = 96; static constexpr bool SINK = false;
    const bf16_t* Q; const bf16_t* KV; const bf16_t* KR; bf16_t* AO; int b, h, qrow0, nt; float c2, sink2;
    DI void prologue(char*) const {}
    DI int ntiles() const { return nt; }
    DI int ktok(int j, int i) const { return (j < 4) ? (TL + b * 256 + 64 * j + i) : (b * 4096 + 64 * (j - 4) + i); }
    DI const bf16_t* qptr(int q, int ch) const { return Q + (long)(qrow0 + q) * 1536 + h * 96 + ch * 8; }
    DI const bf16_t* kptr(int j, int i, int ch) const { const long t = ktok(j, i); return (ch < 8) ? (KV + t * 2048 + h * 128 + ch * 8) : (KR + t * 32 + (ch - 8) * 8); }
    DI const bf16_t* vptr(int j, int i, int ch) const { return KV + (long)ktok(j, i) * 2048 + h * 128 + 64 + ch * 8; }
    DI float mod(float s2, int, int, int) const { return s2; }
    DI bf16_t* optr(int q) const { return AO + (long)(qrow0 + q) * 1024 + h * 64; }
};
struct PolSWA {
    static constexpr int DQK = 64; static constexpr bool SINK = true;
    const bf16_t* QKV; bf16_t* AO; int b, hq, s0; float c2, sink2;
    DI void prologue(char*) const {}
    DI int ntiles() const { return 10; }
    DI int ktok(int j, int i) const { if (j < 4) return TL + b * 256 + 64 * j + i; int kp = s0 - 128 + 64 * (j - 4) + i; kp = kp < 0 ? 0 : (kp > 4095 ? 4095 : kp); return b * 4096 + kp; }
    DI const bf16_t* qptr(int q, int ch) const { return QKV + (long)(b * 4096 + s0 + q) * 1536 + hq * 64 + ch * 8; }
    DI const bf16_t* kptr(int j, int i, int ch) const { return QKV + (long)ktok(j, i) * 1536 + 1024 + (hq >> 2) * 64 + ch * 8; }
    DI const bf16_t* vptr(int j, int i, int ch) const { return QKV + (long)ktok(j, i) * 1536 + 1280 + (hq >> 2) * 64 + ch * 8; }
    DI float mod(float s2, int q, int j, int kc) const {
        if (j < 4) return s2;
        const int kp = s0 - 128 + 64 * (j - 4) + kc, qp = s0 + q, d = qp - kp;
        const bool ok = (kp >= 0) && (kp < 4096) && (d <= 128) && (d >= -128);
        return ok ? s2 : -1e30f;
    }
    DI bf16_t* optr(int q) const { return AO + (long)(b * 4096 + s0 + q) * 1024 + hq * 64; }
};

DI float ftanh(float x) { return 2.0f * fsigmoid(2.0f * x) - 1.0f; }
struct EpiRW1 { bf16_t* RKV; bf16_t* LORA;
    DI f32x4 act(f32x4 a, int lc) const {
        f32x4 r;
#pragma unroll
        for (int i = 0; i < 4; ++i) r[i] = (lc < 128) ? fsigmoid(a[i]) : ((lc < 256) ? ftanh(a[i]) : a[i]);
        return r; }
    DI void operator()(int row, int col, f32x4 a0, f32x4 a1) const {
        if (col < 3072) { bf16_t* p = RKV + (long)row * 3072 + col; st_bf16x4(p, a0); st_bf16x4(p + 16, a1); }
        else if (col < 3456) { const int lc = col - 3072; bf16_t* p = LORA + (long)row * 384 + lc; st_bf16x4(p, act(a0, lc)); st_bf16x4(p + 16, act(a1, lc)); }
    } };
struct EpiRW2 { int seg; bf16_t* O; const float* bias;
    DI f32x4 f(f32x4 a, const float* bp) const {
        f32x4 r;
#pragma unroll
        for (int i = 0; i < 4; ++i) { const float t = fsigmoid(a[i] + bp[i]); r[i] = (seg < 3) ? 0.6065306597126334f * t : t; }
        return r; }
    DI void operator()(int row, int col, f32x4 a0, f32x4 a1) const {
        const int n = col - 1024 * seg; bf16_t* p = O + (long)row * 1024 + n;
        if (seg == 0) { st_bf16x4(p, a0); st_bf16x4(p + 16, a1); }
        else { st_bf16x4(p, f(a0, bias + n)); st_bf16x4(p + 16, f(a1, bias + n + 16)); }
    } };

DI void phase_rw_gemm2(const Params& p, const Bufs& B, const bf16_t* LORA, bf16_t* G, bf16_t* XD0, bf16_t* XD1, bf16_t* AA0, bf16_t* AA1, char* smem) {
    const int ntm = TT >> 7, nt = ntm * 40;
    for (int t = blockIdx.x; t < nt; t += gridDim.x) {
        const int tm = t / 40, tn = t % 40, seg = tn >> 3;
        GemmOp g; g.A = LORA; g.lda = 384; g.Bt = B.WMIX + W_RW_B2; g.ldb = 384;
        g.kbeg = (seg == 0) ? 0 : (64 + 64 * seg); g.kend = (seg == 0) ? 128 : (128 + 64 * seg);
        EpiRW2 e; e.seg = seg;
        e.O = (seg == 0) ? G : (seg == 1 ? XD0 : (seg == 2 ? XD1 : (seg == 3 ? AA0 : AA1)));
        e.bias = (seg == 0) ? nullptr : ((seg < 3) ? p.in[I_RW_W0] + (seg - 1) * 1024 : p.in[I_RW_A0] + (seg - 3) * 1024);
        gemm_tile(g, tm * 128, tn * 128, e, smem);
    }
}

template <int CTRL> DI float dppmov(float x) { return __int_as_float(__builtin_amdgcn_update_dpp(0, __float_as_int(x), CTRL, 0xf, 0xf, false)); }
DI float red8(float x) { x += dppmov<0xB1>(x); x += dppmov<0x4E>(x); x += dppmov<0x141>(x); return x; }
DI float wave_sum_dpp(float x) {
    x += dppmov<0xB1>(x); x += dppmov<0x4E>(x); x += dppmov<0x141>(x); x += dppmov<0x140>(x);
    const int xi = __float_as_int(x);
    const float s0 = __int_as_float(__builtin_amdgcn_readlane(xi, 0)), s1 = __int_as_float(__builtin_amdgcn_readlane(xi, 16)), s2 = __int_as_float(__builtin_amdgcn_readlane(xi, 32)), s3 = __int_as_float(__builtin_amdgcn_readlane(xi, 48));
    return (s0 + s1) + (s2 + s3);
}

constexpr int SCAN_LDS = 32 * 384 * 4 + 32 * 64 * 4;
DI void phase_rw_scan(const Params& p, const bf16_t* RKV, const bf16_t* XD0, const bf16_t* XD1, const bf16_t* AA0, const bf16_t* AA1, bf16_t* YF, bf16_t* YB, char* smem) {
    float* vec = (float*)smem;
    float* ybuf = vec + 32 * 384;
    const int tid = TIDX(), lane = tid & 63, wv = tid >> 6, il = lane >> 3, js = lane & 7, irow = 8 * wv + il;
    const int ss = tid >> 4, jg = tid & 15;
    for (int unit = blockIdx.x; unit < 256; unit += gridDim.x) {
        const int dir = unit & 1, b = unit >> 5, h = (unit >> 1) & 15;
        const bf16_t* XD = dir ? XD1 : XD0; const bf16_t* AA = dir ? AA1 : AA0; bf16_t* Y = dir ? YB : YF;
        const f32x4 kk4 = *(const f32x4*)(p.in[I_RW_KK] + h * 64 + 4 * jg), ka4 = *(const f32x4*)(p.in[I_RW_KA] + h * 64 + 4 * jg);
        float S[8];
#pragma unroll
        for (int e = 0; e < 8; ++e) S[e] = 0.f;
        u32x2 pr, pk, pv, px, pa;
        long gcur;
        {   const int n = ss; const int t = dir ? 255 - n : n; gcur = TL + b * 256 + t;
            const long o = gcur * 3072 + h * 64 + 4 * jg, o1 = gcur * 1024 + h * 64 + 4 * jg;
            pr = *(const u32x2*)(RKV + o); pk = *(const u32x2*)(RKV + o + 1024); pv = *(const u32x2*)(RKV + o + 2048); px = *(const u32x2*)(XD + o1); pa = *(const u32x2*)(AA + o1); }
        for (int c = 0; c < 136; ++c) {
            __syncthreads();
            {
                float kf[4] = {bflo(pk.x), bfhi(pk.x), bflo(pk.y), bfhi(pk.y)};
                float af[4] = {bflo(pa.x), bfhi(pa.x), bflo(pa.y), bfhi(pa.y)};
                float xf[4] = {bflo(px.x), bfhi(px.x), bflo(px.y), bfhi(px.y)};
                f32x4 kkv, kka, kt, wv4, rv4, vv4;
                float sq = 0.f;
#pragma unroll
                for (int e = 0; e < 4; ++e) { kkv[e] = kf[e] * kk4[e]; sq += kkv[e] * kkv[e]; }
                sq += __shfl_xor(sq, 1); sq += __shfl_xor(sq, 2); sq += __shfl_xor(sq, 4); sq += __shfl_xor(sq, 8);
                const float inv = 1.0f / fmaxf(sqrtf(sq), 1e-12f);
#pragma unroll
                for (int e = 0; e < 4; ++e) { kkv[e] *= inv; kka[e] = kkv[e] * af[e]; kt[e] = kf[e] * (1.0f + (af[e] - 1.0f) * ka4[e]); wv4[e] = __expf(-xf[e]); }
                rv4 = (f32x4){bflo(pr.x), bfhi(pr.x), bflo(pr.y), bfhi(pr.y)};
                vv4 = (f32x4){bflo(pv.x), bfhi(pv.x), bflo(pv.y), bfhi(pv.y)};
                float* vb = vec + ss * 384 + 4 * jg;
                *(f32x4*)(vb) = wv4; *(f32x4*)(vb + 64) = kkv; *(f32x4*)(vb + 128) = kka; *(f32x4*)(vb + 192) = kt; *(f32x4*)(vb + 256) = rv4; *(f32x4*)(vb + 320) = vv4;
            }
            const long gthis = gcur;
            __syncthreads();
            if (c + 1 < 136) {
                const int n = (c + 1) * 32 + ss;
                if (n < 256) { const int t = dir ? 255 - n : n; gcur = TL + b * 256 + t; }
                else { const int mm = n - 256; const int t = dir ? 4095 - mm : mm; gcur = (long)b * 4096 + t; }
                const long o = gcur * 3072 + h * 64 + 4 * jg, o1 = gcur * 1024 + h * 64 + 4 * jg;
                pr = *(const u32x2*)(RKV + o); pk = *(const u32x2*)(RKV + o + 1024); pv = *(const u32x2*)(RKV + o + 2048); px = *(const u32x2*)(XD + o1); pa = *(const u32x2*)(AA + o1);
            }
            {
                typedef float f32x2 __attribute__((ext_vector_type(2)));
                float yk[4] = {0.f, 0.f, 0.f, 0.f};
                const float* vb0 = vec + 8 * js;
                f32x4 cw0 = *(const f32x4*)(vb0), cw1 = *(const f32x4*)(vb0 + 4), ck0 = *(const f32x4*)(vb0 + 64), ck1 = *(const f32x4*)(vb0 + 68);
                f32x4 ca0 = *(const f32x4*)(vb0 + 128), ca1 = *(const f32x4*)(vb0 + 132), ct0 = *(const f32x4*)(vb0 + 192), ct1 = *(const f32x4*)(vb0 + 196);
                f32x4 cr0 = *(const f32x4*)(vb0 + 256), cr1 = *(const f32x4*)(vb0 + 260);
                float cvi = vec[320 + irow];
#pragma unroll
                for (int s = 0; s < 32; ++s) {
                    f32x4 nw0 = cw0, nw1 = cw1, nk0 = ck0, nk1 = ck1, na0 = ca0, na1 = ca1, nt0 = ct0, nt1 = ct1, nr0 = cr0, nr1 = cr1; float nvi = cvi;
                    if (s + 1 < 32) {
                        const float* vb = vec + (s + 1) * 384 + 8 * js;
                        nw0 = *(const f32x4*)(vb); nw1 = *(const f32x4*)(vb + 4); nk0 = *(const f32x4*)(vb + 64); nk1 = *(const f32x4*)(vb + 68);
                        na0 = *(const f32x4*)(vb + 128); na1 = *(const f32x4*)(vb + 132); nt0 = *(const f32x4*)(vb + 192); nt1 = *(const f32x4*)(vb + 196);
                        nr0 = *(const f32x4*)(vb + 256); nr1 = *(const f32x4*)(vb + 260); nvi = vec[(s + 1) * 384 + 320 + irow];
                    }
                    f32x2 S0 = {S[0], S[1]}, S1 = {S[2], S[3]}, S2 = {S[4], S[5]}, S3 = {S[6], S[7]};
                    const f32x2 d2 = (S0 * (f32x2){ck0[0], ck0[1]} + S1 * (f32x2){ck0[2], ck0[3]}) + (S2 * (f32x2){ck1[0], ck1[1]} + S3 * (f32x2){ck1[2], ck1[3]});
                    const float sk = red8(d2.x + d2.y);
                    const f32x2 nsk = {-sk, -sk}, vv = {cvi, cvi};
                    S0 = S0 * (f32x2){cw0[0], cw0[1]} + nsk * (f32x2){ca0[0], ca0[1]} + vv * (f32x2){ct0[0], ct0[1]};
                    S1 = S1 * (f32x2){cw0[2], cw0[3]} + nsk * (f32x2){ca0[2], ca0[3]} + vv * (f32x2){ct0[2], ct0[3]};
                    S2 = S2 * (f32x2){cw1[0], cw1[1]} + nsk * (f32x2){ca1[0], ca1[1]} + vv * (f32x2){ct1[0], ct1[1]};
                    S3 = S3 * (f32x2){cw1[2], cw1[3]} + nsk * (f32x2){ca1[2], ca1[3]} + vv * (f32x2){ct1[2], ct1[3]};
                    const f32x2 y2 = (S0 * (f32x2){cr0[0], cr0[1]} + S1 * (f32x2){cr0[2], cr0[3]}) + (S2 * (f32x2){cr1[0], cr1[1]} + S3 * (f32x2){cr1[2], cr1[3]});
                    const float y = red8(y2.x + y2.y);
                    yk[s >> 3] = (js == (s & 7)) ? y : yk[s >> 3];
                    S[0] = S0.x; S[1] = S0.y; S[2] = S1.x; S[3] = S1.y; S[4] = S2.x; S[5] = S2.y; S[6] = S3.x; S[7] = S3.y;
                    cw0 = nw0; cw1 = nw1; ck0 = nk0; ck1 = nk1; ca0 = na0; ca1 = na1; ct0 = nt0; ct1 = nt1; cr0 = nr0; cr1 = nr1; cvi = nvi;
                }
#pragma unroll
                for (int k = 0; k < 4; ++k) ybuf[(8 * k + js) * 64 + irow] = yk[k];
            }
            __syncthreads();
            {
                const f32x4 yv = *(const f32x4*)(ybuf + ss * 64 + 4 * jg);
                st_bf16x4(Y + gthis * 1024 + h * 64 + 4 * jg, yv);
            }
        }
    }
}


constexpr int CS_L1 = 68, CS_L2 = 20;
constexpr int CS_AT = 0, CS_RT = 2176, CS_BL = 4352, CS_KL = 6528, CS_BH = 8704, CS_KH = 11264, CS_VT = 13824, CS_GL = 16384, CS_P1 = 16640;
constexpr int CS_NT = 0, CS_AK = 1024, CS_RB = 1664, CS_RK = 2304, CS_P2 = 2944;
constexpr int SCAN2_LDS = 3 * CS_P1 + 2 * CS_P2;
DI bf16x8 mk8(u32x2 lo, u32x2 hi) { u32x4 v; v.x = lo.x; v.y = lo.y; v.z = hi.x; v.w = hi.y; return __builtin_bit_cast(bf16x8, v); }
DI long scan_token(int b, int dir, int n) {
    if (n < 256) return (long)TL + b * 256 + (dir ? 255 - n : n);
    const int m = n - 256; return (long)b * 4096 + (dir ? 4095 - m : m);
}
struct ScanRaw { unsigned rx[16], xo[4], rk[4], rr[4], ra[4], rv[4]; };
DI unsigned ld16_async(const bf16_t* q) { unsigned r; asm volatile("global_load_ushort %0, %1, off" : "=v"(r) : "v"(q) : "memory"); return r; }
DI void scan_wait_raw(ScanRaw& R) {
    asm volatile("s_waitcnt vmcnt(36)" : "+v"(R.rx[0]), "+v"(R.rx[1]), "+v"(R.rx[2]), "+v"(R.rx[3]), "+v"(R.rx[4]), "+v"(R.rx[5]), "+v"(R.rx[6]), "+v"(R.rx[7]),
                 "+v"(R.rx[8]), "+v"(R.rx[9]), "+v"(R.rx[10]), "+v"(R.rx[11]) :: "memory");
    asm volatile("" : "+v"(R.rx[12]), "+v"(R.rx[13]), "+v"(R.rx[14]), "+v"(R.rx[15]), "+v"(R.xo[0]), "+v"(R.xo[1]), "+v"(R.xo[2]), "+v"(R.xo[3]),
                 "+v"(R.rk[0]), "+v"(R.rk[1]), "+v"(R.rk[2]), "+v"(R.rk[3]) :: "memory");
    asm volatile("" : "+v"(R.rr[0]), "+v"(R.rr[1]), "+v"(R.rr[2]), "+v"(R.rr[3]), "+v"(R.ra[0]), "+v"(R.ra[1]), "+v"(R.ra[2]), "+v"(R.ra[3]),
                 "+v"(R.rv[0]), "+v"(R.rv[1]), "+v"(R.rv[2]), "+v"(R.rv[3]) :: "memory");
}
DI void scan_chunk_tokens(int b, int dir, int chunk, int& g0, int& step) {
    const int n0 = chunk * 16; step = dir ? -1 : 1;
    if (n0 < 256) g0 = TL + b * 256 + (dir ? 255 - n0 : n0); else g0 = b * 4096 + (dir ? 4095 - (n0 - 256) : (n0 - 256));
}
DI void scan_load_raw(ScanRaw& R, const bf16_t* RKV, const bf16_t* XD, const bf16_t* AA, int b, int dir, int h, int j, int pw, int chunk) {
    int g0, step; scan_chunk_tokens(b, dir, chunk, g0, step);
    const bf16_t* px = XD + (long)g0 * 1024 + h * 64; const long sx = (long)step * 1024;
#pragma unroll
    for (int s = 0; s < 16; ++s) R.rx[s] = ld16_async(px + (s * sx + j));
    const int t0 = 4 * pw;
    const bf16_t* pr = RKV + (long)(g0 + t0 * step) * 3072 + h * 64; const bf16_t* pa = AA + (long)(g0 + t0 * step) * 1024 + h * 64; const bf16_t* pxo = px + t0 * sx;
    const long s3 = (long)step * 3072;
#pragma unroll
    for (int q = 0; q < 4; ++q) { R.rr[q] = ld16_async(pr + (q * s3 + j)); R.rk[q] = ld16_async(pr + (q * s3 + 1024 + j)); R.rv[q] = ld16_async(pr + (q * s3 + 2048 + j)); R.ra[q] = ld16_async(pa + (q * sx + j)); R.xo[q] = ld16_async(pxo + (q * sx + j)); }
}
DI void scan_p1(const ScanRaw& R, char* st, int pw, int j, float kkj, float kaj) {
    float before = 0.f, total = 0.f;
#pragma unroll
    for (int s = 0; s < 16; ++s) { const float xv = bf2f(R.rx[s]); total += xv; before += (s < 4 * pw) ? xv : 0.f; }
    float gprev = __expf(-before);
    const float gL = __expf(-total);
    unsigned bhk[4], khk[4];
#pragma unroll
    for (int q = 0; q < 4; ++q) {
        const int t = 4 * pw + q;
        const float gt = gprev * __expf(-bf2f(R.xo[q]));
        const float ig = __builtin_amdgcn_rcpf(gt), gl = gL * ig;
        const float kf = bf2f(R.rk[q]), af = bf2f(R.ra[q]), rf = bf2f(R.rr[q]);
        const float kkraw = kf * kkj;
        const float kk = kkraw * __builtin_amdgcn_rsqf(fmaxf(wave_sum_dpp(kkraw * kkraw), 1e-24f));
        const float bb = kk * af, ktv = kf * (1.0f + (af - 1.0f) * kaj);
        const unsigned p0 = pk2(-kk * gprev, rf * gt), p1 = pk2(bb * ig, ktv * ig);
        ((bf16_t*)(st + CS_AT))[t * CS_L1 + j] = (bf16_t)(p0 & 0xffffu);
        ((bf16_t*)(st + CS_RT))[t * CS_L1 + j] = (bf16_t)(p0 >> 16);
        ((bf16_t*)(st + CS_BL))[t * CS_L1 + j] = (bf16_t)(p1 & 0xffffu);
        ((bf16_t*)(st + CS_KL))[t * CS_L1 + j] = (bf16_t)(p1 >> 16);
        const unsigned p2 = pk2(bb * gl, ktv * gl);
        bhk[q] = p2 & 0xffffu; khk[q] = p2 >> 16;
        gprev = gt;
    }
    u32x2 w2;
    w2.x = bhk[0] | (bhk[1] << 16); w2.y = bhk[2] | (bhk[3] << 16); *(u32x2*)(st + CS_BH + (j * CS_L2 + 4 * pw) * 2) = w2;
    w2.x = khk[0] | (khk[1] << 16); w2.y = khk[2] | (khk[3] << 16); *(u32x2*)(st + CS_KH + (j * CS_L2 + 4 * pw) * 2) = w2;
    w2.x = (unsigned)R.rv[0] | ((unsigned)R.rv[1] << 16); w2.y = (unsigned)R.rv[2] | ((unsigned)R.rv[3] << 16); *(u32x2*)(st + CS_VT + (j * CS_L2 + 4 * pw) * 2) = w2;
    if (pw == 0) ((float*)(st + CS_GL))[j] = gL;
}
DI void scan_p2(const char* s1, char* s2, int pw, int l15, int quad) {
    const bf16_t* Am = (const bf16_t*)(s1 + ((pw < 2) ? CS_AT : CS_RT));
    const bf16_t* Bm = (const bf16_t*)(s1 + ((pw & 1) ? CS_KL : CS_BL));
    f32x4 d = (f32x4){0.f, 0.f, 0.f, 0.f};
#pragma unroll
    for (int ks = 0; ks < 2; ++ks) {
        const bf16_t* ap = Am + l15 * CS_L1 + 32 * ks + 8 * quad; const bf16_t* bp = Bm + l15 * CS_L1 + 32 * ks + 8 * quad;
        const bf16x8 af = mk8(*(const u32x2*)ap, *(const u32x2*)(ap + 4)), bf = mk8(*(const u32x2*)bp, *(const u32x2*)(bp + 4));
        d = __builtin_amdgcn_mfma_f32_16x16x32_bf16(af, bf, d, 0, 0, 0);
    }
#pragma unroll
    for (int r = 0; r < 4; ++r) { const int t = 4 * quad + r; const bool keep = (pw < 2) ? (l15 < t) : (l15 <= t); d[r] = keep ? d[r] : 0.f; }
    if (pw == 0) *(f32x4*)(s2 + CS_NT + (l15 * 16 + 4 * quad) * 4) = d;
    else {
        bf16_t* O = (bf16_t*)(s2 + (pw == 1 ? CS_AK : (pw == 2 ? CS_RB : CS_RK)));
        const unsigned q0 = pk2(d[0], d[1]), q1 = pk2(d[2], d[3]);
        O[(4 * quad + 0) * CS_L2 + l15] = (bf16_t)(q0 & 0xffffu); O[(4 * quad + 1) * CS_L2 + l15] = (bf16_t)(q0 >> 16);
        O[(4 * quad + 2) * CS_L2 + l15] = (bf16_t)(q1 & 0xffffu); O[(4 * quad + 3) * CS_L2 + l15] = (bf16_t)(q1 >> 16);
    }
}
DI void phase_rw_scan2(const Params& p, const bf16_t* RKV, const bf16_t* XD0, const bf16_t* XD1, const bf16_t* AA0, const bf16_t* AA1, bf16_t* YF, bf16_t* YB, char* smem) {
    const int tid = TIDX(), lane = tid & 63, wv = __builtin_amdgcn_readfirstlane(tid >> 6), l15 = lane & 15, quad = lane >> 4;
    constexpr int NCH = 272;
    const u32x2 z2 = (u32x2){0u, 0u};
    for (int unit = blockIdx.x; unit < 256; unit += gridDim.x) {
        const int dir = unit & 1, b = unit >> 5, h = (unit >> 1) & 15;
        const bf16_t* XD = dir ? XD1 : XD0; const bf16_t* AA = dir ? AA1 : AA0; bf16_t* Y = dir ? YB : YF;
        __syncthreads();
        if (wv >= 4) {
            const int pw = wv - 4, j = lane;
            float kkj = p.in[I_RW_KK][h * 64 + j], kaj = p.in[I_RW_KA][h * 64 + j];
            asm volatile("s_waitcnt vmcnt(0)" : "+v"(kkj), "+v"(kaj) :: "memory");
            ScanRaw RA, RB_;
            scan_load_raw(RA, RKV, XD, AA, b, dir, h, j, pw, 0);
            scan_load_raw(RB_, RKV, XD, AA, b, dir, h, j, pw, 1);
            for (int c = -2; c < NCH; c += 2) {
#pragma unroll
                for (int half = 0; half < 2; ++half) {
                    const int cc = c + half, c2 = cc + 2, c1 = cc + 1;
                    if (c2 < NCH) {
                        const int cn = (c2 + 2 < NCH) ? c2 + 2 : NCH - 1;
                        if (half == 0) { scan_wait_raw(RA); scan_p1(RA, smem + (c2 % 3) * CS_P1, pw, j, kkj, kaj); scan_load_raw(RA, RKV, XD, AA, b, dir, h, j, pw, cn); }
                        else { scan_wait_raw(RB_); scan_p1(RB_, smem + (c2 % 3) * CS_P1, pw, j, kkj, kaj); scan_load_raw(RB_, RKV, XD, AA, b, dir, h, j, pw, cn); }
                    }
                    if (c1 >= 0 && c1 < NCH) scan_p2(smem + (c1 % 3) * CS_P1, smem + 3 * CS_P1 + (c1 & 1) * CS_P2, pw, l15, quad);
                    __syncthreads();
                }
            }
            asm volatile("s_waitcnt vmcnt(0)" ::: "memory");
        } else {
            const int w = wv;
            f32x4 ST[4];
#pragma unroll
            for (int jt = 0; jt < 4; ++jt) ST[jt] = (f32x4){0.f, 0.f, 0.f, 0.f};
            for (int c = -2; c < NCH; ++c) {
                if (c >= 0) {
                    int g0, step; scan_chunk_tokens(b, dir, c, g0, step);
                    const long ystep = (long)step * 1024;
                    bf16_t* yp = Y + (long)(g0 + 4 * quad * step) * 1024 + h * 64 + 16 * w + l15;
                    const char* s1 = smem + (c % 3) * CS_P1;
                    const char* s2 = smem + 3 * CS_P1 + (c & 1) * CS_P2;
                    const bf16_t* AT = (const bf16_t*)(s1 + CS_AT); const bf16_t* RT = (const bf16_t*)(s1 + CS_RT);
                    const bf16_t* BH = (const bf16_t*)(s1 + CS_BH); const bf16_t* KH = (const bf16_t*)(s1 + CS_KH); const bf16_t* VT = (const bf16_t*)(s1 + CS_VT);
                    const float* GL = (const float*)(s1 + CS_GL);
                    const float* NT = (const float*)(s2 + CS_NT); const bf16_t* AK = (const bf16_t*)(s2 + CS_AK);
                    const bf16_t* RB = (const bf16_t*)(s2 + CS_RB); const bf16_t* RK = (const bf16_t*)(s2 + CS_RK);
                    float Tr[16];
                    Tr[15] = (l15 == 15) ? 1.0f : 0.f;
#pragma unroll
                    for (int s = 14; s >= 0; --s) {
                        float a0 = (s == l15) ? 1.0f : 0.f, a1 = 0.f;
#pragma unroll
                        for (int u4 = 0; u4 < 4; ++u4) {
                            if (4 * u4 + 3 > s) {
                                const f32x4 nv = *(const f32x4*)(NT + s * 16 + 4 * u4);
#pragma unroll
                                for (int e = 0; e < 4; ++e) if (4 * u4 + e > s) { if (e & 1) a1 += Tr[4 * u4 + e] * nv[e]; else a0 += Tr[4 * u4 + e] * nv[e]; }
                            }
                        }
                        Tr[s] = a0 + a1;
                    }
                    u32x2 th, tl;
                    {
                        float tq[4];
                        const float m0 = (quad == 0) ? 1.0f : 0.f, m1 = (quad == 1) ? 1.0f : 0.f, m2 = (quad == 2) ? 1.0f : 0.f, m3 = (quad == 3) ? 1.0f : 0.f;
#pragma unroll
                        for (int e = 0; e < 4; ++e) tq[e] = (m0 * Tr[e] + m1 * Tr[4 + e]) + (m2 * Tr[8 + e] + m3 * Tr[12 + e]);
                        th.x = pk2(tq[0], tq[1]); th.y = pk2(tq[2], tq[3]);
                        tl.x = pk2(tq[0] - bflo(th.x), tq[1] - bfhi(th.x)); tl.y = pk2(tq[2] - bflo(th.y), tq[3] - bfhi(th.y));
                    }
                    bf16x8 sf[2];
#pragma unroll
                    for (int ks = 0; ks < 2; ++ks) { u32x2 lo, hi; lo.x = pk2(ST[2 * ks][0], ST[2 * ks][1]); lo.y = pk2(ST[2 * ks][2], ST[2 * ks][3]); hi.x = pk2(ST[2 * ks + 1][0], ST[2 * ks + 1][1]); hi.y = pk2(ST[2 * ks + 1][2], ST[2 * ks + 1][3]); sf[ks] = mk8(lo, hi); }
                    const u32x2 vfr = *(const u32x2*)(VT + (16 * w + l15) * CS_L2 + 4 * quad);
                    f32x4 X = (f32x4){0.f, 0.f, 0.f, 0.f}, Yv = X;
#pragma unroll
                    for (int ks = 0; ks < 2; ++ks) {
                        const bf16x8 af = mk8(*(const u32x2*)(AT + l15 * CS_L1 + 32 * ks + 4 * quad), *(const u32x2*)(AT + l15 * CS_L1 + 32 * ks + 16 + 4 * quad));
                        const bf16x8 rf = mk8(*(const u32x2*)(RT + l15 * CS_L1 + 32 * ks + 4 * quad), *(const u32x2*)(RT + l15 * CS_L1 + 32 * ks + 16 + 4 * quad));
                        X = __builtin_amdgcn_mfma_f32_16x16x32_bf16(af, sf[ks], X, 0, 0, 0);
                        Yv = __builtin_amdgcn_mfma_f32_16x16x32_bf16(rf, sf[ks], Yv, 0, 0, 0);
                    }
                    X = __builtin_amdgcn_mfma_f32_16x16x32_bf16(mk8(*(const u32x2*)(AK + l15 * CS_L2 + 4 * quad), z2), mk8(vfr, z2), X, 0, 0, 0);
                    u32x2 xh, xl;
                    {
                        xh.x = pk2(X[0], X[1]); xh.y = pk2(X[2], X[3]);
                        const float r0 = X[0] - bflo(xh.x), r1 = X[1] - bfhi(xh.x), r2 = X[2] - bflo(xh.y), r3 = X[3] - bfhi(xh.y);
                        xl.x = pk2(r0, r1); xl.y = pk2(r2, r3);
                    }
                    f32x4 U = (f32x4){0.f, 0.f, 0.f, 0.f};
                    U = __builtin_amdgcn_mfma_f32_16x16x32_bf16(mk8(th, tl), mk8(xh, xh), U, 0, 0, 0);
                    U = __builtin_amdgcn_mfma_f32_16x16x32_bf16(mk8(th, z2), mk8(xl, z2), U, 0, 0, 0);
                    u32x2 uf; uf.x = pk2(U[0], U[1]); uf.y = pk2(U[2], U[3]);
                    const bf16x8 uv = mk8(uf, vfr);
                    Yv = __builtin_amdgcn_mfma_f32_16x16x32_bf16(mk8(*(const u32x2*)(RB + l15 * CS_L2 + 4 * quad), *(const u32x2*)(RK + l15 * CS_L2 + 4 * quad)), uv, Yv, 0, 0, 0);
#pragma unroll
                    for (int jt = 0; jt < 4; ++jt) {
                        const f32x4 gl = *(const f32x4*)(GL + 16 * jt + 4 * quad);
                        const bf16x8 af = mk8(*(const u32x2*)(BH + (16 * jt + l15) * CS_L2 + 4 * quad), *(const u32x2*)(KH + (16 * jt + l15) * CS_L2 + 4 * quad));
                        ST[jt] = __builtin_amdgcn_mfma_f32_16x16x32_bf16(af, uv, ST[jt] * gl, 0, 0, 0);
                    }
#pragma unroll
                    for (int r = 0; r < 4; r += 2) { const unsigned yq = pk2(Yv[r], Yv[r + 1]); yp[(long)r * ystep] = (bf16_t)(yq & 0xffffu); yp[(long)(r + 1) * ystep] = (bf16_t)(yq >> 16); }
                }
                __syncthreads();
            }
        }
    }
}

DI void ld16f(const float* p, float* v) {
#pragma unroll
    for (int i = 0; i < 4; ++i) { const f32x4 t = *(const f32x4*)(p + 4 * i); v[4 * i] = t[0]; v[4 * i + 1] = t[1]; v[4 * i + 2] = t[2]; v[4 * i + 3] = t[3]; } }
DI void phase_rw_readout(const Params& p, const bf16_t* RKV, const bf16_t* AA0, const bf16_t* AA1, const bf16_t* G, const bf16_t* YF, const bf16_t* YB, bf16_t* Z) {
    const int lane = TIDX() & 63, gw = blockIdx.x * 8 + (TIDX() >> 6), nw = gridDim.x * 8, col = 16 * lane;
    float lng[16], lnb[16], ka[16], rk[16];
    ld16f(p.in[I_RW_LNG] + col, lng); ld16f(p.in[I_RW_LNB] + col, lnb); ld16f(p.in[I_RW_KA] + col, ka); ld16f(p.in[I_RW_RK] + col, rk);
    for (int g = gw; g < TT; g += nw) {
        float y[16], t[16], r[16], k[16], v[16], a0[16], a1[16], gg[16];
        ld16(YF + (size_t)g * 1024 + col, y); ld16(YB + (size_t)g * 1024 + col, t);
        ld16(RKV + (size_t)g * 3072 + col, r); ld16(RKV + (size_t)g * 3072 + 1024 + col, k); ld16(RKV + (size_t)g * 3072 + 2048 + col, v);
        ld16(AA0 + (size_t)g * 1024 + col, a0); ld16(AA1 + (size_t)g * 1024 + col, a1); ld16(G + (size_t)g * 1024 + col, gg);
        float sm = 0.f;
#pragma unroll
        for (int e = 0; e < 16; ++e) { y[e] += t[e]; sm += y[e]; }
        sm += __shfl_xor(sm, 1); sm += __shfl_xor(sm, 2);
        const float mu = sm * (1.0f / 64.0f);
        float sv = 0.f, bs = 0.f;
#pragma unroll
        for (int e = 0; e < 16; ++e) { y[e] -= mu; sv += y[e] * y[e];
            const float kt0 = k[e] * (1.0f + (a0[e] - 1.0f) * ka[e]), kt1 = k[e] * (1.0f + (a1[e] - 1.0f) * ka[e]);
            bs += r[e] * (kt0 + kt1) * rk[e]; }
        sv += __shfl_xor(sv, 1); sv += __shfl_xor(sv, 2); bs += __shfl_xor(bs, 1); bs += __shfl_xor(bs, 2);
        const float rs = rsqrtf(sv * (1.0f / 64.0f) + 64e-5f);
#pragma unroll
        for (int e = 0; e < 16; ++e) y[e] = (y[e] * rs * lng[e] + lnb[e] + bs * v[e]) * gg[e];
        st16(Z + (size_t)g * 1024 + col, y);
    }
}

DI void topk_sort(unsigned long long* keys, const float* src, int n) {
    const int tid = TIDX();
    __syncthreads();
    for (int i = tid; i < n; i += NTHR) keys[i] = ((unsigned long long)__float_as_uint(src[i]) << 32) | (unsigned long long)(0xFFFFFFFFu - (unsigned)i);
    __syncthreads();
    for (int k2 = 2; k2 <= n; k2 <<= 1)
        for (int j = k2 >> 1; j > 0; j >>= 1) {
            for (int pi = tid; pi < (n >> 1); pi += NTHR) {
                const int i = ((pi & ~(j - 1)) << 1) | (pi & (j - 1)), ix = i | j;
                const bool up = (i & k2) == 0;
                const unsigned long long a = keys[i], c = keys[ix];
                if (up ? (a < c) : (a > c)) { keys[i] = c; keys[ix] = a; }
            }
            __syncthreads();
        }
}
DI void topk_emit(const Bufs& B, const unsigned long long* keys, const bf16_t* H, bf16_t* XIN, int b, int e, bool isc, int c0, int cstep, int kcap) {
    const int tid = TIDX(), lane = tid & 63, wv = tid >> 6;
    for (int c = c0 + tid * cstep; c < kcap; c += NTHR * cstep) {
        const unsigned long long key = keys[c];
        const int idx = (int)(0xFFFFFFFFu - (unsigned)(key & 0xFFFFFFFFull));
        const int g = isc ? (TL + b * 256 + idx) : (b * 4096 + idx);
        const int er = isc ? (4096 + b * 32 + c) : (b * 512 + c);
        B.IDX[e * EROWS + er] = g; B.GATE[e * EROWS + er] = __uint_as_float((unsigned)(key >> 32)); B.INV[(size_t)g * 16 + e] = er;
    }
    for (int cb = c0 + wv * cstep; !GATHER_A && cb < kcap; cb += 32 * cstep) {
        u32x4 v0[4], v1[4];
#pragma unroll
        for (int k = 0; k < 4; ++k) {
            const int c = cb + 8 * cstep * k;
            if (c < kcap) {
                const int idx = (int)(0xFFFFFFFFu - (unsigned)(keys[c] & 0xFFFFFFFFull));
                const bf16_t* s = H + (size_t)(isc ? (TL + b * 256 + idx) : (b * 4096 + idx)) * 1024;
                v0[k] = *(const u32x4*)(s + lane * 8); v1[k] = *(const u32x4*)(s + 512 + lane * 8);
            }
        }
#pragma unroll
        for (int k = 0; k < 4; ++k) {
            const int c = cb + 8 * cstep * k;
            if (c < kcap) {
                const int er = isc ? (4096 + b * 32 + c) : (b * 512 + c);
                bf16_t* d = XIN + ((size_t)e * EROWS + er) * 1024;
                *(u32x4*)(d + lane * 8) = v0[k]; *(u32x4*)(d + 512 + lane * 8) = v1[k];
            }
        }
    }
}
constexpr int TOPK_LDS = 4096 * 8;
DI void topk_select(const Bufs& B, const float* src, int n, int kcap, int b, int e, bool isc, char* smem) {
    unsigned* hist = (unsigned*)smem; unsigned* scan = hist + 2048; unsigned* bc = scan + 512;
    const int tid = TIDX();
    const bool act = tid * 8 < n;
    unsigned v[8];
    {
        u32x4 a = (u32x4){0u, 0u, 0u, 0u}, c = a;
        if (act) { a = *(const u32x4*)(src + tid * 8); c = *(const u32x4*)(src + tid * 8 + 4); }
        v[0] = a.x; v[1] = a.y; v[2] = a.z; v[3] = a.w; v[4] = c.x; v[5] = c.y; v[6] = c.z; v[7] = c.w;
    }
    unsigned pval = 0u, pmask = 0u; int krem = kcap;
#pragma unroll
    for (int pass = 0; pass < 3; ++pass) {
        const int shift = (pass == 0) ? 21 : ((pass == 1) ? 10 : 0);
        const unsigned nb = (pass == 2) ? 1024u : 2048u;
        __syncthreads();
        for (unsigned i = tid; i < nb; i += NTHR) hist[i] = 0u;
        __syncthreads();
        if (act) {
#pragma unroll
            for (int i = 0; i < 8; ++i) if ((v[i] & pmask) == pval) atomicAdd(&hist[(v[i] >> shift) & (nb - 1u)], 1u);
        }
        __syncthreads();
        unsigned h4[4] = {0u, 0u, 0u, 0u};
        if ((unsigned)tid * 4u < nb) { const u32x4 hv = *(const u32x4*)(hist + tid * 4); h4[0] = hv.x; h4[1] = hv.y; h4[2] = hv.z; h4[3] = hv.w; }
        const unsigned sown = h4[0] + h4[1] + h4[2] + h4[3];
        scan[tid] = sown;
        __syncthreads();
        for (int d = 1; d < NTHR; d <<= 1) {
            const unsigned x = (tid + d < NTHR) ? scan[tid + d] : 0u;
            __syncthreads();
            scan[tid] += x;
            __syncthreads();
        }
        const unsigned sincl = scan[tid], sexcl = sincl - sown;
        if (sexcl < (unsigned)krem && (unsigned)krem <= sincl) {
            unsigned c = sexcl;
#pragma unroll
            for (int bi = 3; bi >= 0; --bi) {
                if (c < (unsigned)krem && c + h4[bi] >= (unsigned)krem) { bc[0] = (unsigned)(tid * 4 + bi); bc[1] = c; }
                c += h4[bi];
            }
        }
        __syncthreads();
        const unsigned beta = bc[0], above = bc[1];
        pval |= beta << shift; pmask |= (nb - 1u) << shift; krem -= (int)above;
    }
    unsigned ngt = 0u, neq = 0u;
    if (act) {
#pragma unroll
        for (int i = 0; i < 8; ++i) { ngt += (v[i] > pval) ? 1u : 0u; neq += (v[i] == pval) ? 1u : 0u; }
    }
    const unsigned packed = ngt | (neq << 16);
    __syncthreads();
    scan[tid] = packed;
    __syncthreads();
    for (int d = 1; d < NTHR; d <<= 1) {
        const unsigned x = (tid >= d) ? scan[tid - d] : 0u;
        __syncthreads();
        scan[tid] += x;
        __syncthreads();
    }
    const unsigned excl = scan[tid] - packed;
    unsigned g_before = excl & 0xffffu, e_before = excl >> 16;
    if (act) {
#pragma unroll
        for (int i = 0; i < 8; ++i) {
            const bool gt = v[i] > pval, eq = v[i] == pval;
            const bool take = gt || (eq && e_before < (unsigned)krem);
            if (take) {
                const unsigned eb = e_before < (unsigned)krem ? e_before : (unsigned)krem;
                const int slot = (int)(g_before + eb);
                const int idx = tid * 8 + i;
                const int g = isc ? (TL + b * 256 + idx) : (b * 4096 + idx);
                const int er = isc ? (4096 + b * 32 + slot) : (b * 512 + slot);
                B.IDX[e * EROWS + er] = g; B.GATE[e * EROWS + er] = __uint_as_float(v[i]); B.INV[(size_t)g * 16 + e] = er;
            }
            g_before += gt ? 1u : 0u; e_before += eq ? 1u : 0u;
        }
    }
}
#if GATHER_A
DI void phase_topk(const Bufs& B, const bf16_t* H, bf16_t* XIN, bool has_ctx, char* smem) {
    const int nl = has_ctx ? 256 : 128;
    for (int u = blockIdx.x; u < nl; u += gridDim.x) {
        const bool isc = u >= 128; const int li = u & 127, b = li >> 4, e = li & 15;
        if (!isc) topk_select(B, B.AFF + (size_t)(b * 16 + e) * 4096, 4096, 512, b, e, false, smem);
        else topk_select(B, B.AFFC + (size_t)(b * 16 + e) * 256, 256, 32, b, e, true, smem);
    }
}
#else
DI void phase_topk(const Bufs& B, const bf16_t* H, bf16_t* XIN, bool has_ctx, char* smem) {
    unsigned long long* keys = (unsigned long long*)smem;
    for (int u = blockIdx.x; u < 256; u += gridDim.x) {
        const int li = u & 127, b = li >> 4, e = li & 15, half = u >> 7;
        topk_sort(keys, B.AFF + (size_t)(b * 16 + e) * 4096, 4096);
        topk_emit(B, keys, H, XIN, b, e, false, half, 2, 512);
    }
    if (has_ctx) {
        for (int u = blockIdx.x; u < 128; u += gridDim.x) {
            const int b = u >> 4, e = u & 15;
            topk_sort(keys, B.AFFC + (size_t)(b * 16 + e) * 256, 256);
            topk_emit(B, keys, H, XIN, b, e, true, 0, 1, 32);
        }
    }
}
#endif
DI void phase_moe_gemm1(const Bufs& B, const bf16_t* XIN, bf16_t* HID, bool has_ctx, char* smem) {
#if USE_PG8
    pg8::Gemm g; g.A = GATHER_A ? B.slot(0) : XIN; g.Bt = B.W13; g.M = 16 * EROWS; g.N = 16 * 2048; g.K = 1024;
    pg8::GroupedOrder S; S.P = has_ctx ? 17 : 16; S.NT = 8; S.G = (int)gridDim.x; S.c = (int)blockIdx.x;
    pg8::PEpiSwiglu ep; ep.O = HID;
#if GATHER_A
    pg8::gemm_phase_gather<pg8::PEpiSwiglu, pg8::GroupedOrder>((LAS unsigned char*)smem, g, S, ep, B.IDX);
#else
    pg8::gemm_phase<pg8::PEpiSwiglu, pg8::GroupedOrder, false>((LAS unsigned char*)smem, g, S, ep, nullptr);
#endif
#else
    const int ntm = (has_ctx ? EROWS : 4096) >> 7, per = ntm * 16, nt = NEXP * per;
    for (int t = blockIdx.x; t < nt; t += gridDim.x) {
        const int e = t / per, r = t % per, tm = r >> 4, tn = r & 15;
        GemmOp g; g.A = XIN + (size_t)e * EROWS * 1024; g.lda = 1024; g.Bt = B.W13 + (size_t)e * 2048 * 1024; g.ldb = 1024; g.kbeg = 0; g.kend = 1024;
        EpiSwiglu ep; ep.O = HID + (size_t)e * EROWS * 1024;
        gemm_tile(g, tm * 128, tn * 128, ep, smem);
    }
#endif
}
DI void phase_moe_gemm2(const Bufs& B, const bf16_t* HID, bf16_t* Y, bool has_ctx, char* smem, int layer) {
#if USE_PG8
    pg8::Gemm g; g.A = HID; g.Bt = B.w2t(layer); g.M = 16 * EROWS; g.N = 16 * 1024; g.K = 1024;
    pg8::GroupedOrder S; S.P = has_ctx ? 17 : 16; S.NT = 4; S.G = (int)gridDim.x; S.c = (int)blockIdx.x;
    pg8::PEpiGate ep; ep.O = Y; ep.gate = B.GATE;
    pg8::gemm_phase<pg8::PEpiGate, pg8::GroupedOrder, false>((LAS unsigned char*)smem, g, S, ep, nullptr);
#else
    const int ntm = (has_ctx ? EROWS : 4096) >> 7, per = ntm * 8, nt = NEXP * per;
    for (int t = blockIdx.x; t < nt; t += gridDim.x) {
        const int e = t / per, r = t % per, tm = r >> 3, tn = r & 7;
        GemmOp g; g.A = HID + (size_t)e * EROWS * 1024; g.lda = 1024; g.Bt = B.w2t(layer) + (size_t)e * 1024 * 1024; g.ldb = 1024; g.kbeg = 0; g.kend = 1024;
        EpiGate ep; ep.O = Y + (size_t)e * EROWS * 1024; ep.gate = B.GATE + e * EROWS;
        gemm_tile(g, tm * 128, tn * 128, ep, smem);
    }
#endif
}
DI void phase_combine(const Params& p, const Bufs& B, int layer, const bf16_t* Y, int ntok, bool last, bool fuse_next, bf16_t* H) {
    const int lane = TIDX() & 63, gw = blockIdx.x * 8 + (TIDX() >> 6), nw = gridDim.x * 8;
    for (int g = gw; g < ntok; g += nw) {
        float acc[16];
#pragma unroll
        for (int e = 0; e < 16; ++e) acc[e] = 0.f;
        const int myc = B.INV[(size_t)g * 16 + (lane & 15)];
        unsigned sel = (unsigned)(__ballot(myc >= 0) & 0xFFFFull);
        while (sel) {
            const int e = __builtin_ctz(sel); sel &= sel - 1;
            const int c = __builtin_amdgcn_readlane(myc, e);
            const bf16_t* yr = Y + ((size_t)e * EROWS + c) * 1024 + 4 * lane;
#pragma unroll
            for (int i = 0; i < 4; ++i) { const u32x2 t = *(const u32x2*)(yr + 256 * i); acc[4 * i] += bflo(t.x); acc[4 * i + 1] += bfhi(t.x); acc[4 * i + 2] += bflo(t.y); acc[4 * i + 3] += bfhi(t.y); }
        }
        const float* gt = B.MOD + ((size_t)layer * 9 + modrow_of(g)) * 6144 + 5 * 1024;
        float* xr = B.X + (size_t)g * 1024;
#pragma unroll
        for (int i = 0; i < 4; ++i) {
            const f32x4 gv = *(const f32x4*)(gt + 256 * i + 4 * lane); f32x4 xv = *(const f32x4*)(xr + 256 * i + 4 * lane);
            xv[0] += gv[0] * acc[4 * i]; xv[1] += gv[1] * acc[4 * i + 1]; xv[2] += gv[2] * acc[4 * i + 2]; xv[3] += gv[3] * acc[4 * i + 3];
            if (last) *(f32x4*)(p.out + (size_t)g * 1024 + 256 * i + 4 * lane) = xv;
            else *(f32x4*)(xr + 256 * i + 4 * lane) = xv;
            acc[4 * i] = xv[0]; acc[4 * i + 1] = xv[1]; acc[4 * i + 2] = xv[2]; acc[4 * i + 3] = xv[3];
        }
        if (fuse_next) {
            const float* md = B.MOD + ((size_t)(layer + 1) * 9 + modrow_of(g)) * 6144;
            float gg[16], sh[16], sc[16];
            row_load_f32(p.in[I_N1G] + (layer + 1) * 1024, lane, gg); row_load_f32(md, lane, sh); row_load_f32(md + 1024, lane, sc);
            float ss = 0.f;
#pragma unroll
            for (int e = 0; e < 16; ++e) ss += acc[e] * acc[e];
            ss = wave_sum(ss);
            const float r = rsqrtf(ss * (1.0f / 1024.0f) + 1e-6f);
#pragma unroll
            for (int e = 0; e < 16; ++e) acc[e] = acc[e] * r * gg[e] * (1.0f + sc[e]) + sh[e];
            row_store_bf16(H + (size_t)g * 1024, lane, acc);
        }
    }
}


constexpr int AT2_STAGE = 64 * 104 * 2 + 64 * 72 * 2;
constexpr int AT2_BIAS = 2 * AT2_STAGE;
constexpr int ATT2_LDS = 2 * AT2_STAGE + 2048;
template <class P>
DI void attn_unit2(const P& pol, char* smem) {
    constexpr int DQK = P::DQK, KS = DQK + 8, VS = 72, NS = DQK / 32;
    const int tid = TIDX(), lane = tid & 63, w = tid >> 6, l15 = lane & 15, quad = lane >> 4;
    __syncthreads();
    pol.prologue(smem + AT2_BIAS);
    bf16x8 qf[2][NS];
#pragma unroll
    for (int qg = 0; qg < 2; ++qg)
#pragma unroll
        for (int s = 0; s < NS; ++s) qf[qg][s] = *(const bf16x8*)pol.qptr(32 * w + 16 * qg + l15, s * 4 + quad);
    f32x4 o[2][4];
#pragma unroll
    for (int qg = 0; qg < 2; ++qg)
#pragma unroll
        for (int u = 0; u < 4; ++u) o[qg][u] = (f32x4){0.f, 0.f, 0.f, 0.f};
    float m[2] = {-1e30f, -1e30f}, l[2] = {0.f, 0.f};
    const int k0key = (DQK == 64) ? (tid >> 3) : (tid / 12), k0ch = (DQK == 64) ? (tid & 7) : (tid % 12);
    const int k1key = (tid + 512) / 12, k1ch = (tid + 512) % 12;
    const bool k1on = (DQK == 96) && (tid < 256);
    const int vkey = tid >> 3, vch = tid & 7;
    const int nt = pol.ntiles();
    u32x4 rk0, rk1 = (u32x4){0u, 0u, 0u, 0u}, rv;
    rk0 = *(const u32x4*)pol.kptr(0, k0key, k0ch);
    if (k1on) rk1 = *(const u32x4*)pol.kptr(0, k1key, k1ch);
    rv = *(const u32x4*)pol.vptr(0, vkey, vch);
    {
        bf16_t* Ks = (bf16_t*)smem; bf16_t* Vs = (bf16_t*)(smem + 64 * 104 * 2);
        *(u32x4*)(Ks + k0key * KS + k0ch * 8) = rk0;
        if (k1on) *(u32x4*)(Ks + k1key * KS + k1ch * 8) = rk1;
        *(u32x4*)(Vs + vkey * VS + vch * 8) = rv;
    }
    __syncthreads();
    for (int j = 0; j < nt; ++j) {
        const bool more = (j + 1 < nt);
        if (more) {
            rk0 = *(const u32x4*)pol.kptr(j + 1, k0key, k0ch);
            if (k1on) rk1 = *(const u32x4*)pol.kptr(j + 1, k1key, k1ch);
            rv = *(const u32x4*)pol.vptr(j + 1, vkey, vch);
        }
        const bf16_t* Ks = (const bf16_t*)(smem + (j & 1) * AT2_STAGE);
        const bf16_t* Vs = (const bf16_t*)(smem + (j & 1) * AT2_STAGE + 64 * 104 * 2);
        if (pol.needed(j, w)) {
            f32x4 sc[2][2][2];
            __builtin_amdgcn_s_setprio(1);
#pragma unroll
            for (int g = 0; g < 2; ++g)
#pragma unroll
                for (int t = 0; t < 2; ++t) {
                    f32x4 a0 = (f32x4){0.f, 0.f, 0.f, 0.f}, a1 = a0;
                    const int key = 32 * g + 8 * (l15 >> 2) + 4 * t + (l15 & 3);
#pragma unroll
                    for (int s = 0; s < NS; ++s) {
                        const bf16x8 kf = *(const bf16x8*)(Ks + key * KS + 32 * s + 8 * quad);
                        a0 = __builtin_amdgcn_mfma_f32_16x16x32_bf16(kf, qf[0][s], a0, 0, 0, 0);
                        a1 = __builtin_amdgcn_mfma_f32_16x16x32_bf16(kf, qf[1][s], a1, 0, 0, 0);
                    }
                    sc[0][g][t] = a0; sc[1][g][t] = a1;
                    if (t == 1) __builtin_amdgcn_sched_barrier(0);
                }
            __builtin_amdgcn_s_setprio(0);
            asm volatile("" ::: "memory");
            const bool plain = pol.plain(j);
            bf16x8 pf[2][2];
#pragma unroll
            for (int qg = 0; qg < 2; ++qg) {
                if (P::CANFIX && pol.fixed) {
                    if (!plain) {
#pragma unroll
                        for (int g = 0; g < 2; ++g)
#pragma unroll
                            for (int t = 0; t < 2; ++t)
#pragma unroll
                                for (int r = 0; r < 4; ++r) sc[qg][g][t][r] = pol.mod(sc[qg][g][t][r], 32 * w + 16 * qg + l15, j, 32 * g + 8 * quad + 4 * t + r);
                    }
                    const float c2f = plain ? pol.c2 : 1.0f;
                    float ps = 0.f;
#pragma unroll
                    for (int g = 0; g < 2; ++g) {
                        float pv[8];
#pragma unroll
                        for (int t = 0; t < 2; ++t)
#pragma unroll
                            for (int r = 0; r < 4; ++r) { const float e = fexp2(sc[qg][g][t][r] * c2f - pol.mfix); ps += e; pv[4 * t + r] = e; }
                        pf[qg][g] = __builtin_bit_cast(bf16x8, pack8(pv));
                    }
                    l[qg] += ps; m[qg] = pol.mfix;
                } else {
                float tmax = -3.0e38f;
                if (!plain) {
#pragma unroll
                    for (int g = 0; g < 2; ++g)
#pragma unroll
                        for (int t = 0; t < 2; ++t)
#pragma unroll
                            for (int r = 0; r < 4; ++r) sc[qg][g][t][r] = pol.mod(sc[qg][g][t][r], 32 * w + 16 * qg + l15, j, 32 * g + 8 * quad + 4 * t + r);
                }
#pragma unroll
                for (int g = 0; g < 2; ++g)
#pragma unroll
                    for (int t = 0; t < 2; ++t) tmax = fmaxf(fmaxf(tmax, fmaxf(sc[qg][g][t][0], sc[qg][g][t][1])), fmaxf(sc[qg][g][t][2], sc[qg][g][t][3]));
                tmax = quad_max(tmax);
                const float c2 = plain ? pol.c2 : 1.0f;
                const float mn = fmaxf(m[qg], tmax * c2);
                const float alpha = fexp2(m[qg] - mn);
                m[qg] = mn;
                float ps = 0.f;
#pragma unroll
                for (int g = 0; g < 2; ++g) {
                    float pv[8];
#pragma unroll
                    for (int t = 0; t < 2; ++t)
#pragma unroll
                        for (int r = 0; r < 4; ++r) { const float e = fexp2(sc[qg][g][t][r] * c2 - mn); ps += e; pv[4 * t + r] = e; }
                    pf[qg][g] = __builtin_bit_cast(bf16x8, pack8(pv));
                }
                l[qg] = l[qg] * alpha + ps;
                if (__any(alpha != 1.0f)) {
#pragma unroll
                    for (int u = 0; u < 4; ++u) o[qg][u] *= alpha;
                }
                }
            }
            asm volatile("" ::: "memory");
            __builtin_amdgcn_s_setprio(1);
#pragma unroll
            for (int u = 0; u < 4; ++u)
#pragma unroll
                for (int g = 0; g < 2; ++g) {
                    const bf16_t* vb = Vs + (32 * g + 8 * quad + (l15 >> 2)) * VS + 16 * u + 4 * (l15 & 3);
                    const s16x4 lo = tr_read(vb), hi = tr_read(vb + 4 * VS);
                    bf16x8 vf; vf[0] = lo[0]; vf[1] = lo[1]; vf[2] = lo[2]; vf[3] = lo[3]; vf[4] = hi[0]; vf[5] = hi[1]; vf[6] = hi[2]; vf[7] = hi[3];
                    o[0][u] = __builtin_amdgcn_mfma_f32_16x16x32_bf16(vf, pf[0][g], o[0][u], 0, 0, 0);
                    o[1][u] = __builtin_amdgcn_mfma_f32_16x16x32_bf16(vf, pf[1][g], o[1][u], 0, 0, 0);
                }
            __builtin_amdgcn_s_setprio(0);
            asm volatile("" ::: "memory");
        }
        if (more) {
            bf16_t* Kn = (bf16_t*)(smem + ((j + 1) & 1) * AT2_STAGE); bf16_t* Vn = (bf16_t*)(smem + ((j + 1) & 1) * AT2_STAGE + 64 * 104 * 2);
            *(u32x4*)(Kn + k0key * KS + k0ch * 8) = rk0;
            if (k1on) *(u32x4*)(Kn + k1key * KS + k1ch * 8) = rk1;
            *(u32x4*)(Vn + vkey * VS + vch * 8) = rv;
        }
        __syncthreads();
    }
#pragma unroll
    for (int qg = 0; qg < 2; ++qg) {
        float lt = l[qg];
        lt = quad_sum(lt);
        if (P::SINK) lt += fexp2(pol.sink2 - m[qg]);
        const float il = 1.0f / lt;
        bf16_t* op = pol.optr(32 * w + 16 * qg + l15);
#pragma unroll
        for (int u = 0; u < 4; ++u) st_bf16x4(op + 16 * u + 4 * quad, o[qg][u] * il);
    }
}

struct Pol2Plain64 {
    static constexpr int DQK = 64; static constexpr bool SINK = false; static constexpr bool CANFIX = true;
    const bf16_t* Qb; long qs; const bf16_t* Kb; long ks; const bf16_t* Vb; long vs; bf16_t* Ob; long os; int qrow0, krow0, nt; float c2, sink2, mfix; bool fixed;
    DI void prologue(char*) const {}
    DI int ntiles() const { return nt; }
    DI bool needed(int, int) const { return true; }
    DI bool plain(int) const { return true; }
    DI const bf16_t* qptr(int q, int ch) const { return Qb + (long)(qrow0 + q) * qs + ch * 8; }
    DI const bf16_t* kptr(int j, int i, int ch) const { return Kb + (long)(krow0 + 64 * j + i) * ks + ch * 8; }
    DI const bf16_t* vptr(int j, int i, int ch) const { return Vb + (long)(krow0 + 64 * j + i) * vs + ch * 8; }
    DI float mod(float s, int, int, int) const { return s * c2; }
    DI bf16_t* optr(int q) const { return Ob + (long)(qrow0 + q) * os; }
};
struct Pol2NA {
    static constexpr int DQK = 64; static constexpr bool SINK = false; static constexpr bool CANFIX = true;
    const bf16_t* QKV; bf16_t* AO; const float* rpb; const float* bl; int b, h, rq, rbase; float c2, sink2, mfix; bool fixed;
    DI void prologue(char* s) const { float* t = (float*)s; for (int i = TIDX(); i < 465; i += NTHR) t[i] = rpb[h * 465 + i] * LOG2E; }
    DI int ntiles() const { return 15; }
    DI bool plain(int j) const { return j < 4; }
    DI bool needed(int j, int w) const {
        if (j < 4) return true;
        const int kr = rbase + j - 4, qr = 4 * rq + (w >> 1);
        int r0 = qr - 4; r0 = r0 < 0 ? 0 : (r0 > 56 ? 56 : r0);
        return (kr >= r0) && (kr <= r0 + 7);
    }
    DI int qtok(int q) const { return b * 4096 + (4 * rq + (q >> 6)) * 64 + (q & 63); }
    DI int ktok(int j, int i) const { if (j < 4) return TL + b * 256 + 64 * j + i; int kr = rbase + j - 4; kr = kr > 63 ? 63 : kr; return b * 4096 + kr * 64 + i; }
    DI const bf16_t* qptr(int q, int ch) const { return QKV + (long)qtok(q) * 3072 + h * 64 + ch * 8; }
    DI const bf16_t* kptr(int j, int i, int ch) const { return QKV + (long)ktok(j, i) * 3072 + 1024 + h * 64 + ch * 8; }
    DI const bf16_t* vptr(int j, int i, int ch) const { return QKV + (long)ktok(j, i) * 3072 + 2048 + h * 64 + ch * 8; }
    DI float mod(float s, int q, int j, int kc) const {
        const int kr = rbase + j - 4, qr = 4 * rq + (q >> 6), qc = q & 63;
        int c0 = qc - 8; c0 = c0 < 0 ? 0 : (c0 > 48 ? 48 : c0);
        const bool ok = (kc >= c0) && (kc < c0 + 16);
        const int idx = ok ? ((kr - qr + 7) * 31 + (kc - qc + 15)) : 0;
        return ok ? (s * c2 + bl[idx]) : -1e30f;
    }
    DI bf16_t* optr(int q) const { return AO + (long)qtok(q) * 1024 + h * 64; }
};
struct Pol2MLA {
    static constexpr int DQK = 96; static constexpr bool SINK = false; static constexpr bool CANFIX = true;
    const bf16_t* Q; const bf16_t* KV; const bf16_t* KR; bf16_t* AO; int b, h, qrow0, nt; float c2, sink2, mfix; bool fixed;
    DI void prologue(char*) const {}
    DI int ntiles() const { return nt; }
    DI bool needed(int, int) const { return true; }
    DI bool plain(int) const { return true; }
    DI int ktok(int j, int i) const { return (j < 4) ? (TL + b * 256 + 64 * j + i) : (b * 4096 + 64 * (j - 4) + i); }
    DI const bf16_t* qptr(int q, int ch) const { return Q + (long)(qrow0 + q) * 1536 + h * 96 + ch * 8; }
    DI const bf16_t* kptr(int j, int i, int ch) const { const long t = ktok(j, i); return (ch < 8) ? (KV + t * 2048 + h * 128 + ch * 8) : (KR + t * 32 + (ch - 8) * 8); }
    DI const bf16_t* vptr(int j, int i, int ch) const { return KV + (long)ktok(j, i) * 2048 + h * 128 + 64 + ch * 8; }
    DI float mod(float s, int, int, int) const { return s * c2; }
    DI bf16_t* optr(int q) const { return AO + (long)(qrow0 + q) * 1024 + h * 64; }
};
struct Pol2SWA {
    static constexpr int DQK = 64; static constexpr bool SINK = true; static constexpr bool CANFIX = true;
    const bf16_t* QKV; bf16_t* AO; int b, hq, s0; float c2, sink2, mfix; bool fixed;
    DI void prologue(char*) const {}
    DI int ntiles() const { return 12; }
    DI bool plain(int j) const { return j < 4; }
    DI bool needed(int j, int w) const { if (j < 4) return true; const int jj = j - 4; return (64 * jj + 63 >= 32 * w) && (64 * jj <= 32 * w + 287); }
    DI int ktok(int j, int i) const { if (j < 4) return TL + b * 256 + 64 * j + i; int kp = s0 - 128 + 64 * (j - 4) + i; kp = kp < 0 ? 0 : (kp > 4095 ? 4095 : kp); return b * 4096 + kp; }
    DI const bf16_t* qptr(int q, int ch) const { return QKV + (long)(b * 4096 + s0 + q) * 1536 + hq * 64 + ch * 8; }
    DI const bf16_t* kptr(int j, int i, int ch) const { return QKV + (long)ktok(j, i) * 1536 + 1024 + (hq >> 2) * 64 + ch * 8; }
    DI const bf16_t* vptr(int j, int i, int ch) const { return QKV + (long)ktok(j, i) * 1536 + 1280 + (hq >> 2) * 64 + ch * 8; }
    DI float mod(float s, int q, int j, int kc) const {
        const int kp = s0 - 128 + 64 * (j - 4) + kc, d = s0 + q - kp;
        const bool ok = (kp >= 0) && (kp < 4096) && (d <= 128) && (d >= -128);
        return ok ? s * c2 : -1e30f;
    }
    DI bf16_t* optr(int q) const { return AO + (long)(b * 4096 + s0 + q) * 1024 + hq * 64; }
};
DI int attn_unit_xcd(int i, int units_per_pair  , bool ctx_units) {
    if (gridDim.x != 256) { const int u = i * (int)gridDim.x + (int)blockIdx.x; return (u < 2048 + (ctx_units ? 128 : 0)) ? u : -1; }
    const int x = blockIdx.x & 7, Lx = i * 32 + ((int)blockIdx.x >> 3);
    if (Lx < 256) return (16 * x + (Lx >> 4)) * 16 + (Lx & 15);
    if (ctx_units && Lx < 272) return 2048 + 16 * x + (Lx - 256);
    return -1;
}
DI float head64_score_bound(const float* qg, const float* kg) {
    float a = 0.f, b = 0.f;
    for (int i = 0; i < 64; ++i) { a = fmaxf(a, fabsf(qg[i])); b = fmaxf(b, fabsf(kg[i])); }
    return 1.02f * 0.125f * LOG2E * 64.0f * a * b;
}
DI void phase_attn2_na(const Params& p, const bf16_t* QKV, bf16_t* AO, char* smem) {
    float bmax = 0.f;
    {
        float* red = (float*)smem;
        float v = 0.f;
        for (int i = TIDX(); i < 16 * 465; i += NTHR) v = fmaxf(v, fabsf(p.in[I_NA_RPB][i]));
        __syncthreads();
        red[TIDX()] = v;
        __syncthreads();
        for (int i = 0; i < NTHR; ++i) bmax = fmaxf(bmax, red[i]);
        __syncthreads();
    }
    const float sb = head64_score_bound(p.in[I_NA_QG], p.in[I_NA_KG]);
    const float mfix_l = sb + bmax * LOG2E, mfix_c = sb;
    const bool fixed = mfix_l < 60.0f;
    for (int it = 0;; ++it) {
        const int u = attn_unit_xcd(it, 16, true); if (u < 0) break;
        if (u < 2048) {
            Pol2NA pol; pol.QKV = QKV; pol.AO = AO; pol.rpb = p.in[I_NA_RPB]; pol.bl = (const float*)(smem + AT2_BIAS);
            pol.b = u >> 8; pol.h = (u >> 4) & 15; pol.rq = u & 15;
            int rb = 4 * pol.rq - 4; rb = rb < 0 ? 0 : (rb > 56 ? 56 : rb); pol.rbase = rb;
            pol.c2 = 0.125f * LOG2E; pol.sink2 = 0.f; pol.mfix = mfix_l; pol.fixed = fixed;
            attn_unit2(pol, smem);
        } else {
            const int v = u - 2048, b = v >> 4, h = v & 15;
            Pol2Plain64 pol; pol.Qb = QKV + h * 64; pol.qs = 3072; pol.Kb = QKV + 1024 + h * 64; pol.ks = 3072; pol.Vb = QKV + 2048 + h * 64; pol.vs = 3072;
            pol.Ob = AO + h * 64; pol.os = 1024; pol.qrow0 = TL + b * 256; pol.krow0 = TL + b * 256; pol.nt = 4; pol.c2 = 0.125f * LOG2E; pol.sink2 = 0.f; pol.mfix = mfix_c; pol.fixed = fixed;
            attn_unit2(pol, smem);
        }
    }
}
DI void phase_attn2_mla(const Params& p, const bf16_t* Q, const bf16_t* KV, const bf16_t* KR, bf16_t* AO, char* smem) {
    float gq = 0.f, gqr = 0.f, gk = 0.f, gkr = 0.f;
    for (int i = 0; i < 64; ++i) { gq = fmaxf(gq, fabsf(p.in[I_MLA_QN_G][i])); gk = fmaxf(gk, fabsf(p.in[I_MLA_KN_G][i])); }
    for (int i = 0; i < 32; ++i) { gqr = fmaxf(gqr, fabsf(p.in[I_MLA_QR_G][i])); gkr = fmaxf(gkr, fabsf(p.in[I_MLA_KR_G][i])); }
    const float mfix = 1.02f * 0.10206207261596575f * LOG2E * sqrtf(64.f * gq * gq + 32.f * gqr * gqr) * sqrtf(64.f * gk * gk + 32.f * gkr * gkr);
    const bool fixed = mfix < 60.0f;
    for (int it = 0;; ++it) {
        const int u = attn_unit_xcd(it, 16, true); if (u < 0) break;
        Pol2MLA pol; pol.Q = Q; pol.KV = KV; pol.KR = KR; pol.AO = AO; pol.c2 = 0.10206207261596575f * LOG2E; pol.sink2 = 0.f;
        pol.mfix = mfix; pol.fixed = fixed;
        if (u < 2048) { pol.b = u >> 8; pol.h = (u >> 4) & 15; pol.qrow0 = pol.b * 4096 + 256 * (u & 15); pol.nt = 68; }
        else { const int v = u - 2048; pol.b = v >> 4; pol.h = v & 15; pol.qrow0 = TL + pol.b * 256; pol.nt = 4; }
        attn_unit2(pol, smem);
    }
}
DI void phase_attn2_swa(const Params& p, const bf16_t* QKV, bf16_t* AO, char* smem) {
    const float mfix = head64_score_bound(p.in[I_SWA_QG], p.in[I_SWA_KG]);
    const bool fixed = mfix < 60.0f;
    for (int it = 0;; ++it) {
        const int u = attn_unit_xcd(it, 16, false); if (u < 0) break;
        Pol2SWA pol; pol.QKV = QKV; pol.AO = AO; pol.b = u >> 8; pol.hq = (u >> 4) & 15; pol.s0 = 256 * (u & 15);
        pol.c2 = 0.125f * LOG2E; pol.sink2 = p.in[I_SWA_SINK][pol.hq] * LOG2E; pol.mfix = mfix; pol.fixed = fixed;
        attn_unit2(pol, smem);
    }
}

template <class Epi>
DI void pg8_gemm(const bf16_t* A, const bf16_t* Bt, int M, int N, int K, const Epi& e, char* smem) {
    pg8::Gemm g; g.A = A; g.Bt = Bt; g.M = M; g.N = N; g.K = K;
    pg8::StaticOrder S; S.init(M, N, (int)gridDim.x, (int)blockIdx.x);
    pg8::gemm_phase<Epi, pg8::StaticOrder, false>((LAS unsigned char*)smem, g, S, e, nullptr);
}

DI void phase_attn_na(const Params& p, const bf16_t* QKV, bf16_t* AO, char* smem) {
    for (int u = blockIdx.x; u < 4096 + 256; u += gridDim.x) {
        if (u < 4096) {
            PolNA pol; pol.QKV = QKV; pol.AO = AO; pol.rpb = p.in[I_NA_RPB]; pol.bl = (const float*)(smem + 64 * 104 * 2 + 64 * 72 * 2);
            pol.b = u >> 9; pol.h = (u >> 5) & 15; pol.rr = u & 31;
            int rb = 2 * pol.rr - 4; rb = rb < 0 ? 0 : (rb > 56 ? 56 : rb); pol.rbase = rb;
            pol.c2 = 0.125f * LOG2E; pol.sink2 = 0.f;
            attn_unit(pol, smem);
        } else {
            const int v = u - 4096, b = v >> 5, h = (v >> 1) & 15, half = v & 1;
            PolPlain64 pol; pol.Qb = QKV + h * 64; pol.qs = 3072; pol.Kb = QKV + 1024 + h * 64; pol.ks = 3072; pol.Vb = QKV + 2048 + h * 64; pol.vs = 3072;
            pol.Ob = AO + h * 64; pol.os = 1024; pol.qrow0 = TL + b * 256 + 128 * half; pol.krow0 = TL + b * 256; pol.nt = 4; pol.c2 = 0.125f * LOG2E; pol.sink2 = 0.f;
            attn_unit(pol, smem);
        }
    }
}
DI void phase_attn_mla(const bf16_t* Q, const bf16_t* KV, const bf16_t* KR, bf16_t* AO, char* smem) {
    for (int u = blockIdx.x; u < 4096 + 256; u += gridDim.x) {
        PolMLA pol; pol.Q = Q; pol.KV = KV; pol.KR = KR; pol.AO = AO; pol.c2 = 0.10206207261596575f * LOG2E; pol.sink2 = 0.f;
        if (u < 4096) { pol.b = u >> 9; pol.h = (u >> 5) & 15; pol.qrow0 = pol.b * 4096 + 128 * (u & 31); pol.nt = 68; }
        else { const int v = u - 4096; pol.b = v >> 5; pol.h = (v >> 1) & 15; pol.qrow0 = TL + pol.b * 256 + 128 * (v & 1); pol.nt = 4; }
        attn_unit(pol, smem);
    }
}
DI void phase_attn_swa(const Params& p, const bf16_t* QKV, bf16_t* AO, char* smem) {
    for (int u = blockIdx.x; u < 4096; u += gridDim.x) {
        PolSWA pol; pol.QKV = QKV; pol.AO = AO; pol.b = u >> 9; pol.hq = (u >> 5) & 15; pol.s0 = 128 * (u & 31);
        pol.c2 = 0.125f * LOG2E; pol.sink2 = p.in[I_SWA_SINK][pol.hq] * LOG2E;
        attn_unit(pol, smem);
    }
}


DI void wo_phase(const Params& p, const Bufs& B, int layer, const bf16_t* A, const bf16_t* Wt, char* smem) {
    const float* gate = B.MOD + (size_t)layer * 9 * 6144 + 2 * 1024;
    pg8::PEpiResidual e; e.X = B.X; e.gate = gate;
    e.Xl = (layer == 0) ? p.in[I_X] : B.X; e.Xc = (layer == 0) ? p.in[I_CTX] : (B.X + (size_t)TL * 1024);
    pg8_gemm(A, Wt, TL, 1024, 1024, e, smem);
    __syncthreads();
    GemmOp g; g.A = A + (size_t)TL * 1024; g.lda = 1024; g.Bt = Wt; g.ldb = 1024; g.kbeg = 0; g.kend = 1024;
    EpiResidualCtx ec; ec.Xout = B.X + (size_t)TL * 1024; ec.Xin = (layer == 0) ? p.in[I_CTX] : (B.X + (size_t)TL * 1024); ec.gate = gate + (size_t)8 * 6144;
    gemm_all(g, TC, 1024, ec, smem);
}

constexpr int N_PHASES = 44;
constexpr int LDS_BYTES = 131072;
static_assert(GT_LDS <= LDS_BYTES && SCAN_LDS <= LDS_BYTES && ATT_LDS <= LDS_BYTES && TOPK_LDS <= LDS_BYTES && 65536 <= LDS_BYTES, "lds");

template <int SUB>
DI void moe_phase(const Params& p, const Bufs& B, int layer, char* smem) {
    const bool has_ctx = layer < 3;
    const int ntok = has_ctx ? TT : TL;
    bf16_t* H = B.slot(0); bf16_t* XIN = B.slot(1); bf16_t* HID = B.slot(3); bf16_t* Y = B.slot(1);
    if constexpr (SUB == 0) phase_norm2(p, B, layer, H, ntok, smem);
    else if constexpr (SUB == 1) phase_topk(B, H, XIN, has_ctx, smem);
    else if constexpr (SUB == 2) {
        phase_moe_gemm1(B, XIN, HID, has_ctx, smem);
        if (USE_PG8 && layer < 3) {
            const bool split = (gridDim.x == 256);
            const int li = (int)blockIdx.x >> 3;
            if (!split || li >= 16) { __syncthreads(); int base = 0; conv_moe_layer(p, B, layer + 1, base, smem, 2, split ? (li - 16) * 8 + ((int)blockIdx.x & 7) : -1, split ? 128 : 0); }
        }
    }
    else if constexpr (SUB == 3) {
        phase_moe_gemm2(B, HID, Y, has_ctx, smem, layer);
        if (USE_PG8 && layer < 3) {
            const bool split = (gridDim.x == 256);
            const int li = (int)blockIdx.x >> 3;
            if (!split || li >= 8) { __syncthreads(); int base = 0; conv_moe_layer(p, B, layer + 1, base, smem, 1, split ? (li - 8) * 8 + ((int)blockIdx.x & 7) : -1, split ? 192 : 0); }
        }
    }
    else { phase_combine(p, B, layer, Y, ntok, layer == 3, layer == 1 || layer == 2, H); if (!USE_PG8 && layer < 3) { int base = 0; conv_moe_layer(p, B, layer + 1, base, smem, 0); } }
}

template <int PH>
DI void run_phase(const Params& p, char* smem) {
    const Bufs B = make_bufs(p);
    bf16_t* H = B.slot(0);
    if constexpr (PH == 0) phase_prologue(p, B, smem);
    else if constexpr (PH == 1) phase_norm1(p, B, 0, H);
    else if constexpr (PH == 2) { pg8::PEpiQKNorm e; e.O = B.slot(1); e.ldo = 3072; e.nq = 4; e.nk = 8; e.qg = p.in[I_NA_QG]; e.kg = p.in[I_NA_KG]; e.rope = nullptr; pg8_gemm(H, B.WMIX + W_NA_QKV, TT, 3072, 1024, e, smem); }
    else if constexpr (PH == 3) {   }
    else if constexpr (PH == 4) phase_attn2_na(p, B.slot(1), B.slot(4), smem);
    else if constexpr (PH == 5) wo_phase(p, B, 0, B.slot(4), B.WMIX + W_NA_WO, smem);
    else if constexpr (PH >= 6 && PH <= 10) moe_phase<PH - 6>(p, B, 0, smem);
    else if constexpr (PH == 11) phase_norm1_rw(p, B, 1, B.slot(0));
    else if constexpr (PH == 12) { pg8::PEpiRW1 e; e.RKV = B.slot(2); e.LORA = B.slot(5); pg8_gemm(B.slot(0), B.WMIX + W_RW_B1, TT, 3584, 2048, e, smem); }
    else if constexpr (PH == 13) phase_rw_gemm2(p, B, B.slot(5), B.slot(0), B.slot(1), B.slot(6), B.slot(7), B.slot(8), smem);
    else if constexpr (PH == 14) {
#if USE_SCAN2
        phase_rw_scan2(p, B.slot(2), B.slot(1), B.slot(6), B.slot(7), B.slot(8), B.slot(9), B.slot(5), smem);
#else
        phase_rw_scan(p, B.slot(2), B.slot(1), B.slot(6), B.slot(7), B.slot(8), B.slot(9), B.slot(5), smem);
#endif
    }
    else if constexpr (PH == 15) phase_rw_readout(p, B.slot(2), B.slot(7), B.slot(8), B.slot(0), B.slot(9), B.slot(5), B.slot(1));
    else if constexpr (PH == 16) wo_phase(p, B, 1, B.slot(1), B.WMIX + W_RW_WO, smem);
    else if constexpr (PH >= 17 && PH <= 21) moe_phase<PH - 17>(p, B, 1, smem);
    else if constexpr (PH == 22) {   }
    else if constexpr (PH == 23) { pg8::PEpiBf16 e; e.O = B.slot(1); e.ldo = 768; pg8_gemm(H, B.WMIX + W_MLA_DOWN, TT, 768, 1024, e, smem); }
    else if constexpr (PH == 24) { bf16_t* CQ = B.slot(3); phase_mla_dnorm(p, B, B.slot(1), CQ, CQ + (size_t)TT * 384, CQ + (size_t)TT * 640); }
    else if constexpr (PH == 25) {
        bf16_t* CQ = B.slot(3);
        { pg8::PEpiBf16 e; e.O = B.slot(4); e.ldo = 1536; pg8_gemm(CQ, B.WMIX + W_MLA_UQ, TT, 1536, 384, e, smem); }
        { pg8::PEpiBf16 e; e.O = B.slot(6); e.ldo = 2048; pg8_gemm(CQ + (size_t)TT * 384, B.WMIX + W_MLA_UKV, TT, 2048, 256, e, smem); }
    }
    else if constexpr (PH == 26) phase_mla_hnorm(p, B, B.slot(4), B.slot(6));
    else if constexpr (PH == 27) phase_attn2_mla(p, B.slot(4), B.slot(6), B.slot(3) + (size_t)TT * 640, B.slot(8), smem);
    else if constexpr (PH == 28) wo_phase(p, B, 2, B.slot(8), B.WMIX + W_MLA_WO, smem);
    else if constexpr (PH >= 29 && PH <= 33) moe_phase<PH - 29>(p, B, 2, smem);
    else if constexpr (PH == 34) {   }
    else if constexpr (PH == 35) { pg8::PEpiQKNorm e; e.O = B.slot(1); e.ldo = 1536; e.nq = 4; e.nk = 5; e.qg = p.in[I_SWA_QG]; e.kg = p.in[I_SWA_KG]; e.rope = B.ROPE_S; pg8_gemm(H, B.WMIX + W_SWA_QKV, TT, 1536, 1024, e, smem); }
    else if constexpr (PH == 36) {   }
    else if constexpr (PH == 37) phase_attn2_swa(p, B.slot(1), B.slot(3), smem);
    else if constexpr (PH == 38) { pg8::PEpiResidual e; e.X = B.X; e.Xl = B.X; e.Xc = B.X + (size_t)TL * 1024; e.gate = B.MOD + (size_t)3 * 9 * 6144 + 2 * 1024; pg8_gemm(B.slot(3), B.WMIX + W_SWA_WO, TL, 1024, 1024, e, smem); }
    else if constexpr (PH >= 39 && PH <= 43) moe_phase<PH - 39>(p, B, 3, smem);
}

#define XB_TMO      128
#define XB_XCNT(j)  (256  + 64 * (j))
#define XB_XSUB(j)  (1280 + 64 * (j))
#define XB_XGEN(j)  (2304 + 64 * (j))
#define XB_TOP      3328
#define XB_TOPGEN   3392
#define XCD_BAR_WORDS 3456
#define XB_SPIN_CAP (1u << 18)

__device__ __forceinline__ unsigned xb_ld(unsigned* p)              { return __hip_atomic_load(p, __ATOMIC_RELAXED, __HIP_MEMORY_SCOPE_AGENT); }
__device__ __forceinline__ unsigned xb_add(unsigned* p, unsigned v) { return __hip_atomic_fetch_add(p, v, __ATOMIC_RELAXED, __HIP_MEMORY_SCOPE_AGENT); }
__device__ __forceinline__ unsigned xb_xcc_id() { return (unsigned)__builtin_amdgcn_s_getreg((3 << 11) | 20) & 0xFu; }
#define XB_SPIN(cond, bar) do { unsigned _sp = 0; while (cond) { __builtin_amdgcn_s_sleep(1); \
    if ((++_sp & 255u) == 0u) { if (xb_ld(&(bar)[XB_TMO])) break; if (_sp > XB_SPIN_CAP) { atomicAdd(&(bar)[XB_TMO], 1u); break; } } } } while (0)

struct XcdBarrier {
    unsigned* bar; unsigned x;
    volatile LAS unsigned* st;
};

__device__ __forceinline__ XcdBarrier xcd_barrier_post(unsigned* bar, volatile LAS unsigned* st) {
    XcdBarrier b; b.bar = bar; b.x = xb_xcc_id(); b.st = st;
    if (TIDX() == 0) (void)xb_add(&bar[XB_XCNT(b.x)], 1u);
    return b;
}
__device__ __forceinline__ void xcd_barrier_complete(unsigned* bar, unsigned x, unsigned& nloc, unsigned& nx) {
    const unsigned G = gridDim.x * gridDim.y * gridDim.z;
    unsigned sum, cnt, mine, sp = 0u;
    for (;;) {
        sum = 0u; cnt = 0u; mine = 0u;
#pragma unroll
        for (unsigned j = 0; j < 16; ++j) { const unsigned c = xb_ld(&bar[XB_XCNT(j)]); sum += c; cnt += (c > 0u) ? 1u : 0u; mine = (j == x) ? c : mine; }
        if (sum == G) break;
        __builtin_amdgcn_s_sleep(1);
        if ((++sp & 255u) == 0u) { if (xb_ld(&bar[XB_TMO])) break; if (sp > XB_SPIN_CAP) { atomicAdd(&bar[XB_TMO], 1u); break; } }
    }
    nloc = mine > 0u ? mine : 1u; nx = cnt > 0u ? cnt : 1u;
}

__device__ __forceinline__ void xcd_barrier(const XcdBarrier& b) {
    asm volatile("s_waitcnt vmcnt(0)" ::: "memory");
    __syncthreads();
    if (TIDX() == 0) {
        unsigned* bar = b.bar;
        __builtin_amdgcn_s_waitcnt(0);
        unsigned nloc = b.st[0], nx = b.st[1];
        if (nloc == 0u) { xcd_barrier_complete(bar, b.x, nloc, nx); b.st[0] = nloc; b.st[1] = nx; }
        const unsigned old = xb_add(&bar[XB_XSUB(b.x)], 1u);
        const unsigned gen = old / nloc;
        if (old + 1u == (gen + 1u) * nloc) {
            __builtin_amdgcn_fence(__ATOMIC_RELEASE, "agent");
            asm volatile("s_waitcnt vmcnt(0)" ::: "memory");
            const unsigned og = xb_add(&bar[XB_TOP], 1u);
            const unsigned tg = og / nx;
            if (og + 1u == (tg + 1u) * nx) xb_add(&bar[XB_TOPGEN], 1u);
            else XB_SPIN(xb_ld(&bar[XB_TOPGEN]) == tg, bar);
            __builtin_amdgcn_fence(__ATOMIC_ACQUIRE, "agent");
            xb_add(&bar[XB_XGEN(b.x)], 1u);
            asm volatile("s_waitcnt vmcnt(0)" ::: "memory");
        } else {
            XB_SPIN(xb_ld(&bar[XB_XGEN(b.x)]) == gen, bar);
            __builtin_amdgcn_fence(__ATOMIC_ACQUIRE, "agent");
            asm volatile("s_waitcnt vmcnt(0)" ::: "memory");
        }
    }
    __syncthreads();
}

constexpr int LDS_REQ = 147456;

#if MULTI_LAUNCH
template <int PH>
__global__ void __launch_bounds__(NTHR, 2) k_phase(Params p) {
    extern __shared__ __attribute__((aligned(16))) char smem[];
    run_phase<PH>(p, smem);
}
template <int PH>
static void launch_from(const Params& p, int grid, hipStream_t stream, bool setattr) {
    if constexpr (PH < N_PHASES) {
        if (setattr) (void)hipFuncSetAttribute((const void*)k_phase<PH>, hipFuncAttributeMaxDynamicSharedMemorySize, LDS_REQ);
        else hipLaunchKernelGGL(k_phase<PH>, dim3(grid), dim3(NTHR), LDS_REQ, stream, p);
        launch_from<PH + 1>(p, grid, stream, setattr);
    }
}
#else
constexpr int LDS_PARAMS = LDS_BYTES + 64;
DI unsigned long long lds_u64_uniform(const char* lp, int i) {
    const u32x2 v = *(const u32x2*)(lp + 8 * i);
    const unsigned lo = __builtin_amdgcn_readfirstlane(v.x), hi = __builtin_amdgcn_readfirstlane(v.y);
    return ((unsigned long long)hi << 32) | lo;
}
DI Params load_params(const char* lp) {
    Params p;
#pragma unroll
    for (int i = 0; i < N_INPUTS; ++i) p.in[i] = (const float*)lds_u64_uniform(lp, i);
    p.out = (float*)lds_u64_uniform(lp, N_INPUTS); p.ws = (unsigned char*)lds_u64_uniform(lp, N_INPUTS + 1);
    return p;
}
#ifndef PH_LO
#define PH_LO 0
#define PH_HI N_PHASES
#endif
constexpr int dup_start(int ph) {
    if (PROBE == 1) { if (ph == 9) return 6; if (ph == 20) return 17; if (ph == 32) return 29; if (ph == 42) return 39; }
    if (PROBE == 2) { if (ph == 4) return 1; if (ph == 27) return 22; if (ph == 37) return 34; }
    if (PROBE == 3) { if (ph == 15) return 11; }
    if (PROBE == 4) { if (ph == 4) return 4; if (ph == 27) return 27; if (ph == 37) return 37; }
    if (PROBE == 5) { if (ph == 14) return 14; }
    if (PROBE == 7) { if (ph == 0) return 0; }
    if (PROBE == 8) { if (ph == 1 || ph == 11 || ph == 22 || ph == 34 || ph == 6 || ph == 17 || ph == 29 || ph == 39) return ph; }
    if (PROBE == 9) { if (ph == 9) return 8; if (ph == 20) return 19; if (ph == 32) return 31; if (ph == 42) return 41; }
    if (PROBE == 10) { if (ph == 2 || ph == 12 || ph == 13 || ph == 23 || ph == 25 || ph == 35) return ph; }
    return -1;
}
template <int A, int B>
DI void run_range(char* smem, const XcdBarrier& bar) {
    if constexpr (A <= B) { { const Params p = load_params(smem + LDS_PARAMS); run_phase<A>(p, smem); } xcd_barrier(bar); run_range<A + 1, B>(smem, bar); }
}
template <int PH>
DI void run_all(char* smem, const XcdBarrier& bar) {
    if constexpr (PH < N_PHASES) {
        constexpr bool empty = (PH == 22 || PH == 34 || PH == 3 || PH == 36);
        if constexpr (!empty && PH >= PH_LO && PH < PH_HI) { const Params p = load_params(smem + LDS_PARAMS); run_phase<PH>(p, smem); }
        if constexpr (!empty && PH + 1 < N_PHASES) xcd_barrier(bar);
        if constexpr (dup_start(PH) >= 0) run_range<dup_start(PH), PH>(smem, bar);
        run_all<PH + 1>(smem, bar);
    }
}
__global__ void __launch_bounds__(NTHR, 2) k_mega(Params p) {
    extern __shared__ __attribute__((aligned(16))) char smem[];
    if (TIDX() == 0) {
        *(u32x4*)(smem + LDS_BYTES) = (u32x4){0u, 0u, 0u, 0u};
        unsigned long long* lp = (unsigned long long*)(smem + LDS_PARAMS);
#pragma unroll
        for (int i = 0; i < N_INPUTS; ++i) lp[i] = (unsigned long long)p.in[i];
        lp[N_INPUTS] = (unsigned long long)p.out; lp[N_INPUTS + 1] = (unsigned long long)p.ws;
    }
    __syncthreads();
    const XcdBarrier bar = xcd_barrier_post((unsigned*)(p.ws + OFF_CTL), (volatile LAS unsigned*)(LAS char*)(smem + LDS_BYTES));
    run_all<0>(smem, bar);
}
#endif

extern "C" void kernel_launch(void* const* d_in, const int* in_sizes, int n_in, void* d_out, int out_size, void* d_ws, size_t ws_size, hipStream_t stream) {
    static int grid = 0;
    Params p{};
    for (int i = 0; i < N_INPUTS; ++i) p.in[i] = (const float*)d_in[i];
    p.out = (float*)d_out; p.ws = (unsigned char*)d_ws;
    if (grid == 0) {
        if (n_in != N_INPUTS || out_size != TL * 1024 || ws_size < WS_NEED) { grid = -1; return; }
        int dev = 0, cus = 0;
        if (hipGetDevice(&dev) != hipSuccess || hipDeviceGetAttribute(&cus, hipDeviceAttributeMultiprocessorCount, dev) != hipSuccess) { grid = -1; return; }
#if MULTI_LAUNCH
        launch_from<0>(p, 0, stream, true);
#else
        if (hipFuncSetAttribute((const void*)k_mega, hipFuncAttributeMaxDynamicSharedMemorySize, LDS_REQ) != hipSuccess) { grid = -1; return; }
#endif
        grid = cus > 0 ? cus : 256;
    }
    if (grid < 0) return;
    (void)hipMemsetAsync((char*)d_ws + OFF_CTL, 0, 65536, stream);
#if MULTI_LAUNCH
    launch_from<0>(p, grid, stream, false);
#else
    hipLaunchKernelGGL(k_mega, dim3(grid), dim3(NTHR), LDS_REQ, stream, p);
#endif
}
```

```cpp
#include <hip/hip_runtime.h>
#include <stdint.h>

#ifndef MULTI_LAUNCH
#define MULTI_LAUNCH 0
#endif
#ifndef USE_PG8
#define USE_PG8 1
#endif
#ifndef PROBE
#define PROBE 0
#endif
#ifndef USE_SCAN2
#define USE_SCAN2 1
#endif
#ifndef ATT_SCHED_FENCE
#define ATT_SCHED_FENCE 0
#endif
#ifndef GATHER_A
#define GATHER_A 1
#endif

typedef unsigned short bf16_t;
typedef short bf16x8 __attribute__((ext_vector_type(8)));
typedef short s16x4 __attribute__((ext_vector_type(4)));
typedef float f32x4 __attribute__((ext_vector_type(4)));
typedef unsigned u32x4 __attribute__((ext_vector_type(4)));
typedef unsigned u32x2 __attribute__((ext_vector_type(2)));
#define LAS __attribute__((address_space(3)))
#define DI __device__ __forceinline__
DI int TIDX() { int t = (int)threadIdx.x; asm volatile("" : "+v"(t)); return t; }

constexpr int NTHR = 512;
constexpr int D = 1024, NB = 8, SEQ = 4096, CTXL = 256;
constexpr int TL = NB * SEQ, TC = NB * CTXL, TT = TL + TC;
constexpr int NEXP = 16, CAPL = 512, CAPC = 32, EROWS = NB * CAPL + NB * CAPC;
constexpr float LOG2E = 1.4426950408889634f;

enum { I_X = 0, I_C, I_CTX, I_CCTX, I_N1G, I_N2G, I_ADAW, I_ADAB,
       I_NA_WQKV, I_NA_QG, I_NA_KG, I_NA_RPB, I_NA_WO,
       I_RW_MIX, I_RW_WR, I_RW_WK, I_RW_WV, I_RW_W0, I_RW_W1, I_RW_W2, I_RW_A0, I_RW_A1, I_RW_A2, I_RW_G1, I_RW_G2,
       I_RW_KK, I_RW_KA, I_RW_RK, I_RW_LNG, I_RW_LNB, I_RW_WO,
       I_MLA_WDOWN, I_MLA_QNG, I_MLA_KVNG, I_MLA_WUQ, I_MLA_WUKV, I_MLA_QN_G, I_MLA_QR_G, I_MLA_KN_G, I_MLA_KR_G, I_MLA_WO,
       I_SWA_WQKV, I_SWA_QG, I_SWA_KG, I_SWA_SINK, I_SWA_WO,
       I_MOE_ROUTER, I_MOE_W1, I_MOE_W3, I_MOE_W2, N_INPUTS };

constexpr size_t MiB = 1u << 20;
constexpr size_t OFF_CTL = 0;
constexpr size_t OFF_MOD = 65536;
constexpr size_t OFF_ROPE_M = OFF_MOD + 4 * 9 * 6144 * 4;
constexpr size_t OFF_ROPE_S = OFF_ROPE_M + 2 * 4096 * 16 * 4;
constexpr size_t OFF_X = 4 * MiB;
constexpr size_t OFF_WMIX = 140 * MiB;
constexpr size_t OFF_WE = 180 * MiB;
constexpr size_t OFF_MISC = 276 * MiB;
constexpr size_t OFF_WORK = 284 * MiB;
constexpr size_t USLOT = (size_t)TT * 1024 * 2;
constexpr size_t OFF_W2TB = OFF_WORK + 10 * USLOT;
constexpr size_t WS_NEED = OFF_W2TB + 32 * MiB;
static_assert(OFF_ROPE_S + 2 * 4096 * 32 * 4 <= OFF_X, "map");
static_assert(OFF_X + (size_t)TT * 1024 * 4 <= OFF_WMIX, "map");

constexpr size_t W_NA_QKV = 0, W_NA_WO = 3145728, W_RW_B1 = 4194304, W_RW_B2 = 11534336, W_RW_WO = 13500416,
                 W_MLA_DOWN = 14548992, W_MLA_UQ = 15335424, W_MLA_UKV = 15925248, W_MLA_WO = 16449536,
                 W_SWA_QKV = 17498112, W_SWA_WO = 19070976, W_MIX_END = 20119552;
static_assert(OFF_WMIX + W_MIX_END * 2 <= OFF_WE, "map");
static_assert(OFF_WE + 96 * MiB <= OFF_MISC, "map");
constexpr size_t OFF_AFF = OFF_MISC;
constexpr size_t OFF_AFFC = OFF_AFF + 8 * 16 * 4096 * 4;
constexpr size_t OFF_IDX = OFF_AFFC + 8 * 16 * 256 * 4;
constexpr size_t OFF_GATE = OFF_IDX + 16 * EROWS * 4;
constexpr size_t OFF_INV = OFF_GATE + 16 * EROWS * 4;
static_assert(OFF_INV + (size_t)TT * 16 * 4 <= OFF_WORK, "map");

struct Params {
    const float* in[N_INPUTS];
    float* out;
    unsigned char* ws;
};

DI unsigned f2bf(float f) { unsigned u = __float_as_uint(f); return (u + 0x7fffu + ((u >> 16) & 1u)) >> 16; }
typedef float f32x2_t __attribute__((ext_vector_type(2)));
typedef __bf16 bf16x2_t __attribute__((ext_vector_type(2)));
DI unsigned pk2(float lo, float hi) { const f32x2_t v = {lo, hi}; const bf16x2_t b = __builtin_convertvector(v, bf16x2_t); return __builtin_bit_cast(unsigned, b); }
DI float bf2f(unsigned b) { return __uint_as_float(b << 16); }
DI float bflo(unsigned w) { return __uint_as_float(w << 16); }
DI float bfhi(unsigned w) { return __uint_as_float(w & 0xffff0000u); }
DI float wave_sum(float v) {
    v += __shfl_xor(v, 32); v += __shfl_xor(v, 16); v += __shfl_xor(v, 8); v += __shfl_xor(v, 4); v += __shfl_xor(v, 2); v += __shfl_xor(v, 1); return v; }
DI float fsigmoid(float x) { return 1.0f / (1.0f + __expf(-x)); }
DI float fexp2(float x) { return __builtin_amdgcn_exp2f(x); }
DI int modrow_of(int g) { return g < TL ? (g >> 12) : 8; }
DI void unpack8(u32x4 v, float* f) { f[0] = bflo(v.x); f[1] = bfhi(v.x); f[2] = bflo(v.y); f[3] = bfhi(v.y); f[4] = bflo(v.z); f[5] = bfhi(v.z); f[6] = bflo(v.w); f[7] = bfhi(v.w); }
DI u32x4 pack8(const float* f) { u32x4 v; v.x = pk2(f[0], f[1]); v.y = pk2(f[2], f[3]); v.z = pk2(f[4], f[5]); v.w = pk2(f[6], f[7]); return v; }

struct GemmOp { const bf16_t* A; long lda; const bf16_t* Bt; long ldb; int kbeg, kend; };
constexpr int GT_LDS = 4 * 128 * 72 * 2;

template <class Epi>
DI void gemm_tile(const GemmOp& g, int row0, int col0, const Epi& epi, char* smem) {
    const int tid = TIDX(), lane = tid & 63, w = tid >> 6, wm = w >> 2, wn = w & 3, l15 = lane & 15, quad = lane >> 4;
    bf16_t* As = (bf16_t*)smem;
    bf16_t* Bs = As + 2 * 128 * 72;
    const int lr = tid >> 3, lc = (tid & 7) * 8;
    const bf16_t* ga0 = g.A + (long)(row0 + lr) * g.lda + g.kbeg + lc;
    const bf16_t* ga1 = ga0 + 64 * g.lda;
    const bf16_t* gb0 = g.Bt + (long)(col0 + lr) * g.ldb + g.kbeg + lc;
    const bf16_t* gb1 = gb0 + 64 * g.ldb;
    f32x4 acc[4][2];
#pragma unroll
    for (int i = 0; i < 4; ++i) { acc[i][0] = (f32x4){0.f, 0.f, 0.f, 0.f}; acc[i][1] = (f32x4){0.f, 0.f, 0.f, 0.f}; }
    u32x4 ra0 = *(const u32x4*)ga0, ra1 = *(const u32x4*)ga1, rb0 = *(const u32x4*)gb0, rb1 = *(const u32x4*)gb1;
    *(u32x4*)(As + lr * 72 + lc) = ra0; *(u32x4*)(As + (lr + 64) * 72 + lc) = ra1;
    *(u32x4*)(Bs + lr * 72 + lc) = rb0; *(u32x4*)(Bs + (lr + 64) * 72 + lc) = rb1;
    __syncthreads();
    const int nk = (g.kend - g.kbeg) >> 6;
    for (int kt = 0; kt < nk; ++kt) {
        const int cur = kt & 1;
        const bool more = (kt + 1 < nk);
        if (more) { const int ko = (kt + 1) * 64; ra0 = *(const u32x4*)(ga0 + ko); ra1 = *(const u32x4*)(ga1 + ko); rb0 = *(const u32x4*)(gb0 + ko); rb1 = *(const u32x4*)(gb1 + ko); }
        const bf16_t* a = As + cur * 128 * 72;
        const bf16_t* b = Bs + cur * 128 * 72;
#pragma unroll
        for (int ks = 0; ks < 2; ++ks) {
            bf16x8 af[4], bfr[2];
#pragma unroll
            for (int mt = 0; mt < 4; ++mt) af[mt] = *(const bf16x8*)(a + (wm * 64 + mt * 16 + l15) * 72 + ks * 32 + quad * 8);
#pragma unroll
            for (int nt = 0; nt < 2; ++nt) bfr[nt] = *(const bf16x8*)(b + (wn * 32 + nt * 16 + l15) * 72 + ks * 32 + quad * 8);
#pragma unroll
            for (int mt = 0; mt < 4; ++mt)
#pragma unroll
                for (int nt = 0; nt < 2; ++nt) acc[mt][nt] = __builtin_amdgcn_mfma_f32_16x16x32_bf16(bfr[nt], af[mt], acc[mt][nt], 0, 0, 0);
        }
        if (more) {
            bf16_t* a2 = As + (cur ^ 1) * 128 * 72; bf16_t* b2 = Bs + (cur ^ 1) * 128 * 72;
            *(u32x4*)(a2 + lr * 72 + lc) = ra0; *(u32x4*)(a2 + (lr + 64) * 72 + lc) = ra1;
            *(u32x4*)(b2 + lr * 72 + lc) = rb0; *(u32x4*)(b2 + (lr + 64) * 72 + lc) = rb1;
        }
        __syncthreads();
    }
#pragma unroll
    for (int mt = 0; mt < 4; ++mt) epi(row0 + wm * 64 + mt * 16 + l15, col0 + wn * 32 + quad * 4, acc[mt][0], acc[mt][1]);
}

template <class Epi>
DI void gemm_all(const GemmOp& g, int M, int N, const Epi& epi, char* smem) {
    const int ntn = N >> 7, nt = (M >> 7) * ntn;
    for (int t = blockIdx.x; t < nt; t += gridDim.x) gemm_tile(g, (t / ntn) * 128, (t % ntn) * 128, epi, smem);
}

DI void st_bf16x4(bf16_t* p, f32x4 a) { u32x2 v; v.x = pk2(a[0], a[1]); v.y = pk2(a[2], a[3]); *(u32x2*)p = v; }
struct EpiBf16 { bf16_t* O; long ldo;
    DI void operator()(int row, int col, f32x4 a0, f32x4 a1) const { bf16_t* p = O + (long)row * ldo + col; st_bf16x4(p, a0); st_bf16x4(p + 16, a1); } };
struct EpiF32 { float* O; long ldo;
    DI void operator()(int row, int col, f32x4 a0, f32x4 a1) const { float* p = O + (long)row * ldo + col; *(f32x4*)p = a0; *(f32x4*)(p + 16) = a1; } };
struct EpiResidual { float* X; const float* gate;
    DI void operator()(int row, int col, f32x4 a0, f32x4 a1) const {
        const float* gp = gate + (long)modrow_of(row) * 6144 + col; float* xp = X + (long)row * 1024 + col;
        f32x4 g0 = *(const f32x4*)gp, g1 = *(const f32x4*)(gp + 16), x0 = *(const f32x4*)xp, x1 = *(const f32x4*)(xp + 16);
        *(f32x4*)xp = x0 + g0 * a0; *(f32x4*)(xp + 16) = x1 + g1 * a1; } };
struct EpiResidualCtx { float* Xout; const float* Xin; const float* gate;
    DI void operator()(int row, int col, f32x4 a0, f32x4 a1) const {
        const float* gp = gate + col; const float* ip = Xin + (long)row * 1024 + col; float* xp = Xout + (long)row * 1024 + col;
        const f32x4 g0 = *(const f32x4*)gp, g1 = *(const f32x4*)(gp + 16), x0 = *(const f32x4*)ip, x1 = *(const f32x4*)(ip + 16);
        *(f32x4*)xp = x0 + g0 * a0; *(f32x4*)(xp + 16) = x1 + g1 * a1; } };
struct EpiSwiglu { bf16_t* O;
    DI void operator()(int row, int col, f32x4 a0, f32x4 a1) const {
        const int f = ((col >> 7) << 6) + (((col & 127) >> 5) << 4) + (col & 15);
        f32x4 h;
#pragma unroll
        for (int i = 0; i < 4; ++i) h[i] = a0[i] * fsigmoid(a0[i]) * a1[i];
        st_bf16x4(O + (long)row * 1024 + f, h); } };
struct EpiGate { bf16_t* O; const float* gate;
    DI void operator()(int row, int col, f32x4 a0, f32x4 a1) const { const float gt = gate[row]; bf16_t* p = O + (long)row * 1024 + col; st_bf16x4(p, a0 * gt); st_bf16x4(p + 16, a1 * gt); } };


DI float quad_max(float v) {
    auto a = __builtin_amdgcn_permlane16_swap(__float_as_uint(v), __float_as_uint(v), false, false); v = fmaxf(__uint_as_float(a[0]), __uint_as_float(a[1]));
    auto b = __builtin_amdgcn_permlane32_swap(__float_as_uint(v), __float_as_uint(v), false, false); return fmaxf(__uint_as_float(b[0]), __uint_as_float(b[1]));
}
DI float quad_sum(float v) {
    auto a = __builtin_amdgcn_permlane16_swap(__float_as_uint(v), __float_as_uint(v), false, false); v = __uint_as_float(a[0]) + __uint_as_float(a[1]);
    auto b = __builtin_amdgcn_permlane32_swap(__float_as_uint(v), __float_as_uint(v), false, false); return __uint_as_float(b[0]) + __uint_as_float(b[1]);
}

namespace pg8 {
#define PG8_LAS __attribute__((address_space(3)))
typedef unsigned short bf16_t;
typedef short bf16x8 __attribute__((ext_vector_type(8)));
typedef float f32x4 __attribute__((ext_vector_type(4)));
typedef unsigned u32x4 __attribute__((ext_vector_type(4)));
constexpr int BM = 256, BK = 64, HALF = 128, HTB = HALF * BK * 2  , STAGE_BYTES = 8 * HTB, NXCD = 8, WGM = 8;

__host__ __device__ __forceinline__ int lds_byte(int r, int c) { const int st = (r >> 4) * 2 + (c >> 5), rr = r & 15, cc = c & 31, ob = rr * 64 + cc * 2; return st * 1024 + (ob ^ (((ob >> 9) & 1) << 5)); }
__host__ __device__ __forceinline__ void stage_rc(int b, int& R, int& C) { const int st = b / 1024, sb = b % 1024, swz = sb ^ (((sb >> 9) & 1) << 5); R = (st >> 1) * 16 + swz / 64; C = (st & 1) * 32 + (swz % 64) / 2; }
__host__ __device__ __forceinline__ int perm32(int rho) { const int n = rho >> 4, i = rho & 15; return 8 * (i >> 2) + 4 * n + (i & 3); }

struct Unit { int pm, pn; };
struct Gemm { const bf16_t* A; const bf16_t* Bt; int M, N, K; };

struct StaticOrder {
    int nM, nN, nwg, G, c;
    __host__ __device__ void init(int M, int N, int G_, int c_) { nM = M / BM; nN = N / BM; nwg = nM * nN; G = G_; c = c_; }
    __host__ __device__ bool next(int i, Unit& u) const {
        const long L = (long)i * G + c; if (L >= nwg) return false;
        int wgid = (int)L; { const int q = nwg / NXCD, r = nwg % NXCD, xcd = wgid % NXCD, off = wgid / NXCD; wgid = (xcd < r ? xcd * (q + 1) : r * (q + 1) + (xcd - r) * q) + off; }
        const int nig = WGM * nN, gid = wgid / nig, fm = gid * WGM, gsz = (nM - fm) < WGM ? (nM - fm) : WGM;
        u.pm = fm + ((wgid % nig) % gsz); u.pn = (wgid % nig) / gsz; return true;
    }
    __device__ __forceinline__ void a_ready(const Unit&) const {}
    __device__ __forceinline__ void done(const Unit&) const {}
};
__device__ __forceinline__ unsigned cvt_pk_bf16(float lo, float hi) { return ::pk2(lo, hi); }
__device__ __forceinline__ u32x4 pk8(f32x4 v0, f32x4 v1) { u32x4 w; w.x = cvt_pk_bf16(v0[0], v0[1]); w.y = cvt_pk_bf16(v0[2], v0[3]); w.z = cvt_pk_bf16(v1[0], v1[1]); w.w = cvt_pk_bf16(v1[2], v1[3]); return w; }
struct PEpiBf16 {
    static constexpr bool PERM = true, AFTER_DRAIN = false;
    bf16_t* O; long ldo;
    __device__ __forceinline__ void operator()(const f32x4 (&acc)[2][2][4][2], const Unit& u, int wr, int wc, int fr, int fq) const {
        const int row0 = u.pm * BM + wr * 64 + fr, col0 = u.pn * BM + wc * 32 + 8 * fq;
#pragma unroll
        for (int ai = 0; ai < 2; ++ai)
#pragma unroll
            for (int m = 0; m < 4; ++m) { bf16_t* rowp = O + (long)(row0 + ai * HALF + m * 16) * ldo + col0;
#pragma unroll
                for (int bj = 0; bj < 2; ++bj) *(u32x4*)(rowp + bj * HALF) = pk8(acc[ai][bj][m][0], acc[ai][bj][m][1]); }
    }
};
struct PEpiF32 {
    static constexpr bool PERM = false, AFTER_DRAIN = false;
    float* C; long ldc;
    __device__ __forceinline__ void operator()(const f32x4 (&acc)[2][2][4][2], const Unit& u, int wr, int wc, int fr, int fq) const {
        const int row0 = u.pm * BM + wr * 64 + fr, col0 = u.pn * BM + wc * 32 + 4 * fq;
#pragma unroll
        for (int ai = 0; ai < 2; ++ai)
#pragma unroll
            for (int m = 0; m < 4; ++m) { float* rowp = C + (long)(row0 + ai * HALF + m * 16) * ldc + col0;
#pragma unroll
                for (int bj = 0; bj < 2; ++bj)
#pragma unroll
                    for (int n = 0; n < 2; ++n) *(f32x4*)(rowp + bj * HALF + n * 16) = acc[ai][bj][m][n]; }
    }
};
struct PEpiResidual {
    static constexpr bool PERM = false, AFTER_DRAIN = false;
    float* X; const float* gate; const float* Xl; const float* Xc;
    __device__ __forceinline__ void operator()(const f32x4 (&acc)[2][2][4][2], const Unit& u, int wr, int wc, int fr, int fq) const {
        const int row0 = u.pm * BM + wr * 64 + fr, col0 = u.pn * BM + wc * 32 + 4 * fq;
        const float* gp = gate + (long)((row0 < 32768) ? (row0 >> 12) : 8) * 6144 + col0;
        f32x4 gv[2][2];
#pragma unroll
        for (int bj = 0; bj < 2; ++bj)
#pragma unroll
            for (int n = 0; n < 2; ++n) gv[bj][n] = *(const f32x4*)(gp + bj * HALF + n * 16);
#pragma unroll
        for (int ai = 0; ai < 2; ++ai)
#pragma unroll
            for (int m = 0; m < 4; ++m) { const long row = row0 + ai * HALF + m * 16; float* rowp = X + row * 1024 + col0;
                const float* inp = ((row0 < 32768) ? (Xl + row * 1024) : (Xc + (row - 32768) * 1024)) + col0;
#pragma unroll
                for (int bj = 0; bj < 2; ++bj)
#pragma unroll
                    for (int n = 0; n < 2; ++n) { const f32x4 x = *(const f32x4*)(inp + bj * HALF + n * 16); *(f32x4*)(rowp + bj * HALF + n * 16) = x + gv[bj][n] * acc[ai][bj][m][n]; }
                asm volatile("" ::: "memory"); }
    }
};
struct PEpiSwiglu {
    static constexpr bool PERM = true, AFTER_DRAIN = false;
    bf16_t* O;
    __device__ __forceinline__ void operator()(const f32x4 (&acc)[2][2][4][2], const Unit& u, int wr, int wc, int fr, int fq) const {
        const int row0 = u.pm * BM + wr * 64 + fr, f0 = (u.pn & 7) * HALF + wc * 32 + 8 * fq;
#pragma unroll
        for (int ai = 0; ai < 2; ++ai)
#pragma unroll
            for (int m = 0; m < 4; ++m) {
                f32x4 h0, h1;
#pragma unroll
                for (int i = 0; i < 4; ++i) { const float a = acc[ai][0][m][0][i], b = acc[ai][0][m][1][i];
                    h0[i] = a * __builtin_amdgcn_rcpf(1.0f + __expf(-a)) * acc[ai][1][m][0][i]; h1[i] = b * __builtin_amdgcn_rcpf(1.0f + __expf(-b)) * acc[ai][1][m][1][i]; }
                *(u32x4*)(O + (long)(row0 + ai * HALF + m * 16) * 1024 + f0) = pk8(h0, h1); }
    }
};
struct PEpiGate {
    static constexpr bool PERM = true, AFTER_DRAIN = false;
    bf16_t* O; const float* gate;
    __device__ __forceinline__ void operator()(const f32x4 (&acc)[2][2][4][2], const Unit& u, int wr, int wc, int fr, int fq) const {
        const int row0 = u.pm * BM + wr * 64 + fr, col0 = (u.pn & 3) * BM + wc * 32 + 8 * fq;
#pragma unroll
        for (int ai = 0; ai < 2; ++ai)
#pragma unroll
            for (int m = 0; m < 4; ++m) { const int row = row0 + ai * HALF + m * 16; const float gt = gate[row]; bf16_t* rowp = O + (long)row * 1024 + col0;
#pragma unroll
                for (int bj = 0; bj < 2; ++bj) *(u32x4*)(rowp + bj * HALF) = pk8(acc[ai][bj][m][0] * gt, acc[ai][bj][m][1] * gt); }
    }
};
struct PEpiQKNorm {
    static constexpr bool PERM = true, AFTER_DRAIN = false;
    bf16_t* O; long ldo; int nq, nk; const float* qg; const float* kg; const float* rope;
    __device__ __forceinline__ void operator()(const f32x4 (&acc)[2][2][4][2], const Unit& u, int wr, int wc, int fr, int fq) const {
        const int row0 = u.pm * BM + wr * 64 + fr, cb = u.pn * BM + 64 * wc + 8 * fq;
        const int kind = (u.pn < nq) ? 0 : ((u.pn < nk) ? 1 : 2);
        f32x4 gn[2][2];
        if (kind < 2) { const float* g = kind ? kg : qg;
#pragma unroll
            for (int bj = 0; bj < 2; ++bj)
#pragma unroll
                for (int n = 0; n < 2; ++n) gn[bj][n] = *(const f32x4*)(g + 32 * bj + 8 * fq + 4 * n); }
#pragma unroll
        for (int ai = 0; ai < 2; ++ai)
#pragma unroll
            for (int m = 0; m < 4; ++m) {
                const int row = row0 + ai * HALF + m * 16;
                f32x4 x[2][2];
#pragma unroll
                for (int bj = 0; bj < 2; ++bj)
#pragma unroll
                    for (int n = 0; n < 2; ++n) x[bj][n] = acc[ai][bj][m][n];
                if (kind < 2) {
                    float ss = 0.f;
#pragma unroll
                    for (int bj = 0; bj < 2; ++bj)
#pragma unroll
                        for (int n = 0; n < 2; ++n) ss += (x[bj][n][0] * x[bj][n][0] + x[bj][n][1] * x[bj][n][1]) + (x[bj][n][2] * x[bj][n][2] + x[bj][n][3] * x[bj][n][3]);
                    ss = ::quad_sum(ss);
                    const float r = rsqrtf(ss * (1.0f / 64.0f) + 1e-6f);
#pragma unroll
                    for (int bj = 0; bj < 2; ++bj)
#pragma unroll
                        for (int n = 0; n < 2; ++n) x[bj][n] = x[bj][n] * r * gn[bj][n];
                    if (rope != nullptr && row < 32768) {
                        const float* cs = rope + (long)(row & 4095) * 32 + 8 * fq; const float* sn = cs + 4096 * 32;
#pragma unroll
                        for (int n = 0; n < 2; ++n) { const f32x4 c = *(const f32x4*)(cs + 4 * n), sv = *(const f32x4*)(sn + 4 * n);
                            const f32x4 a = x[0][n], b = x[1][n]; x[0][n] = a * c - b * sv; x[1][n] = b * c + a * sv; }
                    }
                }
                bf16_t* rowp = O + (long)row * ldo + cb;
#pragma unroll
                for (int bj = 0; bj < 2; ++bj) *(u32x4*)(rowp + 32 * bj) = pk8(x[bj][0], x[bj][1]);
            }
    }
};
struct PEpiRW1 {
    static constexpr bool PERM = true, AFTER_DRAIN = false;
    bf16_t* RKV; bf16_t* LORA;
    __device__ __forceinline__ void operator()(const f32x4 (&acc)[2][2][4][2], const Unit& u, int wr, int wc, int fr, int fq) const {
        const int row0 = u.pm * BM + wr * 64 + fr, cw = wc * 32 + 8 * fq;
#pragma unroll
        for (int ai = 0; ai < 2; ++ai)
#pragma unroll
            for (int m = 0; m < 4; ++m) { const long row = row0 + ai * HALF + m * 16;
#pragma unroll
                for (int bj = 0; bj < 2; ++bj) {
                    f32x4 v0 = acc[ai][bj][m][0], v1 = acc[ai][bj][m][1];
                    if (u.pn < 12) *(u32x4*)(RKV + row * 3072 + u.pn * BM + bj * HALF + cw) = pk8(v0, v1);
                    else {
                        const int cls = (u.pn - 12) * 2 + bj;
                        if (cls == 0) {
#pragma unroll
                            for (int i = 0; i < 4; ++i) { v0[i] = __builtin_amdgcn_rcpf(1.0f + __expf(-v0[i])); v1[i] = __builtin_amdgcn_rcpf(1.0f + __expf(-v1[i])); } }
                        if (cls == 1) {
#pragma unroll
                            for (int i = 0; i < 4; ++i) { v0[i] = 2.0f * __builtin_amdgcn_rcpf(1.0f + __expf(-2.0f * v0[i])) - 1.0f; v1[i] = 2.0f * __builtin_amdgcn_rcpf(1.0f + __expf(-2.0f * v1[i])) - 1.0f; } }
                        if (cls < 3) *(u32x4*)(LORA + row * 384 + cls * HALF + cw) = pk8(v0, v1);
                    } } }
    }
};
struct GroupedOrder {
    int P, NT, G, c;
    __device__ __forceinline__ bool next(int i, Unit& u) const {
        const int per = P * NT;
        if (G == 256) {
            const int x = c & 7, Lx = i * 32 + (c >> 3); if (Lx >= 2 * per) return false;
            const int e = 2 * x + Lx / per, rem = Lx % per, nig = 8 * NT, gid = rem / nig, fm = gid * 8, gsz = (P - fm) < 8 ? (P - fm) : 8, ri = rem % nig;
            u.pm = e * 17 + fm + (ri % gsz); u.pn = e * NT + (ri / gsz); return true;
        }
        const long L = (long)i * G + c; if (L >= (long)16 * per) return false;
        const int e = (int)(L / per), r = (int)(L % per); u.pm = e * 17 + (r % P); u.pn = e * NT + (r / P); return true; }
    __device__ __forceinline__ void a_ready(const Unit&) const {}
    __device__ __forceinline__ void done(const Unit&) const {}
};

template <class Epi, class Sched, bool STAMP = false>
__device__ __forceinline__ void gemm_phase(PG8_LAS unsigned char* lds, const Gemm g, const Sched& S, const Epi& E, unsigned long long* stamps) {
    const int tid = TIDX(), wid = __builtin_amdgcn_readfirstlane(tid >> 6), lane = tid & 63, wr = wid >> 2, wc = wid & 3, fr = lane & 15, fq = lane >> 4;
    const int K = g.K, nt = K / BK;
    int ts_lo = 0, ts_hi = 0, nts = 0; const unsigned long long rt_entry = STAMP ? (unsigned long long)wall_clock64() : 0ull;
#define PG8_STAMP() do { if (STAMP && wid == 0 && nts < 64) { const unsigned long long _c = (unsigned long long)clock64(); \
        ts_lo = (lane == nts) ? (int)(unsigned)_c : ts_lo; ts_hi = (lane == nts) ? (int)(unsigned)(_c >> 32) : ts_hi; ++nts; } } while (0)
    PG8_STAMP();
    unsigned voffA[2], voffB[2];
#pragma unroll
    for (int i = 0; i < 2; ++i) { int R, C; stage_rc(tid * 16 + i * 8192, R, C); const int Rb = Epi::PERM ? ((R & ~31) + perm32(R & 31)) : R;
        voffA[i] = (unsigned)(R * K + C) * 2u; voffB[i] = (unsigned)(Rb * K + C) * 2u; }
    const size_t kstep = (size_t)(BK * 2);
    const size_t hstep = (size_t)HALF * K * 2;
    const size_t tstep = 2 * hstep;
    const unsigned ldsw = (unsigned)wid * 1024u;
    const int aoff = lds_byte(wr * 64 + fr, fq * 8), boff = lds_byte(wc * 32 + fr, fq * 8);
#define PG8_SA(b, h) (((b) * 2 + (h)) * HTB)
#define PG8_SB(b, h) ((4 + (b) * 2 + (h)) * HTB)
#define PG8_STAGE(bufoff, gbase, voff) do { _Pragma("unroll") for (int _i = 0; _i < 2; ++_i) \
        __builtin_amdgcn_global_load_lds((const unsigned*)((const char*)(gbase) + (voff)[_i]), (PG8_LAS unsigned*)(lds + (bufoff) + ldsw + _i * 8192), 16, 0, 0); } while (0)
#define PG8_LDA(dst, b, h) do { _Pragma("unroll") for (int m = 0; m < 4; ++m) _Pragma("unroll") for (int k = 0; k < 2; ++k) dst[m][k] = *(const PG8_LAS bf16x8*)(lds + PG8_SA(b, h) + aoff + m * 2048 + k * 1024); } while (0)
#define PG8_LDB(dst, b, h) do { _Pragma("unroll") for (int n = 0; n < 2; ++n) _Pragma("unroll") for (int k = 0; k < 2; ++k) dst[n][k] = *(const PG8_LAS bf16x8*)(lds + PG8_SB(b, h) + boff + n * 2048 + k * 1024); } while (0)
#define PG8_MMA(ai, bj, At, Bt) do { __builtin_amdgcn_s_setprio(1); _Pragma("unroll") for (int m = 0; m < 4; ++m) _Pragma("unroll") for (int n = 0; n < 2; ++n) _Pragma("unroll") for (int k = 0; k < 2; ++k) \
        acc[ai][bj][m][n] = __builtin_amdgcn_mfma_f32_16x16x32_bf16(Bt[n][k], At[m][k], acc[ai][bj][m][n], 0, 0, 0); __builtin_amdgcn_s_setprio(0); } while (0)
#define PG8_WAIT_V(n) asm volatile("s_waitcnt vmcnt(" #n ")" ::: "memory")
#define PG8_WAIT_L(n) asm volatile("s_waitcnt lgkmcnt(" #n ")" ::: "memory")
#define PG8_BAR __builtin_amdgcn_s_barrier()
#define PG8_SCHED __builtin_amdgcn_sched_barrier(0)
    Unit cur, nxt; int ui = 0;
    if (!S.next(0, cur)) return;
    f32x4 acc[2][2][4][2];
#pragma unroll
    for (int a = 0; a < 2; ++a)
#pragma unroll
        for (int b = 0; b < 2; ++b)
#pragma unroll
            for (int m = 0; m < 4; ++m)
#pragma unroll
                for (int n = 0; n < 2; ++n) acc[a][b][m][n] = (f32x4){0.f, 0.f, 0.f, 0.f};
    bf16x8 At[4][2], B0[2][2], B1[2][2];
    const char* cA = (const char*)g.A + (size_t)cur.pm * tstep; const char* cB = (const char*)g.Bt + (size_t)cur.pn * tstep;
    S.a_ready(cur);
    PG8_STAGE(PG8_SB(0, 0), cB, voffB); PG8_STAGE(PG8_SA(0, 0), cA, voffA); PG8_STAGE(PG8_SB(0, 1), cB + hstep, voffB); PG8_STAGE(PG8_SA(0, 1), cA + hstep, voffA);
    if (wr == 1) PG8_BAR;
    PG8_WAIT_V(4); PG8_BAR;
    PG8_STAGE(PG8_SB(1, 0), cB + kstep, voffB); PG8_STAGE(PG8_SA(1, 0), cA + kstep, voffA); PG8_STAGE(PG8_SB(1, 1), cB + hstep + kstep, voffB);
    PG8_WAIT_V(6); PG8_BAR;
    PG8_STAMP();
    for (;;) {
        const bool has_next = S.next(ui + 1, nxt);
        const char* nA = has_next ? (const char*)g.A + (size_t)nxt.pm * tstep : cA; const char* nB = has_next ? (const char*)g.Bt + (size_t)nxt.pn * tstep : cB;
        for (int t = 0; t < nt; t += 2) {
            const bool last = (t == nt - 2);
            const char* a1 = cA + (size_t)(t + 1) * kstep;
            const char* a2 = last ? nA : cA + (size_t)(t + 2) * kstep; const char* b2 = last ? nB : cB + (size_t)(t + 2) * kstep;
            const char* a3 = a2 + kstep; const char* b3 = b2 + kstep;
            if (last && has_next) S.a_ready(nxt);
            PG8_LDB(B0, 0, 0); PG8_SCHED; PG8_LDA(At, 0, 0); PG8_STAGE(PG8_SA(1, 1), a1 + hstep, voffA);
            PG8_WAIT_L(8); PG8_BAR; PG8_WAIT_L(0); PG8_MMA(0, 0, At, B0); PG8_BAR; PG8_SCHED;
            PG8_LDB(B1, 0, 1); PG8_STAGE(PG8_SB(0, 0), b2, voffB);
            PG8_BAR; PG8_WAIT_L(0); PG8_MMA(0, 1, At, B1); PG8_BAR;
            PG8_LDA(At, 0, 1); PG8_STAGE(PG8_SA(0, 0), a2, voffA);
            PG8_BAR; PG8_WAIT_L(0); PG8_MMA(1, 0, At, B0); PG8_BAR; PG8_SCHED;
            PG8_STAGE(PG8_SB(0, 1), b2 + hstep, voffB);
            PG8_WAIT_V(6); PG8_BAR; PG8_MMA(1, 1, At, B1); PG8_BAR;
            PG8_LDB(B0, 1, 0); PG8_SCHED; PG8_LDA(At, 1, 0); PG8_STAGE(PG8_SA(0, 1), a2 + hstep, voffA);
            PG8_WAIT_L(8); PG8_BAR; PG8_WAIT_L(0); PG8_MMA(0, 0, At, B0); PG8_BAR; PG8_SCHED;
            PG8_LDB(B1, 1, 1); PG8_STAGE(PG8_SB(1, 0), b3, voffB);
            PG8_BAR; PG8_WAIT_L(0); PG8_MMA(0, 1, At, B1); PG8_BAR;
            PG8_LDA(At, 1, 1); PG8_STAGE(PG8_SA(1, 0), a3, voffA);
            PG8_BAR; PG8_WAIT_L(0); PG8_MMA(1, 0, At, B0); PG8_BAR; PG8_SCHED;
            PG8_STAGE(PG8_SB(1, 1), b3 + hstep, voffB);
            PG8_WAIT_V(6); PG8_BAR; PG8_MMA(1, 1, At, B1); PG8_BAR;
        }
        PG8_STAMP();
        if constexpr (!Epi::AFTER_DRAIN) { E(acc, cur, wr, wc, fr, fq); S.done(cur); }
        PG8_STAMP();
        if (!has_next) break;
#pragma unroll
        for (int a = 0; a < 2; ++a)
#pragma unroll
            for (int b = 0; b < 2; ++b)
#pragma unroll
                for (int m = 0; m < 4; ++m)
#pragma unroll
                    for (int n = 0; n < 2; ++n) acc[a][b][m][n] = (f32x4){0.f, 0.f, 0.f, 0.f};
        cur = nxt; cA = nA; cB = nB; ++ui;
    }
    PG8_WAIT_V(0);
    if (wr == 0) PG8_BAR;
    PG8_BAR;
    if constexpr (Epi::AFTER_DRAIN) { E.fused(acc, cur, wr, wc, fr, fq, lds, wid, lane); S.done(cur); }
    PG8_STAMP();
    if (STAMP && wid == 0) { stamps[lane] = lane < nts ? (((unsigned long long)(unsigned)ts_hi << 32) | (unsigned)ts_lo) : 0ull;
        if (lane == 62) stamps[62] = rt_entry; if (lane == 63) stamps[63] = (unsigned long long)wall_clock64(); }
#undef PG8_STAMP
#undef PG8_SA
#undef PG8_SB
#undef PG8_STAGE
#undef PG8_LDA
#undef PG8_LDB
#undef PG8_MMA
#undef PG8_WAIT_V
#undef PG8_WAIT_L
#undef PG8_BAR
#undef PG8_SCHED
}
template <class Epi, class Sched>
__device__ __forceinline__ void gemm_phase_gather(PG8_LAS unsigned char* lds, const Gemm g, const Sched& S, const Epi& E, const int* idx) {
    constexpr bool STAMP = false; unsigned long long* stamps = nullptr;
    const int tid = TIDX(), wid = __builtin_amdgcn_readfirstlane(tid >> 6), lane = tid & 63, wr = wid >> 2, wc = wid & 3, fr = lane & 15, fq = lane >> 4;
    const int K = g.K, nt = K / BK;
    int ts_lo = 0, ts_hi = 0, nts = 0; const unsigned long long rt_entry = STAMP ? (unsigned long long)wall_clock64() : 0ull;
#define PG8_STAMP() do { if (STAMP && wid == 0 && nts < 64) { const unsigned long long _c = (unsigned long long)clock64(); \
        ts_lo = (lane == nts) ? (int)(unsigned)_c : ts_lo; ts_hi = (lane == nts) ? (int)(unsigned)(_c >> 32) : ts_hi; ++nts; } } while (0)
    PG8_STAMP();
    unsigned voffB[2]; int rowA[2]; unsigned colA[2];
#pragma unroll
    for (int i = 0; i < 2; ++i) { int R, C; stage_rc(tid * 16 + i * 8192, R, C); const int Rb = Epi::PERM ? ((R & ~31) + perm32(R & 31)) : R;
        rowA[i] = R; colA[i] = (unsigned)C * 2u; voffB[i] = (unsigned)(Rb * K + C) * 2u; }
    unsigned vc0[2], vc1[2], vn0[2], vn1[2];
#define PG8_GIDX(u, o0, o1) do { const int* ip = idx + (long)(u).pm * BM; const int g00 = ip[rowA[0]], g01 = ip[rowA[1]], g10 = ip[HALF + rowA[0]], g11 = ip[HALF + rowA[1]]; \
        asm volatile("s_waitcnt vmcnt(0)" ::: "memory"); \
        o0[0] = (unsigned)g00 * (unsigned)(K * 2) + colA[0]; o0[1] = (unsigned)g01 * (unsigned)(K * 2) + colA[1]; o1[0] = (unsigned)g10 * (unsigned)(K * 2) + colA[0]; o1[1] = (unsigned)g11 * (unsigned)(K * 2) + colA[1]; } while (0)
    const size_t kstep = (size_t)(BK * 2);
    const size_t hstep = (size_t)HALF * K * 2;
    const size_t tstep = 2 * hstep;
    const unsigned ldsw = (unsigned)wid * 1024u;
    const int aoff = lds_byte(wr * 64 + fr, fq * 8), boff = lds_byte(wc * 32 + fr, fq * 8);
#define PG8_SA(b, h) (((b) * 2 + (h)) * HTB)
#define PG8_SB(b, h) ((4 + (b) * 2 + (h)) * HTB)
#define PG8_STAGE(bufoff, gbase, voff) do { _Pragma("unroll") for (int _i = 0; _i < 2; ++_i) \
        __builtin_amdgcn_global_load_lds((const unsigned*)((const char*)(gbase) + (voff)[_i]), (PG8_LAS unsigned*)(lds + (bufoff) + ldsw + _i * 8192), 16, 0, 0); } while (0)
#define PG8_LDA(dst, b, h) do { _Pragma("unroll") for (int m = 0; m < 4; ++m) _Pragma("unroll") for (int k = 0; k < 2; ++k) dst[m][k] = *(const PG8_LAS bf16x8*)(lds + PG8_SA(b, h) + aoff + m * 2048 + k * 1024); } while (0)
#define PG8_LDB(dst, b, h) do { _Pragma("unroll") for (int n = 0; n < 2; ++n) _Pragma("unroll") for (int k = 0; k < 2; ++k) dst[n][k] = *(const PG8_LAS bf16x8*)(lds + PG8_SB(b, h) + boff + n * 2048 + k * 1024); } while (0)
#define PG8_MMA(ai, bj, At, Bt) do { __builtin_amdgcn_s_setprio(1); _Pragma("unroll") for (int m = 0; m < 4; ++m) _Pragma("unroll") for (int n = 0; n < 2; ++n) _Pragma("unroll") for (int k = 0; k < 2; ++k) \
        acc[ai][bj][m][n] = __builtin_amdgcn_mfma_f32_16x16x32_bf16(Bt[n][k], At[m][k], acc[ai][bj][m][n], 0, 0, 0); __builtin_amdgcn_s_setprio(0); } while (0)
#define PG8_WAIT_V(n) asm volatile("s_waitcnt vmcnt(" #n ")" ::: "memory")
#define PG8_WAIT_L(n) asm volatile("s_waitcnt lgkmcnt(" #n ")" ::: "memory")
#define PG8_BAR __builtin_amdgcn_s_barrier()
#define PG8_SCHED __builtin_amdgcn_sched_barrier(0)
    Unit cur, nxt; int ui = 0;
    if (!S.next(0, cur)) return;
    f32x4 acc[2][2][4][2];
#pragma unroll
    for (int a = 0; a < 2; ++a)
#pragma unroll
        for (int b = 0; b < 2; ++b)
#pragma unroll
            for (int m = 0; m < 4; ++m)
#pragma unroll
                for (int n = 0; n < 2; ++n) acc[a][b][m][n] = (f32x4){0.f, 0.f, 0.f, 0.f};
    bf16x8 At[4][2], B0[2][2], B1[2][2];
    const char* AB = (const char*)g.A; const char* cB = (const char*)g.Bt + (size_t)cur.pn * tstep;
    S.a_ready(cur);
    PG8_GIDX(cur, vc0, vc1);
    PG8_STAGE(PG8_SB(0, 0), cB, voffB); PG8_STAGE(PG8_SA(0, 0), AB, vc0); PG8_STAGE(PG8_SB(0, 1), cB + hstep, voffB); PG8_STAGE(PG8_SA(0, 1), AB, vc1);
    if (wr == 1) PG8_BAR;
    PG8_WAIT_V(4); PG8_BAR;
    PG8_STAGE(PG8_SB(1, 0), cB + kstep, voffB); PG8_STAGE(PG8_SA(1, 0), AB + kstep, vc0); PG8_STAGE(PG8_SB(1, 1), cB + hstep + kstep, voffB);
    PG8_WAIT_V(6); PG8_BAR;
    PG8_STAMP();
    for (;;) {
        const bool has_next = S.next(ui + 1, nxt);
        const char* nB = has_next ? (const char*)g.Bt + (size_t)nxt.pn * tstep : cB;
        for (int t = 0; t < nt; t += 2) {
            const bool last = (t == nt - 2);
            const char* a1 = AB + (size_t)(t + 1) * kstep;
            const char* b2 = last ? nB : cB + (size_t)(t + 2) * kstep;
            const char* b3 = b2 + kstep;
            if (last) { if (has_next) { S.a_ready(nxt); PG8_GIDX(nxt, vn0, vn1); } else { vn0[0] = vc0[0]; vn0[1] = vc0[1]; vn1[0] = vc1[0]; vn1[1] = vc1[1]; } }
            const char* a2 = last ? AB : AB + (size_t)(t + 2) * kstep; const char* a3 = a2 + kstep;
            unsigned w0[2], w1[2];
            w0[0] = last ? vn0[0] : vc0[0]; w0[1] = last ? vn0[1] : vc0[1]; w1[0] = last ? vn1[0] : vc1[0]; w1[1] = last ? vn1[1] : vc1[1];
            PG8_LDB(B0, 0, 0); PG8_SCHED; PG8_LDA(At, 0, 0); PG8_STAGE(PG8_SA(1, 1), a1, vc1);
            PG8_WAIT_L(8); PG8_BAR; PG8_WAIT_L(0); PG8_MMA(0, 0, At, B0); PG8_BAR; PG8_SCHED;
            PG8_LDB(B1, 0, 1); PG8_STAGE(PG8_SB(0, 0), b2, voffB);
            PG8_BAR; PG8_WAIT_L(0); PG8_MMA(0, 1, At, B1); PG8_BAR;
            PG8_LDA(At, 0, 1); PG8_STAGE(PG8_SA(0, 0), a2, w0);
            PG8_BAR; PG8_WAIT_L(0); PG8_MMA(1, 0, At, B0); PG8_BAR; PG8_SCHED;
            PG8_STAGE(PG8_SB(0, 1), b2 + hstep, voffB);
            PG8_WAIT_V(6); PG8_BAR; PG8_MMA(1, 1, At, B1); PG8_BAR;
            PG8_LDB(B0, 1, 0); PG8_SCHED; PG8_LDA(At, 1, 0); PG8_STAGE(PG8_SA(0, 1), a2, w1);
            PG8_WAIT_L(8); PG8_BAR; PG8_WAIT_L(0); PG8_MMA(0, 0, At, B0); PG8_BAR; PG8_SCHED;
            PG8_LDB(B1, 1, 1); PG8_STAGE(PG8_SB(1, 0), b3, voffB);
            PG8_BAR; PG8_WAIT_L(0); PG8_MMA(0, 1, At, B1); PG8_BAR;
            PG8_LDA(At, 1, 1); PG8_STAGE(PG8_SA(1, 0), a3, w0);
            PG8_BAR; PG8_WAIT_L(0); PG8_MMA(1, 0, At, B0); PG8_BAR; PG8_SCHED;
            PG8_STAGE(PG8_SB(1, 1), b3 + hstep, voffB);
            PG8_WAIT_V(6); PG8_BAR; PG8_MMA(1, 1, At, B1); PG8_BAR;
        }
        PG8_STAMP();
        if constexpr (!Epi::AFTER_DRAIN) { E(acc, cur, wr, wc, fr, fq); S.done(cur); }
        PG8_STAMP();
        if (!has_next) break;
#pragma unroll
        for (int a = 0; a < 2; ++a)
#pragma unroll
            for (int b = 0; b < 2; ++b)
#pragma unroll
                for (int m = 0; m < 4; ++m)
#pragma unroll
                    for (int n = 0; n < 2; ++n) acc[a][b][m][n] = (f32x4){0.f, 0.f, 0.f, 0.f};
        cur = nxt; cB = nB; ++ui; vc0[0] = vn0[0]; vc0[1] = vn0[1]; vc1[0] = vn1[0]; vc1[1] = vn1[1];
    }
    PG8_WAIT_V(0);
    if (wr == 0) PG8_BAR;
    PG8_BAR;
    if constexpr (Epi::AFTER_DRAIN) { E.fused(acc, cur, wr, wc, fr, fq, lds, wid, lane); S.done(cur); }
    PG8_STAMP();
    if (STAMP && wid == 0) { stamps[lane] = lane < nts ? (((unsigned long long)(unsigned)ts_hi << 32) | (unsigned)ts_lo) : 0ull;
        if (lane == 62) stamps[62] = rt_entry; if (lane == 63) stamps[63] = (unsigned long long)wall_clock64(); }
#undef PG8_STAMP
#undef PG8_SA
#undef PG8_SB
#undef PG8_STAGE
#undef PG8_LDA
#undef PG8_LDB
#undef PG8_MMA
#undef PG8_WAIT_V
#undef PG8_WAIT_L
#undef PG8_BAR
#undef PG8_SCHED
#undef PG8_GIDX
}
}

constexpr int CONV_NPAR = 4;
template <int MODE>
DI void conv_tiles(const float* src, int K, int N, int Npad, bf16_t* dst, long ldd, int koff, int rowoff,
                   const float* mixv, float alpha, float beta, int& base, char* smem, int rank = -1, int G = 0) {
    float* t = (float*)smem;
    const int tid = TIDX();
    if (G == 0) { G = gridDim.x; rank = (int)blockIdx.x; }
    const int ntn = Npad >> 6, ntiles = (K >> 6) * ntn;
    int first = (rank - (base % G) + G) % G;
    base += ntiles;
    for (int ti0 = first; ti0 < ntiles; ti0 += CONV_NPAR * G) {
        f32x4 v0[CONV_NPAR], v1[CONV_NPAR]; float sc[CONV_NPAR];
        const int k = tid >> 3, n8 = (tid & 7) * 8;
#pragma unroll
        for (int q = 0; q < CONV_NPAR; ++q) {
            const int ti = ti0 + q * G;
            v0[q] = (f32x4){0.f, 0.f, 0.f, 0.f}; v1[q] = v0[q]; sc[q] = 1.0f;
            if (ti < ntiles) {
                const int k0 = (ti / ntn) << 6, n0 = (ti % ntn) << 6;
                sc[q] = mixv ? (alpha + beta * mixv[k0 + k]) : 1.0f;
                if (n0 + n8 < N) { const float* sp = src + (long)(k0 + k) * N + n0 + n8; v0[q] = *(const f32x4*)sp; v1[q] = *(const f32x4*)(sp + 4); }
            }
        }
#pragma unroll
        for (int q = 0; q < CONV_NPAR; ++q) {
            float* tp = t + q * (64 * 65) + k * 65 + n8;
            tp[0] = v0[q][0] * sc[q]; tp[1] = v0[q][1] * sc[q]; tp[2] = v0[q][2] * sc[q]; tp[3] = v0[q][3] * sc[q]; tp[4] = v1[q][0] * sc[q]; tp[5] = v1[q][1] * sc[q]; tp[6] = v1[q][2] * sc[q]; tp[7] = v1[q][3] * sc[q];
        }
        __syncthreads();
#pragma unroll
        for (int q = 0; q < CONV_NPAR; ++q) {
            const int ti = ti0 + q * G;
            if (ti < ntiles) {
                const int k0 = (ti / ntn) << 6, n0 = (ti % ntn) << 6;
                const int n = tid >> 3, kc = (tid & 7) * 8;
                float f[8];
#pragma unroll
                for (int j = 0; j < 8; ++j) f[j] = t[q * (64 * 65) + (kc + j) * 65 + n];
                const int nn = n0 + n;
                const int r = (MODE == 1) ? (128 * (nn >> 6) + 32 * ((nn >> 4) & 3) + (nn & 15)) : ((MODE == 2) ? (256 * (nn >> 7) + (nn & 127)) : ((MODE == 3) ? ((nn & ~255) + 128 * ((nn >> 5) & 1) + 32 * ((nn >> 6) & 3) + (nn & 31)) : nn));
                *(u32x4*)(dst + (long)(r + rowoff) * ldd + koff + k0 + kc) = pack8(f);
            }
        }
        __syncthreads();
    }
}
DI void zero_bf16(bf16_t* dst, long n8  ) {
    for (long i = (long)blockIdx.x * NTHR + TIDX(); i < n8; i += (long)gridDim.x * NTHR) *(u32x4*)(dst + i * 8) = (u32x4){0u, 0u, 0u, 0u};
}

struct Bufs {
    float* MOD; float* ROPE_M; float* ROPE_S; float* X; bf16_t* WMIX; bf16_t* W13; bf16_t* W2T; bf16_t* W2TB;
    DI bf16_t* w2t(int layer) const { return (layer & 1) ? W2TB : W2T; }
    float* AFF; float* AFFC; int* IDX; float* GATE; int* INV; unsigned char* WORK;
    DI bf16_t* slot(int i) const { return (bf16_t*)(WORK + (size_t)i * USLOT); }
};
DI Bufs make_bufs(const Params& p) {
    Bufs b; unsigned char* w = p.ws;
    b.MOD = (float*)(w + OFF_MOD); b.ROPE_M = (float*)(w + OFF_ROPE_M); b.ROPE_S = (float*)(w + OFF_ROPE_S); b.X = (float*)(w + OFF_X);
    b.WMIX = (bf16_t*)(w + OFF_WMIX); b.W13 = (bf16_t*)(w + OFF_WE); b.W2T = (bf16_t*)(w + OFF_WE + 64 * MiB); b.W2TB = (bf16_t*)(w + OFF_W2TB);
    b.AFF = (float*)(w + OFF_AFF); b.AFFC = (float*)(w + OFF_AFFC); b.IDX = (int*)(w + OFF_IDX); b.GATE = (float*)(w + OFF_GATE); b.INV = (int*)(w + OFF_INV);
    b.WORK = w + OFF_WORK; return b;
}

DI void conv_moe_layer(const Params& p, const Bufs& B, int layer, int& base, char* smem, int part = 0, int rank = -1, int G = 0) {
    for (int e = 0; e < NEXP; ++e) {
        const size_t wo = ((size_t)layer * NEXP + e) * 1024 * 1024;
        if (part != 2) {
            conv_tiles<USE_PG8 ? 2 : 1>(p.in[I_MOE_W1] + wo, 1024, 1024, 1024, B.W13 + (size_t)e * 2048 * 1024, 1024, 0, 0, nullptr, 0.f, 0.f, base, smem, rank, G);
            conv_tiles<USE_PG8 ? 2 : 1>(p.in[I_MOE_W3] + wo, 1024, 1024, 1024, B.W13 + (size_t)e * 2048 * 1024, 1024, 0, USE_PG8 ? 128 : 16, nullptr, 0.f, 0.f, base, smem, rank, G);
        }
        if (part != 1) conv_tiles<0>(p.in[I_MOE_W2] + wo, 1024, 1024, 1024, B.w2t(layer) + (size_t)e * 1024 * 1024, 1024, 0, 0, nullptr, 0.f, 0.f, base, smem, rank, G);
    }
}

DI void phase_prologue(const Params& p, const Bufs& B, char* smem) {
    const int tid = TIDX(), G = gridDim.x;
    {
        float* s = (float*)smem;
        float* red = s + 9 * 1024;
        for (int i = tid; i < 9 * 1024; i += NTHR) { const int r = i >> 10, k = i & 1023; const float x = (r < 8) ? p.in[I_C][r * 1024 + k] : p.in[I_CCTX][k]; s[i] = x * fsigmoid(x); }
        __syncthreads();
        for (int it = blockIdx.x; it < 4 * 96; it += G) {
            const int l = it / 96, cg = it % 96, cl = tid & 63, ks = tid >> 6, n = cg * 64 + cl;
            const float* wp = p.in[I_ADAW] + (size_t)l * 1024 * 6144 + (size_t)(ks * 128) * 6144 + n;
            float acc[9];
#pragma unroll
            for (int r = 0; r < 9; ++r) acc[r] = 0.f;
            for (int k = 0; k < 128; ++k) {
                const float wv = wp[(size_t)k * 6144];
#pragma unroll
                for (int r = 0; r < 9; ++r) acc[r] += s[r * 1024 + ks * 128 + k] * wv;
            }
#pragma unroll
            for (int r = 0; r < 9; ++r) red[(ks * 9 + r) * 64 + cl] = acc[r];
            __syncthreads();
            for (int o = tid; o < 9 * 64; o += NTHR) {
                const int r = o >> 6, c = o & 63; float v = 0.f;
#pragma unroll
                for (int q = 0; q < 8; ++q) v += red[(q * 9 + r) * 64 + c];
                B.MOD[((size_t)l * 9 + r) * 6144 + cg * 64 + c] = v + p.in[I_ADAB][l * 6144 + cg * 64 + c];
            }
            __syncthreads();
        }
    }
    for (int i = blockIdx.x * NTHR + tid; i < 4096 * 48; i += G * NTHR) {
        const int pos = i / 48, j = i % 48;
        const int row = pos >> 6, col = pos & 63;
        float inv, posf; float* cdst; float* sdst;
        if (j < 16) { const int m = j & 7; inv = powf(10000.0f, -(float)(2 * m) / 16.0f); posf = (j < 8) ? (float)row : (float)col; cdst = B.ROPE_M + pos * 16 + j; sdst = B.ROPE_M + 4096 * 16 + pos * 16 + j; }
        else { const int jj = j - 16, m = jj & 15; inv = powf(10000.0f, -(float)(2 * m) / 32.0f); posf = (jj < 16) ? (float)row : (float)col; cdst = B.ROPE_S + pos * 32 + jj; sdst = B.ROPE_S + 4096 * 32 + pos * 32 + jj; }
        const float ang = posf * inv;
        double tr = (double)ang * 0.15915494309189535; tr -= rint(tr);
        const float tf = (float)tr;
        *cdst = __builtin_amdgcn_cosf(tf); *sdst = __builtin_amdgcn_sinf(tf);
    }
    int base = 0;
    bf16_t* W = B.WMIX;
    conv_tiles<3>(p.in[I_NA_WQKV], 1024, 3072, 3072, W + W_NA_QKV, 1024, 0, 0, nullptr, 0.f, 0.f, base, smem);
    conv_tiles<0>(p.in[I_NA_WO], 1024, 1024, 1024, W + W_NA_WO, 1024, 0, 0, nullptr, 0.f, 0.f, base, smem);
    {
        const float* mix = p.in[I_RW_MIX];
        bf16_t* B1 = W + W_RW_B1;
        conv_tiles<0>(p.in[I_RW_WR], 1024, 1024, 1024, B1, 2048, 0, 0, mix + 0 * 1024, 1.f, -1.f, base, smem);
        conv_tiles<0>(p.in[I_RW_WR], 1024, 1024, 1024, B1, 2048, 1024, 0, mix + 0 * 1024, 0.f, 0.5f, base, smem);
        conv_tiles<0>(p.in[I_RW_WK], 1024, 1024, 1024, B1, 2048, 0, 1024, mix + 2 * 1024, 1.f, -1.f, base, smem);
        conv_tiles<0>(p.in[I_RW_WK], 1024, 1024, 1024, B1, 2048, 1024, 1024, mix + 2 * 1024, 0.f, 0.5f, base, smem);
        conv_tiles<0>(p.in[I_RW_WV], 1024, 1024, 1024, B1, 2048, 0, 2048, mix + 3 * 1024, 1.f, -1.f, base, smem);
        conv_tiles<0>(p.in[I_RW_WV], 1024, 1024, 1024, B1, 2048, 1024, 2048, mix + 3 * 1024, 0.f, 0.5f, base, smem);
        conv_tiles<0>(p.in[I_RW_G1], 1024, 128, 128, B1, 2048, 0, 3072, mix + 5 * 1024, 1.f, -1.f, base, smem);
        conv_tiles<0>(p.in[I_RW_G1], 1024, 128, 128, B1, 2048, 1024, 3072, mix + 5 * 1024, 0.f, 0.5f, base, smem);
        for (int z = 0; z < 2; ++z) {
            conv_tiles<0>(p.in[I_RW_W1] + (size_t)z * 1024 * 64, 1024, 64, 64, B1, 2048, 0, 3200 + 64 * z, mix + 1 * 1024, 1.f, -1.f, base, smem);
            conv_tiles<0>(p.in[I_RW_W1] + (size_t)z * 1024 * 64, 1024, 64, 64, B1, 2048, 1024, 3200 + 64 * z, mix + 1 * 1024, 0.f, 0.5f, base, smem);
            conv_tiles<0>(p.in[I_RW_A1] + (size_t)z * 1024 * 64, 1024, 64, 64, B1, 2048, 0, 3328 + 64 * z, mix + 4 * 1024, 1.f, -1.f, base, smem);
            conv_tiles<0>(p.in[I_RW_A1] + (size_t)z * 1024 * 64, 1024, 64, 64, B1, 2048, 1024, 3328 + 64 * z, mix + 4 * 1024, 0.f, 0.5f, base, smem);
        }
        zero_bf16(B1 + (size_t)3456 * 2048, (long)128 * 2048 / 8);
        bf16_t* B2 = W + W_RW_B2;
        conv_tiles<0>(p.in[I_RW_G2], 128, 1024, 1024, B2, 384, 0, 0, nullptr, 0.f, 0.f, base, smem);
        for (int z = 0; z < 2; ++z) {
            conv_tiles<0>(p.in[I_RW_W2] + (size_t)z * 64 * 1024, 64, 1024, 1024, B2, 384, 128 + 64 * z, 1024 + 1024 * z, nullptr, 0.f, 0.f, base, smem);
            conv_tiles<0>(p.in[I_RW_A2] + (size_t)z * 64 * 1024, 64, 1024, 1024, B2, 384, 256 + 64 * z, 3072 + 1024 * z, nullptr, 0.f, 0.f, base, smem);
        }
        conv_tiles<0>(p.in[I_RW_WO], 1024, 1024, 1024, W + W_RW_WO, 1024, 0, 0, nullptr, 0.f, 0.f, base, smem);
    }
    conv_tiles<0>(p.in[I_MLA_WDOWN], 1024, 672, 768, W + W_MLA_DOWN, 1024, 0, 0, nullptr, 0.f, 0.f, base, smem);
    conv_tiles<0>(p.in[I_MLA_WUQ], 384, 1536, 1536, W + W_MLA_UQ, 384, 0, 0, nullptr, 0.f, 0.f, base, smem);
    conv_tiles<0>(p.in[I_MLA_WUKV], 256, 2048, 2048, W + W_MLA_UKV, 256, 0, 0, nullptr, 0.f, 0.f, base, smem);
    conv_tiles<0>(p.in[I_MLA_WO], 1024, 1024, 1024, W + W_MLA_WO, 1024, 0, 0, nullptr, 0.f, 0.f, base, smem);
    conv_tiles<3>(p.in[I_SWA_WQKV], 1024, 1536, 1536, W + W_SWA_QKV, 1024, 0, 0, nullptr, 0.f, 0.f, base, smem);
    conv_tiles<0>(p.in[I_SWA_WO], 1024, 1024, 1024, W + W_SWA_WO, 1024, 0, 0, nullptr, 0.f, 0.f, base, smem);
    conv_moe_layer(p, B, 0, base, smem);
}

DI void row_load_f32(const float* row, int lane, float* v) {
#pragma unroll
    for (int i = 0; i < 4; ++i) { const f32x4 t = *(const f32x4*)(row + 256 * i + 4 * lane); v[4 * i] = t[0]; v[4 * i + 1] = t[1]; v[4 * i + 2] = t[2]; v[4 * i + 3] = t[3]; }
}
DI void row_store_bf16(bf16_t* row, int lane, const float* v) {
#pragma unroll
    for (int i = 0; i < 4; ++i) { u32x2 t; t.x = pk2(v[4 * i], v[4 * i + 1]); t.y = pk2(v[4 * i + 2], v[4 * i + 3]); *(u32x2*)(row + 256 * i + 4 * lane) = t; }
}
DI void norm_mod_row(const float* xrow, const float* gain, const float* shift, const float* scale, int lane, float* h) {
    float x[16], gg[16], sh[16], sc[16];
    row_load_f32(xrow, lane, x); row_load_f32(gain, lane, gg); row_load_f32(shift, lane, sh); row_load_f32(scale, lane, sc);
    float ss = 0.f;
#pragma unroll
    for (int e = 0; e < 16; ++e) ss += x[e] * x[e];
    ss = wave_sum(ss);
    const float r = rsqrtf(ss * (1.0f / 1024.0f) + 1e-6f);
#pragma unroll
    for (int e = 0; e < 16; ++e) h[e] = x[e] * r * gg[e] * (1.0f + sc[e]) + sh[e];
}

DI void phase_norm1(const Params& p, const Bufs& B, int layer, bf16_t* H) {
    const int lane = TIDX() & 63, gw = blockIdx.x * 8 + (TIDX() >> 6), nw = gridDim.x * 8;
    const float* gain = p.in[I_N1G] + layer * 1024;
    for (int g = gw; g < TT; g += nw) {
        const float* md = B.MOD + ((size_t)layer * 9 + modrow_of(g)) * 6144;
        float h[16];
        const float* xrow = (layer == 0) ? ((g < TL) ? p.in[I_X] + (size_t)g * 1024 : p.in[I_CTX] + (size_t)(g - TL) * 1024) : (B.X + (size_t)g * 1024);
        norm_mod_row(xrow, gain, md, md + 1024, lane, h);
        row_store_bf16(H + (size_t)g * 1024, lane, h);
    }
}
DI void phase_norm1_rw(const Params& p, const Bufs& B, int layer, bf16_t* H2) {
    const int lane = TIDX() & 63, gw = blockIdx.x * 8 + (TIDX() >> 6), nw = gridDim.x * 8;
    const float* gain = p.in[I_N1G] + layer * 1024;
    for (int g = gw; g < TT; g += nw) {
        const float* md = B.MOD + ((size_t)layer * 9 + modrow_of(g)) * 6144;
        const int t = (g < TL) ? (g & 4095) : ((g - TL) & 255);
        const int len = (g < TL) ? 4096 : 256;
        float h[16], hp[16], hn[16];
        norm_mod_row(B.X + (size_t)g * 1024, gain, md, md + 1024, lane, h);
        if (t > 0) norm_mod_row(B.X + (size_t)(g - 1) * 1024, gain, md, md + 1024, lane, hp);
        else {
#pragma unroll
            for (int e = 0; e < 16; ++e) hp[e] = 0.f;
        }
        if (t < len - 1) norm_mod_row(B.X + (size_t)(g + 1) * 1024, gain, md, md + 1024, lane, hn);
        else {
#pragma unroll
            for (int e = 0; e < 16; ++e) hn[e] = 0.f;
        }
#pragma unroll
        for (int e = 0; e < 16; ++e) hp[e] += hn[e];
        row_store_bf16(H2 + (size_t)g * 2048, lane, h);
        row_store_bf16(H2 + (size_t)g * 2048 + 1024, lane, hp);
    }
}
template <int CTRL> DI float dpp_mv(float x) { return __int_as_float(__builtin_amdgcn_update_dpp(0, __float_as_int(x), CTRL, 0xf, 0xf, false)); }
DI float lx_xor1(float x) { return dpp_mv<0xB1>(x); }
DI float lx_xor2(float x) { return dpp_mv<0x4E>(x); }
DI float lx_xor4(float x) { return dpp_mv<0x1B>(dpp_mv<0x141>(x)); }
DI float lx_xor8(float x) { return dpp_mv<0x128>(x); }
DI float fold32(float p, float q) { auto r = __builtin_amdgcn_permlane32_swap(__float_as_uint(p), __float_as_uint(q), false, false); return __uint_as_float(r[0]) + __uint_as_float(r[1]); }
DI float fold16(float p, float q) { auto r = __builtin_amdgcn_permlane16_swap(__float_as_uint(p), __float_as_uint(q), false, false); return __uint_as_float(r[0]) + __uint_as_float(r[1]); }
DI float wsum_fast(float x) {
    x += lx_xor1(x); x += lx_xor2(x); x += dpp_mv<0x141>(x); x += dpp_mv<0x140>(x);
    const int xi = __float_as_int(x);
    return (__int_as_float(__builtin_amdgcn_readlane(xi, 0)) + __int_as_float(__builtin_amdgcn_readlane(xi, 16))) + (__int_as_float(__builtin_amdgcn_readlane(xi, 32)) + __int_as_float(__builtin_amdgcn_readlane(xi, 48)));
}
DI void norm2_token(const float* x, const float* A, const float* Bv, const float* wr, int g, int lane, bf16_t* H, const Bufs& B) {
    float ss = 0.f;
#pragma unroll
    for (int e = 0; e < 16; ++e) ss += x[e] * x[e];
    ss = wsum_fast(ss);
    const float r = rsqrtf(ss * (1.0f / 1024.0f) + 1e-6f);
    float h[16];
#pragma unroll
    for (int e = 0; e < 16; ++e) h[e] = x[e] * r * A[e] + Bv[e];
    row_store_bf16(H + (size_t)g * 1024, lane, h);
    float a[16];
#pragma unroll
    for (int e = 0; e < 16; ++e) {
        float acc = 0.f;
#pragma unroll
        for (int i = 0; i < 4; ++i) { const f32x4 w4 = *(const f32x4*)(wr + e * 1024 + 256 * i + 4 * lane); acc += h[4 * i] * w4[0] + h[4 * i + 1] * w4[1] + h[4 * i + 2] * w4[2] + h[4 * i + 3] * w4[3]; }
        a[e] = acc;
        if ((e & 3) == 3) asm volatile("" ::: "memory");
    }
    float b8[8], c4[4], d2[2];
    const bool h8 = (lane & 8) != 0, h4 = (lane & 4) != 0;
#pragma unroll
    for (int e = 0; e < 8; ++e) b8[e] = fold32(a[e], a[e + 8]);
#pragma unroll
    for (int e = 0; e < 4; ++e) c4[e] = fold16(b8[e], b8[e + 4]);
#pragma unroll
    for (int e = 0; e < 2; ++e) { const float send = h8 ? c4[e] : c4[e + 2], keep = h8 ? c4[e + 2] : c4[e]; d2[e] = keep + lx_xor8(send); }
    float lg;
    { const float send = h4 ? d2[0] : d2[1], keep = h4 ? d2[1] : d2[0]; lg = keep + lx_xor4(send); }
    lg += lx_xor2(lg); lg += lx_xor1(lg);
    float mx = lg;
    mx = fmaxf(mx, lx_xor4(mx)); mx = fmaxf(mx, lx_xor8(mx));
    { auto r = __builtin_amdgcn_permlane16_swap(__float_as_uint(mx), __float_as_uint(mx), false, false); mx = fmaxf(__uint_as_float(r[0]), __uint_as_float(r[1])); }
    { auto r = __builtin_amdgcn_permlane32_swap(__float_as_uint(mx), __float_as_uint(mx), false, false); mx = fmaxf(__uint_as_float(r[0]), __uint_as_float(r[1])); }
    const float ex = __expf(lg - mx);
    float se = ex;
    se += lx_xor4(se); se += lx_xor8(se);
    se = fold16(se, se); se = fold32(se, se);
    const float aff = ex / se;
    if ((lane & 3) == 0) {
        const int e = lane >> 2;
        if (g < TL) B.AFF[((size_t)(g >> 12) * 16 + e) * 4096 + (g & 4095)] = aff;
        else { const int gc = g - TL; B.AFFC[((size_t)(gc >> 8) * 16 + e) * 256 + (gc & 255)] = aff; }
        B.INV[(size_t)g * 16 + e] = -1;
    }
}
DI void phase_norm2(const Params& p, const Bufs& B, int layer, bf16_t* H, int ntok, char* smem) {
    float* wr = (float*)smem;
    const float* rsrc = p.in[I_MOE_ROUTER] + (size_t)layer * 1024 * 16;
    for (int i = TIDX(); i < 1024 * 16; i += NTHR) { const int k = i >> 4, e = i & 15; wr[e * 1024 + k] = rsrc[i]; }
    __syncthreads();
    const int lane = TIDX() & 63, gw = blockIdx.x * 8 + (TIDX() >> 6);
    float gain[16];
    row_load_f32(p.in[I_N2G] + layer * 1024, lane, gain);
    const int nr = (ntok > TL) ? 9 : 8;
    float x0[16], x1[16];
    row_load_f32(B.X + (size_t)gw * 1024, lane, x0); row_load_f32(B.X + (size_t)(gw + 2048) * 1024, lane, x1);
    for (int r = 0; r < nr; ++r) {
        float n0[16], n1[16];
        if (r + 1 < nr) {
            const int gb = (r + 1 < 8) ? (r + 1) * 4096 : TL;
            row_load_f32(B.X + (size_t)(gb + gw) * 1024, lane, n0);
            if (r + 1 < 8) row_load_f32(B.X + (size_t)(gb + gw + 2048) * 1024, lane, n1);
        }
        const float* md = B.MOD + ((size_t)layer * 9 + r) * 6144;
        float A[16], Bv[16];
        row_load_f32(md + 4 * 1024, lane, A); row_load_f32(md + 3 * 1024, lane, Bv);
#pragma unroll
        for (int e = 0; e < 16; ++e) A[e] = gain[e] * (1.0f + A[e]);
        const int gb = (r < 8) ? r * 4096 : TL;
        norm2_token(x0, A, Bv, wr, gb + gw, lane, H, B);
        if (r < 8) norm2_token(x1, A, Bv, wr, gb + gw + 2048, lane, H, B);
#pragma unroll
        for (int e = 0; e < 16; ++e) { x0[e] = n0[e]; x1[e] = n1[e]; }
    }
}

DI void ld16(const bf16_t* p, float* v) { unpack8(*(const u32x4*)p, v); unpack8(*(const u32x4*)(p + 8), v + 8); }
DI void st16(bf16_t* p, const float* v) { *(u32x4*)p = pack8(v); *(u32x4*)(p + 8) = pack8(v + 8); }
DI void headnorm64(float* v, const float* gain, int p) {
    float ss = 0.f;
#pragma unroll
    for (int e = 0; e < 16; ++e) ss += v[e] * v[e];
    ss += __shfl_xor(ss, 1); ss += __shfl_xor(ss, 2);
    const float r = rsqrtf(ss * (1.0f / 64.0f) + 1e-6f);
#pragma unroll
    for (int e = 0; e < 16; ++e) v[e] = v[e] * r * gain[16 * p + e];
}
DI void rope64(float* v, const float* cs, const float* sn, int p) {
    const int i0 = 16 * (p & 1);
#pragma unroll
    for (int e = 0; e < 16; ++e) {
        const float o = __shfl_xor(v[e], 2), c = cs[i0 + e], s = sn[i0 + e];
        v[e] = (p < 2) ? (v[e] * c - o * s) : (v[e] * c + o * s);
    }
}

DI void phase_qknorm_na(const Params& p, bf16_t* QKV) {
    const int lane = TIDX() & 63, gw = blockIdx.x * 8 + (TIDX() >> 6), nw = gridDim.x * 8, pp = lane & 3;
    const float* qg = p.in[I_NA_QG]; const float* kg = p.in[I_NA_KG];
    for (int g = gw; g < TT; g += nw) {
        bf16_t* row = QKV + (size_t)g * 3072 + 16 * lane;
        float v[16];
        ld16(row, v); headnorm64(v, qg, pp); st16(row, v);
        ld16(row + 1024, v); headnorm64(v, kg, pp); st16(row + 1024, v);
    }
}
DI void phase_qknorm_swa(const Params& p, const Bufs& B, bf16_t* QKV) {
    const int lane = TIDX() & 63, gw = blockIdx.x * 8 + (TIDX() >> 6), nw = gridDim.x * 8, pp = lane & 3;
    const float* qg = p.in[I_SWA_QG]; const float* kg = p.in[I_SWA_KG];
    for (int g = gw; g < TT; g += nw) {
        bf16_t* row = QKV + (size_t)g * 1536;
        const bool lat = g < TL;
        const int pos = g & 4095;
        const float* cs = B.ROPE_S + (size_t)(lat ? pos : 0) * 32; const float* sn = cs + 4096 * 32;
        float v[16];
        ld16(row + 16 * lane, v); headnorm64(v, qg, pp);
        if (lat) rope64(v, cs, sn, pp);
        st16(row + 16 * lane, v);
        const int kl = lane & 15;
        ld16(row + 1024 + 16 * kl, v); headnorm64(v, kg, pp);
        if (lat) rope64(v, cs, sn, pp);
        if (lane < 16) st16(row + 1024 + 16 * kl, v);
    }
}
DI void phase_mla_dnorm(const Params& p, const Bufs& B, const bf16_t* DOWN, bf16_t* CQ, bf16_t* CKV, bf16_t* KR) {
    const int lane = TIDX() & 63, gw = blockIdx.x * 8 + (TIDX() >> 6), nw = gridDim.x * 8;
    float gq[6], gkv[4];
#pragma unroll
    for (int e = 0; e < 6; ++e) gq[e] = p.in[I_MLA_QNG][6 * lane + e];
#pragma unroll
    for (int e = 0; e < 4; ++e) gkv[e] = p.in[I_MLA_KVNG][4 * lane + e];
    const int l31 = lane & 31;
    const float gkr = p.in[I_MLA_KR_G][l31];
    for (int g = gw; g < TT; g += nw) {
        const bf16_t* d = DOWN + (size_t)g * 768;
        const unsigned q0 = *(const unsigned*)(d + 6 * lane), q1 = *(const unsigned*)(d + 6 * lane + 2), q2 = *(const unsigned*)(d + 6 * lane + 4);
        const u32x2 kv = *(const u32x2*)(d + 384 + 4 * lane);
        const unsigned short krw = d[640 + l31];
        float a[6] = {bflo(q0), bfhi(q0), bflo(q1), bfhi(q1), bflo(q2), bfhi(q2)};
        float ss = 0.f;
#pragma unroll
        for (int e = 0; e < 6; ++e) ss += a[e] * a[e];
        ss = wave_sum(ss);
        float r = rsqrtf(ss * (1.0f / 384.0f) + 1e-6f);
        bf16_t* cq = CQ + (size_t)g * 384 + 6 * lane;
        *(unsigned*)(cq) = pk2(a[0] * r * gq[0], a[1] * r * gq[1]); *(unsigned*)(cq + 2) = pk2(a[2] * r * gq[2], a[3] * r * gq[3]); *(unsigned*)(cq + 4) = pk2(a[4] * r * gq[4], a[5] * r * gq[5]);
        float c[4] = {bflo(kv.x), bfhi(kv.x), bflo(kv.y), bfhi(kv.y)};
        ss = (c[0] * c[0] + c[1] * c[1]) + (c[2] * c[2] + c[3] * c[3]);
        ss = wave_sum(ss);
        r = rsqrtf(ss * (1.0f / 256.0f) + 1e-6f);
        u32x2 o; o.x = pk2(c[0] * r * gkv[0], c[1] * r * gkv[1]); o.y = pk2(c[2] * r * gkv[2], c[3] * r * gkv[3]);
        *(u32x2*)(CKV + (size_t)g * 256 + 4 * lane) = o;
        float x = (lane < 32) ? bf2f(krw) : 0.f;
        ss = wave_sum(x * x);
        r = rsqrtf(ss * (1.0f / 32.0f) + 1e-6f);
        x = x * r * gkr;
        const float ox = __shfl_xor(x, 16);
        if (g < TL) {
            const int pos = g & 4095, ii = lane & 15;
            const float cc = B.ROPE_M[pos * 16 + ii], sn = B.ROPE_M[4096 * 16 + pos * 16 + ii];
            x = (l31 < 16) ? (x * cc - ox * sn) : (x * cc + ox * sn);
        }
        if (lane < 32) KR[(size_t)g * 32 + lane] = (bf16_t)f2bf(x);
    }
}
DI void phase_mla_hnorm(const Params& p, const Bufs& B, bf16_t* Q, bf16_t* KV) {
    const int lane = TIDX() & 63, gw = blockIdx.x * 8 + (TIDX() >> 6), nw = gridDim.x * 8, pp = lane & 3, hh = lane >> 2;
    const float* qng = p.in[I_MLA_QN_G]; const float* qrg = p.in[I_MLA_QR_G]; const float* kng = p.in[I_MLA_KN_G];
    for (int g = gw; g < TT; g += nw) {
        bf16_t* q = Q + (size_t)g * 1536 + hh * 96;
        float v[16];
        ld16(q + 16 * pp, v); headnorm64(v, qng, pp); st16(q + 16 * pp, v);
        float w[8];
        unpack8(*(const u32x4*)(q + 64 + 8 * pp), w);
        float ss = 0.f;
#pragma unroll
        for (int e = 0; e < 8; ++e) ss += w[e] * w[e];
        ss += __shfl_xor(ss, 1); ss += __shfl_xor(ss, 2);
        const float r = rsqrtf(ss * (1.0f / 32.0f) + 1e-6f);
#pragma unroll
        for (int e = 0; e < 8; ++e) w[e] = w[e] * r * qrg[8 * pp + e];
        if (g < TL) {
            const int pos = g & 4095, i0 = 8 * (pp & 1);
#pragma unroll
            for (int e = 0; e < 8; ++e) {
                const float o = __shfl_xor(w[e], 2), c = B.ROPE_M[pos * 16 + i0 + e], s = B.ROPE_M[4096 * 16 + pos * 16 + i0 + e];
                w[e] = (pp < 2) ? (w[e] * c - o * s) : (w[e] * c + o * s);
            }
        }
        *(u32x4*)(q + 64 + 8 * pp) = pack8(w);
        bf16_t* k = KV + (size_t)g * 2048 + hh * 128 + 16 * pp;
        ld16(k, v); headnorm64(v, kng, pp); st16(k, v);
    }
}

typedef short v4i16_t __attribute__((ext_vector_type(4)));
DI s16x4 tr_read(const bf16_t* p) { return __builtin_bit_cast(s16x4, __builtin_amdgcn_ds_read_tr16_b64_v4i16((LAS v4i16_t*)(LAS char*)(char*)p)); }
constexpr int ATT_LDS = 64 * 104 * 2 + 64 * 72 * 2 + 2048;

template <class P>
DI void attn_unit(const P& pol, char* smem) {
    constexpr int DQK = P::DQK, KS = DQK + 8, VS = 72, NS = DQK / 32, NCH = DQK / 8;
    bf16_t* Ks = (bf16_t*)smem;
    bf16_t* Vs = (bf16_t*)(smem + 64 * 104 * 2);
    const int tid = TIDX(), lane = tid & 63, w = tid >> 6, l15 = lane & 15, quad = lane >> 4;
    const int q = w * 16 + l15;
    __syncthreads();
    pol.prologue(smem + 64 * 104 * 2 + 64 * 72 * 2);
    bf16x8 qf[NS];
#pragma unroll
    for (int s = 0; s < NS; ++s) qf[s] = *(const bf16x8*)pol.qptr(q, s * 4 + quad);
    f32x4 o[4];
#pragma unroll
    for (int u = 0; u < 4; ++u) o[u] = (f32x4){0.f, 0.f, 0.f, 0.f};
    float m = -1e30f, l = 0.f;
    const int k0key = (DQK == 64) ? (tid >> 3) : (tid / 12), k0ch = (DQK == 64) ? (tid & 7) : (tid % 12);
    const int k1key = (tid + 512) / 12, k1ch = (tid + 512) % 12;
    const bool k1on = (DQK == 96) && (tid < 256);
    const int vkey = tid >> 3, vch = tid & 7;
    const int nt = pol.ntiles();
    u32x4 rk0, rk1 = (u32x4){0u, 0u, 0u, 0u}, rv;
    rk0 = *(const u32x4*)pol.kptr(0, k0key, k0ch);
    if (k1on) rk1 = *(const u32x4*)pol.kptr(0, k1key, k1ch);
    rv = *(const u32x4*)pol.vptr(0, vkey, vch);
    *(u32x4*)(Ks + k0key * KS + k0ch * 8) = rk0;
    if (k1on) *(u32x4*)(Ks + k1key * KS + k1ch * 8) = rk1;
    *(u32x4*)(Vs + vkey * VS + vch * 8) = rv;
    __syncthreads();
    for (int j = 0; j < nt; ++j) {
        const bool more = (j + 1 < nt);
        if (more) {
            rk0 = *(const u32x4*)pol.kptr(j + 1, k0key, k0ch);
            if (k1on) rk1 = *(const u32x4*)pol.kptr(j + 1, k1key, k1ch);
            rv = *(const u32x4*)pol.vptr(j + 1, vkey, vch);
        }
        f32x4 sc[2][2];
#pragma unroll
        for (int g = 0; g < 2; ++g)
#pragma unroll
            for (int t = 0; t < 2; ++t) {
                f32x4 a = (f32x4){0.f, 0.f, 0.f, 0.f};
                const int key = 32 * g + 8 * (l15 >> 2) + 4 * t + (l15 & 3);
#pragma unroll
                for (int s = 0; s < NS; ++s) { const bf16x8 kf = *(const bf16x8*)(Ks + key * KS + 32 * s + 8 * quad); a = __builtin_amdgcn_mfma_f32_16x16x32_bf16(kf, qf[s], a, 0, 0, 0); }
                sc[g][t] = a;
            }
        float tmax = -3.0e38f;
#pragma unroll
        for (int g = 0; g < 2; ++g)
#pragma unroll
            for (int t = 0; t < 2; ++t)
#pragma unroll
                for (int r = 0; r < 4; ++r) { const float s2 = pol.mod(sc[g][t][r] * pol.c2, q, j, 32 * g + 8 * quad + 4 * t + r); sc[g][t][r] = s2; tmax = fmaxf(tmax, s2); }
        tmax = fmaxf(tmax, __shfl_xor(tmax, 16)); tmax = fmaxf(tmax, __shfl_xor(tmax, 32));
        const float mn = fmaxf(m, tmax), alpha = fexp2(m - mn);
        m = mn;
        float ps = 0.f;
        bf16x8 pf[2];
#pragma unroll
        for (int g = 0; g < 2; ++g) {
            float pv[8];
#pragma unroll
            for (int t = 0; t < 2; ++t)
#pragma unroll
                for (int r = 0; r < 4; ++r) { const float e = fexp2(sc[g][t][r] - mn); ps += e; pv[4 * t + r] = e; }
            pf[g] = __builtin_bit_cast(bf16x8, pack8(pv));
        }
        l = l * alpha + ps;
#pragma unroll
        for (int u = 0; u < 4; ++u) o[u] *= alpha;
#pragma unroll
        for (int u = 0; u < 4; ++u)
#pragma unroll
            for (int g = 0; g < 2; ++g) {
                const bf16_t* vb = Vs + (32 * g + 8 * quad + (l15 >> 2)) * VS + 16 * u + 4 * (l15 & 3);
                const s16x4 lo = tr_read(vb), hi = tr_read(vb + 4 * VS);
                bf16x8 vf; vf[0] = lo[0]; vf[1] = lo[1]; vf[2] = lo[2]; vf[3] = lo[3]; vf[4] = hi[0]; vf[5] = hi[1]; vf[6] = hi[2]; vf[7] = hi[3];
                o[u] = __builtin_amdgcn_mfma_f32_16x16x32_bf16(vf, pf[g], o[u], 0, 0, 0);
            }
        __syncthreads();
        if (more) {
            *(u32x4*)(Ks + k0key * KS + k0ch * 8) = rk0;
            if (k1on) *(u32x4*)(Ks + k1key * KS + k1ch * 8) = rk1;
            *(u32x4*)(Vs + vkey * VS + vch * 8) = rv;
        }
        __syncthreads();
    }
    l += __shfl_xor(l, 16); l += __shfl_xor(l, 32);
    if (P::SINK) l += fexp2(pol.sink2 - m);
    const float il = 1.0f / l;
    bf16_t* op = pol.optr(q);
#pragma unroll
    for (int u = 0; u < 4; ++u) st_bf16x4(op + 16 * u + 4 * quad, o[u] * il);
}

struct PolPlain64 {
    static constexpr int DQK = 64; static constexpr bool SINK = false;
    const bf16_t* Qb; long qs; const bf16_t* Kb; long ks; const bf16_t* Vb; long vs; bf16_t* Ob; long os; int qrow0, krow0, nt; float c2, sink2;
    DI void prologue(char*) const {}
    DI int ntiles() const { return nt; }
    DI const bf16_t* qptr(int q, int ch) const { return Qb + (long)(qrow0 + q) * qs + ch * 8; }
    DI const bf16_t* kptr(int j, int i, int ch) const { return Kb + (long)(krow0 + 64 * j + i) * ks + ch * 8; }
    DI const bf16_t* vptr(int j, int i, int ch) const { return Vb + (long)(krow0 + 64 * j + i) * vs + ch * 8; }
    DI float mod(float s2, int, int, int) const { return s2; }
    DI bf16_t* optr(int q) const { return Ob + (long)(qrow0 + q) * os; }
};
struct PolNA {
    static constexpr int DQK = 64; static constexpr bool SINK = false;
    const bf16_t* QKV; bf16_t* AO; const float* rpb; const float* bl; int b, h, rr, rbase; float c2, sink2;
    DI void prologue(char* s) const { float* t = (float*)s; for (int i = TIDX(); i < 465; i += NTHR) t[i] = rpb[h * 465 + i] * LOG2E; }
    DI int ntiles() const { return 13; }
    DI int qtok(int q) const { return b * 4096 + (2 * rr + (q >> 6)) * 64 + (q & 63); }
    DI int ktok(int j, int i) const { if (j < 4) return TL + b * 256 + 64 * j + i; int kr = rbase + j - 4; kr = kr > 63 ? 63 : kr; return b * 4096 + kr * 64 + i; }
    DI const bf16_t* qptr(int q, int ch) const { return QKV + (long)qtok(q) * 3072 + h * 64 + ch * 8; }
    DI const bf16_t* kptr(int j, int i, int ch) const { return QKV + (long)ktok(j, i) * 3072 + 1024 + h * 64 + ch * 8; }
    DI const bf16_t* vptr(int j, int i, int ch) const { return QKV + (long)ktok(j, i) * 3072 + 2048 + h * 64 + ch * 8; }
    DI float mod(float s2, int q, int j, int kc) const {
        if (j < 4) return s2;
        const int kr = rbase + j - 4, qr = 2 * rr + (q >> 6), qc = q & 63;
        int r0 = qr - 4; r0 = r0 < 0 ? 0 : (r0 > 56 ? 56 : r0);
        int c0 = qc - 8; c0 = c0 < 0 ? 0 : (c0 > 48 ? 48 : c0);
        const bool ok = (kr >= r0) && (kr <= r0 + 7) && (kc >= c0) && (kc < c0 + 16);
        const int idx = ok ? ((kr - qr + 7) * 31 + (kc - qc + 15)) : 0;
        return ok ? (s2 + bl[idx]) : -1e30f;
    }
    DI bf16_t* optr(int q) const { return AO + (long)qtok(q) * 1024 + h * 64; }
};
struct PolMLA {
    static constexpr int DQK = 96; static constexpr bool SINK = false;
    const bf16_t* Q; const bf16_t* KV; const bf16_t* KR; bf16_t* AO; int b, h, qrow0, nt; float c2, sink2;
    DI void prologue(char*) const {}
    DI int ntiles() const { return nt; }
    DI int ktok(int j, int i) const { return (j < 4) ? (TL + b * 256 + 64 * j + i) : (b * 4096 + 64 * (j - 4) + i); }
    DI const bf16_t* qptr(int q, int ch) const { return Q + (long)(qrow0 + q) * 1536 + h * 96 + ch * 8; }
    DI const bf16_t* kptr(int j, int i, int ch) const { const long t = ktok(j, i); return (ch < 8) ? (KV + t * 2048 + h * 128 + ch * 8) : (KR + t * 32 + (ch - 8) * 8); }
    DI const bf16_t* vptr(int j, int i, int ch) const { return KV + (long)ktok(j, i) * 2048 + h * 128 + 64 + ch * 8; }
    DI float mod(float s2, int, int, int) const { return s2; }
    DI bf16_t* optr(int q) const { return AO + (long)(qrow0 + q) * 1024 + h * 64; }
};
struct PolSWA {
    static constexpr int DQK = 64; static constexpr bool SINK = true;
    const bf16_t* QKV; bf16_t* AO; int b, hq, s0; float c2, sink2;
    DI void prologue(char*) const {}
    DI int ntiles() const { return 10; }
    DI int ktok(int j, int i) const { if (j < 4) return TL + b * 256 + 64 * j + i; int kp = s0 - 128 + 64 * (j - 4) + i; kp = kp < 0 ? 0 : (kp > 4095 ? 4095 : kp); return b * 4096 + kp; }
    DI const bf16_t* qptr(int q, int ch) const { return QKV + (long)(b * 4096 + s0 + q) * 1536 + hq * 64 + ch * 8; }
    DI const bf16_t* kptr(int j, int i, int ch) const { return QKV + (long)ktok(j, i) * 1536 + 1024 + (hq >> 2) * 64 + ch * 8; }
    DI const bf16_t* vptr(int j, int i, int ch) const { return QKV + (long)ktok(j, i) * 1536 + 1280 + (hq >> 2) * 64 + ch * 8; }
    DI float mod(float s2, int q, int j, int kc) const {
        if (j < 4) return s2;
        const int kp = s0 - 128 + 64 * (j - 4) + kc, qp = s0 + q, d = qp - kp;
        const bool ok = (kp >= 0) && (kp < 4096) && (d <= 128) && (d >= -128);
        return ok ? s2 : -1e30f;
    }
    DI bf16_t* optr(int q) const { return AO + (long)(b * 4096 + s0 + q) * 1024 + hq * 64; }
};

DI float ftanh(float x) { return 2.0f * fsigmoid(2.0f * x) - 1.0f; }
struct EpiRW1 { bf16_t* RKV; bf16_t* LORA;
    DI f32x4 act(f32x4 a, int lc) const {
        f32x4 r;
#pragma unroll
        for (int i = 0; i < 4; ++i) r[i] = (lc < 128) ? fsigmoid(a[i]) : ((lc < 256) ? ftanh(a[i]) : a[i]);
        return r; }
    DI void operator()(int row, int col, f32x4 a0, f32x4 a1) const {
        if (col < 3072) { bf16_t* p = RKV + (long)row * 3072 + col; st_bf16x4(p, a0); st_bf16x4(p + 16, a1); }
        else if (col < 3456) { const int lc = col - 3072; bf16_t* p = LORA + (long)row * 384 + lc; st_bf16x4(p, act(a0, lc)); st_bf16x4(p + 16, act(a1, lc)); }
    } };
struct EpiRW2 { int seg; bf16_t* O; const float* bias;
    DI f32x4 f(f32x4 a, const float* bp) const {
        f32x4 r;
#pragma unroll
        for (int i = 0; i < 4; ++i) { const float t = fsigmoid(a[i] + bp[i]); r[i] = (seg < 3) ? 0.6065306597126334f * t : t; }
        return r; }
    DI void operator()(int row, int col, f32x4 a0, f32x4 a1) const {
        const int n = col - 1024 * seg; bf16_t* p = O + (long)row * 1024 + n;
        if (seg == 0) { st_bf16x4(p, a0); st_bf16x4(p + 16, a1); }
        else { st_bf16x4(p, f(a0, bias + n)); st_bf16x4(p + 16, f(a1, bias + n + 16)); }
    } };

DI void phase_rw_gemm2(const Params& p, const Bufs& B, const bf16_t* LORA, bf16_t* G, bf16_t* XD0, bf16_t* XD1, bf16_t* AA0, bf16_t* AA1, char* smem) {
    const int ntm = TT >> 7, nt = ntm * 40;
    for (int t = blockIdx.x; t < nt; t += gridDim.x) {
        const int tm = t / 40, tn = t % 40, seg = tn >> 3;
        GemmOp g; g.A = LORA; g.lda = 384; g.Bt = B.WMIX + W_RW_B2; g.ldb = 384;
        g.kbeg = (seg == 0) ? 0 : (64 + 64 * seg); g.kend = (seg == 0) ? 128 : (128 + 64 * seg);
        EpiRW2 e; e.seg = seg;
        e.O = (seg == 0) ? G : (seg == 1 ? XD0 : (seg == 2 ? XD1 : (seg == 3 ? AA0 : AA1)));
        e.bias = (seg == 0) ? nullptr : ((seg < 3) ? p.in[I_RW_W0] + (seg - 1) * 1024 : p.in[I_RW_A0] + (seg - 3) * 1024);
        gemm_tile(g, tm * 128, tn * 128, e, smem);
    }
}

template <int CTRL> DI float dppmov(float x) { return __int_as_float(__builtin_amdgcn_update_dpp(0, __float_as_int(x), CTRL, 0xf, 0xf, false)); }
DI float red8(float x) { x += dppmov<0xB1>(x); x += dppmov<0x4E>(x); x += dppmov<0x141>(x); return x; }
DI float wave_sum_dpp(float x) {
    x += dppmov<0xB1>(x); x += dppmov<0x4E>(x); x += dppmov<0x141>(x); x += dppmov<0x140>(x);
    const int xi = __float_as_int(x);
    const float s0 = __int_as_float(__builtin_amdgcn_readlane(xi, 0)), s1 = __int_as_float(__builtin_amdgcn_readlane(xi, 16)), s2 = __int_as_float(__builtin_amdgcn_readlane(xi, 32)), s3 = __int_as_float(__builtin_amdgcn_readlane(xi, 48));
    return (s0 + s1) + (s2 + s3);
}

constexpr int SCAN_LDS = 32 * 384 * 4 + 32 * 64 * 4;
DI void phase_rw_scan(const Params& p, const bf16_t* RKV, const bf16_t* XD0, const bf16_t* XD1, const bf16_t* AA0, const bf16_t* AA1, bf16_t* YF, bf16_t* YB, char* smem) {
    float* vec = (float*)smem;
    float* ybuf = vec + 32 * 384;
    const int tid = TIDX(), lane = tid & 63, wv = tid >> 6, il = lane >> 3, js = lane & 7, irow = 8 * wv + il;
    const int ss = tid >> 4, jg = tid & 15;
    for (int unit = blockIdx.x; unit < 256; unit += gridDim.x) {
        const int dir = unit & 1, b = unit >> 5, h = (unit >> 1) & 15;
        const bf16_t* XD = dir ? XD1 : XD0; const bf16_t* AA = dir ? AA1 : AA0; bf16_t* Y = dir ? YB : YF;
        const f32x4 kk4 = *(const f32x4*)(p.in[I_RW_KK] + h * 64 + 4 * jg), ka4 = *(const f32x4*)(p.in[I_RW_KA] + h * 64 + 4 * jg);
        float S[8];
#pragma unroll
        for (int e = 0; e < 8; ++e) S[e] = 0.f;
        u32x2 pr, pk, pv, px, pa;
        long gcur;
        {   const int n = ss; const int t = dir ? 255 - n : n; gcur = TL + b * 256 + t;
            const long o = gcur * 3072 + h * 64 + 4 * jg, o1 = gcur * 1024 + h * 64 + 4 * jg;
            pr = *(const u32x2*)(RKV + o); pk = *(const u32x2*)(RKV + o + 1024); pv = *(const u32x2*)(RKV + o + 2048); px = *(const u32x2*)(XD + o1); pa = *(const u32x2*)(AA + o1); }
        for (int c = 0; c < 136; ++c) {
            __syncthreads();
            {
                float kf[4] = {bflo(pk.x), bfhi(pk.x), bflo(pk.y), bfhi(pk.y)};
                float af[4] = {bflo(pa.x), bfhi(pa.x), bflo(pa.y), bfhi(pa.y)};
                float xf[4] = {bflo(px.x), bfhi(px.x), bflo(px.y), bfhi(px.y)};
                f32x4 kkv, kka, kt, wv4, rv4, vv4;
                float sq = 0.f;
#pragma unroll
                for (int e = 0; e < 4; ++e) { kkv[e] = kf[e] * kk4[e]; sq += kkv[e] * kkv[e]; }
                sq += __shfl_xor(sq, 1); sq += __shfl_xor(sq, 2); sq += __shfl_xor(sq, 4); sq += __shfl_xor(sq, 8);
                const float inv = 1.0f / fmaxf(sqrtf(sq), 1e-12f);
#pragma unroll
                for (int e = 0; e < 4; ++e) { kkv[e] *= inv; kka[e] = kkv[e] * af[e]; kt[e] = kf[e] * (1.0f + (af[e] - 1.0f) * ka4[e]); wv4[e] = __expf(-xf[e]); }
                rv4 = (f32x4){bflo(pr.x), bfhi(pr.x), bflo(pr.y), bfhi(pr.y)};
                vv4 = (f32x4){bflo(pv.x), bfhi(pv.x), bflo(pv.y), bfhi(pv.y)};
                float* vb = vec + ss * 384 + 4 * jg;
                *(f32x4*)(vb) = wv4; *(f32x4*)(vb + 64) = kkv; *(f32x4*)(vb + 128) = kka; *(f32x4*)(vb + 192) = kt; *(f32x4*)(vb + 256) = rv4; *(f32x4*)(vb + 320) = vv4;
            }
            const long gthis = gcur;
            __syncthreads();
            if (c + 1 < 136) {
                const int n = (c + 1) * 32 + ss;
                if (n < 256) { const int t = dir ? 255 - n : n; gcur = TL + b * 256 + t; }
                else { const int mm = n - 256; const int t = dir ? 4095 - mm : mm; gcur = (long)b * 4096 + t; }
                const long o = gcur * 3072 + h * 64 + 4 * jg, o1 = gcur * 1024 + h * 64 + 4 * jg;
                pr = *(const u32x2*)(RKV + o); pk = *(const u32x2*)(RKV + o + 1024); pv = *(const u32x2*)(RKV + o + 2048); px = *(const u32x2*)(XD + o1); pa = *(const u32x2*)(AA + o1);
            }
            {
                typedef float f32x2 __attribute__((ext_vector_type(2)));
                float yk[4] = {0.f, 0.f, 0.f, 0.f};
                const float* vb0 = vec + 8 * js;
                f32x4 cw0 = *(const f32x4*)(vb0), cw1 = *(const f32x4*)(vb0 + 4), ck0 = *(const f32x4*)(vb0 + 64), ck1 = *(const f32x4*)(vb0 + 68);
                f32x4 ca0 = *(const f32x4*)(vb0 + 128), ca1 = *(const f32x4*)(vb0 + 132), ct0 = *(const f32x4*)(vb0 + 192), ct1 = *(const f32x4*)(vb0 + 196);
                f32x4 cr0 = *(const f32x4*)(vb0 + 256), cr1 = *(const f32x4*)(vb0 + 260);
                float cvi = vec[320 + irow];
#pragma unroll
                for (int s = 0; s < 32; ++s) {
                    f32x4 nw0 = cw0, nw1 = cw1, nk0 = ck0, nk1 = ck1, na0 = ca0, na1 = ca1, nt0 = ct0, nt1 = ct1, nr0 = cr0, nr1 = cr1; float nvi = cvi;
                    if (s + 1 < 32) {
                        const float* vb = vec + (s + 1) * 384 + 8 * js;
                        nw0 = *(const f32x4*)(vb); nw1 = *(const f32x4*)(vb + 4); nk0 = *(const f32x4*)(vb + 64); nk1 = *(const f32x4*)(vb + 68);
                        na0 = *(const f32x4*)(vb + 128); na1 = *(const f32x4*)(vb + 132); nt0 = *(const f32x4*)(vb + 192); nt1 = *(const f32x4*)(vb + 196);
                        nr0 = *(const f32x4*)(vb + 256); nr1 = *(const f32x4*)(vb + 260); nvi = vec[(s + 1) * 384 + 320 + irow];
                    }
                    f32x2 S0 = {S[0], S[1]}, S1 = {S[2], S[3]}, S2 = {S[4], S[5]}, S3 = {S[6], S[7]};
                    const f32x2 d2 = (S0 * (f32x2){ck0[0], ck0[1]} + S1 * (f32x2){ck0[2], ck0[3]}) + (S2 * (f32x2){ck1[0], ck1[1]} + S3 * (f32x2){ck1[2], ck1[3]});
                    const float sk = red8(d2.x + d2.y);
                    const f32x2 nsk = {-sk, -sk}, vv = {cvi, cvi};
                    S0 = S0 * (f32x2){cw0[0], cw0[1]} + nsk * (f32x2){ca0[0], ca0[1]} + vv * (f32x2){ct0[0], ct0[1]};
                    S1 = S1 * (f32x2){cw0[2], cw0[3]} + nsk * (f32x2){ca0[2], ca0[3]} + vv * (f32x2){ct0[2], ct0[3]};
                    S2 = S2 * (f32x2){cw1[0], cw1[1]} + nsk * (f32x2){ca1[0], ca1[1]} + vv * (f32x2){ct1[0], ct1[1]};
                    S3 = S3 * (f32x2){cw1[2], cw1[3]} + nsk * (f32x2){ca1[2], ca1[3]} + vv * (f32x2){ct1[2], ct1[3]};
                    const f32x2 y2 = (S0 * (f32x2){cr0[0], cr0[1]} + S1 * (f32x2){cr0[2], cr0[3]}) + (S2 * (f32x2){cr1[0], cr1[1]} + S3 * (f32x2){cr1[2], cr1[3]});
                    const float y = red8(y2.x + y2.y);
                    yk[s >> 3] = (js == (s & 7)) ? y : yk[s >> 3];
                    S[0] = S0.x; S[1] = S0.y; S[2] = S1.x; S[3] = S1.y; S[4] = S2.x; S[5] = S2.y; S[6] = S3.x; S[7] = S3.y;
                    cw0 = nw0; cw1 = nw1; ck0 = nk0; ck1 = nk1; ca0 = na0; ca1 = na1; ct0 = nt0; ct1 = nt1; cr0 = nr0; cr1 = nr1; cvi = nvi;
                }
#pragma unroll
                for (int k = 0; k < 4; ++k) ybuf[(8 * k + js) * 64 + irow] = yk[k];
            }
            __syncthreads();
            {
                const f32x4 yv = *(const f32x4*)(ybuf + ss * 64 + 4 * jg);
                st_bf16x4(Y + gthis * 1024 + h * 64 + 4 * jg, yv);
            }
        }
    }
}


constexpr int CS_L1 = 68, CS_L2 = 20;
constexpr int CS_AT = 0, CS_RT = 2176, CS_BL = 4352, CS_KL = 6528, CS_BH = 8704, CS_KH = 11264, CS_VT = 13824, CS_GL = 16384, CS_P1 = 16640;
constexpr int CS_NT = 0, CS_AK = 1024, CS_RB = 1664, CS_RK = 2304, CS_P2 = 2944;
constexpr int SCAN2_LDS = 3 * CS_P1 + 2 * CS_P2;
DI bf16x8 mk8(u32x2 lo, u32x2 hi) { u32x4 v; v.x = lo.x; v.y = lo.y; v.z = hi.x; v.w = hi.y; return __builtin_bit_cast(bf16x8, v); }
DI long scan_token(int b, int dir, int n) {
    if (n < 256) return (long)TL + b * 256 + (dir ? 255 - n : n);
    const int m = n - 256; return (long)b * 4096 + (dir ? 4095 - m : m);
}
struct ScanRaw { unsigned rx[16], xo[4], rk[4], rr[4], ra[4], rv[4]; };
DI unsigned ld16_async(const bf16_t* q) { unsigned r; asm volatile("global_load_ushort %0, %1, off" : "=v"(r) : "v"(q) : "memory"); return r; }
DI void scan_wait_raw(ScanRaw& R) {
    asm volatile("s_waitcnt vmcnt(36)" : "+v"(R.rx[0]), "+v"(R.rx[1]), "+v"(R.rx[2]), "+v"(R.rx[3]), "+v"(R.rx[4]), "+v"(R.rx[5]), "+v"(R.rx[6]), "+v"(R.rx[7]),
                 "+v"(R.rx[8]), "+v"(R.rx[9]), "+v"(R.rx[10]), "+v"(R.rx[11]) :: "memory");
    asm volatile("" : "+v"(R.rx[12]), "+v"(R.rx[13]), "+v"(R.rx[14]), "+v"(R.rx[15]), "+v"(R.xo[0]), "+v"(R.xo[1]), "+v"(R.xo[2]), "+v"(R.xo[3]),
                 "+v"(R.rk[0]), "+v"(R.rk[1]), "+v"(R.rk[2]), "+v"(R.rk[3]) :: "memory");
    asm volatile("" : "+v"(R.rr[0]), "+v"(R.rr[1]), "+v"(R.rr[2]), "+v"(R.rr[3]), "+v"(R.ra[0]), "+v"(R.ra[1]), "+v"(R.ra[2]), "+v"(R.ra[3]),
                 "+v"(R.rv[0]), "+v"(R.rv[1]), "+v"(R.rv[2]), "+v"(R.rv[3]) :: "memory");
}
DI void scan_chunk_tokens(int b, int dir, int chunk, int& g0, int& step) {
    const int n0 = chunk * 16; step = dir ? -1 : 1;
    if (n0 < 256) g0 = TL + b * 256 + (dir ? 255 - n0 : n0); else g0 = b * 4096 + (dir ? 4095 - (n0 - 256) : (n0 - 256));
}
DI void scan_load_raw(ScanRaw& R, const bf16_t* RKV, const bf16_t* XD, const bf16_t* AA, int b, int dir, int h, int j, int pw, int chunk) {
    int g0, step; scan_chunk_tokens(b, dir, chunk, g0, step);
    const bf16_t* px = XD + (long)g0 * 1024 + h * 64; const long sx = (long)step * 1024;
#pragma unroll
    for (int s = 0; s < 16; ++s) R.rx[s] = ld16_async(px + (s * sx + j));
    const int t0 = 4 * pw;
    const bf16_t* pr = RKV + (long)(g0 + t0 * step) * 3072 + h * 64; const bf16_t* pa = AA + (long)(g0 + t0 * step) * 1024 + h * 64; const bf16_t* pxo = px + t0 * sx;
    const long s3 = (long)step * 3072;
#pragma unroll
    for (int q = 0; q < 4; ++q) { R.rr[q] = ld16_async(pr + (q * s3 + j)); R.rk[q] = ld16_async(pr + (q * s3 + 1024 + j)); R.rv[q] = ld16_async(pr + (q * s3 + 2048 + j)); R.ra[q] = ld16_async(pa + (q * sx + j)); R.xo[q] = ld16_async(pxo + (q * sx + j)); }
}
DI void scan_p1(const ScanRaw& R, char* st, int pw, int j, float kkj, float kaj) {
    float before = 0.f, total = 0.f;
#pragma unroll
    for (int s = 0; s < 16; ++s) { const float xv = bf2f(R.rx[s]); total += xv; before += (s < 4 * pw) ? xv : 0.f; }
    float gprev = __expf(-before);
    const float gL = __expf(-total);
    unsigned bhk[4], khk[4];
#pragma unroll
    for (int q = 0; q < 4; ++q) {
        const int t = 4 * pw + q;
        const float gt = gprev * __expf(-bf2f(R.xo[q]));
        const float ig = __builtin_amdgcn_rcpf(gt), gl = gL * ig;
        const float kf = bf2f(R.rk[q]), af = bf2f(R.ra[q]), rf = bf2f(R.rr[q]);
        const float kkraw = kf * kkj;
        const float kk = kkraw * __builtin_amdgcn_rsqf(fmaxf(wave_sum_dpp(kkraw * kkraw), 1e-24f));
        const float bb = kk * af, ktv = kf * (1.0f + (af - 1.0f) * kaj);
        const unsigned p0 = pk2(-kk * gprev, rf * gt), p1 = pk2(bb * ig, ktv * ig);
        ((bf16_t*)(st + CS_AT))[t * CS_L1 + j] = (bf16_t)(p0 & 0xffffu);
        ((bf16_t*)(st + CS_RT))[t * CS_L1 + j] = (bf16_t)(p0 >> 16);
        ((bf16_t*)(st + CS_BL))[t * CS_L1 + j] = (bf16_t)(p1 & 0xffffu);
        ((bf16_t*)(st + CS_KL))[t * CS_L1 + j] = (bf16_t)(p1 >> 16);
        const unsigned p2 = pk2(bb * gl, ktv * gl);
        bhk[q] = p2 & 0xffffu; khk[q] = p2 >> 16;
        gprev = gt;
    }
    u32x2 w2;
    w2.x = bhk[0] | (bhk[1] << 16); w2.y = bhk[2] | (bhk[3] << 16); *(u32x2*)(st + CS_BH + (j * CS_L2 + 4 * pw) * 2) = w2;
    w2.x = khk[0] | (khk[1] << 16); w2.y = khk[2] | (khk[3] << 16); *(u32x2*)(st + CS_KH + (j * CS_L2 + 4 * pw) * 2) = w2;
    w2.x = (unsigned)R.rv[0] | ((unsigned)R.rv[1] << 16); w2.y = (unsigned)R.rv[2] | ((unsigned)R.rv[3] << 16); *(u32x2*)(st + CS_VT + (j * CS_L2 + 4 * pw) * 2) = w2;
    if (pw == 0) ((float*)(st + CS_GL))[j] = gL;
}
DI void scan_p2(const char* s1, char* s2, int pw, int l15, int quad) {
    const bf16_t* Am = (const bf16_t*)(s1 + ((pw < 2) ? CS_AT : CS_RT));
    const bf16_t* Bm = (const bf16_t*)(s1 + ((pw & 1) ? CS_KL : CS_BL));
    f32x4 d = (f32x4){0.f, 0.f, 0.f, 0.f};
#pragma unroll
    for (int ks = 0; ks < 2; ++ks) {
        const bf16_t* ap = Am + l15 * CS_L1 + 32 * ks + 8 * quad; const bf16_t* bp = Bm + l15 * CS_L1 + 32 * ks + 8 * quad;
        const bf16x8 af = mk8(*(const u32x2*)ap, *(const u32x2*)(ap + 4)), bf = mk8(*(const u32x2*)bp, *(const u32x2*)(bp + 4));
        d = __builtin_amdgcn_mfma_f32_16x16x32_bf16(af, bf, d, 0, 0, 0);
    }
#pragma unroll
    for (int r = 0; r < 4; ++r) { const int t = 4 * quad + r; const bool keep = (pw < 2) ? (l15 < t) : (l15 <= t); d[r] = keep ? d[r] : 0.f; }
    if (pw == 0) *(f32x4*)(s2 + CS_NT + (l15 * 16 + 4 * quad) * 4) = d;
    else {
        bf16_t* O = (bf16_t*)(s2 + (pw == 1 ? CS_AK : (pw == 2 ? CS_RB : CS_RK)));
        const unsigned q0 = pk2(d[0], d[1]), q1 = pk2(d[2], d[3]);
        O[(4 * quad + 0) * CS_L2 + l15] = (bf16_t)(q0 & 0xffffu); O[(4 * quad + 1) * CS_L2 + l15] = (bf16_t)(q0 >> 16);
        O[(4 * quad + 2) * CS_L2 + l15] = (bf16_t)(q1 & 0xffffu); O[(4 * quad + 3) * CS_L2 + l15] = (bf16_t)(q1 >> 16);
    }
}
DI void phase_rw_scan2(const Params& p, const bf16_t* RKV, const bf16_t* XD0, const bf16_t* XD1, const bf16_t* AA0, const bf16_t* AA1, bf16_t* YF, bf16_t* YB, char* smem) {
    const int tid = TIDX(), lane = tid & 63, wv = __builtin_amdgcn_readfirstlane(tid >> 6), l15 = lane & 15, quad = lane >> 4;
    constexpr int NCH = 272;
    const u32x2 z2 = (u32x2){0u, 0u};
    for (int unit = blockIdx.x; unit < 256; unit += gridDim.x) {
        const int dir = unit & 1, b = unit >> 5, h = (unit >> 1) & 15;
        const bf16_t* XD = dir ? XD1 : XD0; const bf16_t* AA = dir ? AA1 : AA0; bf16_t* Y = dir ? YB : YF;
        __syncthreads();
        if (wv >= 4) {
            const int pw = wv - 4, j = lane;
            float kkj = p.in[I_RW_KK][h * 64 + j], kaj = p.in[I_RW_KA][h * 64 + j];
            asm volatile("s_waitcnt vmcnt(0)" : "+v"(kkj), "+v"(kaj) :: "memory");
            ScanRaw RA, RB_;
            scan_load_raw(RA, RKV, XD, AA, b, dir, h, j, pw, 0);
            scan_load_raw(RB_, RKV, XD, AA, b, dir, h, j, pw, 1);
            for (int c = -2; c < NCH; c += 2) {
#pragma unroll
                for (int half = 0; half < 2; ++half) {
                    const int cc = c + half, c2 = cc + 2, c1 = cc + 1;
                    if (c2 < NCH) {
                        const int cn = (c2 + 2 < NCH) ? c2 + 2 : NCH - 1;
                        if (half == 0) { scan_wait_raw(RA); scan_p1(RA, smem + (c2 % 3) * CS_P1, pw, j, kkj, kaj); scan_load_raw(RA, RKV, XD, AA, b, dir, h, j, pw, cn); }
                        else { scan_wait_raw(RB_); scan_p1(RB_, smem + (c2 % 3) * CS_P1, pw, j, kkj, kaj); scan_load_raw(RB_, RKV, XD, AA, b, dir, h, j, pw, cn); }
                    }
                    if (c1 >= 0 && c1 < NCH) scan_p2(smem + (c1 % 3) * CS_P1, smem + 3 * CS_P1 + (c1 & 1) * CS_P2, pw, l15, quad);
                    __syncthreads();
                }
            }
            asm volatile("s_waitcnt vmcnt(0)" ::: "memory");
        } else {
            const int w = wv;
            f32x4 ST[4];
#pragma unroll
            for (int jt = 0; jt < 4; ++jt) ST[jt] = (f32x4){0.f, 0.f, 0.f, 0.f};
            for (int c = -2; c < NCH; ++c) {
                if (c >= 0) {
                    int g0, step; scan_chunk_tokens(b, dir, c, g0, step);
                    const long ystep = (long)step * 1024;
                    bf16_t* yp = Y + (long)(g0 + 4 * quad * step) * 1024 + h * 64 + 16 * w + l15;
                    const char* s1 = smem + (c % 3) * CS_P1;
                    const char* s2 = smem + 3 * CS_P1 + (c & 1) * CS_P2;
                    const bf16_t* AT = (const bf16_t*)(s1 + CS_AT); const bf16_t* RT = (const bf16_t*)(s1 + CS_RT);
                    const bf16_t* BH = (const bf16_t*)(s1 + CS_BH); const bf16_t* KH = (const bf16_t*)(s1 + CS_KH); const bf16_t* VT = (const bf16_t*)(s1 + CS_VT);
                    const float* GL = (const float*)(s1 + CS_GL);
                    const float* NT = (const float*)(s2 + CS_NT); const bf16_t* AK = (const bf16_t*)(s2 + CS_AK);
                    const bf16_t* RB = (const bf16_t*)(s2 + CS_RB); const bf16_t* RK = (const bf16_t*)(s2 + CS_RK);
                    float Tr[16];
#pragma unroll
                    for (int u = 0; u < 16; ++u) Tr[u] = (u == l15) ? 1.0f : 0.f;
#pragma unroll
                    for (int s = 14; s >= 0; --s) {
                        float a0 = 0.f, a1 = 0.f;
#pragma unroll
                        for (int u4 = 0; u4 < 4; ++u4) {
                            if (4 * u4 + 3 > s) {
                                const f32x4 nv = *(const f32x4*)(NT + s * 16 + 4 * u4);
#pragma unroll
                                for (int e = 0; e < 4; ++e) if (4 * u4 + e > s) { if (e & 1) a1 += Tr[4 * u4 + e] * nv[e]; else a0 += Tr[4 * u4 + e] * nv[e]; }
                            }
                        }
                        Tr[s] = (s < l15) ? (a0 + a1) : Tr[s];
                    }
                    u32x2 th, tl;
                    {
                        float tq[4];
                        const float m0 = (quad == 0) ? 1.0f : 0.f, m1 = (quad == 1) ? 1.0f : 0.f, m2 = (quad == 2) ? 1.0f : 0.f, m3 = (quad == 3) ? 1.0f : 0.f;
#pragma unroll
                        for (int e = 0; e < 4; ++e) tq[e] = (m0 * Tr[e] + m1 * Tr[4 + e]) + (m2 * Tr[8 + e] + m3 * Tr[12 + e]);
                        th.x = pk2(tq[0], tq[1]); th.y = pk2(tq[2], tq[3]);
                        tl.x = pk2(tq[0] - bflo(th.x), tq[1] - bfhi(th.x)); tl.y = pk2(tq[2] - bflo(th.y), tq[3] - bfhi(th.y));
                    }
                    bf16x8 sf[2];
#pragma unroll
                    for (int ks = 0; ks < 2; ++ks) { u32x2 lo, hi; lo.x = pk2(ST[2 * ks][0], ST[2 * ks][1]); lo.y = pk2(ST[2 * ks][2], ST[2 * ks][3]); hi.x = pk2(ST[2 * ks + 1][0], ST[2 * ks + 1][1]); hi.y = pk2(ST[2 * ks + 1][2], ST[2 * ks + 1][3]); sf[ks] = mk8(lo, hi); }
                    const u32x2 vfr = *(const u32x2*)(VT + (16 * w + l15) * CS_L2 + 4 * quad);
                    f32x4 X = (f32x4){0.f, 0.f, 0.f, 0.f}, Yv = X;
#pragma unroll
                    for (int ks = 0; ks < 2; ++ks) {
                        const bf16x8 af = mk8(*(const u32x2*)(AT + l15 * CS_L1 + 32 * ks + 4 * quad), *(const u32x2*)(AT + l15 * CS_L1 + 32 * ks + 16 + 4 * quad));
                        const bf16x8 rf = mk8(*(const u32x2*)(RT + l15 * CS_L1 + 32 * ks + 4 * quad), *(const u32x2*)(RT + l15 * CS_L1 + 32 * ks + 16 + 4 * quad));
                        X = __builtin_amdgcn_mfma_f32_16x16x32_bf16(af, sf[ks], X, 0, 0, 0);
                        Yv = __builtin_amdgcn_mfma_f32_16x16x32_bf16(rf, sf[ks], Yv, 0, 0, 0);
                    }
                    X = __builtin_amdgcn_mfma_f32_16x16x32_bf16(mk8(*(const u32x2*)(AK + l15 * CS_L2 + 4 * quad), z2), mk8(vfr, z2), X, 0, 0, 0);
                    u32x2 xh, xl;
                    {
                        xh.x = pk2(X[0], X[1]); xh.y = pk2(X[2], X[3]);
                        const float r0 = X[0] - bflo(xh.x), r1 = X[1] - bfhi(xh.x), r2 = X[2] - bflo(xh.y), r3 = X[3] - bfhi(xh.y);
                        xl.x = pk2(r0, r1); xl.y = pk2(r2, r3);
                    }
                    f32x4 U = (f32x4){0.f, 0.f, 0.f, 0.f};
                    U = __builtin_amdgcn_mfma_f32_16x16x32_bf16(mk8(th, tl), mk8(xh, xh), U, 0, 0, 0);
                    U = __builtin_amdgcn_mfma_f32_16x16x32_bf16(mk8(th, z2), mk8(xl, z2), U, 0, 0, 0);
                    u32x2 uf; uf.x = pk2(U[0], U[1]); uf.y = pk2(U[2], U[3]);
                    const bf16x8 uv = mk8(uf, vfr);
                    Yv = __builtin_amdgcn_mfma_f32_16x16x32_bf16(mk8(*(const u32x2*)(RB + l15 * CS_L2 + 4 * quad), *(const u32x2*)(RK + l15 * CS_L2 + 4 * quad)), uv, Yv, 0, 0, 0);
#pragma unroll
                    for (int jt = 0; jt < 4; ++jt) {
                        const f32x4 gl = *(const f32x4*)(GL + 16 * jt + 4 * quad);
                        const bf16x8 af = mk8(*(const u32x2*)(BH + (16 * jt + l15) * CS_L2 + 4 * quad), *(const u32x2*)(KH + (16 * jt + l15) * CS_L2 + 4 * quad));
                        ST[jt] = __builtin_amdgcn_mfma_f32_16x16x32_bf16(af, uv, ST[jt] * gl, 0, 0, 0);
                    }
#pragma unroll
                    for (int r = 0; r < 4; r += 2) { const unsigned yq = pk2(Yv[r], Yv[r + 1]); yp[(long)r * ystep] = (bf16_t)(yq & 0xffffu); yp[(long)(r + 1) * ystep] = (bf16_t)(yq >> 16); }
                }
                __syncthreads();
            }
        }
    }
}

DI void ld16f(const float* p, float* v) {
#pragma unroll
    for (int i = 0; i < 4; ++i) { const f32x4 t = *(const f32x4*)(p + 4 * i); v[4 * i] = t[0]; v[4 * i + 1] = t[1]; v[4 * i + 2] = t[2]; v[4 * i + 3] = t[3]; } }
DI void phase_rw_readout(const Params& p, const bf16_t* RKV, const bf16_t* AA0, const bf16_t* AA1, const bf16_t* G, const bf16_t* YF, const bf16_t* YB, bf16_t* Z) {
    const int lane = TIDX() & 63, gw = blockIdx.x * 8 + (TIDX() >> 6), nw = gridDim.x * 8, col = 16 * lane;
    float lng[16], lnb[16], ka[16], rk[16];
    ld16f(p.in[I_RW_LNG] + col, lng); ld16f(p.in[I_RW_LNB] + col, lnb); ld16f(p.in[I_RW_KA] + col, ka); ld16f(p.in[I_RW_RK] + col, rk);
    for (int g = gw; g < TT; g += nw) {
        float y[16], t[16], r[16], k[16], v[16], a0[16], a1[16], gg[16];
        ld16(YF + (size_t)g * 1024 + col, y); ld16(YB + (size_t)g * 1024 + col, t);
        ld16(RKV + (size_t)g * 3072 + col, r); ld16(RKV + (size_t)g * 3072 + 1024 + col, k); ld16(RKV + (size_t)g * 3072 + 2048 + col, v);
        ld16(AA0 + (size_t)g * 1024 + col, a0); ld16(AA1 + (size_t)g * 1024 + col, a1); ld16(G + (size_t)g * 1024 + col, gg);
        float sm = 0.f;
#pragma unroll
        for (int e = 0; e < 16; ++e) { y[e] += t[e]; sm += y[e]; }
        sm += __shfl_xor(sm, 1); sm += __shfl_xor(sm, 2);
        const float mu = sm * (1.0f / 64.0f);
        float sv = 0.f, bs = 0.f;
#pragma unroll
        for (int e = 0; e < 16; ++e) { y[e] -= mu; sv += y[e] * y[e];
            const float kt0 = k[e] * (1.0f + (a0[e] - 1.0f) * ka[e]), kt1 = k[e] * (1.0f + (a1[e] - 1.0f) * ka[e]);
            bs += r[e] * (kt0 + kt1) * rk[e]; }
        sv += __shfl_xor(sv, 1); sv += __shfl_xor(sv, 2); bs += __shfl_xor(bs, 1); bs += __shfl_xor(bs, 2);
        const float rs = rsqrtf(sv * (1.0f / 64.0f) + 64e-5f);
#pragma unroll
        for (int e = 0; e < 16; ++e) y[e] = (y[e] * rs * lng[e] + lnb[e] + bs * v[e]) * gg[e];
        st16(Z + (size_t)g * 1024 + col, y);
    }
}

DI void topk_sort(unsigned long long* keys, const float* src, int n) {
    const int tid = TIDX();
    __syncthreads();
    for (int i = tid; i < n; i += NTHR) keys[i] = ((unsigned long long)__float_as_uint(src[i]) << 32) | (unsigned long long)(0xFFFFFFFFu - (unsigned)i);
    __syncthreads();
    for (int k2 = 2; k2 <= n; k2 <<= 1)
        for (int j = k2 >> 1; j > 0; j >>= 1) {
            for (int pi = tid; pi < (n >> 1); pi += NTHR) {
                const int i = ((pi & ~(j - 1)) << 1) | (pi & (j - 1)), ix = i | j;
                const bool up = (i & k2) == 0;
                const unsigned long long a = keys[i], c = keys[ix];
                if (up ? (a < c) : (a > c)) { keys[i] = c; keys[ix] = a; }
            }
            __syncthreads();
        }
}
DI void topk_emit(const Bufs& B, const unsigned long long* keys, const bf16_t* H, bf16_t* XIN, int b, int e, bool isc, int c0, int cstep, int kcap) {
    const int tid = TIDX(), lane = tid & 63, wv = tid >> 6;
    for (int c = c0 + tid * cstep; c < kcap; c += NTHR * cstep) {
        const unsigned long long key = keys[c];
        const int idx = (int)(0xFFFFFFFFu - (unsigned)(key & 0xFFFFFFFFull));
        const int g = isc ? (TL + b * 256 + idx) : (b * 4096 + idx);
        const int er = isc ? (4096 + b * 32 + c) : (b * 512 + c);
        B.IDX[e * EROWS + er] = g; B.GATE[e * EROWS + er] = __uint_as_float((unsigned)(key >> 32)); B.INV[(size_t)g * 16 + e] = er;
    }
    for (int cb = c0 + wv * cstep; !GATHER_A && cb < kcap; cb += 32 * cstep) {
        u32x4 v0[4], v1[4];
#pragma unroll
        for (int k = 0; k < 4; ++k) {
            const int c = cb + 8 * cstep * k;
            if (c < kcap) {
                const int idx = (int)(0xFFFFFFFFu - (unsigned)(keys[c] & 0xFFFFFFFFull));
                const bf16_t* s = H + (size_t)(isc ? (TL + b * 256 + idx) : (b * 4096 + idx)) * 1024;
                v0[k] = *(const u32x4*)(s + lane * 8); v1[k] = *(const u32x4*)(s + 512 + lane * 8);
            }
        }
#pragma unroll
        for (int k = 0; k < 4; ++k) {
            const int c = cb + 8 * cstep * k;
            if (c < kcap) {
                const int er = isc ? (4096 + b * 32 + c) : (b * 512 + c);
                bf16_t* d = XIN + ((size_t)e * EROWS + er) * 1024;
                *(u32x4*)(d + lane * 8) = v0[k]; *(u32x4*)(d + 512 + lane * 8) = v1[k];
            }
        }
    }
}
constexpr int TOPK_LDS = 4096 * 8;
DI void topk_select(const Bufs& B, const float* src, int n, int kcap, int b, int e, bool isc, char* smem) {
    unsigned* hist = (unsigned*)smem; unsigned* scan = hist + 2048; unsigned* bc = scan + 512;
    const int tid = TIDX();
    const bool act = tid * 8 < n;
    unsigned v[8];
    {
        u32x4 a = (u32x4){0u, 0u, 0u, 0u}, c = a;
        if (act) { a = *(const u32x4*)(src + tid * 8); c = *(const u32x4*)(src + tid * 8 + 4); }
        v[0] = a.x; v[1] = a.y; v[2] = a.z; v[3] = a.w; v[4] = c.x; v[5] = c.y; v[6] = c.z; v[7] = c.w;
    }
    unsigned pval = 0u, pmask = 0u; int krem = kcap;
#pragma unroll
    for (int pass = 0; pass < 3; ++pass) {
        const int shift = (pass == 0) ? 21 : ((pass == 1) ? 10 : 0);
        const unsigned nb = (pass == 2) ? 1024u : 2048u;
        __syncthreads();
        for (unsigned i = tid; i < nb; i += NTHR) hist[i] = 0u;
        __syncthreads();
        if (act) {
#pragma unroll
            for (int i = 0; i < 8; ++i) if ((v[i] & pmask) == pval) atomicAdd(&hist[(v[i] >> shift) & (nb - 1u)], 1u);
        }
        __syncthreads();
        unsigned h4[4] = {0u, 0u, 0u, 0u};
        if ((unsigned)tid * 4u < nb) { const u32x4 hv = *(const u32x4*)(hist + tid * 4); h4[0] = hv.x; h4[1] = hv.y; h4[2] = hv.z; h4[3] = hv.w; }
        const unsigned sown = h4[0] + h4[1] + h4[2] + h4[3];
        scan[tid] = sown;
        __syncthreads();
        for (int d = 1; d < NTHR; d <<= 1) {
            const unsigned x = (tid + d < NTHR) ? scan[tid + d] : 0u;
            __syncthreads();
            scan[tid] += x;
            __syncthreads();
        }
        const unsigned sincl = scan[tid], sexcl = sincl - sown;
        if (sexcl < (unsigned)krem && (unsigned)krem <= sincl) {
            unsigned c = sexcl;
#pragma unroll
            for (int bi = 3; bi >= 0; --bi) {
                if (c < (unsigned)krem && c + h4[bi] >= (unsigned)krem) { bc[0] = (unsigned)(tid * 4 + bi); bc[1] = c; }
                c += h4[bi];
            }
        }
        __syncthreads();
        const unsigned beta = bc[0], above = bc[1];
        pval |= beta << shift; pmask |= (nb - 1u) << shift; krem -= (int)above;
    }
    unsigned ngt = 0u, neq = 0u;
    if (act) {
#pragma unroll
        for (int i = 0; i < 8; ++i) { ngt += (v[i] > pval) ? 1u : 0u; neq += (v[i] == pval) ? 1u : 0u; }
    }
    const unsigned packed = ngt | (neq << 16);
    __syncthreads();
    scan[tid] = packed;
    __syncthreads();
    for (int d = 1; d < NTHR; d <<= 1) {
        const unsigned x = (tid >= d) ? scan[tid - d] : 0u;
        __syncthreads();
        scan[tid] += x;
        __syncthreads();
    }
    const unsigned excl = scan[tid] - packed;
    unsigned g_before = excl & 0xffffu, e_before = excl >> 16;
    if (act) {
#pragma unroll
        for (int i = 0; i < 8; ++i) {
            const bool gt = v[i] > pval, eq = v[i] == pval;
            const bool take = gt || (eq && e_before < (unsigned)krem);
            if (take) {
                const unsigned eb = e_before < (unsigned)krem ? e_before : (unsigned)krem;
                const int slot = (int)(g_before + eb);
                const int idx = tid * 8 + i;
                const int g = isc ? (TL + b * 256 + idx) : (b * 4096 + idx);
                const int er = isc ? (4096 + b * 32 + slot) : (b * 512 + slot);
                B.IDX[e * EROWS + er] = g; B.GATE[e * EROWS + er] = __uint_as_float(v[i]); B.INV[(size_t)g * 16 + e] = er;
            }
            g_before += gt ? 1u : 0u; e_before += eq ? 1u : 0u;
        }
    }
}
#if GATHER_A
DI void phase_topk(const Bufs& B, const bf16_t* H, bf16_t* XIN, bool has_ctx, char* smem) {
    const int nl = has_ctx ? 256 : 128;
    for (int u = blockIdx.x; u < nl; u += gridDim.x) {
        const bool isc = u >= 128; const int li = u & 127, b = li >> 4, e = li & 15;
        if (!isc) topk_select(B, B.AFF + (size_t)(b * 16 + e) * 4096, 4096, 512, b, e, false, smem);
        else topk_select(B, B.AFFC + (size_t)(b * 16 + e) * 256, 256, 32, b, e, true, smem);
    }
}
#else
DI void phase_topk(const Bufs& B, const bf16_t* H, bf16_t* XIN, bool has_ctx, char* smem) {
    unsigned long long* keys = (unsigned long long*)smem;
    for (int u = blockIdx.x; u < 256; u += gridDim.x) {
        const int li = u & 127, b = li >> 4, e = li & 15, half = u >> 7;
        topk_sort(keys, B.AFF + (size_t)(b * 16 + e) * 4096, 4096);
        topk_emit(B, keys, H, XIN, b, e, false, half, 2, 512);
    }
    if (has_ctx) {
        for (int u = blockIdx.x; u < 128; u += gridDim.x) {
            const int b = u >> 4, e = u & 15;
            topk_sort(keys, B.AFFC + (size_t)(b * 16 + e) * 256, 256);
            topk_emit(B, keys, H, XIN, b, e, true, 0, 1, 32);
        }
    }
}
#endif
DI void phase_moe_gemm1(const Bufs& B, const bf16_t* XIN, bf16_t* HID, bool has_ctx, char* smem) {
#if USE_PG8
    pg8::Gemm g; g.A = GATHER_A ? B.slot(0) : XIN; g.Bt = B.W13; g.M = 16 * EROWS; g.N = 16 * 2048; g.K = 1024;
    pg8::GroupedOrder S; S.P = has_ctx ? 17 : 16; S.NT = 8; S.G = (int)gridDim.x; S.c = (int)blockIdx.x;
    pg8::PEpiSwiglu ep; ep.O = HID;
#if GATHER_A
    pg8::gemm_phase_gather<pg8::PEpiSwiglu, pg8::GroupedOrder>((LAS unsigned char*)smem, g, S, ep, B.IDX);
#else
    pg8::gemm_phase<pg8::PEpiSwiglu, pg8::GroupedOrder, false>((LAS unsigned char*)smem, g, S, ep, nullptr);
#endif
#else
    const int ntm = (has_ctx ? EROWS : 4096) >> 7, per = ntm * 16, nt = NEXP * per;
    for (int t = blockIdx.x; t < nt; t += gridDim.x) {
        const int e = t / per, r = t % per, tm = r >> 4, tn = r & 15;
        GemmOp g; g.A = XIN + (size_t)e * EROWS * 1024; g.lda = 1024; g.Bt = B.W13 + (size_t)e * 2048 * 1024; g.ldb = 1024; g.kbeg = 0; g.kend = 1024;
        EpiSwiglu ep; ep.O = HID + (size_t)e * EROWS * 1024;
        gemm_tile(g, tm * 128, tn * 128, ep, smem);
    }
#endif
}
DI void phase_moe_gemm2(const Bufs& B, const bf16_t* HID, bf16_t* Y, bool has_ctx, char* smem, int layer) {
#if USE_PG8
    pg8::Gemm g; g.A = HID; g.Bt = B.w2t(layer); g.M = 16 * EROWS; g.N = 16 * 1024; g.K = 1024;
    pg8::GroupedOrder S; S.P = has_ctx ? 17 : 16; S.NT = 4; S.G = (int)gridDim.x; S.c = (int)blockIdx.x;
    pg8::PEpiGate ep; ep.O = Y; ep.gate = B.GATE;
    pg8::gemm_phase<pg8::PEpiGate, pg8::GroupedOrder, false>((LAS unsigned char*)smem, g, S, ep, nullptr);
#else
    const int ntm = (has_ctx ? EROWS : 4096) >> 7, per = ntm * 8, nt = NEXP * per;
    for (int t = blockIdx.x; t < nt; t += gridDim.x) {
        const int e = t / per, r = t % per, tm = r >> 3, tn = r & 7;
        GemmOp g; g.A = HID + (size_t)e * EROWS * 1024; g.lda = 1024; g.Bt = B.w2t(layer) + (size_t)e * 1024 * 1024; g.ldb = 1024; g.kbeg = 0; g.kend = 1024;
        EpiGate ep; ep.O = Y + (size_t)e * EROWS * 1024; ep.gate = B.GATE + e * EROWS;
        gemm_tile(g, tm * 128, tn * 128, ep, smem);
    }
#endif
}
DI void phase_combine(const Params& p, const Bufs& B, int layer, const bf16_t* Y, int ntok, bool last, bool fuse_next, bf16_t* H) {
    const int lane = TIDX() & 63, gw = blockIdx.x * 8 + (TIDX() >> 6), nw = gridDim.x * 8;
    for (int g = gw; g < ntok; g += nw) {
        float acc[16];
#pragma unroll
        for (int e = 0; e < 16; ++e) acc[e] = 0.f;
        const int myc = B.INV[(size_t)g * 16 + (lane & 15)];
        unsigned sel = (unsigned)(__ballot(myc >= 0) & 0xFFFFull);
        while (sel) {
            const int e = __builtin_ctz(sel); sel &= sel - 1;
            const int c = __builtin_amdgcn_readlane(myc, e);
            const bf16_t* yr = Y + ((size_t)e * EROWS + c) * 1024 + 4 * lane;
#pragma unroll
            for (int i = 0; i < 4; ++i) { const u32x2 t = *(const u32x2*)(yr + 256 * i); acc[4 * i] += bflo(t.x); acc[4 * i + 1] += bfhi(t.x); acc[4 * i + 2] += bflo(t.y); acc[4 * i + 3] += bfhi(t.y); }
        }
        const float* gt = B.MOD + ((size_t)layer * 9 + modrow_of(g)) * 6144 + 5 * 1024;
        float* xr = B.X + (size_t)g * 1024;
#pragma unroll
        for (int i = 0; i < 4; ++i) {
            const f32x4 gv = *(const f32x4*)(gt + 256 * i + 4 * lane); f32x4 xv = *(const f32x4*)(xr + 256 * i + 4 * lane);
            xv[0] += gv[0] * acc[4 * i]; xv[1] += gv[1] * acc[4 * i + 1]; xv[2] += gv[2] * acc[4 * i + 2]; xv[3] += gv[3] * acc[4 * i + 3];
            if (last) *(f32x4*)(p.out + (size_t)g * 1024 + 256 * i + 4 * lane) = xv;
            else *(f32x4*)(xr + 256 * i + 4 * lane) = xv;
            acc[4 * i] = xv[0]; acc[4 * i + 1] = xv[1]; acc[4 * i + 2] = xv[2]; acc[4 * i + 3] = xv[3];
        }
        if (fuse_next) {
            const float* md = B.MOD + ((size_t)(layer + 1) * 9 + modrow_of(g)) * 6144;
            float gg[16], sh[16], sc[16];
            row_load_f32(p.in[I_N1G] + (layer + 1) * 1024, lane, gg); row_load_f32(md, lane, sh); row_load_f32(md + 1024, lane, sc);
            float ss = 0.f;
#pragma unroll
            for (int e = 0; e < 16; ++e) ss += acc[e] * acc[e];
            ss = wave_sum(ss);
            const float r = rsqrtf(ss * (1.0f / 1024.0f) + 1e-6f);
#pragma unroll
            for (int e = 0; e < 16; ++e) acc[e] = acc[e] * r * gg[e] * (1.0f + sc[e]) + sh[e];
            row_store_bf16(H + (size_t)g * 1024, lane, acc);
        }
    }
}


constexpr int AT2_STAGE = 64 * 104 * 2 + 64 * 72 * 2;
constexpr int AT2_BIAS = 2 * AT2_STAGE;
constexpr int ATT2_LDS = 2 * AT2_STAGE + 2048;
template <class P>
DI void attn_unit2(const P& pol, char* smem) {
    constexpr int DQK = P::DQK, KS = DQK + 8, VS = 72, NS = DQK / 32;
    const int tid = TIDX(), lane = tid & 63, w = tid >> 6, l15 = lane & 15, quad = lane >> 4;
    __syncthreads();
    if (__builtin_amdgcn_readfirstlane(tid) >= 256) __builtin_amdgcn_s_setprio(1);
    pol.prologue(smem + AT2_BIAS);
    bf16x8 qf[2][NS];
#pragma unroll
    for (int qg = 0; qg < 2; ++qg)
#pragma unroll
        for (int s = 0; s < NS; ++s) qf[qg][s] = *(const bf16x8*)pol.qptr(32 * w + 16 * qg + l15, s * 4 + quad);
    f32x4 o[2][4];
#pragma unroll
    for (int qg = 0; qg < 2; ++qg)
#pragma unroll
        for (int u = 0; u < 4; ++u) o[qg][u] = (f32x4){0.f, 0.f, 0.f, 0.f};
    float m[2] = {-1e30f, -1e30f}, l[2] = {0.f, 0.f};
    const int k0key = (DQK == 64) ? (tid >> 3) : (tid / 12), k0ch = (DQK == 64) ? (tid & 7) : (tid % 12);
    const int k1key = (tid + 512) / 12, k1ch = (tid + 512) % 12;
    const bool k1on = (DQK == 96) && (tid < 256);
    const int vkey = tid >> 3, vch = tid & 7;
    const int nt = pol.ntiles();
    u32x4 rk0, rk1 = (u32x4){0u, 0u, 0u, 0u}, rv;
    rk0 = *(const u32x4*)pol.kptr(0, k0key, k0ch);
    if (k1on) rk1 = *(const u32x4*)pol.kptr(0, k1key, k1ch);
    rv = *(const u32x4*)pol.vptr(0, vkey, vch);
    {
        bf16_t* Ks = (bf16_t*)smem; bf16_t* Vs = (bf16_t*)(smem + 64 * 104 * 2);
        *(u32x4*)(Ks + k0key * KS + k0ch * 8) = rk0;
        if (k1on) *(u32x4*)(Ks + k1key * KS + k1ch * 8) = rk1;
        *(u32x4*)(Vs + vkey * VS + vch * 8) = rv;
    }
    __syncthreads();
    for (int j = 0; j < nt; ++j) {
        const bool more = (j + 1 < nt);
        if (more) {
            rk0 = *(const u32x4*)pol.kptr(j + 1, k0key, k0ch);
            if (k1on) rk1 = *(const u32x4*)pol.kptr(j + 1, k1key, k1ch);
            rv = *(const u32x4*)pol.vptr(j + 1, vkey, vch);
        }
        const bf16_t* Ks = (const bf16_t*)(smem + (j & 1) * AT2_STAGE);
        const bf16_t* Vs = (const bf16_t*)(smem + (j & 1) * AT2_STAGE + 64 * 104 * 2);
        if (pol.needed(j, w)) {
            f32x4 sc[2][2][2];
#pragma unroll
            for (int g = 0; g < 2; ++g)
#pragma unroll
                for (int t = 0; t < 2; ++t) {
                    f32x4 a0 = (f32x4){0.f, 0.f, 0.f, 0.f}, a1 = a0;
                    const int key = 32 * g + 8 * (l15 >> 2) + 4 * t + (l15 & 3);
#pragma unroll
                    for (int s = 0; s < NS; ++s) {
                        const bf16x8 kf = *(const bf16x8*)(Ks + key * KS + 32 * s + 8 * quad);
                        a0 = __builtin_amdgcn_mfma_f32_16x16x32_bf16(kf, qf[0][s], a0, 0, 0, 0);
                        a1 = __builtin_amdgcn_mfma_f32_16x16x32_bf16(kf, qf[1][s], a1, 0, 0, 0);
                    }
                    sc[0][g][t] = a0; sc[1][g][t] = a1;
                    if (t == 1) __builtin_amdgcn_sched_barrier(0);
                }
            asm volatile("" ::: "memory");
            const bool plain = pol.plain(j);
            bf16x8 pf[2][2];
#pragma unroll
            for (int qg = 0; qg < 2; ++qg) {
                if (P::CANFIX && pol.fixed) {
                    if (!plain) {
#pragma unroll
                        for (int g = 0; g < 2; ++g)
#pragma unroll
                            for (int t = 0; t < 2; ++t)
#pragma unroll
                                for (int r = 0; r < 4; ++r) sc[qg][g][t][r] = pol.mod(sc[qg][g][t][r], 32 * w + 16 * qg + l15, j, 32 * g + 8 * quad + 4 * t + r);
                    }
                    const float c2f = plain ? pol.c2 : 1.0f;
                    float ps = 0.f;
#pragma unroll
                    for (int g = 0; g < 2; ++g) {
                        float pv[8];
#pragma unroll
                        for (int t = 0; t < 2; ++t)
#pragma unroll
                            for (int r = 0; r < 4; ++r) { const float e = fexp2(sc[qg][g][t][r] * c2f - pol.mfix); ps += e; pv[4 * t + r] = e; }
                        pf[qg][g] = __builtin_bit_cast(bf16x8, pack8(pv));
                    }
                    l[qg] += ps; m[qg] = pol.mfix;
                } else {
                float tmax = -3.0e38f;
                if (!plain) {
#pragma unroll
                    for (int g = 0; g < 2; ++g)
#pragma unroll
                        for (int t = 0; t < 2; ++t)
#pragma unroll
                            for (int r = 0; r < 4; ++r) sc[qg][g][t][r] = pol.mod(sc[qg][g][t][r], 32 * w + 16 * qg + l15, j, 32 * g + 8 * quad + 4 * t + r);
                }
#pragma unroll
                for (int g = 0; g < 2; ++g)
#pragma unroll
                    for (int t = 0; t < 2; ++t) tmax = fmaxf(fmaxf(tmax, fmaxf(sc[qg][g][t][0], sc[qg][g][t][1])), fmaxf(sc[qg][g][t][2], sc[qg][g][t][3]));
                tmax = quad_max(tmax);
                const float c2 = plain ? pol.c2 : 1.0f;
                const float mn = fmaxf(m[qg], tmax * c2);
                const float alpha = fexp2(m[qg] - mn);
                m[qg] = mn;
                float ps = 0.f;
#pragma unroll
                for (int g = 0; g < 2; ++g) {
                    float pv[8];
#pragma unroll
                    for (int t = 0; t < 2; ++t)
#pragma unroll
                        for (int r = 0; r < 4; ++r) { const float e = fexp2(sc[qg][g][t][r] * c2 - mn); ps += e; pv[4 * t + r] = e; }
                    pf[qg][g] = __builtin_bit_cast(bf16x8, pack8(pv));
                }
                l[qg] = l[qg] * alpha + ps;
                if (__any(alpha != 1.0f)) {
#pragma unroll
                    for (int u = 0; u < 4; ++u) o[qg][u] *= alpha;
                }
                }
            }
            asm volatile("" ::: "memory");
#pragma unroll
            for (int u = 0; u < 4; ++u)
#pragma unroll
                for (int g = 0; g < 2; ++g) {
                    const bf16_t* vb = Vs + (32 * g + 8 * quad + (l15 >> 2)) * VS + 16 * u + 4 * (l15 & 3);
                    const s16x4 lo = tr_read(vb), hi = tr_read(vb + 4 * VS);
                    bf16x8 vf; vf[0] = lo[0]; vf[1] = lo[1]; vf[2] = lo[2]; vf[3] = lo[3]; vf[4] = hi[0]; vf[5] = hi[1]; vf[6] = hi[2]; vf[7] = hi[3];
                    o[0][u] = __builtin_amdgcn_mfma_f32_16x16x32_bf16(vf, pf[0][g], o[0][u], 0, 0, 0);
                    o[1][u] = __builtin_amdgcn_mfma_f32_16x16x32_bf16(vf, pf[1][g], o[1][u], 0, 0, 0);
                }
            asm volatile("" ::: "memory");
        }
        if (more) {
            bf16_t* Kn = (bf16_t*)(smem + ((j + 1) & 1) * AT2_STAGE); bf16_t* Vn = (bf16_t*)(smem + ((j + 1) & 1) * AT2_STAGE + 64 * 104 * 2);
            *(u32x4*)(Kn + k0key * KS + k0ch * 8) = rk0;
            if (k1on) *(u32x4*)(Kn + k1key * KS + k1ch * 8) = rk1;
            *(u32x4*)(Vn + vkey * VS + vch * 8) = rv;
        }
        __syncthreads();
    }
#pragma unroll
    for (int qg = 0; qg < 2; ++qg) {
        float lt = l[qg];
        lt = quad_sum(lt);
        if (P::SINK) lt += fexp2(pol.sink2 - m[qg]);
        const float il = 1.0f / lt;
        bf16_t* op = pol.optr(32 * w + 16 * qg + l15);
#pragma unroll
        for (int u = 0; u < 4; ++u) st_bf16x4(op + 16 * u + 4 * quad, o[qg][u] * il);
    }
    __builtin_amdgcn_s_setprio(0);
}

struct Pol2Plain64 {
    static constexpr int DQK = 64; static constexpr bool SINK = false; static constexpr bool CANFIX = true;
    const bf16_t* Qb; long qs; const bf16_t* Kb; long ks; const bf16_t* Vb; long vs; bf16_t* Ob; long os; int qrow0, krow0, nt; float c2, sink2, mfix; bool fixed;
    DI void prologue(char*) const {}
    DI int ntiles() const { return nt; }
    DI bool needed(int, int) const { return true; }
    DI bool plain(int) const { return true; }
    DI const bf16_t* qptr(int q, int ch) const { return Qb + (long)(qrow0 + q) * qs + ch * 8; }
    DI const bf16_t* kptr(int j, int i, int ch) const { return Kb + (long)(krow0 + 64 * j + i) * ks + ch * 8; }
    DI const bf16_t* vptr(int j, int i, int ch) const { return Vb + (long)(krow0 + 64 * j + i) * vs + ch * 8; }
    DI float mod(float s, int, int, int) const { return s * c2; }
    DI bf16_t* optr(int q) const { return Ob + (long)(qrow0 + q) * os; }
};
struct Pol2NA {
    static constexpr int DQK = 64; static constexpr bool SINK = false; static constexpr bool CANFIX = true;
    const bf16_t* QKV; bf16_t* AO; const float* rpb; const float* bl; int b, h, rq, rbase; float c2, sink2, mfix; bool fixed;
    DI void prologue(char* s) const { float* t = (float*)s; for (int i = TIDX(); i < 465; i += NTHR) t[i] = rpb[h * 465 + i] * LOG2E; }
    DI int ntiles() const { return 15; }
    DI bool plain(int j) const { return j < 4; }
    DI bool needed(int j, int w) const {
        if (j < 4) return true;
        const int kr = rbase + j - 4, qr = 4 * rq + (w >> 1);
        int r0 = qr - 4; r0 = r0 < 0 ? 0 : (r0 > 56 ? 56 : r0);
        return (kr >= r0) && (kr <= r0 + 7);
    }
    DI int qtok(int q) const { return b * 4096 + (4 * rq + (q >> 6)) * 64 + (q & 63); }
    DI int ktok(int j, int i) const { if (j < 4) return TL + b * 256 + 64 * j + i; int kr = rbase + j - 4; kr = kr > 63 ? 63 : kr; return b * 4096 + kr * 64 + i; }
    DI const bf16_t* qptr(int q, int ch) const { return QKV + (long)qtok(q) * 3072 + h * 64 + ch * 8; }
    DI const bf16_t* kptr(int j, int i, int ch) const { return QKV + (long)ktok(j, i) * 3072 + 1024 + h * 64 + ch * 8; }
    DI const bf16_t* vptr(int j, int i, int ch) const { return QKV + (long)ktok(j, i) * 3072 + 2048 + h * 64 + ch * 8; }
    DI float mod(float s, int q, int j, int kc) const {
        const int kr = rbase + j - 4, qr = 4 * rq + (q >> 6), qc = q & 63;
        int c0 = qc - 8; c0 = c0 < 0 ? 0 : (c0 > 48 ? 48 : c0);
        const bool ok = (kc >= c0) && (kc < c0 + 16);
        const int idx = ok ? ((kr - qr + 7) * 31 + (kc - qc + 15)) : 0;
        return ok ? (s * c2 + bl[idx]) : -1e30f;
    }
    DI bf16_t* optr(int q) const { return AO + (long)qtok(q) * 1024 + h * 64; }
};
struct Pol2MLA {
    static constexpr int DQK = 96; static constexpr bool SINK = false; static constexpr bool CANFIX = true;
    const bf16_t* Q; const bf16_t* KV; const bf16_t* KR; bf16_t* AO; int b, h, qrow0, nt; float c2, sink2, mfix; bool fixed;
    DI void prologue(char*) const {}
    DI int ntiles() const { return nt; }
    DI bool needed(int, int) const { return true; }
    DI bool plain(int) const { return true; }
    DI int ktok(int j, int i) const { return (j < 4) ? (TL + b * 256 + 64 * j + i) : (b * 4096 + 64 * (j - 4) + i); }
    DI const bf16_t* qptr(int q, int ch) const { return Q + (long)(qrow0 + q) * 1536 + h * 96 + ch * 8; }
    DI const bf16_t* kptr(int j, int i, int ch) const { const long t = ktok(j, i); return (ch < 8) ? (KV + t * 2048 + h * 128 + ch * 8) : (KR + t * 32 + (ch - 8) * 8); }
    DI const bf16_t* vptr(int j, int i, int ch) const { return KV + (long)ktok(j, i) * 2048 + h * 128 + 64 + ch * 8; }
    DI float mod(float s, int, int, int) const { return s * c2; }
    DI bf16_t* optr(int q) const { return AO + (long)(qrow0 + q) * 1024 + h * 64; }
};
struct Pol2SWA {
    static constexpr int DQK = 64; static constexpr bool SINK = true; static constexpr bool CANFIX = true;
    const bf16_t* QKV; bf16_t* AO; int b, hq, s0; float c2, sink2, mfix; bool fixed;
    DI void prologue(char*) const {}
    DI int ntiles() const { return 12; }
    DI bool plain(int j) const { return j < 4; }
    DI bool needed(int j, int w) const { if (j < 4) return true; const int jj = j - 4; return (64 * jj + 63 >= 32 * w) && (64 * jj <= 32 * w + 287); }
    DI int ktok(int j, int i) const { if (j < 4) return TL + b * 256 + 64 * j + i; int kp = s0 - 128 + 64 * (j - 4) + i; kp = kp < 0 ? 0 : (kp > 4095 ? 4095 : kp); return b * 4096 + kp; }
    DI const bf16_t* qptr(int q, int ch) const { return QKV + (long)(b * 4096 + s0 + q) * 1536 + hq * 64 + ch * 8; }
    DI const bf16_t* kptr(int j, int i, int ch) const { return QKV + (long)ktok(j, i) * 1536 + 1024 + (hq >> 2) * 64 + ch * 8; }
    DI const bf16_t* vptr(int j, int i, int ch) const { return QKV + (long)ktok(j, i) * 1536 + 1280 + (hq >> 2) * 64 + ch * 8; }
    DI float mod(float s, int q, int j, int kc) const {
        const int kp = s0 - 128 + 64 * (j - 4) + kc, d = s0 + q - kp;
        const bool ok = (kp >= 0) && (kp < 4096) && (d <= 128) && (d >= -128);
        return ok ? s * c2 : -1e30f;
    }
    DI bf16_t* optr(int q) const { return AO + (long)(b * 4096 + s0 + q) * 1024 + hq * 64; }
};
DI int attn_unit_xcd(int i, int units_per_pair  , bool ctx_units) {
    if (gridDim.x != 256) { const int u = i * (int)gridDim.x + (int)blockIdx.x; return (u < 2048 + (ctx_units ? 128 : 0)) ? u : -1; }
    const int x = blockIdx.x & 7, Lx = i * 32 + ((int)blockIdx.x >> 3);
    if (Lx < 256) return (16 * x + (Lx >> 4)) * 16 + (Lx & 15);
    if (ctx_units && Lx < 272) return 2048 + 16 * x + (Lx - 256);
    return -1;
}
DI float head64_score_bound(const float* qg, const float* kg) {
    float a = 0.f, b = 0.f;
    for (int i = 0; i < 64; ++i) { a = fmaxf(a, fabsf(qg[i])); b = fmaxf(b, fabsf(kg[i])); }
    return 1.02f * 0.125f * LOG2E * 64.0f * a * b;
}
DI void phase_attn2_na(const Params& p, const bf16_t* QKV, bf16_t* AO, char* smem) {
    float bmax = 0.f;
    {
        float* red = (float*)smem;
        float v = 0.f;
        for (int i = TIDX(); i < 16 * 465; i += NTHR) v = fmaxf(v, fabsf(p.in[I_NA_RPB][i]));
        __syncthreads();
        red[TIDX()] = v;
        __syncthreads();
        for (int i = 0; i < NTHR; ++i) bmax = fmaxf(bmax, red[i]);
        __syncthreads();
    }
    const float sb = head64_score_bound(p.in[I_NA_QG], p.in[I_NA_KG]);
    const float mfix_l = sb + bmax * LOG2E, mfix_c = sb;
    const bool fixed = mfix_l < 60.0f;
    for (int it = 0;; ++it) {
        const int u = attn_unit_xcd(it, 16, true); if (u < 0) break;
        if (u < 2048) {
            Pol2NA pol; pol.QKV = QKV; pol.AO = AO; pol.rpb = p.in[I_NA_RPB]; pol.bl = (const float*)(smem + AT2_BIAS);
            pol.b = u >> 8; pol.h = (u >> 4) & 15; pol.rq = u & 15;
            int rb = 4 * pol.rq - 4; rb = rb < 0 ? 0 : (rb > 56 ? 56 : rb); pol.rbase = rb;
            pol.c2 = 0.125f * LOG2E; pol.sink2 = 0.f; pol.mfix = mfix_l; pol.fixed = fixed;
            attn_unit2(pol, smem);
        } else {
            const int v = u - 2048, b = v >> 4, h = v & 15;
            Pol2Plain64 pol; pol.Qb = QKV + h * 64; pol.qs = 3072; pol.Kb = QKV + 1024 + h * 64; pol.ks = 3072; pol.Vb = QKV + 2048 + h * 64; pol.vs = 3072;
            pol.Ob = AO + h * 64; pol.os = 1024; pol.qrow0 = TL + b * 256; pol.krow0 = TL + b * 256; pol.nt = 4; pol.c2 = 0.125f * LOG2E; pol.sink2 = 0.f; pol.mfix = mfix_c; pol.fixed = fixed;
            attn_unit2(pol, smem);
        }
    }
}
DI void phase_attn2_mla(const Params& p, const bf16_t* Q, const bf16_t* KV, const bf16_t* KR, bf16_t* AO, char* smem) {
    float gq = 0.f, gqr = 0.f, gk = 0.f, gkr = 0.f;
    for (int i = 0; i < 64; ++i) { gq = fmaxf(gq, fabsf(p.in[I_MLA_QN_G][i])); gk = fmaxf(gk, fabsf(p.in[I_MLA_KN_G][i])); }
    for (int i = 0; i < 32; ++i) { gqr = fmaxf(gqr, fabsf(p.in[I_MLA_QR_G][i])); gkr = fmaxf(gkr, fabsf(p.in[I_MLA_KR_G][i])); }
    const float mfix = 1.02f * 0.10206207261596575f * LOG2E * sqrtf(64.f * gq * gq + 32.f * gqr * gqr) * sqrtf(64.f * gk * gk + 32.f * gkr * gkr);
    const bool fixed = mfix < 60.0f;
    for (int it = 0;; ++it) {
        const int u = attn_unit_xcd(it, 16, true); if (u < 0) break;
        Pol2MLA pol; pol.Q = Q; pol.KV = KV; pol.KR = KR; pol.AO = AO; pol.c2 = 0.10206207261596575f * LOG2E; pol.sink2 = 0.f;
        pol.mfix = mfix; pol.fixed = fixed;
        if (u < 2048) { pol.b = u >> 8; pol.h = (u >> 4) & 15; pol.qrow0 = pol.b * 4096 + 256 * (u & 15); pol.nt = 68; }
        else { const int v = u - 2048; pol.b = v >> 4; pol.h = v & 15; pol.qrow0 = TL + pol.b * 256; pol.nt = 4; }
        attn_unit2(pol, smem);
    }
}
DI void phase_attn2_swa(const Params& p, const bf16_t* QKV, bf16_t* AO, char* smem) {
    const float mfix = head64_score_bound(p.in[I_SWA_QG], p.in[I_SWA_KG]);
    const bool fixed = mfix < 60.0f;
    for (int it = 0;; ++it) {
        const int u = attn_unit_xcd(it, 16, false); if (u < 0) break;
        Pol2SWA pol; pol.QKV = QKV; pol.AO = AO; pol.b = u >> 8; pol.hq = (u >> 4) & 15; pol.s0 = 256 * (u & 15);
        pol.c2 = 0.125f * LOG2E; pol.sink2 = p.in[I_SWA_SINK][pol.hq] * LOG2E; pol.mfix = mfix; pol.fixed = fixed;
        attn_unit2(pol, smem);
    }
}

template <class Epi>
DI void pg8_gemm(const bf16_t* A, const bf16_t* Bt, int M, int N, int K, const Epi& e, char* smem) {
    pg8::Gemm g; g.A = A; g.Bt = Bt; g.M = M; g.N = N; g.K = K;
    pg8::StaticOrder S; S.init(M, N, (int)gridDim.x, (int)blockIdx.x);
    pg8::gemm_phase<Epi, pg8::StaticOrder, false>((LAS unsigned char*)smem, g, S, e, nullptr);
}

DI void phase_attn_na(const Params& p, const bf16_t* QKV, bf16_t* AO, char* smem) {
    for (int u = blockIdx.x; u < 4096 + 256; u += gridDim.x) {
        if (u < 4096) {
            PolNA pol; pol.QKV = QKV; pol.AO = AO; pol.rpb = p.in[I_NA_RPB]; pol.bl = (const float*)(smem + 64 * 104 * 2 + 64 * 72 * 2);
            pol.b = u >> 9; pol.h = (u >> 5) & 15; pol.rr = u & 31;
            int rb = 2 * pol.rr - 4; rb = rb < 0 ? 0 : (rb > 56 ? 56 : rb); pol.rbase = rb;
            pol.c2 = 0.125f * LOG2E; pol.sink2 = 0.f;
            attn_unit(pol, smem);
        } else {
            const int v = u - 4096, b = v >> 5, h = (v >> 1) & 15, half = v & 1;
            PolPlain64 pol; pol.Qb = QKV + h * 64; pol.qs = 3072; pol.Kb = QKV + 1024 + h * 64; pol.ks = 3072; pol.Vb = QKV + 2048 + h * 64; pol.vs = 3072;
            pol.Ob = AO + h * 64; pol.os = 1024; pol.qrow0 = TL + b * 256 + 128 * half; pol.krow0 = TL + b * 256; pol.nt = 4; pol.c2 = 0.125f * LOG2E; pol.sink2 = 0.f;
            attn_unit(pol, smem);
        }
    }
}
DI void phase_attn_mla(const bf16_t* Q, const bf16_t* KV, const bf16_t* KR, bf16_t* AO, char* smem) {
    for (int u = blockIdx.x; u < 4096 + 256; u += gridDim.x) {
        PolMLA pol; pol.Q = Q; pol.KV = KV; pol.KR = KR; pol.AO = AO; pol.c2 = 0.10206207261596575f * LOG2E; pol.sink2 = 0.f;
        if (u < 4096) { pol.b = u >> 9; pol.h = (u >> 5) & 15; pol.qrow0 = pol.b * 4096 + 128 * (u & 31); pol.nt = 68; }
        else { const int v = u - 4096; pol.b = v >> 5; pol.h = (v >> 1) & 15; pol.qrow0 = TL + pol.b * 256 + 128 * (v & 1); pol.nt = 4; }
        attn_unit(pol, smem);
    }
}
DI void phase_attn_swa(const Params& p, const bf16_t* QKV, bf16_t* AO, char* smem) {
    for (int u = blockIdx.x; u < 4096; u += gridDim.x) {
        PolSWA pol; pol.QKV = QKV; pol.AO = AO; pol.b = u >> 9; pol.hq = (u >> 5) & 15; pol.s0 = 128 * (u & 31);
        pol.c2 = 0.125f * LOG2E; pol.sink2 = p.in[I_SWA_SINK][pol.hq] * LOG2E;
        attn_unit(pol, smem);
    }
}


DI void wo_phase(const Params& p, const Bufs& B, int layer, const bf16_t* A, const bf16_t* Wt, char* smem) {
    const float* gate = B.MOD + (size_t)layer * 9 * 6144 + 2 * 1024;
    pg8::PEpiResidual e; e.X = B.X; e.gate = gate;
    e.Xl = (layer == 0) ? p.in[I_X] : B.X; e.Xc = (layer == 0) ? p.in[I_CTX] : (B.X + (size_t)TL * 1024);
    pg8_gemm(A, Wt, TL, 1024, 1024, e, smem);
    __syncthreads();
    GemmOp g; g.A = A + (size_t)TL * 1024; g.lda = 1024; g.Bt = Wt; g.ldb = 1024; g.kbeg = 0; g.kend = 1024;
    EpiResidualCtx ec; ec.Xout = B.X + (size_t)TL * 1024; ec.Xin = (layer == 0) ? p.in[I_CTX] : (B.X + (size_t)TL * 1024); ec.gate = gate + (size_t)8 * 6144;
    gemm_all(g, TC, 1024, ec, smem);
}

constexpr int N_PHASES = 44;
constexpr int LDS_BYTES = 131072;
static_assert(GT_LDS <= LDS_BYTES && SCAN_LDS <= LDS_BYTES && ATT_LDS <= LDS_BYTES && TOPK_LDS <= LDS_BYTES && 65536 <= LDS_BYTES, "lds");

template <int SUB>
DI void moe_phase(const Params& p, const Bufs& B, int layer, char* smem) {
    const bool has_ctx = layer < 3;
    const int ntok = has_ctx ? TT : TL;
    bf16_t* H = B.slot(0); bf16_t* XIN = B.slot(1); bf16_t* HID = B.slot(3); bf16_t* Y = B.slot(1);
    if constexpr (SUB == 0) phase_norm2(p, B, layer, H, ntok, smem);
    else if constexpr (SUB == 1) phase_topk(B, H, XIN, has_ctx, smem);
    else if constexpr (SUB == 2) {
        phase_moe_gemm1(B, XIN, HID, has_ctx, smem);
        if (USE_PG8 && layer < 3) {
            const bool split = (gridDim.x == 256);
            const int li = (int)blockIdx.x >> 3;
            if (!split || li >= 16) { __syncthreads(); int base = 0; conv_moe_layer(p, B, layer + 1, base, smem, 2, split ? (li - 16) * 8 + ((int)blockIdx.x & 7) : -1, split ? 128 : 0); }
        }
    }
    else if constexpr (SUB == 3) {
        phase_moe_gemm2(B, HID, Y, has_ctx, smem, layer);
        if (USE_PG8 && layer < 3) {
            const bool split = (gridDim.x == 256);
            const int li = (int)blockIdx.x >> 3;
            if (!split || li >= 8) { __syncthreads(); int base = 0; conv_moe_layer(p, B, layer + 1, base, smem, 1, split ? (li - 8) * 8 + ((int)blockIdx.x & 7) : -1, split ? 192 : 0); }
        }
    }
    else { phase_combine(p, B, layer, Y, ntok, layer == 3, layer == 1 || layer == 2, H); if (!USE_PG8 && layer < 3) { int base = 0; conv_moe_layer(p, B, layer + 1, base, smem, 0); } }
}

template <int PH>
DI void run_phase(const Params& p, char* smem) {
    const Bufs B = make_bufs(p);
    bf16_t* H = B.slot(0);
    if constexpr (PH == 0) phase_prologue(p, B, smem);
    else if constexpr (PH == 1) phase_norm1(p, B, 0, H);
    else if constexpr (PH == 2) { pg8::PEpiQKNorm e; e.O = B.slot(1); e.ldo = 3072; e.nq = 4; e.nk = 8; e.qg = p.in[I_NA_QG]; e.kg = p.in[I_NA_KG]; e.rope = nullptr; pg8_gemm(H, B.WMIX + W_NA_QKV, TT, 3072, 1024, e, smem); }
    else if constexpr (PH == 3) {   }
    else if constexpr (PH == 4) phase_attn2_na(p, B.slot(1), B.slot(4), smem);
    else if constexpr (PH == 5) wo_phase(p, B, 0, B.slot(4), B.WMIX + W_NA_WO, smem);
    else if constexpr (PH >= 6 && PH <= 10) moe_phase<PH - 6>(p, B, 0, smem);
    else if constexpr (PH == 11) phase_norm1_rw(p, B, 1, B.slot(0));
    else if constexpr (PH == 12) { pg8::PEpiRW1 e; e.RKV = B.slot(2); e.LORA = B.slot(5); pg8_gemm(B.slot(0), B.WMIX + W_RW_B1, TT, 3584, 2048, e, smem); }
    else if constexpr (PH == 13) phase_rw_gemm2(p, B, B.slot(5), B.slot(0), B.slot(1), B.slot(6), B.slot(7), B.slot(8), smem);
    else if constexpr (PH == 14) {
#if USE_SCAN2
        phase_rw_scan2(p, B.slot(2), B.slot(1), B.slot(6), B.slot(7), B.slot(8), B.slot(9), B.slot(5), smem);
#else
        phase_rw_scan(p, B.slot(2), B.slot(1), B.slot(6), B.slot(7), B.slot(8), B.slot(9), B.slot(5), smem);
#endif
    }
    else if constexpr (PH == 15) phase_rw_readout(p, B.slot(2), B.slot(7), B.slot(8), B.slot(0), B.slot(9), B.slot(5), B.slot(1));
    else if constexpr (PH == 16) wo_phase(p, B, 1, B.slot(1), B.WMIX + W_RW_WO, smem);
    else if constexpr (PH >= 17 && PH <= 21) moe_phase<PH - 17>(p, B, 1, smem);
    else if constexpr (PH == 22) {   }
    else if constexpr (PH == 23) { pg8::PEpiBf16 e; e.O = B.slot(1); e.ldo = 768; pg8_gemm(H, B.WMIX + W_MLA_DOWN, TT, 768, 1024, e, smem); }
    else if constexpr (PH == 24) { bf16_t* CQ = B.slot(3); phase_mla_dnorm(p, B, B.slot(1), CQ, CQ + (size_t)TT * 384, CQ + (size_t)TT * 640); }
    else if constexpr (PH == 25) {
        bf16_t* CQ = B.slot(3);
        { pg8::PEpiBf16 e; e.O = B.slot(4); e.ldo = 1536; pg8_gemm(CQ, B.WMIX + W_MLA_UQ, TT, 1536, 384, e, smem); }
        { pg8::PEpiBf16 e; e.O = B.slot(6); e.ldo = 2048; pg8_gemm(CQ + (size_t)TT * 384, B.WMIX + W_MLA_UKV, TT, 2048, 256, e, smem); }
    }
    else if constexpr (PH == 26) phase_mla_hnorm(p, B, B.slot(4), B.slot(6));
    else if constexpr (PH == 27) phase_attn2_mla(p, B.slot(4), B.slot(6), B.slot(3) + (size_t)TT * 640, B.slot(8), smem);
    else if constexpr (PH == 28) wo_phase(p, B, 2, B.slot(8), B.WMIX + W_MLA_WO, smem);
    else if constexpr (PH >= 29 && PH <= 33) moe_phase<PH - 29>(p, B, 2, smem);
    else if constexpr (PH == 34) {   }
    else if constexpr (PH == 35) { pg8::PEpiQKNorm e; e.O = B.slot(1); e.ldo = 1536; e.nq = 4; e.nk = 5; e.qg = p.in[I_SWA_QG]; e.kg = p.in[I_SWA_KG]; e.rope = B.ROPE_S; pg8_gemm(H, B.WMIX + W_SWA_QKV, TT, 1536, 1024, e, smem); }
    else if constexpr (PH == 36) {   }
    else if constexpr (PH == 37) phase_attn2_swa(p, B.slot(1), B.slot(3), smem);
    else if constexpr (PH == 38) { pg8::PEpiResidual e; e.X = B.X; e.Xl = B.X; e.Xc = B.X + (size_t)TL * 1024; e.gate = B.MOD + (size_t)3 * 9 * 6144 + 2 * 1024; pg8_gemm(B.slot(3), B.WMIX + W_SWA_WO, TL, 1024, 1024, e, smem); }
    else if constexpr (PH >= 39 && PH <= 43) moe_phase<PH - 39>(p, B, 3, smem);
}

#define XB_TMO      128
#define XB_XCNT(j)  (256  + 64 * (j))
#define XB_XSUB(j)  (1280 + 64 * (j))
#define XB_XGEN(j)  (2304 + 64 * (j))
#define XB_TOP      3328
#define XB_TOPGEN   3392
#define XCD_BAR_WORDS 3456
#define XB_SPIN_CAP (1u << 18)

__device__ __forceinline__ unsigned xb_ld(unsigned* p)              { return __hip_atomic_load(p, __ATOMIC_RELAXED, __HIP_MEMORY_SCOPE_AGENT); }
__device__ __forceinline__ unsigned xb_add(unsigned* p, unsigned v) { return __hip_atomic_fetch_add(p, v, __ATOMIC_RELAXED, __HIP_MEMORY_SCOPE_AGENT); }
__device__ __forceinline__ unsigned xb_xcc_id() { return (unsigned)__builtin_amdgcn_s_getreg((3 << 11) | 20) & 0xFu; }
#define XB_SPIN(cond, bar) do { unsigned _sp = 0; while (cond) { __builtin_amdgcn_s_sleep(1); \
    if ((++_sp & 255u) == 0u) { if (xb_ld(&(bar)[XB_TMO])) break; if (_sp > XB_SPIN_CAP) { atomicAdd(&(bar)[XB_TMO], 1u); break; } } } } while (0)

struct XcdBarrier {
    unsigned* bar; unsigned x;
    volatile LAS unsigned* st;
};

__device__ __forceinline__ XcdBarrier xcd_barrier_post(unsigned* bar, volatile LAS unsigned* st) {
    XcdBarrier b; b.bar = bar; b.x = xb_xcc_id(); b.st = st;
    if (TIDX() == 0) (void)xb_add(&bar[XB_XCNT(b.x)], 1u);
    return b;
}
__device__ __forceinline__ void xcd_barrier_complete(unsigned* bar, unsigned x, unsigned& nloc, unsigned& nx) {
    const unsigned G = gridDim.x * gridDim.y * gridDim.z;
    unsigned sum, cnt, mine, sp = 0u;
    for (;;) {
        sum = 0u; cnt = 0u; mine = 0u;
#pragma unroll
        for (unsigned j = 0; j < 16; ++j) { const unsigned c = xb_ld(&bar[XB_XCNT(j)]); sum += c; cnt += (c > 0u) ? 1u : 0u; mine = (j == x) ? c : mine; }
        if (sum == G) break;
        __builtin_amdgcn_s_sleep(1);
        if ((++sp & 255u) == 0u) { if (xb_ld(&bar[XB_TMO])) break; if (sp > XB_SPIN_CAP) { atomicAdd(&bar[XB_TMO], 1u); break; } }
    }
    nloc = mine > 0u ? mine : 1u; nx = cnt > 0u ? cnt : 1u;
}

__device__ __forceinline__ void xcd_barrier(const XcdBarrier& b) {
    asm volatile("s_waitcnt vmcnt(0)" ::: "memory");
    __syncthreads();
    if (TIDX() == 0) {
        unsigned* bar = b.bar;
        __builtin_amdgcn_s_waitcnt(0);
        unsigned nloc = b.st[0], nx = b.st[1];
        if (nloc == 0u) { xcd_barrier_complete(bar, b.x, nloc, nx); b.st[0] = nloc; b.st[1] = nx; }
        const unsigned old = xb_add(&bar[XB_XSUB(b.x)], 1u);
        const unsigned gen = old / nloc;
        if (old + 1u == (gen + 1u) * nloc) {
            __builtin_amdgcn_fence(__ATOMIC_RELEASE, "agent");
            asm volatile("s_waitcnt vmcnt(0)" ::: "memory");
            const unsigned og = xb_add(&bar[XB_TOP], 1u);
            const unsigned tg = og / nx;
            if (og + 1u == (tg + 1u) * nx) xb_add(&bar[XB_TOPGEN], 1u);
            else XB_SPIN(xb_ld(&bar[XB_TOPGEN]) == tg, bar);
            __builtin_amdgcn_fence(__ATOMIC_ACQUIRE, "agent");
            xb_add(&bar[XB_XGEN(b.x)], 1u);
            asm volatile("s_waitcnt vmcnt(0)" ::: "memory");
        } else {
            XB_SPIN(xb_ld(&bar[XB_XGEN(b.x)]) == gen, bar);
            __builtin_amdgcn_fence(__ATOMIC_ACQUIRE, "agent");
            asm volatile("s_waitcnt vmcnt(0)" ::: "memory");
        }
    }
    __syncthreads();
}

constexpr int LDS_REQ = 147456;

#if MULTI_LAUNCH
template <int PH>
__global__ void __launch_bounds__(NTHR, 2) k_phase(Params p) {
    extern __shared__ __attribute__((aligned(16))) char smem[];
    run_phase<PH>(p, smem);
}
template <int PH>
static void launch_from(const Params& p, int grid, hipStream_t stream, bool setattr) {
    if constexpr (PH < N_PHASES) {
        if (setattr) (void)hipFuncSetAttribute((const void*)k_phase<PH>, hipFuncAttributeMaxDynamicSharedMemorySize, LDS_REQ);
        else hipLaunchKernelGGL(k_phase<PH>, dim3(grid), dim3(NTHR), LDS_REQ, stream, p);
        launch_from<PH + 1>(p, grid, stream, setattr);
    }
}
#else
constexpr int LDS_PARAMS = LDS_BYTES + 64;
DI unsigned long long lds_u64_uniform(const char* lp, int i) {
    const u32x2 v = *(const u32x2*)(lp + 8 * i);
    const unsigned lo = __builtin_amdgcn_readfirstlane(v.x), hi = __builtin_amdgcn_readfirstlane(v.y);
    return ((unsigned long long)hi << 32) | lo;
}
DI Params load_params(const char* lp) {
    Params p;
#pragma unroll
    for (int i = 0; i < N_INPUTS; ++i) p.in[i] = (const float*)lds_u64_uniform(lp, i);
    p.out = (float*)lds_u64_uniform(lp, N_INPUTS); p.ws = (unsigned char*)lds_u64_uniform(lp, N_INPUTS + 1);
    return p;
}
#ifndef PH_LO
#define PH_LO 0
#define PH_HI N_PHASES
#endif
constexpr int dup_start(int ph) {
    if (PROBE == 1) { if (ph == 9) return 6; if (ph == 20) return 17; if (ph == 32) return 29; if (ph == 42) return 39; }
    if (PROBE == 2) { if (ph == 4) return 1; if (ph == 27) return 22; if (ph == 37) return 34; }
    if (PROBE == 3) { if (ph == 15) return 11; }
    if (PROBE == 4) { if (ph == 4) return 4; if (ph == 27) return 27; if (ph == 37) return 37; }
    if (PROBE == 5) { if (ph == 14) return 14; }
    if (PROBE == 7) { if (ph == 0) return 0; }
    if (PROBE == 8) { if (ph == 1 || ph == 11 || ph == 22 || ph == 34 || ph == 6 || ph == 17 || ph == 29 || ph == 39) return ph; }
    if (PROBE == 9) { if (ph == 9) return 8; if (ph == 20) return 19; if (ph == 32) return 31; if (ph == 42) return 41; }
    if (PROBE == 10) { if (ph == 2 || ph == 12 || ph == 13 || ph == 23 || ph == 25 || ph == 35) return ph; }
    return -1;
}
template <int A, int B>
DI void run_range(char* smem, const XcdBarrier& bar) {
    if constexpr (A <= B) { { const Params p = load_params(smem + LDS_PARAMS); run_phase<A>(p, smem); } xcd_barrier(bar); run_range<A + 1, B>(smem, bar); }
}
template <int PH>
DI void run_all(char* smem, const XcdBarrier& bar) {
    if constexpr (PH < N_PHASES) {
        constexpr bool empty = (PH == 22 || PH == 34 || PH == 3 || PH == 36);
        if constexpr (!empty && PH >= PH_LO && PH < PH_HI) { const Params p = load_params(smem + LDS_PARAMS); run_phase<PH>(p, smem); }
        if constexpr (!empty && PH + 1 < N_PHASES) xcd_barrier(bar);
        if constexpr (dup_start(PH) >= 0) run_range<dup_start(PH), PH>(smem, bar);
        run_all<PH + 1>(smem, bar);
    }
}
__global__ void __launch_bounds__(NTHR, 2) k_mega(Params p) {
    extern __shared__ __attribute__((aligned(16))) char smem[];
    if (TIDX() == 0) {
        *(u32x4*)(smem + LDS_BYTES) = (u32x4){0u, 0u, 0u, 0u};
        unsigned long long* lp = (unsigned long long*)(smem + LDS_PARAMS);
#pragma unroll
        for (int i = 0; i < N_INPUTS; ++i) lp[i] = (unsigned long long)p.in[i];
        lp[N_INPUTS] = (unsigned long long)p.out; lp[N_INPUTS + 1] = (unsigned long long)p.ws;
    }
    __syncthreads();
    const XcdBarrier bar = xcd_barrier_post((unsigned*)(p.ws + OFF_CTL), (volatile LAS unsigned*)(LAS char*)(smem + LDS_BYTES));
    run_all<0>(smem, bar);
}
#endif

extern "C" void kernel_launch(void* const* d_in, const int* in_sizes, int n_in, void* d_out, int out_size, void* d_ws, size_t ws_size, hipStream_t stream) {
    static int grid = 0;
    Params p{};
    for (int i = 0; i < N_INPUTS; ++i) p.in[i] = (const float*)d_in[i];
    p.out = (float*)d_out; p.ws = (unsigned char*)d_ws;
    if (grid == 0) {
        if (n_in != N_INPUTS || out_size != TL * 1024 || ws_size < WS_NEED) { grid = -1; return; }
        int dev = 0, cus = 0;
        if (hipGetDevice(&dev) != hipSuccess || hipDeviceGetAttribute(&cus, hipDeviceAttributeMultiprocessorCount, dev) != hipSuccess) { grid = -1; return; }
#if MULTI_LAUNCH
        launch_from<0>(p, 0, stream, true);
#else
        if (hipFuncSetAttribute((const void*)k_mega, hipFuncAttributeMaxDynamicSharedMemorySize, LDS_REQ) != hipSuccess) { grid = -1; return; }
#endif
        grid = cus > 0 ? cus : 256;
    }
    if (grid < 0) return;
    (void)hipMemsetAsync((char*)d_ws + OFF_CTL, 0, 65536, stream);
#if MULTI_LAUNCH
    launch_from<0>(p, grid, stream, false);
#else
    hipLaunchKernelGGL(k_mega, dim3(grid), dim3(NTHR), LDS_REQ, stream, p);
#endif
}
```

```cpp
#include <hip/hip_runtime.h>
#include <stdint.h>

#ifndef MULTI_LAUNCH
#define MULTI_LAUNCH 0
#endif
#ifndef USE_PG8
#define USE_PG8 1
#endif
#ifndef PROBE
#define PROBE 0
#endif
#ifndef USE_SCAN2
#define USE_SCAN2 1
#endif
#ifndef ATT_SCHED_FENCE
#define ATT_SCHED_FENCE 0
#endif
#ifndef GATHER_A
#define GATHER_A 1
#endif

typedef unsigned short bf16_t;
typedef short bf16x8 __attribute__((ext_vector_type(8)));
typedef short s16x4 __attribute__((ext_vector_type(4)));
typedef float f32x4 __attribute__((ext_vector_type(4)));
typedef unsigned u32x4 __attribute__((ext_vector_type(4)));
typedef unsigned u32x2 __attribute__((ext_vector_type(2)));
#define LAS __attribute__((address_space(3)))
#define DI __device__ __forceinline__
DI int TIDX() { int t = (int)threadIdx.x; asm volatile("" : "+v"(t)); return t; }

constexpr int NTHR = 512;
constexpr int D = 1024, NB = 8, SEQ = 4096, CTXL = 256;
constexpr int TL = NB * SEQ, TC = NB * CTXL, TT = TL + TC;
constexpr int NEXP = 16, CAPL = 512, CAPC = 32, EROWS = NB * CAPL + NB * CAPC;
constexpr float LOG2E = 1.4426950408889634f;

enum { I_X = 0, I_C, I_CTX, I_CCTX, I_N1G, I_N2G, I_ADAW, I_ADAB,
       I_NA_WQKV, I_NA_QG, I_NA_KG, I_NA_RPB, I_NA_WO,
       I_RW_MIX, I_RW_WR, I_RW_WK, I_RW_WV, I_RW_W0, I_RW_W1, I_RW_W2, I_RW_A0, I_RW_A1, I_RW_A2, I_RW_G1, I_RW_G2,
       I_RW_KK, I_RW_KA, I_RW_RK, I_RW_LNG, I_RW_LNB, I_RW_WO,
       I_MLA_WDOWN, I_MLA_QNG, I_MLA_KVNG, I_MLA_WUQ, I_MLA_WUKV, I_MLA_QN_G, I_MLA_QR_G, I_MLA_KN_G, I_MLA_KR_G, I_MLA_WO,
       I_SWA_WQKV, I_SWA_QG, I_SWA_KG, I_SWA_SINK, I_SWA_WO,
       I_MOE_ROUTER, I_MOE_W1, I_MOE_W3, I_MOE_W2, N_INPUTS };

constexpr size_t MiB = 1u << 20;
constexpr size_t OFF_CTL = 0;
constexpr size_t OFF_MOD = 65536;
constexpr size_t OFF_ROPE_M = OFF_MOD + 4 * 9 * 6144 * 4;
constexpr size_t OFF_ROPE_S = OFF_ROPE_M + 2 * 4096 * 16 * 4;
constexpr size_t OFF_X = 4 * MiB;
constexpr size_t OFF_WMIX = 140 * MiB;
constexpr size_t OFF_WE = 180 * MiB;
constexpr size_t OFF_MISC = 276 * MiB;
constexpr size_t OFF_WORK = 284 * MiB;
constexpr size_t USLOT = (size_t)TT * 1024 * 2;
constexpr size_t OFF_W2TB = OFF_WORK + 10 * USLOT;
constexpr size_t WS_NEED = OFF_W2TB + 32 * MiB;
static_assert(OFF_ROPE_S + 2 * 4096 * 32 * 4 <= OFF_X, "map");
static_assert(OFF_X + (size_t)TT * 1024 * 4 <= OFF_WMIX, "map");

constexpr size_t W_NA_QKV = 0, W_NA_WO = 3145728, W_RW_B1 = 4194304, W_RW_B2 = 11534336, W_RW_WO = 13500416,
                 W_MLA_DOWN = 14548992, W_MLA_UQ = 15335424, W_MLA_UKV = 15925248, W_MLA_WO = 16449536,
                 W_SWA_QKV = 17498112, W_SWA_WO = 19070976, W_MIX_END = 20119552;
static_assert(OFF_WMIX + W_MIX_END * 2 <= OFF_WE, "map");
static_assert(OFF_WE + 96 * MiB <= OFF_MISC, "map");
constexpr size_t OFF_AFF = OFF_MISC;
constexpr size_t OFF_AFFC = OFF_AFF + 8 * 16 * 4096 * 4;
constexpr size_t OFF_IDX = OFF_AFFC + 8 * 16 * 256 * 4;
constexpr size_t OFF_GATE = OFF_IDX + 16 * EROWS * 4;
constexpr size_t OFF_INV = OFF_GATE + 16 * EROWS * 4;
static_assert(OFF_INV + (size_t)TT * 16 * 4 <= OFF_WORK, "map");

struct Params {
    const float* in[N_INPUTS];
    float* out;
    unsigned char* ws;
};

DI unsigned f2bf(float f) { unsigned u = __float_as_uint(f); return (u + 0x7fffu + ((u >> 16) & 1u)) >> 16; }
typedef float f32x2_t __attribute__((ext_vector_type(2)));
typedef __bf16 bf16x2_t __attribute__((ext_vector_type(2)));
DI unsigned pk2(float lo, float hi) { const f32x2_t v = {lo, hi}; const bf16x2_t b = __builtin_convertvector(v, bf16x2_t); return __builtin_bit_cast(unsigned, b); }
DI float bf2f(unsigned b) { return __uint_as_float(b << 16); }
DI float bflo(unsigned w) { return __uint_as_float(w << 16); }
DI float bfhi(unsigned w) { return __uint_as_float(w & 0xffff0000u); }
DI float wave_sum(float v) {
    v += __shfl_xor(v, 32); v += __shfl_xor(v, 16); v += __shfl_xor(v, 8); v += __shfl_xor(v, 4); v += __shfl_xor(v, 2); v += __shfl_xor(v, 1); return v; }
DI float fsigmoid(float x) { return 1.0f / (1.0f + __expf(-x)); }
DI float fexp2(float x) { return __builtin_amdgcn_exp2f(x); }
DI int modrow_of(int g) { return g < TL ? (g >> 12) : 8; }
DI void unpack8(u32x4 v, float* f) { f[0] = bflo(v.x); f[1] = bfhi(v.x); f[2] = bflo(v.y); f[3] = bfhi(v.y); f[4] = bflo(v.z); f[5] = bfhi(v.z); f[6] = bflo(v.w); f[7] = bfhi(v.w); }
DI u32x4 pack8(const float* f) { u32x4 v; v.x = pk2(f[0], f[1]); v.y = pk2(f[2], f[3]); v.z = pk2(f[4], f[5]); v.w = pk2(f[6], f[7]); return v; }

struct GemmOp { const bf16_t* A; long lda; const bf16_t* Bt; long ldb; int kbeg, kend; };
constexpr int GT_LDS = 4 * 128 * 72 * 2;

template <class Epi>
DI void gemm_tile(const GemmOp& g, int row0, int col0, const Epi& epi, char* smem) {
    const int tid = TIDX(), lane = tid & 63, w = tid >> 6, wm = w >> 2, wn = w & 3, l15 = lane & 15, quad = lane >> 4;
    bf16_t* As = (bf16_t*)smem;
    bf16_t* Bs = As + 2 * 128 * 72;
    const int lr = tid >> 3, lc = (tid & 7) * 8;
    const bf16_t* ga0 = g.A + (long)(row0 + lr) * g.lda + g.kbeg + lc;
    const bf16_t* ga1 = ga0 + 64 * g.lda;
    const bf16_t* gb0 = g.Bt + (long)(col0 + lr) * g.ldb + g.kbeg + lc;
    const bf16_t* gb1 = gb0 + 64 * g.ldb;
    f32x4 acc[4][2];
#pragma unroll
    for (int i = 0; i < 4; ++i) { acc[i][0] = (f32x4){0.f, 0.f, 0.f, 0.f}; acc[i][1] = (f32x4){0.f, 0.f, 0.f, 0.f}; }
    u32x4 ra0 = *(const u32x4*)ga0, ra1 = *(const u32x4*)ga1, rb0 = *(const u32x4*)gb0, rb1 = *(const u32x4*)gb1;
    *(u32x4*)(As + lr * 72 + lc) = ra0; *(u32x4*)(As + (lr + 64) * 72 + lc) = ra1;
    *(u32x4*)(Bs + lr * 72 + lc) = rb0; *(u32x4*)(Bs + (lr + 64) * 72 + lc) = rb1;
    __syncthreads();
    const int nk = (g.kend - g.kbeg) >> 6;
    for (int kt = 0; kt < nk; ++kt) {
        const int cur = kt & 1;
        const bool more = (kt + 1 < nk);
        if (more) { const int ko = (kt + 1) * 64; ra0 = *(const u32x4*)(ga0 + ko); ra1 = *(const u32x4*)(ga1 + ko); rb0 = *(const u32x4*)(gb0 + ko); rb1 = *(const u32x4*)(gb1 + ko); }
        const bf16_t* a = As + cur * 128 * 72;
        const bf16_t* b = Bs + cur * 128 * 72;
#pragma unroll
        for (int ks = 0; ks < 2; ++ks) {
            bf16x8 af[4], bfr[2];
#pragma unroll
            for (int mt = 0; mt < 4; ++mt) af[mt] = *(const bf16x8*)(a + (wm * 64 + mt * 16 + l15) * 72 + ks * 32 + quad * 8);
#pragma unroll
            for (int nt = 0; nt < 2; ++nt) bfr[nt] = *(const bf16x8*)(b + (wn * 32 + nt * 16 + l15) * 72 + ks * 32 + quad * 8);
#pragma unroll
            for (int mt = 0; mt < 4; ++mt)
#pragma unroll
                for (int nt = 0; nt < 2; ++nt) acc[mt][nt] = __builtin_amdgcn_mfma_f32_16x16x32_bf16(bfr[nt], af[mt], acc[mt][nt], 0, 0, 0);
        }
        if (more) {
            bf16_t* a2 = As + (cur ^ 1) * 128 * 72; bf16_t* b2 = Bs + (cur ^ 1) * 128 * 72;
            *(u32x4*)(a2 + lr * 72 + lc) = ra0; *(u32x4*)(a2 + (lr + 64) * 72 + lc) = ra1;
            *(u32x4*)(b2 + lr * 72 + lc) = rb0; *(u32x4*)(b2 + (lr + 64) * 72 + lc) = rb1;
        }
        __syncthreads();
    }
#pragma unroll
    for (int mt = 0; mt < 4; ++mt) epi(row0 + wm * 64 + mt * 16 + l15, col0 + wn * 32 + quad * 4, acc[mt][0], acc[mt][1]);
}

template <class Epi>
DI void gemm_all(const GemmOp& g, int M, int N, const Epi& epi, char* smem) {
    const int ntn = N >> 7, nt = (M >> 7) * ntn;
    for (int t = blockIdx.x; t < nt; t += gridDim.x) gemm_tile(g, (t / ntn) * 128, (t % ntn) * 128, epi, smem);
}

DI void st_bf16x4(bf16_t* p, f32x4 a) { u32x2 v; v.x = pk2(a[0], a[1]); v.y = pk2(a[2], a[3]); *(u32x2*)p = v; }
struct EpiBf16 { bf16_t* O; long ldo;
    DI void operator()(int row, int col, f32x4 a0, f32x4 a1) const { bf16_t* p = O + (long)row * ldo + col; st_bf16x4(p, a0); st_bf16x4(p + 16, a1); } };
struct EpiF32 { float* O; long ldo;
    DI void operator()(int row, int col, f32x4 a0, f32x4 a1) const { float* p = O + (long)row * ldo + col; *(f32x4*)p = a0; *(f32x4*)(p + 16) = a1; } };
struct EpiResidual { float* X; const float* gate;
    DI void operator()(int row, int col, f32x4 a0, f32x4 a1) const {
        const float* gp = gate + (long)modrow_of(row) * 6144 + col; float* xp = X + (long)row * 1024 + col;
        f32x4 g0 = *(const f32x4*)gp, g1 = *(const f32x4*)(gp + 16), x0 = *(const f32x4*)xp, x1 = *(const f32x4*)(xp + 16);
        *(f32x4*)xp = x0 + g0 * a0; *(f32x4*)(xp + 16) = x1 + g1 * a1; } };
struct EpiResidualCtx { float* Xout; const float* Xin; const float* gate;
    DI void operator()(int row, int col, f32x4 a0, f32x4 a1) const {
        const float* gp = gate + col; const float* ip = Xin + (long)row * 1024 + col; float* xp = Xout + (long)row * 1024 + col;
        const f32x4 g0 = *(const f32x4*)gp, g1 = *(const f32x4*)(gp + 16), x0 = *(const f32x4*)ip, x1 = *(const f32x4*)(ip + 16);
        *(f32x4*)xp = x0 + g0 * a0; *(f32x4*)(xp + 16) = x1 + g1 * a1; } };
struct EpiSwiglu { bf16_t* O;
    DI void operator()(int row, int col, f32x4 a0, f32x4 a1) const {
        const int f = ((col >> 7) << 6) + (((col & 127) >> 5) << 4) + (col & 15);
        f32x4 h;
#pragma unroll
        for (int i = 0; i < 4; ++i) h[i] = a0[i] * fsigmoid(a0[i]) * a1[i];
        st_bf16x4(O + (long)row * 1024 + f, h); } };
struct EpiGate { bf16_t* O; const float* gate;
    DI void operator()(int row, int col, f32x4 a0, f32x4 a1) const { const float gt = gate[row]; bf16_t* p = O + (long)row * 1024 + col; st_bf16x4(p, a0 * gt); st_bf16x4(p + 16, a1 * gt); } };


DI float quad_max(float v) {
    auto a = __builtin_amdgcn_permlane16_swap(__float_as_uint(v), __float_as_uint(v), false, false); v = fmaxf(__uint_as_float(a[0]), __uint_as_float(a[1]));
    auto b = __builtin_amdgcn_permlane32_swap(__float_as_uint(v), __float_as_uint(v), false, false); return fmaxf(__uint_as_float(b[0]), __uint_as_float(b[1]));
}
DI float quad_sum(float v) {
    auto a = __builtin_amdgcn_permlane16_swap(__float_as_uint(v), __float_as_uint(v), false, false); v = __uint_as_float(a[0]) + __uint_as_float(a[1]);
    auto b = __builtin_amdgcn_permlane32_swap(__float_as_uint(v), __float_as_uint(v), false, false); return __uint_as_float(b[0]) + __uint_as_float(b[1]);
}

namespace pg8 {
#define PG8_LAS __attribute__((address_space(3)))
typedef unsigned short bf16_t;
typedef short bf16x8 __attribute__((ext_vector_type(8)));
typedef float f32x4 __attribute__((ext_vector_type(4)));
typedef unsigned u32x4 __attribute__((ext_vector_type(4)));
constexpr int BM = 256, BK = 64, HALF = 128, HTB = HALF * BK * 2  , STAGE_BYTES = 8 * HTB, NXCD = 8, WGM = 8;

__host__ __device__ __forceinline__ int lds_byte(int r, int c) { const int st = (r >> 4) * 2 + (c >> 5), rr = r & 15, cc = c & 31, ob = rr * 64 + cc * 2; return st * 1024 + (ob ^ (((ob >> 9) & 1) << 5)); }
__host__ __device__ __forceinline__ void stage_rc(int b, int& R, int& C) { const int st = b / 1024, sb = b % 1024, swz = sb ^ (((sb >> 9) & 1) << 5); R = (st >> 1) * 16 + swz / 64; C = (st & 1) * 32 + (swz % 64) / 2; }
__host__ __device__ __forceinline__ int perm32(int rho) { const int n = rho >> 4, i = rho & 15; return 8 * (i >> 2) + 4 * n + (i & 3); }

struct Unit { int pm, pn; };
struct Gemm { const bf16_t* A; const bf16_t* Bt; int M, N, K; };

struct StaticOrder {
    int nM, nN, nwg, G, c;
    __host__ __device__ void init(int M, int N, int G_, int c_) { nM = M / BM; nN = N / BM; nwg = nM * nN; G = G_; c = c_; }
    __host__ __device__ bool next(int i, Unit& u) const {
        const long L = (long)i * G + c; if (L >= nwg) return false;
        int wgid = (int)L; { const int q = nwg / NXCD, r = nwg % NXCD, xcd = wgid % NXCD, off = wgid / NXCD; wgid = (xcd < r ? xcd * (q + 1) : r * (q + 1) + (xcd - r) * q) + off; }
        const int nig = WGM * nN, gid = wgid / nig, fm = gid * WGM, gsz = (nM - fm) < WGM ? (nM - fm) : WGM;
        u.pm = fm + ((wgid % nig) % gsz); u.pn = (wgid % nig) / gsz; return true;
    }
    __device__ __forceinline__ void a_ready(const Unit&) const {}
    __device__ __forceinline__ void done(const Unit&) const {}
};
__device__ __forceinline__ unsigned cvt_pk_bf16(float lo, float hi) { return ::pk2(lo, hi); }
__device__ __forceinline__ u32x4 pk8(f32x4 v0, f32x4 v1) { u32x4 w; w.x = cvt_pk_bf16(v0[0], v0[1]); w.y = cvt_pk_bf16(v0[2], v0[3]); w.z = cvt_pk_bf16(v1[0], v1[1]); w.w = cvt_pk_bf16(v1[2], v1[3]); return w; }
struct PEpiBf16 {
    static constexpr bool PERM = true, AFTER_DRAIN = false;
    bf16_t* O; long ldo;
    __device__ __forceinline__ void operator()(const f32x4 (&acc)[2][2][4][2], const Unit& u, int wr, int wc, int fr, int fq) const {
        const int row0 = u.pm * BM + wr * 64 + fr, col0 = u.pn * BM + wc * 32 + 8 * fq;
#pragma unroll
        for (int ai = 0; ai < 2; ++ai)
#pragma unroll
            for (int m = 0; m < 4; ++m) { bf16_t* rowp = O + (long)(row0 + ai * HALF + m * 16) * ldo + col0;
#pragma unroll
                for (int bj = 0; bj < 2; ++bj) *(u32x4*)(rowp + bj * HALF) = pk8(acc[ai][bj][m][0], acc[ai][bj][m][1]); }
    }
};
struct PEpiF32 {
    static constexpr bool PERM = false, AFTER_DRAIN = false;
    float* C; long ldc;
    __device__ __forceinline__ void operator()(const f32x4 (&acc)[2][2][4][2], const Unit& u, int wr, int wc, int fr, int fq) const {
        const int row0 = u.pm * BM + wr * 64 + fr, col0 = u.pn * BM + wc * 32 + 4 * fq;
#pragma unroll
        for (int ai = 0; ai < 2; ++ai)
#pragma unroll
            for (int m = 0; m < 4; ++m) { float* rowp = C + (long)(row0 + ai * HALF + m * 16) * ldc + col0;
#pragma unroll
                for (int bj = 0; bj < 2; ++bj)
#pragma unroll
                    for (int n = 0; n < 2; ++n) *(f32x4*)(rowp + bj * HALF + n * 16) = acc[ai][bj][m][n]; }
    }
};
struct PEpiResidual {
    static constexpr bool PERM = false, AFTER_DRAIN = false;
    float* X; const float* gate; const float* Xl; const float* Xc;
    __device__ __forceinline__ void operator()(const f32x4 (&acc)[2][2][4][2], const Unit& u, int wr, int wc, int fr, int fq) const {
        const int row0 = u.pm * BM + wr * 64 + fr, col0 = u.pn * BM + wc * 32 + 4 * fq;
        const float* gp = gate + (long)((row0 < 32768) ? (row0 >> 12) : 8) * 6144 + col0;
        f32x4 gv[2][2];
#pragma unroll
        for (int bj = 0; bj < 2; ++bj)
#pragma unroll
            for (int n = 0; n < 2; ++n) gv[bj][n] = *(const f32x4*)(gp + bj * HALF + n * 16);
#pragma unroll
        for (int ai = 0; ai < 2; ++ai)
#pragma unroll
            for (int m = 0; m < 4; ++m) { const long row = row0 + ai * HALF + m * 16; float* rowp = X + row * 1024 + col0;
                const float* inp = ((row0 < 32768) ? (Xl + row * 1024) : (Xc + (row - 32768) * 1024)) + col0;
#pragma unroll
                for (int bj = 0; bj < 2; ++bj)
#pragma unroll
                    for (int n = 0; n < 2; ++n) { const f32x4 x = *(const f32x4*)(inp + bj * HALF + n * 16); *(f32x4*)(rowp + bj * HALF + n * 16) = x + gv[bj][n] * acc[ai][bj][m][n]; }
                asm volatile("" ::: "memory"); }
    }
};
struct PEpiSwiglu {
    static constexpr bool PERM = true, AFTER_DRAIN = false;
    bf16_t* O;
    __device__ __forceinline__ void operator()(const f32x4 (&acc)[2][2][4][2], const Unit& u, int wr, int wc, int fr, int fq) const {
        const int row0 = u.pm * BM + wr * 64 + fr, f0 = (u.pn & 7) * HALF + wc * 32 + 8 * fq;
#pragma unroll
        for (int ai = 0; ai < 2; ++ai)
#pragma unroll
            for (int m = 0; m < 4; ++m) {
                f32x4 h0, h1;
#pragma unroll
                for (int i = 0; i < 4; ++i) { const float a = acc[ai][0][m][0][i], b = acc[ai][0][m][1][i];
                    h0[i] = a * __builtin_amdgcn_rcpf(1.0f + __expf(-a)) * acc[ai][1][m][0][i]; h1[i] = b * __builtin_amdgcn_rcpf(1.0f + __expf(-b)) * acc[ai][1][m][1][i]; }
                *(u32x4*)(O + (long)(row0 + ai * HALF + m * 16) * 1024 + f0) = pk8(h0, h1); }
    }
};
struct PEpiGate {
    static constexpr bool PERM = true, AFTER_DRAIN = false;
    bf16_t* O; const float* gate;
    __device__ __forceinline__ void operator()(const f32x4 (&acc)[2][2][4][2], const Unit& u, int wr, int wc, int fr, int fq) const {
        const int row0 = u.pm * BM + wr * 64 + fr, col0 = (u.pn & 3) * BM + wc * 32 + 8 * fq;
#pragma unroll
        for (int ai = 0; ai < 2; ++ai)
#pragma unroll
            for (int m = 0; m < 4; ++m) { const int row = row0 + ai * HALF + m * 16; const float gt = gate[row]; bf16_t* rowp = O + (long)row * 1024 + col0;
#pragma unroll
                for (int bj = 0; bj < 2; ++bj) *(u32x4*)(rowp + bj * HALF) = pk8(acc[ai][bj][m][0] * gt, acc[ai][bj][m][1] * gt); }
    }
};
struct PEpiQKNorm {
    static constexpr bool PERM = true, AFTER_DRAIN = false;
    bf16_t* O; long ldo; int nq, nk; const float* qg; const float* kg; const float* rope;
    __device__ __forceinline__ void operator()(const f32x4 (&acc)[2][2][4][2], const Unit& u, int wr, int wc, int fr, int fq) const {
        const int row0 = u.pm * BM + wr * 64 + fr, cb = u.pn * BM + 64 * wc + 8 * fq;
        const int kind = (u.pn < nq) ? 0 : ((u.pn < nk) ? 1 : 2);
        f32x4 gn[2][2];
        if (kind < 2) { const float* g = kind ? kg : qg;
#pragma unroll
            for (int bj = 0; bj < 2; ++bj)
#pragma unroll
                for (int n = 0; n < 2; ++n) gn[bj][n] = *(const f32x4*)(g + 32 * bj + 8 * fq + 4 * n); }
#pragma unroll
        for (int ai = 0; ai < 2; ++ai)
#pragma unroll
            for (int m = 0; m < 4; ++m) {
                const int row = row0 + ai * HALF + m * 16;
                f32x4 x[2][2];
#pragma unroll
                for (int bj = 0; bj < 2; ++bj)
#pragma unroll
                    for (int n = 0; n < 2; ++n) x[bj][n] = acc[ai][bj][m][n];
                if (kind < 2) {
                    float ss = 0.f;
#pragma unroll
                    for (int bj = 0; bj < 2; ++bj)
#pragma unroll
                        for (int n = 0; n < 2; ++n) ss += (x[bj][n][0] * x[bj][n][0] + x[bj][n][1] * x[bj][n][1]) + (x[bj][n][2] * x[bj][n][2] + x[bj][n][3] * x[bj][n][3]);
                    ss = ::quad_sum(ss);
                    const float r = rsqrtf(ss * (1.0f / 64.0f) + 1e-6f);
#pragma unroll
                    for (int bj = 0; bj < 2; ++bj)
#pragma unroll
                        for (int n = 0; n < 2; ++n) x[bj][n] = x[bj][n] * r * gn[bj][n];
                    if (rope != nullptr && row < 32768) {
                        const float* cs = rope + (long)(row & 4095) * 32 + 8 * fq; const float* sn = cs + 4096 * 32;
#pragma unroll
                        for (int n = 0; n < 2; ++n) { const f32x4 c = *(const f32x4*)(cs + 4 * n), sv = *(const f32x4*)(sn + 4 * n);
                            const f32x4 a = x[0][n], b = x[1][n]; x[0][n] = a * c - b * sv; x[1][n] = b * c + a * sv; }
                    }
                }
                bf16_t* rowp = O + (long)row * ldo + cb;
#pragma unroll
                for (int bj = 0; bj < 2; ++bj) *(u32x4*)(rowp + 32 * bj) = pk8(x[bj][0], x[bj][1]);
            }
    }
};
struct PEpiRW1 {
    static constexpr bool PERM = true, AFTER_DRAIN = false;
    bf16_t* RKV; bf16_t* LORA;
    __device__ __forceinline__ void operator()(const f32x4 (&acc)[2][2][4][2], const Unit& u, int wr, int wc, int fr, int fq) const {
        const int row0 = u.pm * BM + wr * 64 + fr, cw = wc * 32 + 8 * fq;
#pragma unroll
        for (int ai = 0; ai < 2; ++ai)
#pragma unroll
            for (int m = 0; m < 4; ++m) { const long row = row0 + ai * HALF + m * 16;
#pragma unroll
                for (int bj = 0; bj < 2; ++bj) {
                    f32x4 v0 = acc[ai][bj][m][0], v1 = acc[ai][bj][m][1];
                    if (u.pn < 12) *(u32x4*)(RKV + row * 3072 + u.pn * BM + bj * HALF + cw) = pk8(v0, v1);
                    else {
                        const int cls = (u.pn - 12) * 2 + bj;
                        if (cls == 0) {
#pragma unroll
                            for (int i = 0; i < 4; ++i) { v0[i] = __builtin_amdgcn_rcpf(1.0f + __expf(-v0[i])); v1[i] = __builtin_amdgcn_rcpf(1.0f + __expf(-v1[i])); } }
                        if (cls == 1) {
#pragma unroll
                            for (int i = 0; i < 4; ++i) { v0[i] = 2.0f * __builtin_amdgcn_rcpf(1.0f + __expf(-2.0f * v0[i])) - 1.0f; v1[i] = 2.0f * __builtin_amdgcn_rcpf(1.0f + __expf(-2.0f * v1[i])) - 1.0f; } }
                        if (cls < 3) *(u32x4*)(LORA + row * 384 + cls * HALF + cw) = pk8(v0, v1);
                    } } }
    }
};
struct GroupedOrder {
    int P, NT, G, c;
    __device__ __forceinline__ bool next(int i, Unit& u) const {
        const int per = P * NT;
        if (G == 256) {
            const int x = c & 7, Lx = i * 32 + (c >> 3); if (Lx >= 2 * per) return false;
            const int e = 2 * x + Lx / per, rem = Lx % per, nig = 8 * NT, gid = rem / nig, fm = gid * 8, gsz = (P - fm) < 8 ? (P - fm) : 8, ri = rem % nig;
            u.pm = e * 17 + fm + (ri % gsz); u.pn = e * NT + (ri / gsz); return true;
        }
        const long L = (long)i * G + c; if (L >= (long)16 * per) return false;
        const int e = (int)(L / per), r = (int)(L % per); u.pm = e * 17 + (r % P); u.pn = e * NT + (r / P); return true; }
    __device__ __forceinline__ void a_ready(const Unit&) const {}
    __device__ __forceinline__ void done(const Unit&) const {}
};

template <class Epi, class Sched, bool STAMP = false>
__device__ __forceinline__ void gemm_phase(PG8_LAS unsigned char* lds, const Gemm g, const Sched& S, const Epi& E, unsigned long long* stamps) {
    const int tid = TIDX(), wid = __builtin_amdgcn_readfirstlane(tid >> 6), lane = tid & 63, wr = wid >> 2, wc = wid & 3, fr = lane & 15, fq = lane >> 4;
    const int K = g.K, nt = K / BK;
    int ts_lo = 0, ts_hi = 0, nts = 0; const unsigned long long rt_entry = STAMP ? (unsigned long long)wall_clock64() : 0ull;
#define PG8_STAMP() do { if (STAMP && wid == 0 && nts < 64) { const unsigned long long _c = (unsigned long long)clock64(); \
        ts_lo = (lane == nts) ? (int)(unsigned)_c : ts_lo; ts_hi = (lane == nts) ? (int)(unsigned)(_c >> 32) : ts_hi; ++nts; } } while (0)
    PG8_STAMP();
    unsigned voffA[2], voffB[2];
#pragma unroll
    for (int i = 0; i < 2; ++i) { int R, C; stage_rc(tid * 16 + i * 8192, R, C); const int Rb = Epi::PERM ? ((R & ~31) + perm32(R & 31)) : R;
        voffA[i] = (unsigned)(R * K + C) * 2u; voffB[i] = (unsigned)(Rb * K + C) * 2u; }
    const size_t kstep = (size_t)(BK * 2);
    const size_t hstep = (size_t)HALF * K * 2;
    const size_t tstep = 2 * hstep;
    const unsigned ldsw = (unsigned)wid * 1024u;
    const int aoff = lds_byte(wr * 64 + fr, fq * 8), boff = lds_byte(wc * 32 + fr, fq * 8);
#define PG8_SA(b, h) (((b) * 2 + (h)) * HTB)
#define PG8_SB(b, h) ((4 + (b) * 2 + (h)) * HTB)
#define PG8_STAGE(bufoff, gbase, voff) do { _Pragma("unroll") for (int _i = 0; _i < 2; ++_i) \
        __builtin_amdgcn_global_load_lds((const unsigned*)((const char*)(gbase) + (voff)[_i]), (PG8_LAS unsigned*)(lds + (bufoff) + ldsw + _i * 8192), 16, 0, 0); } while (0)
#define PG8_LDA(dst, b, h) do { _Pragma("unroll") for (int m = 0; m < 4; ++m) _Pragma("unroll") for (int k = 0; k < 2; ++k) dst[m][k] = *(const PG8_LAS bf16x8*)(lds + PG8_SA(b, h) + aoff + m * 2048 + k * 1024); } while (0)
#define PG8_LDB(dst, b, h) do { _Pragma("unroll") for (int n = 0; n < 2; ++n) _Pragma("unroll") for (int k = 0; k < 2; ++k) dst[n][k] = *(const PG8_LAS bf16x8*)(lds + PG8_SB(b, h) + boff + n * 2048 + k * 1024); } while (0)
#define PG8_MMA(ai, bj, At, Bt) do { __builtin_amdgcn_s_setprio(1); _Pragma("unroll") for (int m = 0; m < 4; ++m) _Pragma("unroll") for (int n = 0; n < 2; ++n) _Pragma("unroll") for (int k = 0; k < 2; ++k) \
        acc[ai][bj][m][n] = __builtin_amdgcn_mfma_f32_16x16x32_bf16(Bt[n][k], At[m][k], acc[ai][bj][m][n], 0, 0, 0); __builtin_amdgcn_s_setprio(0); } while (0)
#define PG8_WAIT_V(n) asm volatile("s_waitcnt vmcnt(" #n ")" ::: "memory")
#define PG8_WAIT_L(n) asm volatile("s_waitcnt lgkmcnt(" #n ")" ::: "memory")
#define PG8_BAR __builtin_amdgcn_s_barrier()
#define PG8_SCHED __builtin_amdgcn_sched_barrier(0)
    Unit cur, nxt; int ui = 0;
    if (!S.next(0, cur)) return;
    f32x4 acc[2][2][4][2];
#pragma unroll
    for (int a = 0; a < 2; ++a)
#pragma unroll
        for (int b = 0; b < 2; ++b)
#pragma unroll
            for (int m = 0; m < 4; ++m)
#pragma unroll
                for (int n = 0; n < 2; ++n) acc[a][b][m][n] = (f32x4){0.f, 0.f, 0.f, 0.f};
    bf16x8 At[4][2], B0[2][2], B1[2][2];
    const char* cA = (const char*)g.A + (size_t)cur.pm * tstep; const char* cB = (const char*)g.Bt + (size_t)cur.pn * tstep;
    S.a_ready(cur);
    PG8_STAGE(PG8_SB(0, 0), cB, voffB); PG8_STAGE(PG8_SA(0, 0), cA, voffA); PG8_STAGE(PG8_SB(0, 1), cB + hstep, voffB); PG8_STAGE(PG8_SA(0, 1), cA + hstep, voffA);
    if (wr == 1) PG8_BAR;
    PG8_WAIT_V(4); PG8_BAR;
    PG8_STAGE(PG8_SB(1, 0), cB + kstep, voffB); PG8_STAGE(PG8_SA(1, 0), cA + kstep, voffA); PG8_STAGE(PG8_SB(1, 1), cB + hstep + kstep, voffB);
    PG8_WAIT_V(6); PG8_BAR;
    PG8_STAMP();
    for (;;) {
        const bool has_next = S.next(ui + 1, nxt);
        const char* nA = has_next ? (const char*)g.A + (size_t)nxt.pm * tstep : cA; const char* nB = has_next ? (const char*)g.Bt + (size_t)nxt.pn * tstep : cB;
        for (int t = 0; t < nt; t += 2) {
            const bool last = (t == nt - 2);
            const char* a1 = cA + (size_t)(t + 1) * kstep;
            const char* a2 = last ? nA : cA + (size_t)(t + 2) * kstep; const char* b2 = last ? nB : cB + (size_t)(t + 2) * kstep;
            const char* a3 = a2 + kstep; const char* b3 = b2 + kstep;
            if (last && has_next) S.a_ready(nxt);
            PG8_LDB(B0, 0, 0); PG8_SCHED; PG8_LDA(At, 0, 0); PG8_STAGE(PG8_SA(1, 1), a1 + hstep, voffA);
            PG8_WAIT_L(8); PG8_BAR; PG8_WAIT_L(0); PG8_MMA(0, 0, At, B0); PG8_BAR; PG8_SCHED;
            PG8_LDB(B1, 0, 1); PG8_STAGE(PG8_SB(0, 0), b2, voffB);
            PG8_BAR; PG8_WAIT_L(0); PG8_MMA(0, 1, At, B1); PG8_BAR;
            PG8_LDA(At, 0, 1); PG8_STAGE(PG8_SA(0, 0), a2, voffA);
            PG8_BAR; PG8_WAIT_L(0); PG8_MMA(1, 0, At, B0); PG8_BAR; PG8_SCHED;
            PG8_STAGE(PG8_SB(0, 1), b2 + hstep, voffB);
            PG8_WAIT_V(6); PG8_BAR; PG8_MMA(1, 1, At, B1); PG8_BAR;
            PG8_LDB(B0, 1, 0); PG8_SCHED; PG8_LDA(At, 1, 0); PG8_STAGE(PG8_SA(0, 1), a2 + hstep, voffA);
            PG8_WAIT_L(8); PG8_BAR; PG8_WAIT_L(0); PG8_MMA(0, 0, At, B0); PG8_BAR; PG8_SCHED;
            PG8_LDB(B1, 1, 1); PG8_STAGE(PG8_SB(1, 0), b3, voffB);
            PG8_BAR; PG8_WAIT_L(0); PG8_MMA(0, 1, At, B1); PG8_BAR;
            PG8_LDA(At, 1, 1); PG8_STAGE(PG8_SA(1, 0), a3, voffA);
            PG8_BAR; PG8_WAIT_L(0); PG8_MMA(1, 0, At, B0); PG8_BAR; PG8_SCHED;
            PG8_STAGE(PG8_SB(1, 1), b3 + hstep, voffB);
            PG8_WAIT_V(6); PG8_BAR; PG8_MMA(1, 1, At, B1); PG8_BAR;
        }
        PG8_STAMP();
        if constexpr (!Epi::AFTER_DRAIN) { E(acc, cur, wr, wc, fr, fq); S.done(cur); }
        PG8_STAMP();
        if (!has_next) break;
#pragma unroll
        for (int a = 0; a < 2; ++a)
#pragma unroll
            for (int b = 0; b < 2; ++b)
#pragma unroll
                for (int m = 0; m < 4; ++m)
#pragma unroll
                    for (int n = 0; n < 2; ++n) acc[a][b][m][n] = (f32x4){0.f, 0.f, 0.f, 0.f};
        cur = nxt; cA = nA; cB = nB; ++ui;
    }
    PG8_WAIT_V(0);
    if (wr == 0) PG8_BAR;
    PG8_BAR;
    if constexpr (Epi::AFTER_DRAIN) { E.fused(acc, cur, wr, wc, fr, fq, lds, wid, lane); S.done(cur); }
    PG8_STAMP();
    if (STAMP && wid == 0) { stamps[lane] = lane < nts ? (((unsigned long long)(unsigned)ts_hi << 32) | (unsigned)ts_lo) : 0ull;
        if (lane == 62) stamps[62] = rt_entry; if (lane == 63) stamps[63] = (unsigned long long)wall_clock64(); }
#undef PG8_STAMP
#undef PG8_SA
#undef PG8_SB
#undef PG8_STAGE
#undef PG8_LDA
#undef PG8_LDB
#undef PG8_MMA
#undef PG8_WAIT_V
#undef PG8_WAIT_L
#undef PG8_BAR
#undef PG8_SCHED
}
template <class Epi, class Sched>
__device__ __forceinline__ void gemm_phase_gather(PG8_LAS unsigned char* lds, const Gemm g, const Sched& S, const Epi& E, const int* idx) {
    constexpr bool STAMP = false; unsigned long long* stamps = nullptr;
    const int tid = TIDX(), wid = __builtin_amdgcn_readfirstlane(tid >> 6), lane = tid & 63, wr = wid >> 2, wc = wid & 3, fr = lane & 15, fq = lane >> 4;
    const int K = g.K, nt = K / BK;
    int ts_lo = 0, ts_hi = 0, nts = 0; const unsigned long long rt_entry = STAMP ? (unsigned long long)wall_clock64() : 0ull;
#define PG8_STAMP() do { if (STAMP && wid == 0 && nts < 64) { const unsigned long long _c = (unsigned long long)clock64(); \
        ts_lo = (lane == nts) ? (int)(unsigned)_c : ts_lo; ts_hi = (lane == nts) ? (int)(unsigned)(_c >> 32) : ts_hi; ++nts; } } while (0)
    PG8_STAMP();
    unsigned voffB[2]; int rowA[2]; unsigned colA[2];
#pragma unroll
    for (int i = 0; i < 2; ++i) { int R, C; stage_rc(tid * 16 + i * 8192, R, C); const int Rb = Epi::PERM ? ((R & ~31) + perm32(R & 31)) : R;
        rowA[i] = R; colA[i] = (unsigned)C * 2u; voffB[i] = (unsigned)(Rb * K + C) * 2u; }
    unsigned vc0[2], vc1[2], vn0[2], vn1[2];
#define PG8_GIDX(u, o0, o1) do { const int* ip = idx + (long)(u).pm * BM; const int g00 = ip[rowA[0]], g01 = ip[rowA[1]], g10 = ip[HALF + rowA[0]], g11 = ip[HALF + rowA[1]]; \
        asm volatile("s_waitcnt vmcnt(0)" ::: "memory"); \
        o0[0] = (unsigned)g00 * (unsigned)(K * 2) + colA[0]; o0[1] = (unsigned)g01 * (unsigned)(K * 2) + colA[1]; o1[0] = (unsigned)g10 * (unsigned)(K * 2) + colA[0]; o1[1] = (unsigned)g11 * (unsigned)(K * 2) + colA[1]; } while (0)
    const size_t kstep = (size_t)(BK * 2);
    const size_t hstep = (size_t)HALF * K * 2;
    const size_t tstep = 2 * hstep;
    const unsigned ldsw = (unsigned)wid * 1024u;
    const int aoff = lds_byte(wr * 64 + fr, fq * 8), boff = lds_byte(wc * 32 + fr, fq * 8);
#define PG8_SA(b, h) (((b) * 2 + (h)) * HTB)
#define PG8_SB(b, h) ((4 + (b) * 2 + (h)) * HTB)
#define PG8_STAGE(bufoff, gbase, voff) do { _Pragma("unroll") for (int _i = 0; _i < 2; ++_i) \
        __builtin_amdgcn_global_load_lds((const unsigned*)((const char*)(gbase) + (voff)[_i]), (PG8_LAS unsigned*)(lds + (bufoff) + ldsw + _i * 8192), 16, 0, 0); } while (0)
#define PG8_LDA(dst, b, h) do { _Pragma("unroll") for (int m = 0; m < 4; ++m) _Pragma("unroll") for (int k = 0; k < 2; ++k) dst[m][k] = *(const PG8_LAS bf16x8*)(lds + PG8_SA(b, h) + aoff + m * 2048 + k * 1024); } while (0)
#define PG8_LDB(dst, b, h) do { _Pragma("unroll") for (int n = 0; n < 2; ++n) _Pragma("unroll") for (int k = 0; k < 2; ++k) dst[n][k] = *(const PG8_LAS bf16x8*)(lds + PG8_SB(b, h) + boff + n * 2048 + k * 1024); } while (0)
#define PG8_MMA(ai, bj, At, Bt) do { __builtin_amdgcn_s_setprio(1); _Pragma("unroll") for (int m = 0; m < 4; ++m) _Pragma("unroll") for (int n = 0; n < 2; ++n) _Pragma("unroll") for (int k = 0; k < 2; ++k) \
        acc[ai][bj][m][n] = __builtin_amdgcn_mfma_f32_16x16x32_bf16(Bt[n][k], At[m][k], acc[ai][bj][m][n], 0, 0, 0); __builtin_amdgcn_s_setprio(0); } while (0)
#define PG8_WAIT_V(n) asm volatile("s_waitcnt vmcnt(" #n ")" ::: "memory")
#define PG8_WAIT_L(n) asm volatile("s_waitcnt lgkmcnt(" #n ")" ::: "memory")
#define PG8_BAR __builtin_amdgcn_s_barrier()
#define PG8_SCHED __builtin_amdgcn_sched_barrier(0)
    Unit cur, nxt; int ui = 0;
    if (!S.next(0, cur)) return;
    f32x4 acc[2][2][4][2];
#pragma unroll
    for (int a = 0; a < 2; ++a)
#pragma unroll
        for (int b = 0; b < 2; ++b)
#pragma unroll
            for (int m = 0; m < 4; ++m)
#pragma unroll
                for (int n = 0; n < 2; ++n) acc[a][b][m][n] = (f32x4){0.f, 0.f, 0.f, 0.f};
    bf16x8 At[4][2], B0[2][2], B1[2][2];
    const char* AB = (const char*)g.A; const char* cB = (const char*)g.Bt + (size_t)cur.pn * tstep;
    S.a_ready(cur);
    PG8_GIDX(cur, vc0, vc1);
    PG8_STAGE(PG8_SB(0, 0), cB, voffB); PG8_STAGE(PG8_SA(0, 0), AB, vc0); PG8_STAGE(PG8_SB(0, 1), cB + hstep, voffB); PG8_STAGE(PG8_SA(0, 1), AB, vc1);
    if (wr == 1) PG8_BAR;
    PG8_WAIT_V(4); PG8_BAR;
    PG8_STAGE(PG8_SB(1, 0), cB + kstep, voffB); PG8_STAGE(PG8_SA(1, 0), AB + kstep, vc0); PG8_STAGE(PG8_SB(1, 1), cB + hstep + kstep, voffB);
    PG8_WAIT_V(6); PG8_BAR;
    PG8_STAMP();
    for (;;) {
        const bool has_next = S.next(ui + 1, nxt);
        const char* nB = has_next ? (const char*)g.Bt + (size_t)nxt.pn * tstep : cB;
        for (int t = 0; t < nt; t += 2) {
            const bool last = (t == nt - 2);
            const char* a1 = AB + (size_t)(t + 1) * kstep;
            const char* b2 = last ? nB : cB + (size_t)(t + 2) * kstep;
            const char* b3 = b2 + kstep;
            if (last) { if (has_next) { S.a_ready(nxt); PG8_GIDX(nxt, vn0, vn1); } else { vn0[0] = vc0[0]; vn0[1] = vc0[1]; vn1[0] = vc1[0]; vn1[1] = vc1[1]; } }
            const char* a2 = last ? AB : AB + (size_t)(t + 2) * kstep; const char* a3 = a2 + kstep;
            unsigned w0[2], w1[2];
            w0[0] = last ? vn0[0] : vc0[0]; w0[1] = last ? vn0[1] : vc0[1]; w1[0] = last ? vn1[0] : vc1[0]; w1[1] = last ? vn1[1] : vc1[1];
            PG8_LDB(B0, 0, 0); PG8_SCHED; PG8_LDA(At, 0, 0); PG8_STAGE(PG8_SA(1, 1), a1, vc1);
            PG8_WAIT_L(8); PG8_BAR; PG8_WAIT_L(0); PG8_MMA(0, 0, At, B0); PG8_BAR; PG8_SCHED;
            PG8_LDB(B1, 0, 1); PG8_STAGE(PG8_SB(0, 0), b2, voffB);
            PG8_BAR; PG8_WAIT_L(0); PG8_MMA(0, 1, At, B1); PG8_BAR;
            PG8_LDA(At, 0, 1); PG8_STAGE(PG8_SA(0, 0), a2, w0);
            PG8_BAR; PG8_WAIT_L(0); PG8_MMA(1, 0, At, B0); PG8_BAR; PG8_SCHED;
            PG8_STAGE(PG8_SB(0, 1), b2 + hstep, voffB);
            PG8_WAIT_V(6); PG8_BAR; PG8_MMA(1, 1, At, B1); PG8_BAR;
            PG8_LDB(B0, 1, 0); PG8_SCHED; PG8_LDA(At, 1, 0); PG8_STAGE(PG8_SA(0, 1), a2, w1);
            PG8_WAIT_L(8); PG8_BAR; PG8_WAIT_L(0); PG8_MMA(0, 0, At, B0); PG8_BAR; PG8_SCHED;
            PG8_LDB(B1, 1, 1); PG8_STAGE(PG8_SB(1, 0), b3, voffB);
            PG8_BAR; PG8_WAIT_L(0); PG8_MMA(0, 1, At, B1); PG8_BAR;
            PG8_LDA(At, 1, 1); PG8_STAGE(PG8_SA(1, 0), a3, w0);
            PG8_BAR; PG8_WAIT_L(0); PG8_MMA(1, 0, At, B0); PG8_BAR; PG8_SCHED;
            PG8_STAGE(PG8_SB(1, 1), b3 + hstep, voffB);
            PG8_WAIT_V(6); PG8_BAR; PG8_MMA(1, 1, At, B1); PG8_BAR;
        }
        PG8_STAMP();
        if constexpr (!Epi::AFTER_DRAIN) { E(acc, cur, wr, wc, fr, fq); S.done(cur); }
        PG8_STAMP();
        if (!has_next) break;
#pragma unroll
        for (int a = 0; a < 2; ++a)
#pragma unroll
            for (int b = 0; b < 2; ++b)
#pragma unroll
                for (int m = 0; m < 4; ++m)
#pragma unroll
                    for (int n = 0; n < 2; ++n) acc[a][b][m][n] = (f32x4){0.f, 0.f, 0.f, 0.f};
        cur = nxt; cB = nB; ++ui; vc0[0] = vn0[0]; vc0[1] = vn0[1]; vc1[0] = vn1[0]; vc1[1] = vn1[1];
    }
    PG8_WAIT_V(0);
    if (wr == 0) PG8_BAR;
    PG8_BAR;
    if constexpr (Epi::AFTER_DRAIN) { E.fused(acc, cur, wr, wc, fr, fq, lds, wid, lane); S.done(cur); }
    PG8_STAMP();
    if (STAMP && wid == 0) { stamps[lane] = lane < nts ? (((unsigned long long)(unsigned)ts_hi << 32) | (unsigned)ts_lo) : 0ull;
        if (lane == 62) stamps[62] = rt_entry; if (lane == 63) stamps[63] = (unsigned long long)wall_clock64(); }
#undef PG8_STAMP
#undef PG8_SA
#undef PG8_SB
#undef PG8_STAGE
#undef PG8_LDA
#undef PG8_LDB
#undef PG8_MMA
#undef PG8_WAIT_V
#undef PG8_WAIT_L
#undef PG8_BAR
#undef PG8_SCHED
#undef PG8_GIDX
}
}

constexpr int CONV_NPAR = 4;
template <int MODE>
DI void conv_tiles(const float* src, int K, int N, int Npad, bf16_t* dst, long ldd, int koff, int rowoff,
                   const float* mixv, float alpha, float beta, int& base, char* smem, int rank = -1, int G = 0) {
    float* t = (float*)smem;
    const int tid = TIDX();
    if (G == 0) { G = gridDim.x; rank = (int)blockIdx.x; }
    const int ntn = Npad >> 6, ntiles = (K >> 6) * ntn;
    int first = (rank - (base % G) + G) % G;
    base += ntiles;
    for (int ti0 = first; ti0 < ntiles; ti0 += CONV_NPAR * G) {
        f32x4 v0[CONV_NPAR], v1[CONV_NPAR]; float sc[CONV_NPAR];
        const int k = tid >> 3, n8 = (tid & 7) * 8;
#pragma unroll
        for (int q = 0; q < CONV_NPAR; ++q) {
            const int ti = ti0 + q * G;
            v0[q] = (f32x4){0.f, 0.f, 0.f, 0.f}; v1[q] = v0[q]; sc[q] = 1.0f;
            if (ti < ntiles) {
                const int k0 = (ti / ntn) << 6, n0 = (ti % ntn) << 6;
                sc[q] = mixv ? (alpha + beta * mixv[k0 + k]) : 1.0f;
                if (n0 + n8 < N) { const float* sp = src + (long)(k0 + k) * N + n0 + n8; v0[q] = *(const f32x4*)sp; v1[q] = *(const f32x4*)(sp + 4); }
            }
        }
#pragma unroll
        for (int q = 0; q < CONV_NPAR; ++q) {
            float* tp = t + q * (64 * 65) + k * 65 + n8;
            tp[0] = v0[q][0] * sc[q]; tp[1] = v0[q][1] * sc[q]; tp[2] = v0[q][2] * sc[q]; tp[3] = v0[q][3] * sc[q]; tp[4] = v1[q][0] * sc[q]; tp[5] = v1[q][1] * sc[q]; tp[6] = v1[q][2] * sc[q]; tp[7] = v1[q][3] * sc[q];
        }
        __syncthreads();
#pragma unroll
        for (int q = 0; q < CONV_NPAR; ++q) {
            const int ti = ti0 + q * G;
            if (ti < ntiles) {
                const int k0 = (ti / ntn) << 6, n0 = (ti % ntn) << 6;
                const int n = tid >> 3, kc = (tid & 7) * 8;
                float f[8];
#pragma unroll
                for (int j = 0; j < 8; ++j) f[j] = t[q * (64 * 65) + (kc + j) * 65 + n];
                const int nn = n0 + n;
                const int r = (MODE == 1) ? (128 * (nn >> 6) + 32 * ((nn >> 4) & 3) + (nn & 15)) : ((MODE == 2) ? (256 * (nn >> 7) + (nn & 127)) : ((MODE == 3) ? ((nn & ~255) + 128 * ((nn >> 5) & 1) + 32 * ((nn >> 6) & 3) + (nn & 31)) : nn));
                *(u32x4*)(dst + (long)(r + rowoff) * ldd + koff + k0 + kc) = pack8(f);
            }
        }
        __syncthreads();
    }
}
DI void zero_bf16(bf16_t* dst, long n8  ) {
    for (long i = (long)blockIdx.x * NTHR + TIDX(); i < n8; i += (long)gridDim.x * NTHR) *(u32x4*)(dst + i * 8) = (u32x4){0u, 0u, 0u, 0u};
}

struct Bufs {
    float* MOD; float* ROPE_M; float* ROPE_S; float* X; bf16_t* WMIX; bf16_t* W13; bf16_t* W2T; bf16_t* W2TB;
    DI bf16_t* w2t(int layer) const { return (layer & 1) ? W2TB : W2T; }
    float* AFF; float* AFFC; int* IDX; float* GATE; int* INV; unsigned char* WORK;
    DI bf16_t* slot(int i) const { return (bf16_t*)(WORK + (size_t)i * USLOT); }
};
DI Bufs make_bufs(const Params& p) {
    Bufs b; unsigned char* w = p.ws;
    b.MOD = (float*)(w + OFF_MOD); b.ROPE_M = (float*)(w + OFF_ROPE_M); b.ROPE_S = (float*)(w + OFF_ROPE_S); b.X = (float*)(w + OFF_X);
    b.WMIX = (bf16_t*)(w + OFF_WMIX); b.W13 = (bf16_t*)(w + OFF_WE); b.W2T = (bf16_t*)(w + OFF_WE + 64 * MiB); b.W2TB = (bf16_t*)(w + OFF_W2TB);
    b.AFF = (float*)(w + OFF_AFF); b.AFFC = (float*)(w + OFF_AFFC); b.IDX = (int*)(w + OFF_IDX); b.GATE = (float*)(w + OFF_GATE); b.INV = (int*)(w + OFF_INV);
    b.WORK = w + OFF_WORK; return b;
}

DI void conv_moe_layer(const Params& p, const Bufs& B, int layer, int& base, char* smem, int part = 0, int rank = -1, int G = 0) {
    for (int e = 0; e < NEXP; ++e) {
        const size_t wo = ((size_t)layer * NEXP + e) * 1024 * 1024;
        if (part != 2) {
            conv_tiles<USE_PG8 ? 2 : 1>(p.in[I_MOE_W1] + wo, 1024, 1024, 1024, B.W13 + (size_t)e * 2048 * 1024, 1024, 0, 0, nullptr, 0.f, 0.f, base, smem, rank, G);
            conv_tiles<USE_PG8 ? 2 : 1>(p.in[I_MOE_W3] + wo, 1024, 1024, 1024, B.W13 + (size_t)e * 2048 * 1024, 1024, 0, USE_PG8 ? 128 : 16, nullptr, 0.f, 0.f, base, smem, rank, G);
        }
        if (part != 1) conv_tiles<0>(p.in[I_MOE_W2] + wo, 1024, 1024, 1024, B.w2t(layer) + (size_t)e * 1024 * 1024, 1024, 0, 0, nullptr, 0.f, 0.f, base, smem, rank, G);
    }
}

DI void phase_prologue(const Params& p, const Bufs& B, char* smem) {
    const int tid = TIDX(), G = gridDim.x;
    {
        float* s = (float*)smem;
        float* red = s + 9 * 1024;
        for (int i = tid; i < 9 * 1024; i += NTHR) { const int r = i >> 10, k = i & 1023; const float x = (r < 8) ? p.in[I_C][r * 1024 + k] : p.in[I_CCTX][k]; s[i] = x * fsigmoid(x); }
        __syncthreads();
        for (int it = blockIdx.x; it < 4 * 96; it += G) {
            const int l = it / 96, cg = it % 96, cl = tid & 63, ks = tid >> 6, n = cg * 64 + cl;
            const float* wp = p.in[I_ADAW] + (size_t)l * 1024 * 6144 + (size_t)(ks * 128) * 6144 + n;
            float acc[9];
#pragma unroll
            for (int r = 0; r < 9; ++r) acc[r] = 0.f;
            for (int k = 0; k < 128; ++k) {
                const float wv = wp[(size_t)k * 6144];
#pragma unroll
                for (int r = 0; r < 9; ++r) acc[r] += s[r * 1024 + ks * 128 + k] * wv;
            }
#pragma unroll
            for (int r = 0; r < 9; ++r) red[(ks * 9 + r) * 64 + cl] = acc[r];
            __syncthreads();
            for (int o = tid; o < 9 * 64; o += NTHR) {
                const int r = o >> 6, c = o & 63; float v = 0.f;
#pragma unroll
                for (int q = 0; q < 8; ++q) v += red[(q * 9 + r) * 64 + c];
                B.MOD[((size_t)l * 9 + r) * 6144 + cg * 64 + c] = v + p.in[I_ADAB][l * 6144 + cg * 64 + c];
            }
            __syncthreads();
        }
    }
    for (int i = blockIdx.x * NTHR + tid; i < 4096 * 48; i += G * NTHR) {
        const int pos = i / 48, j = i % 48;
        const int row = pos >> 6, col = pos & 63;
        float inv, posf; float* cdst; float* sdst;
        if (j < 16) { const int m = j & 7; inv = powf(10000.0f, -(float)(2 * m) / 16.0f); posf = (j < 8) ? (float)row : (float)col; cdst = B.ROPE_M + pos * 16 + j; sdst = B.ROPE_M + 4096 * 16 + pos * 16 + j; }
        else { const int jj = j - 16, m = jj & 15; inv = powf(10000.0f, -(float)(2 * m) / 32.0f); posf = (jj < 16) ? (float)row : (float)col; cdst = B.ROPE_S + pos * 32 + jj; sdst = B.ROPE_S + 4096 * 32 + pos * 32 + jj; }
        const float ang = posf * inv;
        double tr = (double)ang * 0.15915494309189535; tr -= rint(tr);
        const float tf = (float)tr;
        *cdst = __builtin_amdgcn_cosf(tf); *sdst = __builtin_amdgcn_sinf(tf);
    }
    int base = 0;
    bf16_t* W = B.WMIX;
    conv_tiles<3>(p.in[I_NA_WQKV], 1024, 3072, 3072, W + W_NA_QKV, 1024, 0, 0, nullptr, 0.f, 0.f, base, smem);
    conv_tiles<0>(p.in[I_NA_WO], 1024, 1024, 1024, W + W_NA_WO, 1024, 0, 0, nullptr, 0.f, 0.f, base, smem);
    {
        const float* mix = p.in[I_RW_MIX];
        bf16_t* B1 = W + W_RW_B1;
        conv_tiles<0>(p.in[I_RW_WR], 1024, 1024, 1024, B1, 2048, 0, 0, mix + 0 * 1024, 1.f, -1.f, base, smem);
        conv_tiles<0>(p.in[I_RW_WR], 1024, 1024, 1024, B1, 2048, 1024, 0, mix + 0 * 1024, 0.f, 0.5f, base, smem);
        conv_tiles<0>(p.in[I_RW_WK], 1024, 1024, 1024, B1, 2048, 0, 1024, mix + 2 * 1024, 1.f, -1.f, base, smem);
        conv_tiles<0>(p.in[I_RW_WK], 1024, 1024, 1024, B1, 2048, 1024, 1024, mix + 2 * 1024, 0.f, 0.5f, base, smem);
        conv_tiles<0>(p.in[I_RW_WV], 1024, 1024, 1024, B1, 2048, 0, 2048, mix + 3 * 1024, 1.f, -1.f, base, smem);
        conv_tiles<0>(p.in[I_RW_WV], 1024, 1024, 1024, B1, 2048, 1024, 2048, mix + 3 * 1024, 0.f, 0.5f, base, smem);
        conv_tiles<0>(p.in[I_RW_G1], 1024, 128, 128, B1, 2048, 0, 3072, mix + 5 * 1024, 1.f, -1.f, base, smem);
        conv_tiles<0>(p.in[I_RW_G1], 1024, 128, 128, B1, 2048, 1024, 3072, mix + 5 * 1024, 0.f, 0.5f, base, smem);
        for (int z = 0; z < 2; ++z) {
            conv_tiles<0>(p.in[I_RW_W1] + (size_t)z * 1024 * 64, 1024, 64, 64, B1, 2048, 0, 3200 + 64 * z, mix + 1 * 1024, 1.f, -1.f, base, smem);
            conv_tiles<0>(p.in[I_RW_W1] + (size_t)z * 1024 * 64, 1024, 64, 64, B1, 2048, 1024, 3200 + 64 * z, mix + 1 * 1024, 0.f, 0.5f, base, smem);
            conv_tiles<0>(p.in[I_RW_A1] + (size_t)z * 1024 * 64, 1024, 64, 64, B1, 2048, 0, 3328 + 64 * z, mix + 4 * 1024, 1.f, -1.f, base, smem);
            conv_tiles<0>(p.in[I_RW_A1] + (size_t)z * 1024 * 64, 1024, 64, 64, B1, 2048, 1024, 3328 + 64 * z, mix + 4 * 1024, 0.f, 0.5f, base, smem);
        }
        zero_bf16(B1 + (size_t)3456 * 2048, (long)128 * 2048 / 8);
        bf16_t* B2 = W + W_RW_B2;
        conv_tiles<0>(p.in[I_RW_G2], 128, 1024, 1024, B2, 384, 0, 0, nullptr, 0.f, 0.f, base, smem);
        for (int z = 0; z < 2; ++z) {
            conv_tiles<0>(p.in[I_RW_W2] + (size_t)z * 64 * 1024, 64, 1024, 1024, B2, 384, 128 + 64 * z, 1024 + 1024 * z, nullptr, 0.f, 0.f, base, smem);
            conv_tiles<0>(p.in[I_RW_A2] + (size_t)z * 64 * 1024, 64, 1024, 1024, B2, 384, 256 + 64 * z, 3072 + 1024 * z, nullptr, 0.f, 0.f, base, smem);
        }
        conv_tiles<0>(p.in[I_RW_WO], 1024, 1024, 1024, W + W_RW_WO, 1024, 0, 0, nullptr, 0.f, 0.f, base, smem);
    }
    conv_tiles<0>(p.in[I_MLA_WDOWN], 1024, 672, 768, W + W_MLA_DOWN, 1024, 0, 0, nullptr, 0.f, 0.f, base, smem);
    conv_tiles<0>(p.in[I_MLA_WUQ], 384, 1536, 1536, W + W_MLA_UQ, 384, 0, 0, nullptr, 0.f, 0.f, base, smem);
    conv_tiles<0>(p.in[I_MLA_WUKV], 256, 2048, 2048, W + W_MLA_UKV, 256, 0, 0, nullptr, 0.f, 0.f, base, smem);
    conv_tiles<0>(p.in[I_MLA_WO], 1024, 1024, 1024, W + W_MLA_WO, 1024, 0, 0, nullptr, 0.f, 0.f, base, smem);
    conv_tiles<3>(p.in[I_SWA_WQKV], 1024, 1536, 1536, W + W_SWA_QKV, 1024, 0, 0, nullptr, 0.f, 0.f, base, smem);
    conv_tiles<0>(p.in[I_SWA_WO], 1024, 1024, 1024, W + W_SWA_WO, 1024, 0, 0, nullptr, 0.f, 0.f, base, smem);
    conv_moe_layer(p, B, 0, base, smem);
}

DI void row_load_f32(const float* row, int lane, float* v) {
#pragma unroll
    for (int i = 0; i < 4; ++i) { const f32x4 t = *(const f32x4*)(row + 256 * i + 4 * lane); v[4 * i] = t[0]; v[4 * i + 1] = t[1]; v[4 * i + 2] = t[2]; v[4 * i + 3] = t[3]; }
}
DI void row_store_bf16(bf16_t* row, int lane, const float* v) {
#pragma unroll
    for (int i = 0; i < 4; ++i) { u32x2 t; t.x = pk2(v[4 * i], v[4 * i + 1]); t.y = pk2(v[4 * i + 2], v[4 * i + 3]); *(u32x2*)(row + 256 * i + 4 * lane) = t; }
}
DI void norm_mod_row(const float* xrow, const float* gain, const float* shift, const float* scale, int lane, float* h) {
    float x[16], gg[16], sh[16], sc[16];
    row_load_f32(xrow, lane, x); row_load_f32(gain, lane, gg); row_load_f32(shift, lane, sh); row_load_f32(scale, lane, sc);
    float ss = 0.f;
#pragma unroll
    for (int e = 0; e < 16; ++e) ss += x[e] * x[e];
    ss = wave_sum(ss);
    const float r = rsqrtf(ss * (1.0f / 1024.0f) + 1e-6f);
#pragma unroll
    for (int e = 0; e < 16; ++e) h[e] = x[e] * r * gg[e] * (1.0f + sc[e]) + sh[e];
}

DI void phase_norm1(const Params& p, const Bufs& B, int layer, bf16_t* H) {
    const int lane = TIDX() & 63, gw = blockIdx.x * 8 + (TIDX() >> 6), nw = gridDim.x * 8;
    const float* gain = p.in[I_N1G] + layer * 1024;
    for (int g = gw; g < TT; g += nw) {
        const float* md = B.MOD + ((size_t)layer * 9 + modrow_of(g)) * 6144;
        float h[16];
        const float* xrow = (layer == 0) ? ((g < TL) ? p.in[I_X] + (size_t)g * 1024 : p.in[I_CTX] + (size_t)(g - TL) * 1024) : (B.X + (size_t)g * 1024);
        norm_mod_row(xrow, gain, md, md + 1024, lane, h);
        row_store_bf16(H + (size_t)g * 1024, lane, h);
    }
}
DI void phase_norm1_rw(const Params& p, const Bufs& B, int layer, bf16_t* H2) {
    const int lane = TIDX() & 63, gw = blockIdx.x * 8 + (TIDX() >> 6), nw = gridDim.x * 8;
    const float* gain = p.in[I_N1G] + layer * 1024;
    for (int g = gw; g < TT; g += nw) {
        const float* md = B.MOD + ((size_t)layer * 9 + modrow_of(g)) * 6144;
        const int t = (g < TL) ? (g & 4095) : ((g - TL) & 255);
        const int len = (g < TL) ? 4096 : 256;
        float h[16], hp[16], hn[16];
        norm_mod_row(B.X + (size_t)g * 1024, gain, md, md + 1024, lane, h);
        if (t > 0) norm_mod_row(B.X + (size_t)(g - 1) * 1024, gain, md, md + 1024, lane, hp);
        else {
#pragma unroll
            for (int e = 0; e < 16; ++e) hp[e] = 0.f;
        }
        if (t < len - 1) norm_mod_row(B.X + (size_t)(g + 1) * 1024, gain, md, md + 1024, lane, hn);
        else {
#pragma unroll
            for (int e = 0; e < 16; ++e) hn[e] = 0.f;
        }
#pragma unroll
        for (int e = 0; e < 16; ++e) hp[e] += hn[e];
        row_store_bf16(H2 + (size_t)g * 2048, lane, h);
        row_store_bf16(H2 + (size_t)g * 2048 + 1024, lane, hp);
    }
}
template <int CTRL> DI float dpp_mv(float x) { return __int_as_float(__builtin_amdgcn_update_dpp(0, __float_as_int(x), CTRL, 0xf, 0xf, false)); }
DI float lx_xor1(float x) { return dpp_mv<0xB1>(x); }
DI float lx_xor2(float x) { return dpp_mv<0x4E>(x); }
DI float lx_xor4(float x) { return dpp_mv<0x1B>(dpp_mv<0x141>(x)); }
DI float lx_xor8(float x) { return dpp_mv<0x128>(x); }
DI float fold32(float p, float q) { auto r = __builtin_amdgcn_permlane32_swap(__float_as_uint(p), __float_as_uint(q), false, false); return __uint_as_float(r[0]) + __uint_as_float(r[1]); }
DI float fold16(float p, float q) { auto r = __builtin_amdgcn_permlane16_swap(__float_as_uint(p), __float_as_uint(q), false, false); return __uint_as_float(r[0]) + __uint_as_float(r[1]); }
DI float wsum_fast(float x) {
    x += lx_xor1(x); x += lx_xor2(x); x += dpp_mv<0x141>(x); x += dpp_mv<0x140>(x);
    const int xi = __float_as_int(x);
    return (__int_as_float(__builtin_amdgcn_readlane(xi, 0)) + __int_as_float(__builtin_amdgcn_readlane(xi, 16))) + (__int_as_float(__builtin_amdgcn_readlane(xi, 32)) + __int_as_float(__builtin_amdgcn_readlane(xi, 48)));
}
DI void norm2_token(const float* x, const float* A, const float* Bv, const float* wr, int g, int lane, bf16_t* H, const Bufs& B) {
    float ss = 0.f;
#pragma unroll
    for (int e = 0; e < 16; ++e) ss += x[e] * x[e];
    ss = wsum_fast(ss);
    const float r = rsqrtf(ss * (1.0f / 1024.0f) + 1e-6f);
    float h[16];
#pragma unroll
    for (int e = 0; e < 16; ++e) h[e] = x[e] * r * A[e] + Bv[e];
    row_store_bf16(H + (size_t)g * 1024, lane, h);
    float a[16];
#pragma unroll
    for (int e = 0; e < 16; ++e) {
        float acc = 0.f;
#pragma unroll
        for (int i = 0; i < 4; ++i) { const f32x4 w4 = *(const f32x4*)(wr + e * 1024 + 256 * i + 4 * lane); acc += h[4 * i] * w4[0] + h[4 * i + 1] * w4[1] + h[4 * i + 2] * w4[2] + h[4 * i + 3] * w4[3]; }
        a[e] = acc;
        if ((e & 3) == 3) asm volatile("" ::: "memory");
    }
    float b8[8], c4[4], d2[2];
    const bool h8 = (lane & 8) != 0, h4 = (lane & 4) != 0;
#pragma unroll
    for (int e = 0; e < 8; ++e) b8[e] = fold32(a[e], a[e + 8]);
#pragma unroll
    for (int e = 0; e < 4; ++e) c4[e] = fold16(b8[e], b8[e + 4]);
#pragma unroll
    for (int e = 0; e < 2; ++e) { const float send = h8 ? c4[e] : c4[e + 2], keep = h8 ? c4[e + 2] : c4[e]; d2[e] = keep + lx_xor8(send); }
    float lg;
    { const float send = h4 ? d2[0] : d2[1], keep = h4 ? d2[1] : d2[0]; lg = keep + lx_xor4(send); }
    lg += lx_xor2(lg); lg += lx_xor1(lg);
    float mx = lg;
    mx = fmaxf(mx, lx_xor4(mx)); mx = fmaxf(mx, lx_xor8(mx));
    { auto r = __builtin_amdgcn_permlane16_swap(__float_as_uint(mx), __float_as_uint(mx), false, false); mx = fmaxf(__uint_as_float(r[0]), __uint_as_float(r[1])); }
    { auto r = __builtin_amdgcn_permlane32_swap(__float_as_uint(mx), __float_as_uint(mx), false, false); mx = fmaxf(__uint_as_float(r[0]), __uint_as_float(r[1])); }
    const float ex = __expf(lg - mx);
    float se = ex;
    se += lx_xor4(se); se += lx_xor8(se);
    se = fold16(se, se); se = fold32(se, se);
    const float aff = ex / se;
    if ((lane & 3) == 0) {
        const int e = lane >> 2;
        if (g < TL) B.AFF[((size_t)(g >> 12) * 16 + e) * 4096 + (g & 4095)] = aff;
        else { const int gc = g - TL; B.AFFC[((size_t)(gc >> 8) * 16 + e) * 256 + (gc & 255)] = aff; }
        B.INV[(size_t)g * 16 + e] = -1;
    }
}
DI void phase_norm2(const Params& p, const Bufs& B, int layer, bf16_t* H, int ntok, char* smem) {
    float* wr = (float*)smem;
    const float* rsrc = p.in[I_MOE_ROUTER] + (size_t)layer * 1024 * 16;
    for (int i = TIDX(); i < 1024 * 16; i += NTHR) { const int k = i >> 4, e = i & 15; wr[e * 1024 + k] = rsrc[i]; }
    __syncthreads();
    const int lane = TIDX() & 63, gw = blockIdx.x * 8 + (TIDX() >> 6);
    float gain[16];
    row_load_f32(p.in[I_N2G] + layer * 1024, lane, gain);
    const int nr = (ntok > TL) ? 9 : 8;
    float x0[16], x1[16];
    row_load_f32(B.X + (size_t)gw * 1024, lane, x0); row_load_f32(B.X + (size_t)(gw + 2048) * 1024, lane, x1);
    for (int r = 0; r < nr; ++r) {
        float n0[16], n1[16];
        if (r + 1 < nr) {
            const int gb = (r + 1 < 8) ? (r + 1) * 4096 : TL;
            row_load_f32(B.X + (size_t)(gb + gw) * 1024, lane, n0);
            if (r + 1 < 8) row_load_f32(B.X + (size_t)(gb + gw + 2048) * 1024, lane, n1);
        }
        const float* md = B.MOD + ((size_t)layer * 9 + r) * 6144;
        float A[16], Bv[16];
        row_load_f32(md + 4 * 1024, lane, A); row_load_f32(md + 3 * 1024, lane, Bv);
#pragma unroll
        for (int e = 0; e < 16; ++e) A[e] = gain[e] * (1.0f + A[e]);
        const int gb = (r < 8) ? r * 4096 : TL;
        norm2_token(x0, A, Bv, wr, gb + gw, lane, H, B);
        if (r < 8) norm2_token(x1, A, Bv, wr, gb + gw + 2048, lane, H, B);
#pragma unroll
        for (int e = 0; e < 16; ++e) { x0[e] = n0[e]; x1[e] = n1[e]; }
    }
}

DI void ld16(const bf16_t* p, float* v) { unpack8(*(const u32x4*)p, v); unpack8(*(const u32x4*)(p + 8), v + 8); }
DI void st16(bf16_t* p, const float* v) { *(u32x4*)p = pack8(v); *(u32x4*)(p + 8) = pack8(v + 8); }
DI void headnorm64(float* v, const float* gain, int p) {
    float ss = 0.f;
#pragma unroll
    for (int e = 0; e < 16; ++e) ss += v[e] * v[e];
    ss += __shfl_xor(ss, 1); ss += __shfl_xor(ss, 2);
    const float r = rsqrtf(ss * (1.0f / 64.0f) + 1e-6f);
#pragma unroll
    for (int e = 0; e < 16; ++e) v[e] = v[e] * r * gain[16 * p + e];
}
DI void rope64(float* v, const float* cs, const float* sn, int p) {
    const int i0 = 16 * (p & 1);
#pragma unroll
    for (int e = 0; e < 16; ++e) {
        const float o = __shfl_xor(v[e], 2), c = cs[i0 + e], s = sn[i0 + e];
        v[e] = (p < 2) ? (v[e] * c - o * s) : (v[e] * c + o * s);
    }
}

DI void phase_qknorm_na(const Params& p, bf16_t* QKV) {
    const int lane = TIDX() & 63, gw = blockIdx.x * 8 + (TIDX() >> 6), nw = gridDim.x * 8, pp = lane & 3;
    const float* qg = p.in[I_NA_QG]; const float* kg = p.in[I_NA_KG];
    for (int g = gw; g < TT; g += nw) {
        bf16_t* row = QKV + (size_t)g * 3072 + 16 * lane;
        float v[16];
        ld16(row, v); headnorm64(v, qg, pp); st16(row, v);
        ld16(row + 1024, v); headnorm64(v, kg, pp); st16(row + 1024, v);
    }
}
DI void phase_qknorm_swa(const Params& p, const Bufs& B, bf16_t* QKV) {
    const int lane = TIDX() & 63, gw = blockIdx.x * 8 + (TIDX() >> 6), nw = gridDim.x * 8, pp = lane & 3;
    const float* qg = p.in[I_SWA_QG]; const float* kg = p.in[I_SWA_KG];
    for (int g = gw; g < TT; g += nw) {
        bf16_t* row = QKV + (size_t)g * 1536;
        const bool lat = g < TL;
        const int pos = g & 4095;
        const float* cs = B.ROPE_S + (size_t)(lat ? pos : 0) * 32; const float* sn = cs + 4096 * 32;
        float v[16];
        ld16(row + 16 * lane, v); headnorm64(v, qg, pp);
        if (lat) rope64(v, cs, sn, pp);
        st16(row + 16 * lane, v);
        const int kl = lane & 15;
        ld16(row + 1024 + 16 * kl, v); headnorm64(v, kg, pp);
        if (lat) rope64(v, cs, sn, pp);
        if (lane < 16) st16(row + 1024 + 16 * kl, v);
    }
}
DI void phase_mla_dnorm(const Params& p, const Bufs& B, const bf16_t* DOWN, bf16_t* CQ, bf16_t* CKV, bf16_t* KR) {
    const int lane = TIDX() & 63, gw = blockIdx.x * 8 + (TIDX() >> 6), nw = gridDim.x * 8;
    float gq[6], gkv[4];
#pragma unroll
    for (int e = 0; e < 6; ++e) gq[e] = p.in[I_MLA_QNG][6 * lane + e];
#pragma unroll
    for (int e = 0; e < 4; ++e) gkv[e] = p.in[I_MLA_KVNG][4 * lane + e];
    const int l31 = lane & 31;
    const float gkr = p.in[I_MLA_KR_G][l31];
    for (int g = gw; g < TT; g += nw) {
        const bf16_t* d = DOWN + (size_t)g * 768;
        const unsigned q0 = *(const unsigned*)(d + 6 * lane), q1 = *(const unsigned*)(d + 6 * lane + 2), q2 = *(const unsigned*)(d + 6 * lane + 4);
        const u32x2 kv = *(const u32x2*)(d + 384 + 4 * lane);
        const unsigned short krw = d[640 + l31];
        float a[6] = {bflo(q0), bfhi(q0), bflo(q1), bfhi(q1), bflo(q2), bfhi(q2)};
        float ss = 0.f;
#pragma unroll
        for (int e = 0; e < 6; ++e) ss += a[e] * a[e];
        ss = wave_sum(ss);
        float r = rsqrtf(ss * (1.0f / 384.0f) + 1e-6f);
        bf16_t* cq = CQ + (size_t)g * 384 + 6 * lane;
        *(unsigned*)(cq) = pk2(a[0] * r * gq[0], a[1] * r * gq[1]); *(unsigned*)(cq + 2) = pk2(a[2] * r * gq[2], a[3] * r * gq[3]); *(unsigned*)(cq + 4) = pk2(a[4] * r * gq[4], a[5] * r * gq[5]);
        float c[4] = {bflo(kv.x), bfhi(kv.x), bflo(kv.y), bfhi(kv.y)};
        ss = (c[0] * c[0] + c[1] * c[1]) + (c[2] * c[2] + c[3] * c[3]);
        ss = wave_sum(ss);
        r = rsqrtf(ss * (1.0f / 256.0f) + 1e-6f);
        u32x2 o; o.x = pk2(c[0] * r * gkv[0], c[1] * r * gkv[1]); o.y = pk2(c[2] * r * gkv[2], c[3] * r * gkv[3]);
        *(u32x2*)(CKV + (size_t)g * 256 + 4 * lane) = o;
        float x = (lane < 32) ? bf2f(krw) : 0.f;
        ss = wave_sum(x * x);
        r = rsqrtf(ss * (1.0f / 32.0f) + 1e-6f);
        x = x * r * gkr;
        const float ox = __shfl_xor(x, 16);
        if (g < TL) {
            const int pos = g & 4095, ii = lane & 15;
            const float cc = B.ROPE_M[pos * 16 + ii], sn = B.ROPE_M[4096 * 16 + pos * 16 + ii];
            x = (l31 < 16) ? (x * cc - ox * sn) : (x * cc + ox * sn);
        }
        if (lane < 32) KR[(size_t)g * 32 + lane] = (bf16_t)f2bf(x);
    }
}
DI void phase_mla_hnorm(const Params& p, const Bufs& B, bf16_t* Q, bf16_t* KV) {
    const int lane = TIDX() & 63, gw = blockIdx.x * 8 + (TIDX() >> 6), nw = gridDim.x * 8, pp = lane & 3, hh = lane >> 2;
    const float* qng = p.in[I_MLA_QN_G]; const float* qrg = p.in[I_MLA_QR_G]; const float* kng = p.in[I_MLA_KN_G];
    for (int g = gw; g < TT; g += nw) {
        bf16_t* q = Q + (size_t)g * 1536 + hh * 96;
        float v[16];
        ld16(q + 16 * pp, v); headnorm64(v, qng, pp); st16(q + 16 * pp, v);
        float w[8];
        unpack8(*(const u32x4*)(q + 64 + 8 * pp), w);
        float ss = 0.f;
#pragma unroll
        for (int e = 0; e < 8; ++e) ss += w[e] * w[e];
        ss += __shfl_xor(ss, 1); ss += __shfl_xor(ss, 2);
        const float r = rsqrtf(ss * (1.0f / 32.0f) + 1e-6f);
#pragma unroll
        for (int e = 0; e < 8; ++e) w[e] = w[e] * r * qrg[8 * pp + e];
        if (g < TL) {
            const int pos = g & 4095, i0 = 8 * (pp & 1);
#pragma unroll
            for (int e = 0; e < 8; ++e) {
                const float o = __shfl_xor(w[e], 2), c = B.ROPE_M[pos * 16 + i0 + e], s = B.ROPE_M[4096 * 16 + pos * 16 + i0 + e];
                w[e] = (pp < 2) ? (w[e] * c - o * s) : (w[e] * c + o * s);
            }
        }
        *(u32x4*)(q + 64 + 8 * pp) = pack8(w);
        bf16_t* k = KV + (size_t)g * 2048 + hh * 128 + 16 * pp;
        ld16(k, v); headnorm64(v, kng, pp); st16(k, v);
    }
}

typedef short v4i16_t __attribute__((ext_vector_type(4)));
DI s16x4 tr_read(const bf16_t* p) { return __builtin_bit_cast(s16x4, __builtin_amdgcn_ds_read_tr16_b64_v4i16((LAS v4i16_t*)(LAS char*)(char*)p)); }
constexpr int ATT_LDS = 64 * 104 * 2 + 64 * 72 * 2 + 2048;

template <class P>
DI void attn_unit(const P& pol, char* smem) {
    constexpr int DQK = P::DQK, KS = DQK + 8, VS = 72, NS = DQK / 32, NCH = DQK / 8;
    bf16_t* Ks = (bf16_t*)smem;
    bf16_t* Vs = (bf16_t*)(smem + 64 * 104 * 2);
    const int tid = TIDX(), lane = tid & 63, w = tid >> 6, l15 = lane & 15, quad = lane >> 4;
    const int q = w * 16 + l15;
    __syncthreads();
    pol.prologue(smem + 64 * 104 * 2 + 64 * 72 * 2);
    bf16x8 qf[NS];
#pragma unroll
    for (int s = 0; s < NS; ++s) qf[s] = *(const bf16x8*)pol.qptr(q, s * 4 + quad);
    f32x4 o[4];
#pragma unroll
    for (int u = 0; u < 4; ++u) o[u] = (f32x4){0.f, 0.f, 0.f, 0.f};
    float m = -1e30f, l = 0.f;
    const int k0key = (DQK == 64) ? (tid >> 3) : (tid / 12), k0ch = (DQK == 64) ? (tid & 7) : (tid % 12);
    const int k1key = (tid + 512) / 12, k1ch = (tid + 512) % 12;
    const bool k1on = (DQK == 96) && (tid < 256);
    const int vkey = tid >> 3, vch = tid & 7;
    const int nt = pol.ntiles();
    u32x4 rk0, rk1 = (u32x4){0u, 0u, 0u, 0u}, rv;
    rk0 = *(const u32x4*)pol.kptr(0, k0key, k0ch);
    if (k1on) rk1 = *(const u32x4*)pol.kptr(0, k1key, k1ch);
    rv = *(const u32x4*)pol.vptr(0, vkey, vch);
    *(u32x4*)(Ks + k0key * KS + k0ch * 8) = rk0;
    if (k1on) *(u32x4*)(Ks + k1key * KS + k1ch * 8) = rk1;
    *(u32x4*)(Vs + vkey * VS + vch * 8) = rv;
    __syncthreads();
    for (int j = 0; j < nt; ++j) {
        const bool more = (j + 1 < nt);
        if (more) {
            rk0 = *(const u32x4*)pol.kptr(j + 1, k0key, k0ch);
            if (k1on) rk1 = *(const u32x4*)pol.kptr(j + 1, k1key, k1ch);
            rv = *(const u32x4*)pol.vptr(j + 1, vkey, vch);
        }
        f32x4 sc[2][2];
#pragma unroll
        for (int g = 0; g < 2; ++g)
#pragma unroll
            for (int t = 0; t < 2; ++t) {
                f32x4 a = (f32x4){0.f, 0.f, 0.f, 0.f};
                const int key = 32 * g + 8 * (l15 >> 2) + 4 * t + (l15 & 3);
#pragma unroll
                for (int s = 0; s < NS; ++s) { const bf16x8 kf = *(const bf16x8*)(Ks + key * KS + 32 * s + 8 * quad); a = __builtin_amdgcn_mfma_f32_16x16x32_bf16(kf, qf[s], a, 0, 0, 0); }
                sc[g][t] = a;
            }
        float tmax = -3.0e38f;
#pragma unroll
        for (int g = 0; g < 2; ++g)
#pragma unroll
            for (int t = 0; t < 2; ++t)
#pragma unroll
                for (int r = 0; r < 4; ++r) { const float s2 = pol.mod(sc[g][t][r] * pol.c2, q, j, 32 * g + 8 * quad + 4 * t + r); sc[g][t][r] = s2; tmax = fmaxf(tmax, s2); }
        tmax = fmaxf(tmax, __shfl_xor(tmax, 16)); tmax = fmaxf(tmax, __shfl_xor(tmax, 32));
        const float mn = fmaxf(m, tmax), alpha = fexp2(m - mn);
        m = mn;
        float ps = 0.f;
        bf16x8 pf[2];
#pragma unroll
        for (int g = 0; g < 2; ++g) {
            float pv[8];
#pragma unroll
            for (int t = 0; t < 2; ++t)
#pragma unroll
                for (int r = 0; r < 4; ++r) { const float e = fexp2(sc[g][t][r] - mn); ps += e; pv[4 * t + r] = e; }
            pf[g] = __builtin_bit_cast(bf16x8, pack8(pv));
        }
        l = l * alpha + ps;
#pragma unroll
        for (int u = 0; u < 4; ++u) o[u] *= alpha;
#pragma unroll
        for (int u = 0; u < 4; ++u)
#pragma unroll
            for (int g = 0; g < 2; ++g) {
                const bf16_t* vb = Vs + (32 * g + 8 * quad + (l15 >> 2)) * VS + 16 * u + 4 * (l15 & 3);
                const s16x4 lo = tr_read(vb), hi = tr_read(vb + 4 * VS);
                bf16x8 vf; vf[0] = lo[0]; vf[1] = lo[1]; vf[2] = lo[2]; vf[3] = lo[3]; vf[4] = hi[0]; vf[5] = hi[1]; vf[6] = hi[2]; vf[7] = hi[3];
                o[u] = __builtin_amdgcn_mfma_f32_16x16x32_bf16(vf, pf[g], o[u], 0, 0, 0);
            }
        __syncthreads();
        if (more) {
            *(u32x4*)(Ks + k0key * KS + k0ch * 8) = rk0;
            if (k1on) *(u32x4*)(Ks + k1key * KS + k1ch * 8) = rk1;
            *(u32x4*)(Vs + vkey * VS + vch * 8) = rv;
        }
        __syncthreads();
    }
    l += __shfl_xor(l, 16); l += __shfl_xor(l, 32);
    if (P::SINK) l += fexp2(pol.sink2 - m);
    const float il = 1.0f / l;
    bf16_t* op = pol.optr(q);
#pragma unroll
    for (int u = 0; u < 4; ++u) st_bf16x4(op + 16 * u + 4 * quad, o[u] * il);
}

struct PolPlain64 {
    static constexpr int DQK = 64; static constexpr bool SINK = false;
    const bf16_t* Qb; long qs; const bf16_t* Kb; long ks; const bf16_t* Vb; long vs; bf16_t* Ob; long os; int qrow0, krow0, nt; float c2, sink2;
    DI void prologue(char*) const {}
    DI int ntiles() const { return nt; }
    DI const bf16_t* qptr(int q, int ch) const { return Qb + (long)(qrow0 + q) * qs + ch * 8; }
    DI const bf16_t* kptr(int j, int i, int ch) const { return Kb + (long)(krow0 + 64 * j + i) * ks + ch * 8; }
    DI const bf16_t* vptr(int j, int i, int ch) const { return Vb + (long)(krow0 + 64 * j + i) * vs + ch * 8; }
    DI float mod(float s2, int, int, int) const { return s2; }
    DI bf16_t* optr(int q) const { return Ob + (long)(qrow0 + q) * os; }
};
struct PolNA {
    static constexpr int DQK = 64; static constexpr bool SINK = false;
    const bf16_t* QKV; bf16_t* AO; const float* rpb; const float* bl; int b, h, rr, rbase; float c2, sink2;
    DI void prologue(char* s) const { float* t = (float*)s; for (int i = TIDX(); i < 465; i += NTHR) t[i] = rpb[h * 465 + i] * LOG2E; }
    DI int ntiles() const { return 13; }
    DI int qtok(int q) const { return b * 4096 + (2 * rr + (q >> 6)) * 64 + (q & 63); }
    DI int ktok(int j, int i) const { if (j < 4) return TL + b * 256 + 64 * j + i; int kr = rbase + j - 4; kr = kr > 63 ? 63 : kr; return b * 4096 + kr * 64 + i; }
    DI const bf16_t* qptr(int q, int ch) const { return QKV + (long)qtok(q) * 3072 + h * 64 + ch * 8; }
    DI const bf16_t* kptr(int j, int i, int ch) const { return QKV + (long)ktok(j, i) * 3072 + 1024 + h * 64 + ch * 8; }
    DI const bf16_t* vptr(int j, int i, int ch) const { return QKV + (long)ktok(j, i) * 3072 + 2048 + h * 64 + ch * 8; }
    DI float mod(float s2, int q, int j, int kc) const {
        if (j < 4) return s2;
        const int kr = rbase + j - 4, qr = 2 * rr + (q >> 6), qc = q & 63;
        int r0 = qr - 4; r0 = r0 < 0 ? 0 : (r0 > 56 ? 56 : r0);
        int c0 = qc - 8; c0 = c0 < 0 ? 0 : (c0 > 48 ? 48 : c0);
        const bool ok = (kr >= r0) && (kr <= r0 + 7) && (kc >= c0) && (kc < c0 + 16);
        const int idx = ok ? ((kr - qr + 7) * 31 + (kc - qc + 15)) : 0;
        return ok ? (s2 + bl[idx]) : -1e30f;
    }
    DI bf16_t* optr(int q) const { return AO + (long)qtok(q) * 1024 + h * 64; }
};
struct PolMLA {
    static constexpr int DQK = 96; static constexpr bool SINK = false;
    const bf16_t* Q; const bf16_t* KV; const bf16_t* KR; bf16_t* AO; int b, h, qrow0, nt; float c2, sink2;
    DI void prologue(char*) const {}
    DI int ntiles() const { return nt; }
    DI int ktok(int j, int i) const { return (j < 4) ? (TL + b * 256 + 64 * j + i) : (b * 4096 + 64 * (j - 4) + i); }
    DI const bf16_t* qptr(int q, int ch) const { return Q + (long)(qrow0 + q) * 1536 + h * 96 + ch * 8; }
    DI const bf16_t* kptr(int j, int i, int ch) const { const long t = ktok(j, i); return (ch < 8) ? (KV + t * 2048 + h * 128 + ch * 8) : (KR + t * 32 + (ch - 8) * 8); }
    DI const bf16_t* vptr(int j, int i, int ch) const { return KV + (long)ktok(j, i) * 2048 + h * 128 + 64 + ch * 8; }
    DI float mod(float s2, int, int, int) const { return s2; }
    DI bf16_t* optr(int q) const { return AO + (long)(qrow0 + q) * 1024 + h * 64; }
};
struct PolSWA {
    static constexpr int DQK = 64; static constexpr bool SINK = true;
    const bf16_t* QKV; bf16_t* AO; int b, hq, s0; float c2, sink2;
    DI void prologue(char*) const {}
    DI int ntiles() const { return 10; }
    DI int ktok(int j, int i) const { if (j < 4) return TL + b * 256 + 64 * j + i; int kp = s0 - 128 + 64 * (j - 4) + i; kp = kp < 0 ? 0 : (kp > 4095 ? 4095 : kp); return b * 4096 + kp; }
    DI const bf16_t* qptr(int q, int ch) const { return QKV + (long)(b * 4096 + s0 + q) * 1536 + hq * 64 + ch * 8; }
    DI const bf16_t* kptr(int j, int i, int ch) const { return QKV + (long)ktok(j, i) * 1536 + 1024 + (hq >> 2) * 64 + ch * 8; }
    DI const bf16_t* vptr(int j, int i, int ch) const { return QKV + (long)ktok(j, i) * 1536 + 1280 + (hq >> 2) * 64 + ch * 8; }
    DI float mod(float s2, int q, int j, int kc) const {
        if (j < 4) return s2;
        const int kp = s0 - 128 + 64 * (j - 4) + kc, qp = s0 + q, d = qp - kp;
        const bool ok = (kp >= 0) && (kp < 4096) && (d <= 128) && (d >= -128);
        return ok ? s2 : -1e30f;
    }
    DI bf16_t* optr(int q) const { return AO + (long)(b * 4096 + s0 + q) * 1024 + hq * 64; }
};

DI float ftanh(float x) { return 2.0f * fsigmoid(2.0f * x) - 1.0f; }
struct EpiRW1 { bf16_t* RKV; bf16_t* LORA;
    DI f32x4 act(f32x4 a, int lc) const {
        f32x4 r;
#pragma unroll
        for (int i = 0; i < 4; ++i) r[i] = (lc < 128) ? fsigmoid(a[i]) : ((lc < 256) ? ftanh(a[i]) : a[i]);
        return r; }
    DI void operator()(int row, int col, f32x4 a0, f32x4 a1) const {
        if (col < 3072) { bf16_t* p = RKV + (long)row * 3072 + col; st_bf16x4(p, a0); st_bf16x4(p + 16, a1); }
        else if (col < 3456) { const int lc = col - 3072; bf16_t* p = LORA + (long)row * 384 + lc; st_bf16x4(p, act(a0, lc)); st_bf16x4(p + 16, act(a1, lc)); }
    } };
struct EpiRW2 { int seg; bf16_t* O; const float* bias;
    DI f32x4 f(f32x4 a, const float* bp) const {
        f32x4 r;
#pragma unroll
        for (int i = 0; i < 4; ++i) { const float t = fsigmoid(a[i] + bp[i]); r[i] = (seg < 3) ? 0.6065306597126334f * t : t; }
        return r; }
    DI void operator()(int row, int col, f32x4 a0, f32x4 a1) const {
        const int n = col - 1024 * seg; bf16_t* p = O + (long)row * 1024 + n;
        if (seg == 0) { st_bf16x4(p, a0); st_bf16x4(p + 16, a1); }
        else { st_bf16x4(p, f(a0, bias + n)); st_bf16x4(p + 16, f(a1, bias + n + 16)); }
    } };

DI void phase_rw_gemm2(const Params& p, const Bufs& B, const bf16_t* LORA, bf16_t* G, bf16_t* XD0, bf16_t* XD1, bf16_t* AA0, bf16_t* AA1, char* smem) {
    const int ntm = TT >> 7, nt = ntm * 40;
    for (int t = blockIdx.x; t < nt; t += gridDim.x) {
        const int tm = t / 40, tn = t % 40, seg = tn >> 3;
        GemmOp g; g.A = LORA; g.lda = 384; g.Bt = B.WMIX + W_RW_B2; g.ldb = 384;
        g.kbeg = (seg == 0) ? 0 : (64 + 64 * seg); g.kend = (seg == 0) ? 128 : (128 + 64 * seg);
        EpiRW2 e; e.seg = seg;
        e.O = (seg == 0) ? G : (seg == 1 ? XD0 : (seg == 2 ? XD1 : (seg == 3 ? AA0 : AA1)));
        e.bias = (seg == 0) ? nullptr : ((seg < 3) ? p.in[I_RW_W0] + (seg - 1) * 1024 : p.in[I_RW_A0] + (seg - 3) * 1024);
        gemm_tile(g, tm * 128, tn * 128, e, smem);
    }
}

template <int CTRL> DI float dppmov(float x) { return __int_as_float(__builtin_amdgcn_update_dpp(0, __float_as_int(x), CTRL, 0xf, 0xf, false)); }
DI float red8(float x) { x += dppmov<0xB1>(x); x += dppmov<0x4E>(x); x += dppmov<0x141>(x); return x; }
DI float wave_sum_dpp(float x) {
    x += dppmov<0xB1>(x); x += dppmov<0x4E>(x); x += dppmov<0x141>(x); x += dppmov<0x140>(x);
    const int xi = __float_as_int(x);
    const float s0 = __int_as_float(__builtin_amdgcn_readlane(xi, 0)), s1 = __int_as_float(__builtin_amdgcn_readlane(xi, 16)), s2 = __int_as_float(__builtin_amdgcn_readlane(xi, 32)), s3 = __int_as_float(__builtin_amdgcn_readlane(xi, 48));
    return (s0 + s1) + (s2 + s3);
}

constexpr int SCAN_LDS = 32 * 384 * 4 + 32 * 64 * 4;
DI void phase_rw_scan(const Params& p, const bf16_t* RKV, const bf16_t* XD0, const bf16_t* XD1, const bf16_t* AA0, const bf16_t* AA1, bf16_t* YF, bf16_t* YB, char* smem) {
    float* vec = (float*)smem;
    float* ybuf = vec + 32 * 384;
    const int tid = TIDX(), lane = tid & 63, wv = tid >> 6, il = lane >> 3, js = lane & 7, irow = 8 * wv + il;
    const int ss = tid >> 4, jg = tid & 15;
    for (int unit = blockIdx.x; unit < 256; unit += gridDim.x) {
        const int dir = unit & 1, b = unit >> 5, h = (unit >> 1) & 15;
        const bf16_t* XD = dir ? XD1 : XD0; const bf16_t* AA = dir ? AA1 : AA0; bf16_t* Y = dir ? YB : YF;
        const f32x4 kk4 = *(const f32x4*)(p.in[I_RW_KK] + h * 64 + 4 * jg), ka4 = *(const f32x4*)(p.in[I_RW_KA] + h * 64 + 4 * jg);
        float S[8];
#pragma unroll
        for (int e = 0; e < 8; ++e) S[e] = 0.f;
        u32x2 pr, pk, pv, px, pa;
        long gcur;
        {   const int n = ss; const int t = dir ? 255 - n : n; gcur = TL + b * 256 + t;
            const long o = gcur * 3072 + h * 64 + 4 * jg, o1 = gcur * 1024 + h * 64 + 4 * jg;
            pr = *(const u32x2*)(RKV + o); pk = *(const u32x2*)(RKV + o + 1024); pv = *(const u32x2*)(RKV + o + 2048); px = *(const u32x2*)(XD + o1); pa = *(const u32x2*)(AA + o1); }
        for (int c = 0; c < 136; ++c) {
            __syncthreads();
            {
                float kf[4] = {bflo(pk.x), bfhi(pk.x), bflo(pk.y), bfhi(pk.y)};
                float af[4] = {bflo(pa.x), bfhi(pa.x), bflo(pa.y), bfhi(pa.y)};
                float xf[4] = {bflo(px.x), bfhi(px.x), bflo(px.y), bfhi(px.y)};
                f32x4 kkv, kka, kt, wv4, rv4, vv4;
                float sq = 0.f;
#pragma unroll
                for (int e = 0; e < 4; ++e) { kkv[e] = kf[e] * kk4[e]; sq += kkv[e] * kkv[e]; }
                sq += __shfl_xor(sq, 1); sq += __shfl_xor(sq, 2); sq += __shfl_xor(sq, 4); sq += __shfl_xor(sq, 8);
                const float inv = 1.0f / fmaxf(sqrtf(sq), 1e-12f);
#pragma unroll
                for (int e = 0; e < 4; ++e) { kkv[e] *= inv; kka[e] = kkv[e] * af[e]; kt[e] = kf[e] * (1.0f + (af[e] - 1.0f) * ka4[e]); wv4[e] = __expf(-xf[e]); }
                rv4 = (f32x4){bflo(pr.x), bfhi(pr.x), bflo(pr.y), bfhi(pr.y)};
                vv4 = (f32x4){bflo(pv.x), bfhi(pv.x), bflo(pv.y), bfhi(pv.y)};
                float* vb = vec + ss * 384 + 4 * jg;
                *(f32x4*)(vb) = wv4; *(f32x4*)(vb + 64) = kkv; *(f32x4*)(vb + 128) = kka; *(f32x4*)(vb + 192) = kt; *(f32x4*)(vb + 256) = rv4; *(f32x4*)(vb + 320) = vv4;
            }
            const long gthis = gcur;
            __syncthreads();
            if (c + 1 < 136) {
                const int n = (c + 1) * 32 + ss;
                if (n < 256) { const int t = dir ? 255 - n : n; gcur = TL + b * 256 + t; }
                else { const int mm = n - 256; const int t = dir ? 4095 - mm : mm; gcur = (long)b * 4096 + t; }
                const long o = gcur * 3072 + h * 64 + 4 * jg, o1 = gcur * 1024 + h * 64 + 4 * jg;
                pr = *(const u32x2*)(RKV + o); pk = *(const u32x2*)(RKV + o + 1024); pv = *(const u32x2*)(RKV + o + 2048); px = *(const u32x2*)(XD + o1); pa = *(const u32x2*)(AA + o1);
            }
            {
                typedef float f32x2 __attribute__((ext_vector_type(2)));
                float yk[4] = {0.f, 0.f, 0.f, 0.f};
                const float* vb0 = vec + 8 * js;
                f32x4 cw0 = *(const f32x4*)(vb0), cw1 = *(const f32x4*)(vb0 + 4), ck0 = *(const f32x4*)(vb0 + 64), ck1 = *(const f32x4*)(vb0 + 68);
                f32x4 ca0 = *(const f32x4*)(vb0 + 128), ca1 = *(const f32x4*)(vb0 + 132), ct0 = *(const f32x4*)(vb0 + 192), ct1 = *(const f32x4*)(vb0 + 196);
                f32x4 cr0 = *(const f32x4*)(vb0 + 256), cr1 = *(const f32x4*)(vb0 + 260);
                float cvi = vec[320 + irow];
#pragma unroll
                for (int s = 0; s < 32; ++s) {
                    f32x4 nw0 = cw0, nw1 = cw1, nk0 = ck0, nk1 = ck1, na0 = ca0, na1 = ca1, nt0 = ct0, nt1 = ct1, nr0 = cr0, nr1 = cr1; float nvi = cvi;
                    if (s + 1 < 32) {
                        const float* vb = vec + (s + 1) * 384 + 8 * js;
                        nw0 = *(const f32x4*)(vb); nw1 = *(const f32x4*)(vb + 4); nk0 = *(const f32x4*)(vb + 64); nk1 = *(const f32x4*)(vb + 68);
                        na0 = *(const f32x4*)(vb + 128); na1 = *(const f32x4*)(vb + 132); nt0 = *(const f32x4*)(vb + 192); nt1 = *(const f32x4*)(vb + 196);
                        nr0 = *(const f32x4*)(vb + 256); nr1 = *(const f32x4*)(vb + 260); nvi = vec[(s + 1) * 384 + 320 + irow];
                    }
                    f32x2 S0 = {S[0], S[1]}, S1 = {S[2], S[3]}, S2 = {S[4], S[5]}, S3 = {S[6], S[7]};
                    const f32x2 d2 = (S0 * (f32x2){ck0[0], ck0[1]} + S1 * (f32x2){ck0[2], ck0[3]}) + (S2 * (f32x2){ck1[0], ck1[1]} + S3 * (f32x2){ck1[2], ck1[3]});
                    const float sk = red8(d2.x + d2.y);
                    const f32x2 nsk = {-sk, -sk}, vv = {cvi, cvi};
                    S0 = S0 * (f32x2){cw0[0], cw0[1]} + nsk * (f32x2){ca0[0], ca0[1]} + vv * (f32x2){ct0[0], ct0[1]};
                    S1 = S1 * (f32x2){cw0[2], cw0[3]} + nsk * (f32x2){ca0[2], ca0[3]} + vv * (f32x2){ct0[2], ct0[3]};
                    S2 = S2 * (f32x2){cw1[0], cw1[1]} + nsk * (f32x2){ca1[0], ca1[1]} + vv * (f32x2){ct1[0], ct1[1]};
                    S3 = S3 * (f32x2){cw1[2], cw1[3]} + nsk * (f32x2){ca1[2], ca1[3]} + vv * (f32x2){ct1[2], ct1[3]};
                    const f32x2 y2 = (S0 * (f32x2){cr0[0], cr0[1]} + S1 * (f32x2){cr0[2], cr0[3]}) + (S2 * (f32x2){cr1[0], cr1[1]} + S3 * (f32x2){cr1[2], cr1[3]});
                    const float y = red8(y2.x + y2.y);
                    yk[s >> 3] = (js == (s & 7)) ? y : yk[s >> 3];
                    S[0] = S0.x; S[1] = S0.y; S[2] = S1.x; S[3] = S1.y; S[4] = S2.x; S[5] = S2.y; S[6] = S3.x; S[7] = S3.y;
                    cw0 = nw0; cw1 = nw1; ck0 = nk0; ck1 = nk1; ca0 = na0; ca1 = na1; ct0 = nt0; ct1 = nt1; cr0 = nr0; cr1 = nr1; cvi = nvi;
                }
#pragma unroll
                for (int k = 0; k < 4; ++k) ybuf[(8 * k + js) * 64 + irow] = yk[k];
            }
            __syncthreads();
            {
                const f32x4 yv = *(const f32x4*)(ybuf + ss * 64 + 4 * jg);
                st_bf16x4(Y + gthis * 1024 + h * 64 + 4 * jg, yv);
            }
        }
    }
}


constexpr int CS_L1 = 68, CS_L2 = 20;
constexpr int CS_AT = 0, CS_RT = 2176, CS_BL = 4352, CS_KL = 6528, CS_BH = 8704, CS_KH = 11264, CS_VT = 13824, CS_GL = 16384, CS_P1 = 16640;
constexpr int CS_NT = 0, CS_AK = 1024, CS_RB = 1664, CS_RK = 2304, CS_P2 = 2944;
constexpr int SCAN2_LDS = 3 * CS_P1 + 2 * CS_P2;
DI bf16x8 mk8(u32x2 lo, u32x2 hi) { u32x4 v; v.x = lo.x; v.y = lo.y; v.z = hi.x; v.w = hi.y; return __builtin_bit_cast(bf16x8, v); }
DI long scan_token(int b, int dir, int n) {
    if (n < 256) return (long)TL + b * 256 + (dir ? 255 - n : n);
    const int m = n - 256; return (long)b * 4096 + (dir ? 4095 - m : m);
}
struct ScanRaw { unsigned rx[16], xo[4], rk[4], rr[4], ra[4], rv[4]; };
DI unsigned ld16_async(const bf16_t* q) { unsigned r; asm volatile("global_load_ushort %0, %1, off" : "=v"(r) : "v"(q) : "memory"); return r; }
DI void scan_wait_raw(ScanRaw& R) {
    asm volatile("s_waitcnt vmcnt(36)" : "+v"(R.rx[0]), "+v"(R.rx[1]), "+v"(R.rx[2]), "+v"(R.rx[3]), "+v"(R.rx[4]), "+v"(R.rx[5]), "+v"(R.rx[6]), "+v"(R.rx[7]),
                 "+v"(R.rx[8]), "+v"(R.rx[9]), "+v"(R.rx[10]), "+v"(R.rx[11]) :: "memory");
    asm volatile("" : "+v"(R.rx[12]), "+v"(R.rx[13]), "+v"(R.rx[14]), "+v"(R.rx[15]), "+v"(R.xo[0]), "+v"(R.xo[1]), "+v"(R.xo[2]), "+v"(R.xo[3]),
                 "+v"(R.rk[0]), "+v"(R.rk[1]), "+v"(R.rk[2]), "+v"(R.rk[3]) :: "memory");
    asm volatile("" : "+v"(R.rr[0]), "+v"(R.rr[1]), "+v"(R.rr[2]), "+v"(R.rr[3]), "+v"(R.ra[0]), "+v"(R.ra[1]), "+v"(R.ra[2]), "+v"(R.ra[3]),
                 "+v"(R.rv[0]), "+v"(R.rv[1]), "+v"(R.rv[2]), "+v"(R.rv[3]) :: "memory");
}
DI void scan_chunk_tokens(int b, int dir, int chunk, int& g0, int& step) {
    const int n0 = chunk * 16; step = dir ? -1 : 1;
    if (n0 < 256) g0 = TL + b * 256 + (dir ? 255 - n0 : n0); else g0 = b * 4096 + (dir ? 4095 - (n0 - 256) : (n0 - 256));
}
DI void scan_load_raw(ScanRaw& R, const bf16_t* RKV, const bf16_t* XD, const bf16_t* AA, int b, int dir, int h, int j, int pw, int chunk) {
    int g0, step; scan_chunk_tokens(b, dir, chunk, g0, step);
    const bf16_t* px = XD + (long)g0 * 1024 + h * 64; const long sx = (long)step * 1024;
#pragma unroll
    for (int s = 0; s < 16; ++s) R.rx[s] = ld16_async(px + (s * sx + j));
    const int t0 = 4 * pw;
    const bf16_t* pr = RKV + (long)(g0 + t0 * step) * 3072 + h * 64; const bf16_t* pa = AA + (long)(g0 + t0 * step) * 1024 + h * 64; const bf16_t* pxo = px + t0 * sx;
    const long s3 = (long)step * 3072;
#pragma unroll
    for (int q = 0; q < 4; ++q) { R.rr[q] = ld16_async(pr + (q * s3 + j)); R.rk[q] = ld16_async(pr + (q * s3 + 1024 + j)); R.rv[q] = ld16_async(pr + (q * s3 + 2048 + j)); R.ra[q] = ld16_async(pa + (q * sx + j)); R.xo[q] = ld16_async(pxo + (q * sx + j)); }
}
DI void scan_p1(const ScanRaw& R, char* st, int pw, int j, float kkj, float kaj) {
    float before = 0.f, total = 0.f;
#pragma unroll
    for (int s = 0; s < 16; ++s) { const float xv = bf2f(R.rx[s]); total += xv; before += (s < 4 * pw) ? xv : 0.f; }
    float gprev = __expf(-before);
    const float gL = __expf(-total);
    unsigned bhk[4], khk[4];
#pragma unroll
    for (int q = 0; q < 4; ++q) {
        const int t = 4 * pw + q;
        const float gt = gprev * __expf(-bf2f(R.xo[q]));
        const float ig = __builtin_amdgcn_rcpf(gt), gl = gL * ig;
        const float kf = bf2f(R.rk[q]), af = bf2f(R.ra[q]), rf = bf2f(R.rr[q]);
        const float kkraw = kf * kkj;
        const float kk = kkraw * __builtin_amdgcn_rsqf(fmaxf(wave_sum_dpp(kkraw * kkraw), 1e-24f));
        const float bb = kk * af, ktv = kf * (1.0f + (af - 1.0f) * kaj);
        const unsigned p0 = pk2(-kk * gprev, rf * gt), p1 = pk2(bb * ig, ktv * ig);
        ((bf16_t*)(st + CS_AT))[t * CS_L1 + j] = (bf16_t)(p0 & 0xffffu);
        ((bf16_t*)(st + CS_RT))[t * CS_L1 + j] = (bf16_t)(p0 >> 16);
        ((bf16_t*)(st + CS_BL))[t * CS_L1 + j] = (bf16_t)(p1 & 0xffffu);
        ((bf16_t*)(st + CS_KL))[t * CS_L1 + j] = (bf16_t)(p1 >> 16);
        const unsigned p2 = pk2(bb * gl, ktv * gl);
        bhk[q] = p2 & 0xffffu; khk[q] = p2 >> 16;
        gprev = gt;
    }
    u32x2 w2;
    w2.x = bhk[0] | (bhk[1] << 16); w2.y = bhk[2] | (bhk[3] << 16); *(u32x2*)(st + CS_BH + (j * CS_L2 + 4 * pw) * 2) = w2;
    w2.x = khk[0] | (khk[1] << 16); w2.y = khk[2] | (khk[3] << 16); *(u32x2*)(st + CS_KH + (j * CS_L2 + 4 * pw) * 2) = w2;
    w2.x = (unsigned)R.rv[0] | ((unsigned)R.rv[1] << 16); w2.y = (unsigned)R.rv[2] | ((unsigned)R.rv[3] << 16); *(u32x2*)(st + CS_VT + (j * CS_L2 + 4 * pw) * 2) = w2;
    if (pw == 0) ((float*)(st + CS_GL))[j] = gL;
}
DI void scan_p2(const char* s1, char* s2, int pw, int l15, int quad) {
    const bf16_t* Am = (const bf16_t*)(s1 + ((pw < 2) ? CS_AT : CS_RT));
    const bf16_t* Bm = (const bf16_t*)(s1 + ((pw & 1) ? CS_KL : CS_BL));
    f32x4 d = (f32x4){0.f, 0.f, 0.f, 0.f};
#pragma unroll
    for (int ks = 0; ks < 2; ++ks) {
        const bf16_t* ap = Am + l15 * CS_L1 + 32 * ks + 8 * quad; const bf16_t* bp = Bm + l15 * CS_L1 + 32 * ks + 8 * quad;
        const bf16x8 af = mk8(*(const u32x2*)ap, *(const u32x2*)(ap + 4)), bf = mk8(*(const u32x2*)bp, *(const u32x2*)(bp + 4));
        d = __builtin_amdgcn_mfma_f32_16x16x32_bf16(af, bf, d, 0, 0, 0);
    }
#pragma unroll
    for (int r = 0; r < 4; ++r) { const int t = 4 * quad + r; const bool keep = (pw < 2) ? (l15 < t) : (l15 <= t); d[r] = keep ? d[r] : 0.f; }
    if (pw == 0) *(f32x4*)(s2 + CS_NT + (l15 * 16 + 4 * quad) * 4) = d;
    else {
        bf16_t* O = (bf16_t*)(s2 + (pw == 1 ? CS_AK : (pw == 2 ? CS_RB : CS_RK)));
        const unsigned q0 = pk2(d[0], d[1]), q1 = pk2(d[2], d[3]);
        O[(4 * quad + 0) * CS_L2 + l15] = (bf16_t)(q0 & 0xffffu); O[(4 * quad + 1) * CS_L2 + l15] = (bf16_t)(q0 >> 16);
        O[(4 * quad + 2) * CS_L2 + l15] = (bf16_t)(q1 & 0xffffu); O[(4 * quad + 3) * CS_L2 + l15] = (bf16_t)(q1 >> 16);
    }
}
DI void phase_rw_scan2(const Params& p, const bf16_t* RKV, const bf16_t* XD0, const bf16_t* XD1, const bf16_t* AA0, const bf16_t* AA1, bf16_t* YF, bf16_t* YB, char* smem) {
    const int tid = TIDX(), lane = tid & 63, wv = __builtin_amdgcn_readfirstlane(tid >> 6), l15 = lane & 15, quad = lane >> 4;
    constexpr int NCH = 272;
    const u32x2 z2 = (u32x2){0u, 0u};
    for (int unit = blockIdx.x; unit < 256; unit += gridDim.x) {
        const int dir = unit & 1, b = unit >> 5, h = (unit >> 1) & 15;
        const bf16_t* XD = dir ? XD1 : XD0; const bf16_t* AA = dir ? AA1 : AA0; bf16_t* Y = dir ? YB : YF;
        __syncthreads();
        if (wv >= 4) {
            const int pw = wv - 4, j = lane;
            float kkj = p.in[I_RW_KK][h * 64 + j], kaj = p.in[I_RW_KA][h * 64 + j];
            asm volatile("s_waitcnt vmcnt(0)" : "+v"(kkj), "+v"(kaj) :: "memory");
            ScanRaw RA, RB_;
            scan_load_raw(RA, RKV, XD, AA, b, dir, h, j, pw, 0);
            scan_load_raw(RB_, RKV, XD, AA, b, dir, h, j, pw, 1);
            for (int c = -2; c < NCH; c += 2) {
#pragma unroll
                for (int half = 0; half < 2; ++half) {
                    const int cc = c + half, c2 = cc + 2, c1 = cc + 1;
                    if (c2 < NCH) {
                        const int cn = (c2 + 2 < NCH) ? c2 + 2 : NCH - 1;
                        if (half == 0) { scan_wait_raw(RA); scan_p1(RA, smem + (c2 % 3) * CS_P1, pw, j, kkj, kaj); scan_load_raw(RA, RKV, XD, AA, b, dir, h, j, pw, cn); }
                        else { scan_wait_raw(RB_); scan_p1(RB_, smem + (c2 % 3) * CS_P1, pw, j, kkj, kaj); scan_load_raw(RB_, RKV, XD, AA, b, dir, h, j, pw, cn); }
                    }
                    if (c1 >= 0 && c1 < NCH) scan_p2(smem + (c1 % 3) * CS_P1, smem + 3 * CS_P1 + (c1 & 1) * CS_P2, pw, l15, quad);
                    __syncthreads();
                }
            }
            asm volatile("s_waitcnt vmcnt(0)" ::: "memory");
        } else {
            const int w = wv;
            f32x4 ST[4];
#pragma unroll
            for (int jt = 0; jt < 4; ++jt) ST[jt] = (f32x4){0.f, 0.f, 0.f, 0.f};
            for (int c = -2; c < NCH; ++c) {
                if (c >= 0) {
                    int g0, step; scan_chunk_tokens(b, dir, c, g0, step);
                    const long ystep = (long)step * 1024;
                    bf16_t* yp = Y + (long)(g0 + 4 * quad * step) * 1024 + h * 64 + 16 * w + l15;
                    const char* s1 = smem + (c % 3) * CS_P1;
                    const char* s2 = smem + 3 * CS_P1 + (c & 1) * CS_P2;
                    const bf16_t* AT = (const bf16_t*)(s1 + CS_AT); const bf16_t* RT = (const bf16_t*)(s1 + CS_RT);
                    const bf16_t* BH = (const bf16_t*)(s1 + CS_BH); const bf16_t* KH = (const bf16_t*)(s1 + CS_KH); const bf16_t* VT = (const bf16_t*)(s1 + CS_VT);
                    const float* GL = (const float*)(s1 + CS_GL);
                    const float* NT = (const float*)(s2 + CS_NT); const bf16_t* AK = (const bf16_t*)(s2 + CS_AK);
                    const bf16_t* RB = (const bf16_t*)(s2 + CS_RB); const bf16_t* RK = (const bf16_t*)(s2 + CS_RK);
                    float Tr[16];
                    Tr[15] = (l15 == 15) ? 1.0f : 0.f;
#pragma unroll
                    for (int s = 14; s >= 0; --s) {
                        float a0 = (s == l15) ? 1.0f : 0.f, a1 = 0.f;
#pragma unroll
                        for (int u4 = 0; u4 < 4; ++u4) {
                            if (4 * u4 + 3 > s) {
                                const f32x4 nv = *(const f32x4*)(NT + s * 16 + 4 * u4);
#pragma unroll
                                for (int e = 0; e < 4; ++e) if (4 * u4 + e > s) { if (e & 1) a1 += Tr[4 * u4 + e] * nv[e]; else a0 += Tr[4 * u4 + e] * nv[e]; }
                            }
                        }
                        Tr[s] = a0 + a1;
                    }
                    u32x2 th, tl;
                    {
                        float tq[4];
                        const float m0 = (quad == 0) ? 1.0f : 0.f, m1 = (quad == 1) ? 1.0f : 0.f, m2 = (quad == 2) ? 1.0f : 0.f, m3 = (quad == 3) ? 1.0f : 0.f;
#pragma unroll
                        for (int e = 0; e < 4; ++e) tq[e] = (m0 * Tr[e] + m1 * Tr[4 + e]) + (m2 * Tr[8 + e] + m3 * Tr[12 + e]);
                        th.x = pk2(tq[0], tq[1]); th.y = pk2(tq[2], tq[3]);
                        tl.x = pk2(tq[0] - bflo(th.x), tq[1] - bfhi(th.x)); tl.y = pk2(tq[2] - bflo(th.y), tq[3] - bfhi(th.y));
                    }
                    bf16x8 sf[2];
#pragma unroll
                    for (int ks = 0; ks < 2; ++ks) { u32x2 lo, hi; lo.x = pk2(ST[2 * ks][0], ST[2 * ks][1]); lo.y = pk2(ST[2 * ks][2], ST[2 * ks][3]); hi.x = pk2(ST[2 * ks + 1][0], ST[2 * ks + 1][1]); hi.y = pk2(ST[2 * ks + 1][2], ST[2 * ks + 1][3]); sf[ks] = mk8(lo, hi); }
                    const u32x2 vfr = *(const u32x2*)(VT + (16 * w + l15) * CS_L2 + 4 * quad);
                    f32x4 X = (f32x4){0.f, 0.f, 0.f, 0.f}, Yv = X;
#pragma unroll
                    for (int ks = 0; ks < 2; ++ks) {
                        const bf16x8 af = mk8(*(const u32x2*)(AT + l15 * CS_L1 + 32 * ks + 4 * quad), *(const u32x2*)(AT + l15 * CS_L1 + 32 * ks + 16 + 4 * quad));
                        const bf16x8 rf = mk8(*(const u32x2*)(RT + l15 * CS_L1 + 32 * ks + 4 * quad), *(const u32x2*)(RT + l15 * CS_L1 + 32 * ks + 16 + 4 * quad));
                        X = __builtin_amdgcn_mfma_f32_16x16x32_bf16(af, sf[ks], X, 0, 0, 0);
                        Yv = __builtin_amdgcn_mfma_f32_16x16x32_bf16(rf, sf[ks], Yv, 0, 0, 0);
                    }
                    X = __builtin_amdgcn_mfma_f32_16x16x32_bf16(mk8(*(const u32x2*)(AK + l15 * CS_L2 + 4 * quad), z2), mk8(vfr, z2), X, 0, 0, 0);
                    u32x2 xh, xl;
                    {
                        xh.x = pk2(X[0], X[1]); xh.y = pk2(X[2], X[3]);
                        const float r0 = X[0] - bflo(xh.x), r1 = X[1] - bfhi(xh.x), r2 = X[2] - bflo(xh.y), r3 = X[3] - bfhi(xh.y);
                        xl.x = pk2(r0, r1); xl.y = pk2(r2, r3);
                    }
                    f32x4 U = (f32x4){0.f, 0.f, 0.f, 0.f};
                    U = __builtin_amdgcn_mfma_f32_16x16x32_bf16(mk8(th, tl), mk8(xh, xh), U, 0, 0, 0);
                    U = __builtin_amdgcn_mfma_f32_16x16x32_bf16(mk8(th, z2), mk8(xl, z2), U, 0, 0, 0);
                    u32x2 uf; uf.x = pk2(U[0], U[1]); uf.y = pk2(U[2], U[3]);
                    const bf16x8 uv = mk8(uf, vfr);
                    Yv = __builtin_amdgcn_mfma_f32_16x16x32_bf16(mk8(*(const u32x2*)(RB + l15 * CS_L2 + 4 * quad), *(const u32x2*)(RK + l15 * CS_L2 + 4 * quad)), uv, Yv, 0, 0, 0);
#pragma unroll
                    for (int jt = 0; jt < 4; ++jt) {
                        const f32x4 gl = *(const f32x4*)(GL + 16 * jt + 4 * quad);
                        const bf16x8 af = mk8(*(const u32x2*)(BH + (16 * jt + l15) * CS_L2 + 4 * quad), *(const u32x2*)(KH + (16 * jt + l15) * CS_L2 + 4 * quad));
                        ST[jt] = __builtin_amdgcn_mfma_f32_16x16x32_bf16(af, uv, ST[jt] * gl, 0, 0, 0);
                    }
#pragma unroll
                    for (int r = 0; r < 4; r += 2) { const unsigned yq = pk2(Yv[r], Yv[r + 1]); yp[(long)r * ystep] = (bf16_t)(yq & 0xffffu); yp[(long)(r + 1) * ystep] = (bf16_t)(yq >> 16); }
                }
                __syncthreads();
            }
        }
    }
}

DI void ld16f(const float* p, float* v) {
#pragma unroll
    for (int i = 0; i < 4; ++i) { const f32x4 t = *(const f32x4*)(p + 4 * i); v[4 * i] = t[0]; v[4 * i + 1] = t[1]; v[4 * i + 2] = t[2]; v[4 * i + 3] = t[3]; } }
DI void phase_rw_readout(const Params& p, const bf16_t* RKV, const bf16_t* AA0, const bf16_t* AA1, const bf16_t* G, const bf16_t* YF, const bf16_t* YB, bf16_t* Z) {
    const int lane = TIDX() & 63, gw = blockIdx.x * 8 + (TIDX() >> 6), nw = gridDim.x * 8, col = 16 * lane;
    float lng[16], lnb[16], ka[16], rk[16];
    ld16f(p.in[I_RW_LNG] + col, lng); ld16f(p.in[I_RW_LNB] + col, lnb); ld16f(p.in[I_RW_KA] + col, ka); ld16f(p.in[I_RW_RK] + col, rk);
    for (int g = gw; g < TT; g += nw) {
        float y[16], t[16], r[16], k[16], v[16], a0[16], a1[16], gg[16];
        ld16(YF + (size_t)g * 1024 + col, y); ld16(YB + (size_t)g * 1024 + col, t);
        ld16(RKV + (size_t)g * 3072 + col, r); ld16(RKV + (size_t)g * 3072 + 1024 + col, k); ld16(RKV + (size_t)g * 3072 + 2048 + col, v);
        ld16(AA0 + (size_t)g * 1024 + col, a0); ld16(AA1 + (size_t)g * 1024 + col, a1); ld16(G + (size_t)g * 1024 + col, gg);
        float sm = 0.f;
#pragma unroll
        for (int e = 0; e < 16; ++e) { y[e] += t[e]; sm += y[e]; }
        sm += __shfl_xor(sm, 1); sm += __shfl_xor(sm, 2);
        const float mu = sm * (1.0f / 64.0f);
        float sv = 0.f, bs = 0.f;
#pragma unroll
        for (int e = 0; e < 16; ++e) { y[e] -= mu; sv += y[e] * y[e];
            const float kt0 = k[e] * (1.0f + (a0[e] - 1.0f) * ka[e]), kt1 = k[e] * (1.0f + (a1[e] - 1.0f) * ka[e]);
            bs += r[e] * (kt0 + kt1) * rk[e]; }
        sv += __shfl_xor(sv, 1); sv += __shfl_xor(sv, 2); bs += __shfl_xor(bs, 1); bs += __shfl_xor(bs, 2);
        const float rs = rsqrtf(sv * (1.0f / 64.0f) + 64e-5f);
#pragma unroll
        for (int e = 0; e < 16; ++e) y[e] = (y[e] * rs * lng[e] + lnb[e] + bs * v[e]) * gg[e];
        st16(Z + (size_t)g * 1024 + col, y);
    }
}

DI void topk_sort(unsigned long long* keys, const float* src, int n) {
    const int tid = TIDX();
    __syncthreads();
    for (int i = tid; i < n; i += NTHR) keys[i] = ((unsigned long long)__float_as_uint(src[i]) << 32) | (unsigned long long)(0xFFFFFFFFu - (unsigned)i);
    __syncthreads();
    for (int k2 = 2; k2 <= n; k2 <<= 1)
        for (int j = k2 >> 1; j > 0; j >>= 1) {
            for (int pi = tid; pi < (n >> 1); pi += NTHR) {
                const int i = ((pi & ~(j - 1)) << 1) | (pi & (j - 1)), ix = i | j;
                const bool up = (i & k2) == 0;
                const unsigned long long a = keys[i], c = keys[ix];
                if (up ? (a < c) : (a > c)) { keys[i] = c; keys[ix] = a; }
            }
            __syncthreads();
        }
}
DI void topk_emit(const Bufs& B, const unsigned long long* keys, const bf16_t* H, bf16_t* XIN, int b, int e, bool isc, int c0, int cstep, int kcap) {
    const int tid = TIDX(), lane = tid & 63, wv = tid >> 6;
    for (int c = c0 + tid * cstep; c < kcap; c += NTHR * cstep) {
        const unsigned long long key = keys[c];
        const int idx = (int)(0xFFFFFFFFu - (unsigned)(key & 0xFFFFFFFFull));
        const int g = isc ? (TL + b * 256 + idx) : (b * 4096 + idx);
        const int er = isc ? (4096 + b * 32 + c) : (b * 512 + c);
        B.IDX[e * EROWS + er] = g; B.GATE[e * EROWS + er] = __uint_as_float((unsigned)(key >> 32)); B.INV[(size_t)g * 16 + e] = er;
    }
    for (int cb = c0 + wv * cstep; !GATHER_A && cb < kcap; cb += 32 * cstep) {
        u32x4 v0[4], v1[4];
#pragma unroll
        for (int k = 0; k < 4; ++k) {
            const int c = cb + 8 * cstep * k;
            if (c < kcap) {
                const int idx = (int)(0xFFFFFFFFu - (unsigned)(keys[c] & 0xFFFFFFFFull));
                const bf16_t* s = H + (size_t)(isc ? (TL + b * 256 + idx) : (b * 4096 + idx)) * 1024;
                v0[k] = *(const u32x4*)(s + lane * 8); v1[k] = *(const u32x4*)(s + 512 + lane * 8);
            }
        }
#pragma unroll
        for (int k = 0; k < 4; ++k) {
            const int c = cb + 8 * cstep * k;
            if (c < kcap) {
                const int er = isc ? (4096 + b * 32 + c) : (b * 512 + c);
                bf16_t* d = XIN + ((size_t)e * EROWS + er) * 1024;
                *(u32x4*)(d + lane * 8) = v0[k]; *(u32x4*)(d + 512 + lane * 8) = v1[k];
            }
        }
    }
}
constexpr int TOPK_LDS = 4096 * 8;
DI void topk_select(const Bufs& B, const float* src, int n, int kcap, int b, int e, bool isc, char* smem) {
    unsigned* hist = (unsigned*)smem; unsigned* scan = hist + 2048; unsigned* bc = scan + 512;
    const int tid = TIDX();
    const bool act = tid * 8 < n;
    unsigned v[8];
    {
        u32x4 a = (u32x4){0u, 0u, 0u, 0u}, c = a;
        if (act) { a = *(const u32x4*)(src + tid * 8); c = *(const u32x4*)(src + tid * 8 + 4); }
        v[0] = a.x; v[1] = a.y; v[2] = a.z; v[3] = a.w; v[4] = c.x; v[5] = c.y; v[6] = c.z; v[7] = c.w;
    }
    unsigned pval = 0u, pmask = 0u; int krem = kcap;
#pragma unroll
    for (int pass = 0; pass < 3; ++pass) {
        const int shift = (pass == 0) ? 21 : ((pass == 1) ? 10 : 0);
        const unsigned nb = (pass == 2) ? 1024u : 2048u;
        __syncthreads();
        for (unsigned i = tid; i < nb; i += NTHR) hist[i] = 0u;
        __syncthreads();
        if (act) {
#pragma unroll
            for (int i = 0; i < 8; ++i) if ((v[i] & pmask) == pval) atomicAdd(&hist[(v[i] >> shift) & (nb - 1u)], 1u);
        }
        __syncthreads();
        unsigned h4[4] = {0u, 0u, 0u, 0u};
        if ((unsigned)tid * 4u < nb) { const u32x4 hv = *(const u32x4*)(hist + tid * 4); h4[0] = hv.x; h4[1] = hv.y; h4[2] = hv.z; h4[3] = hv.w; }
        const unsigned sown = h4[0] + h4[1] + h4[2] + h4[3];
        scan[tid] = sown;
        __syncthreads();
        for (int d = 1; d < NTHR; d <<= 1) {
            const unsigned x = (tid + d < NTHR) ? scan[tid + d] : 0u;
            __syncthreads();
            scan[tid] += x;
            __syncthreads();
        }
        const unsigned sincl = scan[tid], sexcl = sincl - sown;
        if (sexcl < (unsigned)krem && (unsigned)krem <= sincl) {
            unsigned c = sexcl;
#pragma unroll
            for (int bi = 3; bi >= 0; --bi) {
                if (c < (unsigned)krem && c + h4[bi] >= (unsigned)krem) { bc[0] = (unsigned)(tid * 4 + bi); bc[1] = c; }
                c += h4[bi];
            }
        }
        __syncthreads();
        const unsigned beta = bc[0], above = bc[1];
        pval |= beta << shift; pmask |= (nb - 1u) << shift; krem -= (int)above;
    }
    unsigned ngt = 0u, neq = 0u;
    if (act) {
#pragma unroll
        for (int i = 0; i < 8; ++i) { ngt += (v[i] > pval) ? 1u : 0u; neq += (v[i] == pval) ? 1u : 0u; }
    }
    const unsigned packed = ngt | (neq << 16);
    __syncthreads();
    scan[tid] = packed;
    __syncthreads();
    for (int d = 1; d < NTHR; d <<= 1) {
        const unsigned x = (tid >= d) ? scan[tid - d] : 0u;
        __syncthreads();
        scan[tid] += x;
        __syncthreads();
    }
    const unsigned excl = scan[tid] - packed;
    unsigned g_before = excl & 0xffffu, e_before = excl >> 16;
    if (act) {
#pragma unroll
        for (int i = 0; i < 8; ++i) {
            const bool gt = v[i] > pval, eq = v[i] == pval;
            const bool take = gt || (eq && e_before < (unsigned)krem);
            if (take) {
                const unsigned eb = e_before < (unsigned)krem ? e_before : (unsigned)krem;
                const int slot = (int)(g_before + eb);
                const int idx = tid * 8 + i;
                const int g = isc ? (TL + b * 256 + idx) : (b * 4096 + idx);
                const int er = isc ? (4096 + b * 32 + slot) : (b * 512 + slot);
                B.IDX[e * EROWS + er] = g; B.GATE[e * EROWS + er] = __uint_as_float(v[i]); B.INV[(size_t)g * 16 + e] = er;
            }
            g_before += gt ? 1u : 0u; e_before += eq ? 1u : 0u;
        }
    }
}
#if GATHER_A
DI void phase_topk(const Bufs& B, const bf16_t* H, bf16_t* XIN, bool has_ctx, char* smem) {
    const int nl = has_ctx ? 256 : 128;
    for (int u = blockIdx.x; u < nl; u += gridDim.x) {
        const bool isc = u >= 128; const int li = u & 127, b = li >> 4, e = li & 15;
        if (!isc) topk_select(B, B.AFF + (size_t)(b * 16 + e) * 4096, 4096, 512, b, e, false, smem);
        else topk_select(B, B.AFFC + (size_t)(b * 16 + e) * 256, 256, 32, b, e, true, smem);
    }
}
#else
DI void phase_topk(const Bufs& B, const bf16_t* H, bf16_t* XIN, bool has_ctx, char* smem) {
    unsigned long long* keys = (unsigned long long*)smem;
    for (int u = blockIdx.x; u < 256; u += gridDim.x) {
        const int li = u & 127, b = li >> 4, e = li & 15, half = u >> 7;
        topk_sort(keys, B.AFF + (size_t)(b * 16 + e) * 4096, 4096);
        topk_emit(B, keys, H, XIN, b, e, false, half, 2, 512);
    }
    if (has_ctx) {
        for (int u = blockIdx.x; u < 128; u += gridDim.x) {
            const int b = u >> 4, e = u & 15;
            topk_sort(keys, B.AFFC + (size_t)(b * 16 + e) * 256, 256);
            topk_emit(B, keys, H, XIN, b, e, true, 0, 1, 32);
        }
    }
}
#endif
DI void phase_moe_gemm1(const Bufs& B, const bf16_t* XIN, bf16_t* HID, bool has_ctx, char* smem) {
#if USE_PG8
    pg8::Gemm g; g.A = GATHER_A ? B.slot(0) : XIN; g.Bt = B.W13; g.M = 16 * EROWS; g.N = 16 * 2048; g.K = 1024;
    pg8::GroupedOrder S; S.P = has_ctx ? 17 : 16; S.NT = 8; S.G = (int)gridDim.x; S.c = (int)blockIdx.x;
    pg8::PEpiSwiglu ep; ep.O = HID;
#if GATHER_A
    pg8::gemm_phase_gather<pg8::PEpiSwiglu, pg8::GroupedOrder>((LAS unsigned char*)smem, g, S, ep, B.IDX);
#else
    pg8::gemm_phase<pg8::PEpiSwiglu, pg8::GroupedOrder, false>((LAS unsigned char*)smem, g, S, ep, nullptr);
#endif
#else
    const int ntm = (has_ctx ? EROWS : 4096) >> 7, per = ntm * 16, nt = NEXP * per;
    for (int t = blockIdx.x; t < nt; t += gridDim.x) {
        const int e = t / per, r = t % per, tm = r >> 4, tn = r & 15;
        GemmOp g; g.A = XIN + (size_t)e * EROWS * 1024; g.lda = 1024; g.Bt = B.W13 + (size_t)e * 2048 * 1024; g.ldb = 1024; g.kbeg = 0; g.kend = 1024;
        EpiSwiglu ep; ep.O = HID + (size_t)e * EROWS * 1024;
        gemm_tile(g, tm * 128, tn * 128, ep, smem);
    }
#endif
}
DI void phase_moe_gemm2(const Bufs& B, const bf16_t* HID, bf16_t* Y, bool has_ctx, char* smem, int layer) {
#if USE_PG8
    pg8::Gemm g; g.A = HID; g.Bt = B.w2t(layer); g.M = 16 * EROWS; g.N = 16 * 1024; g.K = 1024;
    pg8::GroupedOrder S; S.P = has_ctx ? 17 : 16; S.NT = 4; S.G = (int)gridDim.x; S.c = (int)blockIdx.x;
    pg8::PEpiGate ep; ep.O = Y; ep.gate = B.GATE;
    pg8::gemm_phase<pg8::PEpiGate, pg8::GroupedOrder, false>((LAS unsigned char*)smem, g, S, ep, nullptr);
#else
    const int ntm = (has_ctx ? EROWS : 4096) >> 7, per = ntm * 8, nt = NEXP * per;
    for (int t = blockIdx.x; t < nt; t += gridDim.x) {
        const int e = t / per, r = t % per, tm = r >> 3, tn = r & 7;
        GemmOp g; g.A = HID + (size_t)e * EROWS * 1024; g.lda = 1024; g.Bt = B.w2t(layer) + (size_t)e * 1024 * 1024; g.ldb = 1024; g.kbeg = 0; g.kend = 1024;
        EpiGate ep; ep.O = Y + (size_t)e * EROWS * 1024; ep.gate = B.GATE + e * EROWS;
        gemm_tile(g, tm * 128, tn * 128, ep, smem);
    }
#endif
}
DI void phase_combine(const Params& p, const Bufs& B, int layer, const bf16_t* Y, int ntok, bool last, bool fuse_next, bf16_t* H) {
    const int lane = TIDX() & 63, gw = blockIdx.x * 8 + (TIDX() >> 6), nw = gridDim.x * 8;
    for (int g = gw; g < ntok; g += nw) {
        float acc[16];
#pragma unroll
        for (int e = 0; e < 16; ++e) acc[e] = 0.f;
        const int myc = B.INV[(size_t)g * 16 + (lane & 15)];
        unsigned sel = (unsigned)(__ballot(myc >= 0) & 0xFFFFull);
        while (sel) {
            const int e = __builtin_ctz(sel); sel &= sel - 1;
            const int c = __builtin_amdgcn_readlane(myc, e);
            const bf16_t* yr = Y + ((size_t)e * EROWS + c) * 1024 + 4 * lane;
#pragma unroll
            for (int i = 0; i < 4; ++i) { const u32x2 t = *(const u32x2*)(yr + 256 * i); acc[4 * i] += bflo(t.x); acc[4 * i + 1] += bfhi(t.x); acc[4 * i + 2] += bflo(t.y); acc[4 * i + 3] += bfhi(t.y); }
        }
        const float* gt = B.MOD + ((size_t)layer * 9 + modrow_of(g)) * 6144 + 5 * 1024;
        float* xr = B.X + (size_t)g * 1024;
#pragma unroll
        for (int i = 0; i < 4; ++i) {
            const f32x4 gv = *(const f32x4*)(gt + 256 * i + 4 * lane); f32x4 xv = *(const f32x4*)(xr + 256 * i + 4 * lane);
            xv[0] += gv[0] * acc[4 * i]; xv[1] += gv[1] * acc[4 * i + 1]; xv[2] += gv[2] * acc[4 * i + 2]; xv[3] += gv[3] * acc[4 * i + 3];
            if (last) *(f32x4*)(p.out + (size_t)g * 1024 + 256 * i + 4 * lane) = xv;
            else *(f32x4*)(xr + 256 * i + 4 * lane) = xv;
            acc[4 * i] = xv[0]; acc[4 * i + 1] = xv[1]; acc[4 * i + 2] = xv[2]; acc[4 * i + 3] = xv[3];
        }
        if (fuse_next) {
            const float* md = B.MOD + ((size_t)(layer + 1) * 9 + modrow_of(g)) * 6144;
            float gg[16], sh[16], sc[16];
            row_load_f32(p.in[I_N1G] + (layer + 1) * 1024, lane, gg); row_load_f32(md, lane, sh); row_load_f32(md + 1024, lane, sc);
            float ss = 0.f;
#pragma unroll
            for (int e = 0; e < 16; ++e) ss += acc[e] * acc[e];
            ss = wave_sum(ss);
            const float r = rsqrtf(ss * (1.0f / 1024.0f) + 1e-6f);
#pragma unroll
            for (int e = 0; e < 16; ++e) acc[e] = acc[e] * r * gg[e] * (1.0f + sc[e]) + sh[e];
            row_store_bf16(H + (size_t)g * 1024, lane, acc);
        }
    }
}


constexpr int AT2_STAGE = 64 * 104 * 2 + 64 * 72 * 2;
constexpr int AT2_BIAS = 2 * AT2_STAGE;
constexpr int ATT2_LDS = 2 * AT2_STAGE + 2048;
template <class P>
DI void attn_unit2(const P& pol, char* smem) {
    constexpr int DQK = P::DQK, KS = DQK + 8, VS = 72, NS = DQK / 32;
    const int tid = TIDX(), lane = tid & 63, w = tid >> 6, l15 = lane & 15, quad = lane >> 4;
    __syncthreads();
    if (__builtin_amdgcn_readfirstlane(tid) >= 256) __builtin_amdgcn_s_setprio(1);
    pol.prologue(smem + AT2_BIAS);
    bf16x8 qf[2][NS];
#pragma unroll
    for (int qg = 0; qg < 2; ++qg)
#pragma unroll
        for (int s = 0; s < NS; ++s) qf[qg][s] = *(const bf16x8*)pol.qptr(32 * w + 16 * qg + l15, s * 4 + quad);
    f32x4 o[2][4];
#pragma unroll
    for (int qg = 0; qg < 2; ++qg)
#pragma unroll
        for (int u = 0; u < 4; ++u) o[qg][u] = (f32x4){0.f, 0.f, 0.f, 0.f};
    float m[2] = {-1e30f, -1e30f}, l[2] = {0.f, 0.f};
    const int k0key = (DQK == 64) ? (tid >> 3) : (tid / 12), k0ch = (DQK == 64) ? (tid & 7) : (tid % 12);
    const int k1key = (tid + 512) / 12, k1ch = (tid + 512) % 12;
    const bool k1on = (DQK == 96) && (tid < 256);
    const int vkey = tid >> 3, vch = tid & 7;
    const int nt = pol.ntiles();
    u32x4 rk0, rk1 = (u32x4){0u, 0u, 0u, 0u}, rv;
    rk0 = *(const u32x4*)pol.kptr(0, k0key, k0ch);
    if (k1on) rk1 = *(const u32x4*)pol.kptr(0, k1key, k1ch);
    rv = *(const u32x4*)pol.vptr(0, vkey, vch);
    {
        bf16_t* Ks = (bf16_t*)smem; bf16_t* Vs = (bf16_t*)(smem + 64 * 104 * 2);
        *(u32x4*)(Ks + k0key * KS + k0ch * 8) = rk0;
        if (k1on) *(u32x4*)(Ks + k1key * KS + k1ch * 8) = rk1;
        *(u32x4*)(Vs + vkey * VS + vch * 8) = rv;
    }
    __syncthreads();
    for (int j = 0; j < nt; ++j) {
        const bool more = (j + 1 < nt);
        if (more) {
            rk0 = *(const u32x4*)pol.kptr(j + 1, k0key, k0ch);
            if (k1on) rk1 = *(const u32x4*)pol.kptr(j + 1, k1key, k1ch);
            rv = *(const u32x4*)pol.vptr(j + 1, vkey, vch);
        }
        const bf16_t* Ks = (const bf16_t*)(smem + (j & 1) * AT2_STAGE);
        const bf16_t* Vs = (const bf16_t*)(smem + (j & 1) * AT2_STAGE + 64 * 104 * 2);
        if (pol.needed(j, w)) {
            f32x4 sc[2][2][2];
#pragma unroll
            for (int g = 0; g < 2; ++g)
#pragma unroll
                for (int t = 0; t < 2; ++t) {
                    f32x4 a0 = (f32x4){0.f, 0.f, 0.f, 0.f}, a1 = a0;
                    const int key = 32 * g + 8 * (l15 >> 2) + 4 * t + (l15 & 3);
#pragma unroll
                    for (int s = 0; s < NS; ++s) {
                        const bf16x8 kf = *(const bf16x8*)(Ks + key * KS + 32 * s + 8 * quad);
                        a0 = __builtin_amdgcn_mfma_f32_16x16x32_bf16(kf, qf[0][s], a0, 0, 0, 0);
                        a1 = __builtin_amdgcn_mfma_f32_16x16x32_bf16(kf, qf[1][s], a1, 0, 0, 0);
                    }
                    sc[0][g][t] = a0; sc[1][g][t] = a1;
                    if (t == 1) __builtin_amdgcn_sched_barrier(0);
                }
            asm volatile("" ::: "memory");
            const bool plain = pol.plain(j);
            bf16x8 pf[2][2];
#pragma unroll
            for (int qg = 0; qg < 2; ++qg) {
                if (P::CANFIX && pol.fixed) {
                    if (!plain) {
#pragma unroll
                        for (int g = 0; g < 2; ++g)
#pragma unroll
                            for (int t = 0; t < 2; ++t)
#pragma unroll
                                for (int r = 0; r < 4; ++r) sc[qg][g][t][r] = pol.mod(sc[qg][g][t][r], 32 * w + 16 * qg + l15, j, 32 * g + 8 * quad + 4 * t + r);
                    }
                    const float c2f = plain ? pol.c2 : 1.0f;
                    float ps = 0.f;
#pragma unroll
                    for (int g = 0; g < 2; ++g) {
                        float pv[8];
#pragma unroll
                        for (int t = 0; t < 2; ++t)
#pragma unroll
                            for (int r = 0; r < 4; ++r) { const float e = fexp2(sc[qg][g][t][r] * c2f - pol.mfix); ps += e; pv[4 * t + r] = e; }
                        pf[qg][g] = __builtin_bit_cast(bf16x8, pack8(pv));
                    }
                    l[qg] += ps; m[qg] = pol.mfix;
                } else {
                float tmax = -3.0e38f;
                if (!plain) {
#pragma unroll
                    for (int g = 0; g < 2; ++g)
#pragma unroll
                        for (int t = 0; t < 2; ++t)
#pragma unroll
                            for (int r = 0; r < 4; ++r) sc[qg][g][t][r] = pol.mod(sc[qg][g][t][r], 32 * w + 16 * qg + l15, j, 32 * g + 8 * quad + 4 * t + r);
                }
#pragma unroll
                for (int g = 0; g < 2; ++g)
#pragma unroll
                    for (int t = 0; t < 2; ++t) tmax = fmaxf(fmaxf(tmax, fmaxf(sc[qg][g][t][0], sc[qg][g][t][1])), fmaxf(sc[qg][g][t][2], sc[qg][g][t][3]));
                tmax = quad_max(tmax);
                const float c2 = plain ? pol.c2 : 1.0f;
                const float mn = fmaxf(m[qg], tmax * c2);
                const float alpha = fexp2(m[qg] - mn);
                m[qg] = mn;
                float ps = 0.f;
#pragma unroll
                for (int g = 0; g < 2; ++g) {
                    float pv[8];
#pragma unroll
                    for (int t = 0; t < 2; ++t)
#pragma unroll
                        for (int r = 0; r < 4; ++r) { const float e = fexp2(sc[qg][g][t][r] * c2 - mn); ps += e; pv[4 * t + r] = e; }
                    pf[qg][g] = __builtin_bit_cast(bf16x8, pack8(pv));
                }
                l[qg] = l[qg] * alpha + ps;
                if (__any(alpha != 1.0f)) {
#pragma unroll
                    for (int u = 0; u < 4; ++u) o[qg][u] *= alpha;
                }
                }
            }
            asm volatile("" ::: "memory");
#pragma unroll
            for (int u = 0; u < 4; ++u)
#pragma unroll
                for (int g = 0; g < 2; ++g) {
                    const bf16_t* vb = Vs + (32 * g + 8 * quad + (l15 >> 2)) * VS + 16 * u + 4 * (l15 & 3);
                    const s16x4 lo = tr_read(vb), hi = tr_read(vb + 4 * VS);
                    bf16x8 vf; vf[0] = lo[0]; vf[1] = lo[1]; vf[2] = lo[2]; vf[3] = lo[3]; vf[4] = hi[0]; vf[5] = hi[1]; vf[6] = hi[2]; vf[7] = hi[3];
                    o[0][u] = __builtin_amdgcn_mfma_f32_16x16x32_bf16(vf, pf[0][g], o[0][u], 0, 0, 0);
                    o[1][u] = __builtin_amdgcn_mfma_f32_16x16x32_bf16(vf, pf[1][g], o[1][u], 0, 0, 0);
                }
            asm volatile("" ::: "memory");
        }
        if (more) {
            bf16_t* Kn = (bf16_t*)(smem + ((j + 1) & 1) * AT2_STAGE); bf16_t* Vn = (bf16_t*)(smem + ((j + 1) & 1) * AT2_STAGE + 64 * 104 * 2);
            *(u32x4*)(Kn + k0key * KS + k0ch * 8) = rk0;
            if (k1on) *(u32x4*)(Kn + k1key * KS + k1ch * 8) = rk1;
            *(u32x4*)(Vn + vkey * VS + vch * 8) = rv;
        }
        __syncthreads();
    }
#pragma unroll
    for (int qg = 0; qg < 2; ++qg) {
        float lt = l[qg];
        lt = quad_sum(lt);
        if (P::SINK) lt += fexp2(pol.sink2 - m[qg]);
        const float il = 1.0f / lt;
        bf16_t* op = pol.optr(32 * w + 16 * qg + l15);
#pragma unroll
        for (int u = 0; u < 4; ++u) st_bf16x4(op + 16 * u + 4 * quad, o[qg][u] * il);
    }
    __builtin_amdgcn_s_setprio(0);
}

struct Pol2Plain64 {
    static constexpr int DQK = 64; static constexpr bool SINK = false; static constexpr bool CANFIX = true;
    const bf16_t* Qb; long qs; const bf16_t* Kb; long ks; const bf16_t* Vb; long vs; bf16_t* Ob; long os; int qrow0, krow0, nt; float c2, sink2, mfix; bool fixed;
    DI void prologue(char*) const {}
    DI int ntiles() const { return nt; }
    DI bool needed(int, int) const { return true; }
    DI bool plain(int) const { return true; }
    DI const bf16_t* qptr(int q, int ch) const { return Qb + (long)(qrow0 + q) * qs + ch * 8; }
    DI const bf16_t* kptr(int j, int i, int ch) const { return Kb + (long)(krow0 + 64 * j + i) * ks + ch * 8; }
    DI const bf16_t* vptr(int j, int i, int ch) const { return Vb + (long)(krow0 + 64 * j + i) * vs + ch * 8; }
    DI float mod(float s, int, int, int) const { return s * c2; }
    DI bf16_t* optr(int q) const { return Ob + (long)(qrow0 + q) * os; }
};
struct Pol2NA {
    static constexpr int DQK = 64; static constexpr bool SINK = false; static constexpr bool CANFIX = true;
    const bf16_t* QKV; bf16_t* AO; const float* rpb; const float* bl; int b, h, rq, rbase; float c2, sink2, mfix; bool fixed;
    DI void prologue(char* s) const { float* t = (float*)s; for (int i = TIDX(); i < 465; i += NTHR) t[i] = rpb[h * 465 + i] * LOG2E; }
    DI int ntiles() const { return 15; }
    DI bool plain(int j) const { return j < 4; }
    DI bool needed(int j, int w) const {
        if (j < 4) return true;
        const int kr = rbase + j - 4, qr = 4 * rq + (w >> 1);
        int r0 = qr - 4; r0 = r0 < 0 ? 0 : (r0 > 56 ? 56 : r0);
        return (kr >= r0) && (kr <= r0 + 7);
    }
    DI int qtok(int q) const { return b * 4096 + (4 * rq + (q >> 6)) * 64 + (q & 63); }
    DI int ktok(int j, int i) const { if (j < 4) return TL + b * 256 + 64 * j + i; int kr = rbase + j - 4; kr = kr > 63 ? 63 : kr; return b * 4096 + kr * 64 + i; }
    DI const bf16_t* qptr(int q, int ch) const { return QKV + (long)qtok(q) * 3072 + h * 64 + ch * 8; }
    DI const bf16_t* kptr(int j, int i, int ch) const { return QKV + (long)ktok(j, i) * 3072 + 1024 + h * 64 + ch * 8; }
    DI const bf16_t* vptr(int j, int i, int ch) const { return QKV + (long)ktok(j, i) * 3072 + 2048 + h * 64 + ch * 8; }
    DI float mod(float s, int q, int j, int kc) const {
        const int kr = rbase + j - 4, qr = 4 * rq + (q >> 6), qc = q & 63;
        int c0 = qc - 8; c0 = c0 < 0 ? 0 : (c0 > 48 ? 48 : c0);
        const bool ok = (kc >= c0) && (kc < c0 + 16);
        const int idx = ok ? ((kr - qr + 7) * 31 + (kc - qc + 15)) : 0;
        return ok ? (s * c2 + bl[idx]) : -1e30f;
    }
    DI bf16_t* optr(int q) const { return AO + (long)qtok(q) * 1024 + h * 64; }
};
struct Pol2MLA {
    static constexpr int DQK = 96; static constexpr bool SINK = false; static constexpr bool CANFIX = true;
    const bf16_t* Q; const bf16_t* KV; const bf16_t* KR; bf16_t* AO; int b, h, qrow0, nt; float c2, sink2, mfix; bool fixed;
    DI void prologue(char*) const {}
    DI int ntiles() const { return nt; }
    DI bool needed(int, int) const { return true; }
    DI bool plain(int) const { return true; }
    DI int ktok(int j, int i) const { return (j < 4) ? (TL + b * 256 + 64 * j + i) : (b * 4096 + 64 * (j - 4) + i); }
    DI const bf16_t* qptr(int q, int ch) const { return Q + (long)(qrow0 + q) * 1536 + h * 96 + ch * 8; }
    DI const bf16_t* kptr(int j, int i, int ch) const { const long t = ktok(j, i); return (ch < 8) ? (KV + t * 2048 + h * 128 + ch * 8) : (KR + t * 32 + (ch - 8) * 8); }
    DI const bf16_t* vptr(int j, int i, int ch) const { return KV + (long)ktok(j, i) * 2048 + h * 128 + 64 + ch * 8; }
    DI float mod(float s, int, int, int) const { return s * c2; }
    DI bf16_t* optr(int q) const { return AO + (long)(qrow0 + q) * 1024 + h * 64; }
};
struct Pol2SWA {
    static constexpr int DQK = 64; static constexpr bool SINK = true; static constexpr bool CANFIX = true;
    const bf16_t* QKV; bf16_t* AO; int b, hq, s0; float c2, sink2, mfix; bool fixed;
    DI void prologue(char*) const {}
    DI int ntiles() const { return 12; }
    DI bool plain(int j) const { return j < 4; }
    DI bool needed(int j, int w) const { if (j < 4) return true; const int jj = j - 4; return (64 * jj + 63 >= 32 * w) && (64 * jj <= 32 * w + 287); }
    DI int ktok(int j, int i) const { if (j < 4) return TL + b * 256 + 64 * j + i; int kp = s0 - 128 + 64 * (j - 4) + i; kp = kp < 0 ? 0 : (kp > 4095 ? 4095 : kp); return b * 4096 + kp; }
    DI const bf16_t* qptr(int q, int ch) const { return QKV + (long)(b * 4096 + s0 + q) * 1536 + hq * 64 + ch * 8; }
    DI const bf16_t* kptr(int j, int i, int ch) const { return QKV + (long)ktok(j, i) * 1536 + 1024 + (hq >> 2) * 64 + ch * 8; }
    DI const bf16_t* vptr(int j, int i, int ch) const { return QKV + (long)ktok(j, i) * 1536 + 1280 + (hq >> 2) * 64 + ch * 8; }
    DI float mod(float s, int q, int j, int kc) const {
        const int kp = s0 - 128 + 64 * (j - 4) + kc, d = s0 + q - kp;
        const bool ok = (kp >= 0) && (kp < 4096) && (d <= 128) && (d >= -128);
        return ok ? s * c2 : -1e30f;
    }
    DI bf16_t* optr(int q) const { return AO + (long)(b * 4096 + s0 + q) * 1024 + hq * 64; }
};
DI int attn_unit_xcd(int i, int units_per_pair  , bool ctx_units) {
    if (gridDim.x != 256) { const int u = i * (int)gridDim.x + (int)blockIdx.x; return (u < 2048 + (ctx_units ? 128 : 0)) ? u : -1; }
    const int x = blockIdx.x & 7, Lx = i * 32 + ((int)blockIdx.x >> 3);
    if (Lx < 256) return (16 * x + (Lx >> 4)) * 16 + (Lx & 15);
    if (ctx_units && Lx < 272) return 2048 + 16 * x + (Lx - 256);
    return -1;
}
DI float head64_score_bound(const float* qg, const float* kg) {
    float a = 0.f, b = 0.f;
    for (int i = 0; i < 64; ++i) { a = fmaxf(a, fabsf(qg[i])); b = fmaxf(b, fabsf(kg[i])); }
    return 1.02f * 0.125f * LOG2E * 64.0f * a * b;
}
DI void phase_attn2_na(const Params& p, const bf16_t* QKV, bf16_t* AO, char* smem) {
    float bmax = 0.f;
    {
        float* red = (float*)smem;
        float v = 0.f;
        for (int i = TIDX(); i < 16 * 465; i += NTHR) v = fmaxf(v, fabsf(p.in[I_NA_RPB][i]));
        __syncthreads();
        red[TIDX()] = v;
        __syncthreads();
        for (int i = 0; i < NTHR; ++i) bmax = fmaxf(bmax, red[i]);
        __syncthreads();
    }
    const float sb = head64_score_bound(p.in[I_NA_QG], p.in[I_NA_KG]);
    const float mfix_l = sb + bmax * LOG2E, mfix_c = sb;
    const bool fixed = mfix_l < 60.0f;
    for (int it = 0;; ++it) {
        const int u = attn_unit_xcd(it, 16, true); if (u < 0) break;
        if (u < 2048) {
            Pol2NA pol; pol.QKV = QKV; pol.AO = AO; pol.rpb = p.in[I_NA_RPB]; pol.bl = (const float*)(smem + AT2_BIAS);
            pol.b = u >> 8; pol.h = (u >> 4) & 15; pol.rq = u & 15;
            int rb = 4 * pol.rq - 4; rb = rb < 0 ? 0 : (rb > 56 ? 56 : rb); pol.rbase = rb;
            pol.c2 = 0.125f * LOG2E; pol.sink2 = 0.f; pol.mfix = mfix_l; pol.fixed = fixed;
            attn_unit2(pol, smem);
        } else {
            const int v = u - 2048, b = v >> 4, h = v & 15;
            Pol2Plain64 pol; pol.Qb = QKV + h * 64; pol.qs = 3072; pol.Kb = QKV + 1024 + h * 64; pol.ks = 3072; pol.Vb = QKV + 2048 + h * 64; pol.vs = 3072;
            pol.Ob = AO + h * 64; pol.os = 1024; pol.qrow0 = TL + b * 256; pol.krow0 = TL + b * 256; pol.nt = 4; pol.c2 = 0.125f * LOG2E; pol.sink2 = 0.f; pol.mfix = mfix_c; pol.fixed = fixed;
            attn_unit2(pol, smem);
        }
    }
}
DI void phase_attn2_mla(const Params& p, const bf16_t* Q, const bf16_t* KV, const bf16_t* KR, bf16_t* AO, char* smem) {
    float gq = 0.f, gqr = 0.f, gk = 0.f, gkr = 0.f;
    for (int i = 0; i < 64; ++i) { gq = fmaxf(gq, fabsf(p.in[I_MLA_QN_G][i])); gk = fmaxf(gk, fabsf(p.in[I_MLA_KN_G][i])); }
    for (int i = 0; i < 32; ++i) { gqr = fmaxf(gqr, fabsf(p.in[I_MLA_QR_G][i])); gkr = fmaxf(gkr, fabsf(p.in[I_MLA_KR_G][i])); }
    const float mfix = 1.02f * 0.10206207261596575f * LOG2E * sqrtf(64.f * gq * gq + 32.f * gqr * gqr) * sqrtf(64.f * gk * gk + 32.f * gkr * gkr);
    const bool fixed = mfix < 60.0f;
    for (int it = 0;; ++it) {
        const int u = attn_unit_xcd(it, 16, true); if (u < 0) break;
        Pol2MLA pol; pol.Q = Q; pol.KV = KV; pol.KR = KR; pol.AO = AO; pol.c2 = 0.10206207261596575f * LOG2E; pol.sink2 = 0.f;
        pol.mfix = mfix; pol.fixed = fixed;
        if (u < 2048) { pol.b = u >> 8; pol.h = (u >> 4) & 15; pol.qrow0 = pol.b * 4096 + 256 * (u & 15); pol.nt = 68; }
        else { const int v = u - 2048; pol.b = v >> 4; pol.h = v & 15; pol.qrow0 = TL + pol.b * 256; pol.nt = 4; }
        attn_unit2(pol, smem);
    }
}
DI void phase_attn2_swa(const Params& p, const bf16_t* QKV, bf16_t* AO, char* smem) {
    const float mfix = head64_score_bound(p.in[I_SWA_QG], p.in[I_SWA_KG]);
    const bool fixed = mfix < 60.0f;
    for (int it = 0;; ++it) {
        const int u = attn_unit_xcd(it, 16, false); if (u < 0) break;
        Pol2SWA pol; pol.QKV = QKV; pol.AO = AO; pol.b = u >> 8; pol.hq = (u >> 4) & 15; pol.s0 = 256 * (u & 15);
        pol.c2 = 0.125f * LOG2E; pol.sink2 = p.in[I_SWA_SINK][pol.hq] * LOG2E; pol.mfix = mfix; pol.fixed = fixed;
        attn_unit2(pol, smem);
    }
}

template <class Epi>
DI void pg8_gemm(const bf16_t* A, const bf16_t* Bt, int M, int N, int K, const Epi& e, char* smem) {
    pg8::Gemm g; g.A = A; g.Bt = Bt; g.M = M; g.N = N; g.K = K;
    pg8::StaticOrder S; S.init(M, N, (int)gridDim.x, (int)blockIdx.x);
    pg8::gemm_phase<Epi, pg8::StaticOrder, false>((LAS unsigned char*)smem, g, S, e, nullptr);
}

DI void phase_attn_na(const Params& p, const bf16_t* QKV, bf16_t* AO, char* smem) {
    for (int u = blockIdx.x; u < 4096 + 256; u += gridDim.x) {
        if (u < 4096) {
            PolNA pol; pol.QKV = QKV; pol.AO = AO; pol.rpb = p.in[I_NA_RPB]; pol.bl = (const float*)(smem + 64 * 104 * 2 + 64 * 72 * 2);
            pol.b = u >> 9; pol.h = (u >> 5) & 15; pol.rr = u & 31;
            int rb = 2 * pol.rr - 4; rb = rb < 0 ? 0 : (rb > 56 ? 56 : rb); pol.rbase = rb;
            pol.c2 = 0.125f * LOG2E; pol.sink2 = 0.f;
            attn_unit(pol, smem);
        } else {
            const int v = u - 4096, b = v >> 5, h = (v >> 1) & 15, half = v & 1;
            PolPlain64 pol; pol.Qb = QKV + h * 64; pol.qs = 3072; pol.Kb = QKV + 1024 + h * 64; pol.ks = 3072; pol.Vb = QKV + 2048 + h * 64; pol.vs = 3072;
            pol.Ob = AO + h * 64; pol.os = 1024; pol.qrow0 = TL + b * 256 + 128 * half; pol.krow0 = TL + b * 256; pol.nt = 4; pol.c2 = 0.125f * LOG2E; pol.sink2 = 0.f;
            attn_unit(pol, smem);
        }
    }
}
DI void phase_attn_mla(const bf16_t* Q, const bf16_t* KV, const bf16_t* KR, bf16_t* AO, char* smem) {
    for (int u = blockIdx.x; u < 4096 + 256; u += gridDim.x) {
        PolMLA pol; pol.Q = Q; pol.KV = KV; pol.KR = KR; pol.AO = AO; pol.c2 = 0.10206207261596575f * LOG2E; pol.sink2 = 0.f;
        if (u < 4096) { pol.b = u >> 9; pol.h = (u >> 5) & 15; pol.qrow0 = pol.b * 4096 + 128 * (u & 31); pol.nt = 68; }
        else { const int v = u - 4096; pol.b = v >> 5; pol.h = (v >> 1) & 15; pol.qrow0 = TL + pol.b * 256 + 128 * (v & 1); pol.nt = 4; }
        attn_unit(pol, smem);
    }
}
DI void phase_attn_swa(const Params& p, const bf16_t* QKV, bf16_t* AO, char* smem) {
    for (int u = blockIdx.x; u < 4096; u += gridDim.x) {
        PolSWA pol; pol.QKV = QKV; pol.AO = AO; pol.b = u >> 9; pol.hq = (u >> 5) & 15; pol.s0 = 128 * (u & 31);
        pol.c2 = 0.125f * LOG2E; pol.sink2 = p.in[I_SWA_SINK][pol.hq] * LOG2E;
        attn_unit(pol, smem);
    }
}


DI void wo_phase(const Params& p, const Bufs& B, int layer, const bf16_t* A, const bf16_t* Wt, char* smem) {
    const float* gate = B.MOD + (size_t)layer * 9 * 6144 + 2 * 1024;
    pg8::PEpiResidual e; e.X = B.X; e.gate = gate;
    e.Xl = (layer == 0) ? p.in[I_X] : B.X; e.Xc = (layer == 0) ? p.in[I_CTX] : (B.X + (size_t)TL * 1024);
    pg8_gemm(A, Wt, TL, 1024, 1024, e, smem);
    __syncthreads();
    GemmOp g; g.A = A + (size_t)TL * 1024; g.lda = 1024; g.Bt = Wt; g.ldb = 1024; g.kbeg = 0; g.kend = 1024;
    EpiResidualCtx ec; ec.Xout = B.X + (size_t)TL * 1024; ec.Xin = (layer == 0) ? p.in[I_CTX] : (B.X + (size_t)TL * 1024); ec.gate = gate + (size_t)8 * 6144;
    gemm_all(g, TC, 1024, ec, smem);
}

constexpr int N_PHASES = 44;
constexpr int LDS_BYTES = 131072;
static_assert(GT_LDS <= LDS_BYTES && SCAN_LDS <= LDS_BYTES && ATT_LDS <= LDS_BYTES && TOPK_LDS <= LDS_BYTES && 65536 <= LDS_BYTES, "lds");

template <int SUB>
DI void moe_phase(const Params& p, const Bufs& B, int layer, char* smem) {
    const bool has_ctx = layer < 3;
    const int ntok = has_ctx ? TT : TL;
    bf16_t* H = B.slot(0); bf16_t* XIN = B.slot(1); bf16_t* HID = B.slot(3); bf16_t* Y = B.slot(1);
    if constexpr (SUB == 0) phase_norm2(p, B, layer, H, ntok, smem);
    else if constexpr (SUB == 1) phase_topk(B, H, XIN, has_ctx, smem);
    else if constexpr (SUB == 2) {
        phase_moe_gemm1(B, XIN, HID, has_ctx, smem);
        if (USE_PG8 && layer < 3) {
            const bool split = (gridDim.x == 256);
            const int li = (int)blockIdx.x >> 3;
            if (!split || li >= 16) { __syncthreads(); int base = 0; conv_moe_layer(p, B, layer + 1, base, smem, 2, split ? (li - 16) * 8 + ((int)blockIdx.x & 7) : -1, split ? 128 : 0); }
        }
    }
    else if constexpr (SUB == 3) {
        phase_moe_gemm2(B, HID, Y, has_ctx, smem, layer);
        if (USE_PG8 && layer < 3) {
            const bool split = (gridDim.x == 256);
            const int li = (int)blockIdx.x >> 3;
            if (!split || li >= 8) { __syncthreads(); int base = 0; conv_moe_layer(p, B, layer + 1, base, smem, 1, split ? (li - 8) * 8 + ((int)blockIdx.x & 7) : -1, split ? 192 : 0); }
        }
    }
    else { phase_combine(p, B, layer, Y, ntok, layer == 3, layer == 1 || layer == 2, H); if (!USE_PG8 && layer < 3) { int base = 0; conv_moe_layer(p, B, layer + 1, base, smem, 0); } }
}

template <int PH>
DI void run_phase(const Params& p, char* smem) {
    const Bufs B = make_bufs(p);
    bf16_t* H = B.slot(0);
    if constexpr (PH == 0) phase_prologue(p, B, smem);
    else if constexpr (PH == 1) phase_norm1(p, B, 0, H);
    else if constexpr (PH == 2) { pg8::PEpiQKNorm e; e.O = B.slot(1); e.ldo = 3072; e.nq = 4; e.nk = 8; e.qg = p.in[I_NA_QG]; e.kg = p.in[I_NA_KG]; e.rope = nullptr; pg8_gemm(H, B.WMIX + W_NA_QKV, TT, 3072, 1024, e, smem); }
    else if constexpr (PH == 3) {   }
    else if constexpr (PH == 4) phase_attn2_na(p, B.slot(1), B.slot(4), smem);
    else if constexpr (PH == 5) wo_phase(p, B, 0, B.slot(4), B.WMIX + W_NA_WO, smem);
    else if constexpr (PH >= 6 && PH <= 10) moe_phase<PH - 6>(p, B, 0, smem);
    else if constexpr (PH == 11) phase_norm1_rw(p, B, 1, B.slot(0));
    else if constexpr (PH == 12) { pg8::PEpiRW1 e; e.RKV = B.slot(2); e.LORA = B.slot(5); pg8_gemm(B.slot(0), B.WMIX + W_RW_B1, TT, 3584, 2048, e, smem); }
    else if constexpr (PH == 13) phase_rw_gemm2(p, B, B.slot(5), B.slot(0), B.slot(1), B.slot(6), B.slot(7), B.slot(8), smem);
    else if constexpr (PH == 14) {
#if USE_SCAN2
        phase_rw_scan2(p, B.slot(2), B.slot(1), B.slot(6), B.slot(7), B.slot(8), B.slot(9), B.slot(5), smem);
#else
        phase_rw_scan(p, B.slot(2), B.slot(1), B.slot(6), B.slot(7), B.slot(8), B.slot(9), B.slot(5), smem);
#endif
    }
    else if constexpr (PH == 15) phase_rw_readout(p, B.slot(2), B.slot(7), B.slot(8), B.slot(0), B.slot(9), B.slot(5), B.slot(1));
    else if constexpr (PH == 16) wo_phase(p, B, 1, B.slot(1), B.WMIX + W_RW_WO, smem);
    else if constexpr (PH >= 17 && PH <= 21) moe_phase<PH - 17>(p, B, 1, smem);
    else if constexpr (PH == 22) {   }
    else if constexpr (PH == 23) { pg8::PEpiBf16 e; e.O = B.slot(1); e.ldo = 768; pg8_gemm(H, B.WMIX + W_MLA_DOWN, TT, 768, 1024, e, smem); }
    else if constexpr (PH == 24) { bf16_t* CQ = B.slot(3); phase_mla_dnorm(p, B, B.slot(1), CQ, CQ + (size_t)TT * 384, CQ + (size_t)TT * 640); }
    else if constexpr (PH == 25) {
        bf16_t* CQ = B.slot(3);
        { pg8::PEpiBf16 e; e.O = B.slot(4); e.ldo = 1536; pg8_gemm(CQ, B.WMIX + W_MLA_UQ, TT, 1536, 384, e, smem); }
        { pg8::PEpiBf16 e; e.O = B.slot(6); e.ldo = 2048; pg8_gemm(CQ + (size_t)TT * 384, B.WMIX + W_MLA_UKV, TT, 2048, 256, e, smem); }
    }
    else if constexpr (PH == 26) phase_mla_hnorm(p, B, B.slot(4), B.slot(6));
    else if constexpr (PH == 27) phase_attn2_mla(p, B.slot(4), B.slot(6), B.slot(3) + (size_t)TT * 640, B.slot(8), smem);
    else if constexpr (PH == 28) wo_phase(p, B, 2, B.slot(8), B.WMIX + W_MLA_WO, smem);
    else if constexpr (PH >= 29 && PH <= 33) moe_phase<PH - 29>(p, B, 2, smem);
    else if constexpr (PH == 34) {   }
    else if constexpr (PH == 35) { pg8::PEpiQKNorm e; e.O = B.slot(1); e.ldo = 1536; e.nq = 4; e.nk = 5; e.qg = p.in[I_SWA_QG]; e.kg = p.in[I_SWA_KG]; e.rope = B.ROPE_S; pg8_gemm(H, B.WMIX + W_SWA_QKV, TT, 1536, 1024, e, smem); }
    else if constexpr (PH == 36) {   }
    else if constexpr (PH == 37) phase_attn2_swa(p, B.slot(1), B.slot(3), smem);
    else if constexpr (PH == 38) { pg8::PEpiResidual e; e.X = B.X; e.Xl = B.X; e.Xc = B.X + (size_t)TL * 1024; e.gate = B.MOD + (size_t)3 * 9 * 6144 + 2 * 1024; pg8_gemm(B.slot(3), B.WMIX + W_SWA_WO, TL, 1024, 1024, e, smem); }
    else if constexpr (PH >= 39 && PH <= 43) moe_phase<PH - 39>(p, B, 3, smem);
}

#define XB_TMO      128
#define XB_XCNT(j)  (256  + 64 * (j))
#define XB_XSUB(j)  (1280 + 64 * (j))
#define XB_XGEN(j)  (2304 + 64 * (j))
#define XB_TOP      3328
#define XB_TOPGEN   3392
#define XCD_BAR_WORDS 3456
#define XB_SPIN_CAP (1u << 18)

__device__ __forceinline__ unsigned xb_ld(unsigned* p)              { return __hip_atomic_load(p, __ATOMIC_RELAXED, __HIP_MEMORY_SCOPE_AGENT); }
__device__ __forceinline__ unsigned xb_add(unsigned* p, unsigned v) { return __hip_atomic_fetch_add(p, v, __ATOMIC_RELAXED, __HIP_MEMORY_SCOPE_AGENT); }
__device__ __forceinline__ unsigned xb_xcc_id() { return (unsigned)__builtin_amdgcn_s_getreg((3 << 11) | 20) & 0xFu; }
#define XB_SPIN(cond, bar) do { unsigned _sp = 0; while (cond) { __builtin_amdgcn_s_sleep(1); \
    if ((++_sp & 255u) == 0u) { if (xb_ld(&(bar)[XB_TMO])) break; if (_sp > XB_SPIN_CAP) { atomicAdd(&(bar)[XB_TMO], 1u); break; } } } } while (0)

struct XcdBarrier {
    unsigned* bar; unsigned x;
    volatile LAS unsigned* st;
};

__device__ __forceinline__ XcdBarrier xcd_barrier_post(unsigned* bar, volatile LAS unsigned* st) {
    XcdBarrier b; b.bar = bar; b.x = xb_xcc_id(); b.st = st;
    if (TIDX() == 0) (void)xb_add(&bar[XB_XCNT(b.x)], 1u);
    return b;
}
__device__ __forceinline__ void xcd_barrier_complete(unsigned* bar, unsigned x, unsigned& nloc, unsigned& nx) {
    const unsigned G = gridDim.x * gridDim.y * gridDim.z;
    unsigned sum, cnt, mine, sp = 0u;
    for (;;) {
        sum = 0u; cnt = 0u; mine = 0u;
#pragma unroll
        for (unsigned j = 0; j < 16; ++j) { const unsigned c = xb_ld(&bar[XB_XCNT(j)]); sum += c; cnt += (c > 0u) ? 1u : 0u; mine = (j == x) ? c : mine; }
        if (sum == G) break;
        __builtin_amdgcn_s_sleep(1);
        if ((++sp & 255u) == 0u) { if (xb_ld(&bar[XB_TMO])) break; if (sp > XB_SPIN_CAP) { atomicAdd(&bar[XB_TMO], 1u); break; } }
    }
    nloc = mine > 0u ? mine : 1u; nx = cnt > 0u ? cnt : 1u;
}

__device__ __forceinline__ void xcd_barrier(const XcdBarrier& b) {
    asm volatile("s_waitcnt vmcnt(0)" ::: "memory");
    __syncthreads();
    if (TIDX() == 0) {
        unsigned* bar = b.bar;
        __builtin_amdgcn_s_waitcnt(0);
        unsigned nloc = b.st[0], nx = b.st[1];
        if (nloc == 0u) { xcd_barrier_complete(bar, b.x, nloc, nx); b.st[0] = nloc; b.st[1] = nx; }
        const unsigned old = xb_add(&bar[XB_XSUB(b.x)], 1u);
        const unsigned gen = old / nloc;
        if (old + 1u == (gen + 1u) * nloc) {
            __builtin_amdgcn_fence(__ATOMIC_RELEASE, "agent");
            asm volatile("s_waitcnt vmcnt(0)" ::: "memory");
            const unsigned og = xb_add(&bar[XB_TOP], 1u);
            const unsigned tg = og / nx;
            if (og + 1u == (tg + 1u) * nx) xb_add(&bar[XB_TOPGEN], 1u);
            else XB_SPIN(xb_ld(&bar[XB_TOPGEN]) == tg, bar);
            __builtin_amdgcn_fence(__ATOMIC_ACQUIRE, "agent");
            xb_add(&bar[XB_XGEN(b.x)], 1u);
            asm volatile("s_waitcnt vmcnt(0)" ::: "memory");
        } else {
            XB_SPIN(xb_ld(&bar[XB_XGEN(b.x)]) == gen, bar);
            __builtin_amdgcn_fence(__ATOMIC_ACQUIRE, "agent");
            asm volatile("s_waitcnt vmcnt(0)" ::: "memory");
        }
    }
    __syncthreads();
}

constexpr int LDS_REQ = 147456;

#if MULTI_LAUNCH
template <int PH>
__global__ void __launch_bounds__(NTHR, 2) k_phase(Params p) {
    extern __shared__ __attribute__((aligned(16))) char smem[];
    run_phase<PH>(p, smem);
}
template <int PH>
static void launch_from(const Params& p, int grid, hipStream_t stream, bool setattr) {
    if constexpr (PH < N_PHASES) {
        if (setattr) (void)hipFuncSetAttribute((const void*)k_phase<PH>, hipFuncAttributeMaxDynamicSharedMemorySize, LDS_REQ);
        else hipLaunchKernelGGL(k_phase<PH>, dim3(grid), dim3(NTHR), LDS_REQ, stream, p);
        launch_from<PH + 1>(p, grid, stream, setattr);
    }
}
#else
constexpr int LDS_PARAMS = LDS_BYTES + 64;
DI unsigned long long lds_u64_uniform(const char* lp, int i) {
    const u32x2 v = *(const u32x2*)(lp + 8 * i);
    const unsigned lo = __builtin_amdgcn_readfirstlane(v.x), hi = __builtin_amdgcn_readfirstlane(v.y);
    return ((unsigned long long)hi << 32) | lo;
}
DI Params load_params(const char* lp) {
    Params p;
#pragma unroll
    for (int i = 0; i < N_INPUTS; ++i) p.in[i] = (const float*)lds_u64_uniform(lp, i);
    p.out = (float*)lds_u64_uniform(lp, N_INPUTS); p.ws = (unsigned char*)lds_u64_uniform(lp, N_INPUTS + 1);
    return p;
}
#ifndef PH_LO
#define PH_LO 0
#define PH_HI N_PHASES
#endif
constexpr int dup_start(int ph) {
    if (PROBE == 1) { if (ph == 9) return 6; if (ph == 20) return 17; if (ph == 32) return 29; if (ph == 42) return 39; }
    if (PROBE == 2) { if (ph == 4) return 1; if (ph == 27) return 22; if (ph == 37) return 34; }
    if (PROBE == 3) { if (ph == 15) return 11; }
    if (PROBE == 4) { if (ph == 4) return 4; if (ph == 27) return 27; if (ph == 37) return 37; }
    if (PROBE == 5) { if (ph == 14) return 14; }
    if (PROBE == 7) { if (ph == 0) return 0; }
    if (PROBE == 8) { if (ph == 1 || ph == 11 || ph == 22 || ph == 34 || ph == 6 || ph == 17 || ph == 29 || ph == 39) return ph; }
    if (PROBE == 9) { if (ph == 9) return 8; if (ph == 20) return 19; if (ph == 32) return 31; if (ph == 42) return 41; }
    if (PROBE == 10) { if (ph == 2 || ph == 12 || ph == 13 || ph == 23 || ph == 25 || ph == 35) return ph; }
    return -1;
}
template <int A, int B>
DI void run_range(char* smem, const XcdBarrier& bar) {
    if constexpr (A <= B) { { const Params p = load_params(smem + LDS_PARAMS); run_phase<A>(p, smem); } xcd_barrier(bar); run_range<A + 1, B>(smem, bar); }
}
template <int PH>
DI void run_all(char* smem, const XcdBarrier& bar) {
    if constexpr (PH < N_PHASES) {
        constexpr bool empty = (PH == 22 || PH == 34 || PH == 3 || PH == 36);
        if constexpr (!empty && PH >= PH_LO && PH < PH_HI) { const Params p = load_params(smem + LDS_PARAMS); run_phase<PH>(p, smem); }
        if constexpr (!empty && PH + 1 < N_PHASES) xcd_barrier(bar);
        if constexpr (dup_start(PH) >= 0) run_range<dup_start(PH), PH>(smem, bar);
        run_all<PH + 1>(smem, bar);
    }
}
__global__ void __launch_bounds__(NTHR, 2) k_mega(Params p) {
    extern __shared__ __attribute__((aligned(16))) char smem[];
    if (TIDX() == 0) {
        *(u32x4*)(smem + LDS_BYTES) = (u32x4){0u, 0u, 0u, 0u};
        unsigned long long* lp = (unsigned long long*)(smem + LDS_PARAMS);
#pragma unroll
        for (int i = 0; i < N_INPUTS; ++i) lp[i] = (unsigned long long)p.in[i];
        lp[N_INPUTS] = (unsigned long long)p.out; lp[N_INPUTS + 1] = (unsigned long long)p.ws;
    }
    __syncthreads();
    const XcdBarrier bar = xcd_barrier_post((unsigned*)(p.ws + OFF_CTL), (volatile LAS unsigned*)(LAS char*)(smem + LDS_BYTES));
    run_all<0>(smem, bar);
}
#endif

extern "C" void kernel_launch(void* const* d_in, const int* in_sizes, int n_in, void* d_out, int out_size, void* d_ws, size_t ws_size, hipStream_t stream) {
    static int grid = 0;
    Params p{};
    for (int i = 0; i < N_INPUTS; ++i) p.in[i] = (const float*)d_in[i];
    p.out = (float*)d_out; p.ws = (unsigned char*)d_ws;
    if (grid == 0) {
        if (n_in != N_INPUTS || out_size != TL * 1024 || ws_size < WS_NEED) { grid = -1; return; }
        int dev = 0, cus = 0;
        if (hipGetDevice(&dev) != hipSuccess || hipDeviceGetAttribute(&cus, hipDeviceAttributeMultiprocessorCount, dev) != hipSuccess) { grid = -1; return; }
#if MULTI_LAUNCH
        launch_from<0>(p, 0, stream, true);
#else
        if (hipFuncSetAttribute((const void*)k_mega, hipFuncAttributeMaxDynamicSharedMemorySize, LDS_REQ) != hipSuccess) { grid = -1; return; }
#endif
        grid = cus > 0 ? cus : 256;
    }
    if (grid < 0) return;
    (void)hipMemsetAsync((char*)d_ws + OFF_CTL, 0, 65536, stream);
#if MULTI_LAUNCH
    launch_from<0>(p, grid, stream, false);
#else
    hipLaunchKernelGGL(k_mega, dim3(grid), dim3(NTHR), LDS_REQ, stream, p);
#endif
}
```
